# Optimizing an MI355X kernel written in HIP

```python
import math
import jax, jax.numpy as jnp
from jax import lax
import numpy as np

D_MODEL = 1024
BATCH = 2
SEQ = 8192
DEPTH = 2

N_EVEN = (DEPTH + 1) // 2
N_ODD = DEPTH // 2

ALPHA = (2 * DEPTH) ** 0.25
BETA = (8 * DEPTH) ** -0.25
LN_EPS = 1e-5

MLSTM_HEADS = 4
RET_HEADS = 4
HEAD_DIM = D_MODEL // 8
MLSTM_W = MLSTM_HEADS * HEAD_DIM
RET_W = RET_HEADS * HEAD_DIM
CHUNK = 128
CONV_WIDTH = 4
IN0_SPLITS = (MLSTM_W, 2 * MLSTM_W, 3 * MLSTM_W, 4 * MLSTM_W,
              4 * MLSTM_W + MLSTM_HEADS, 4 * MLSTM_W + 2 * MLSTM_HEADS,
              4 * MLSTM_W + 2 * MLSTM_HEADS + RET_W,
              4 * MLSTM_W + 2 * MLSTM_HEADS + 2 * RET_W,
              4 * MLSTM_W + 2 * MLSTM_HEADS + 3 * RET_W)
IN0_COLS = 4 * MLSTM_W + 2 * MLSTM_HEADS + 4 * RET_W

DIL_HEADS = 8
DIL_DH = D_MODEL // 16
DIL_W = DIL_HEADS * DIL_DH
DIL_CONFIGS = ((128, 1), (512, 4), (2048, 16))
IN1_COLS = len(DIL_CONFIGS) * 3 * DIL_W

N_EXPERTS = 32
N_GROUPS = 4
EXPERTS_PER_GROUP = N_EXPERTS // N_GROUPS
TOP_K = 2
D_EXPERT = D_MODEL // 4
MOE_BLOCK = 128

kernel_name = "hybrid_mlstm_retention_dilated_moe_deepnorm"


def layer_norm(x, g, b):
    xf = x.astype(jnp.float32)
    mu = jnp.mean(xf, -1, keepdims=True)
    var = jnp.mean(jnp.square(xf - mu), -1, keepdims=True)
    return ((xf - mu) * lax.rsqrt(var + LN_EPS)).astype(x.dtype) * g + b


def head_norm(h, g):
    B, T, H, dh = h.shape
    mu = jnp.mean(h, -1, keepdims=True)
    var = jnp.mean(jnp.square(h - mu), -1, keepdims=True)
    y = (h - mu) * lax.rsqrt(var + LN_EPS)
    return y.reshape(B, T, H * dh) * g.astype(jnp.float32)


def causal_depthwise_conv(x, w, b):
    K, C = w.shape
    y = lax.conv_general_dilated(x, w[:, None, :], window_strides=(1,),
                                 padding=[(K - 1, 0)],
                                 dimension_numbers=('NWC', 'WIO', 'NWC'),
                                 feature_group_count=C)
    return y + b


def to_chunks(a):
    n = a.shape[2] // CHUNK
    a = a.reshape(a.shape[:2] + (n, CHUNK) + a.shape[3:])
    return jnp.moveaxis(a, 2, 0)


def from_chunks(a):
    a = jnp.moveaxis(a, 0, 2)
    return a.reshape(a.shape[:2] + (a.shape[2] * a.shape[3],) + a.shape[4:])


def mlstm_chunkwise(q, k, v, i_pre, log_f):
    B, H, T, dh = q.shape
    causal = jnp.tril(jnp.ones((CHUNK, CHUNK), bool))

    def step(carry, inp):
        C, n, m = carry
        qb, kb, vb, ib, fb = inp
        b = jnp.cumsum(fb, axis=-1)
        g = b[..., -1]
        log_d = jnp.where(causal, b[..., :, None] - b[..., None, :] + ib[..., None, :], -jnp.inf)
        a = b + m[..., None]
        m_t = jnp.maximum(a, jnp.max(log_d, -1))
        d = jnp.exp(log_d - m_t[..., None])
        inter = jnp.exp(a - m_t)
        s = jnp.einsum('bhld,bhsd->bhls', qb, kb) * d
        num = jnp.einsum('bhls,bhse->bhle', s, vb) + inter[..., None] * jnp.einsum('bhld,bhde->bhle', qb, C)
        den = jnp.sum(s, -1) + inter * jnp.einsum('bhld,bhd->bhl', qb, n)
        h = num / jnp.maximum(jnp.abs(den), jnp.exp(-m_t))[..., None]
        log_w = g[..., None] - b + ib
        m_new = jnp.maximum(g + m, jnp.max(log_w, -1))
        w = jnp.exp(log_w - m_new[..., None])
        decay = jnp.exp(g + m - m_new)
        C_new = decay[..., None, None] * C + jnp.einsum('bhs,bhsd,bhse->bhde', w, kb, vb)
        n_new = decay[..., None] * n + jnp.einsum('bhs,bhsd->bhd', w, kb)
        return (C_new, n_new, m_new), h

    init = (jnp.zeros((B, H, dh, dh), jnp.float32), jnp.zeros((B, H, dh), jnp.float32),
            jnp.zeros((B, H), jnp.float32))
    _, hs = lax.scan(step, init, (to_chunks(q), to_chunks(k), to_chunks(v),
                                   to_chunks(i_pre), to_chunks(log_f)))
    return from_chunks(hs)


def retention_chunkwise(q, k, v, log_gamma):
    B, H, T, dh = q.shape
    idx = jnp.arange(CHUNK)
    rel = idx[:, None] - idx[None, :]
    decay_in = jnp.where(rel >= 0, jnp.exp(log_gamma[:, None, None] * jnp.maximum(rel, 0)), 0.0)
    xi = jnp.exp(log_gamma[:, None] * (idx + 1))
    zeta = jnp.exp(log_gamma[:, None] * (CHUNK - 1 - idx))
    g_chunk = jnp.exp(log_gamma * CHUNK)

    def step(R, inp):
        qb, kb, vb = inp
        inner = jnp.einsum('bhld,bhsd->bhls', qb, kb) * decay_in
        y = jnp.einsum('bhls,bhse->bhle', inner, vb) + \
            xi[None, :, :, None] * jnp.einsum('bhld,bhde->bhle', qb, R)
        R_new = g_chunk[None, :, None, None] * R + jnp.einsum('bhsd,hs,bhse->bhde', kb, zeta, vb)
        return R_new, y

    _, ys = lax.scan(step, jnp.zeros((B, H, dh, dh), jnp.float32),
                     (to_chunks(q), to_chunks(k), to_chunks(v)))
    return from_chunks(ys)


def alibi_slopes(n_heads):
    return jnp.exp2(-8.0 * jnp.arange(1, n_heads + 1, dtype=jnp.float32) / n_heads)


def dilated_band_attention(q, k, v, window, dilation, slopes):
    B, T, H, dh = q.shape
    L = window // dilation
    span = L * dilation
    T_pad = -(-T // span) * span
    NB = T_pad // span

    def blocks(a):
        a = jnp.pad(a.astype(jnp.float32), ((0, 0), (0, T_pad - T), (0, 0), (0, 0)))
        return a.reshape(B, NB, L, dilation, H, dh).transpose(0, 3, 4, 1, 2, 5)

    def with_prev(a):
        prev = jnp.pad(a, ((0, 0), (0, 0), (0, 0), (1, 0), (0, 0), (0, 0)))[:, :, :, :-1]
        return jnp.concatenate([prev, a], axis=4)

    qb = blocks(q)
    kk, vv = with_prev(blocks(k)), with_prev(blocks(v))
    qi = jnp.arange(L)[:, None]
    kr = jnp.arange(2 * L)[None, :]
    steps = qi + L - kr
    band = (steps >= 0) & (steps <= L)
    first = (jnp.arange(NB) == 0)[:, None, None]
    valid = band[None] & ~(first & (kr < L)[None])
    bias = -slopes[:, None, None] * (steps * dilation).astype(jnp.float32)
    s = jnp.einsum('brhnqd,brhnkd->brhnqk', qb, kk) * (dh ** -0.5) + bias[:, None]
    s = jnp.where(valid, s, -jnp.inf)
    m = jnp.max(s, -1, keepdims=True)
    p = jnp.exp(s - m)
    den = jnp.sum(p, -1)
    o = jnp.einsum('brhnqk,brhnkd->brhnqd', p, vv) / den[..., None]
    lse = m[..., 0] + jnp.log(den)
    o = o.transpose(0, 3, 4, 1, 2, 5).reshape(B, T_pad, H, dh)[:, :T]
    lse = lse.transpose(0, 3, 4, 1, 2).reshape(B, T_pad, H)[:, :T]
    return o, lse


def even_mixer(x, w_in, i_bias, f_bias, conv_w, conv_b, mlstm_norm_g, ret_norm_g, w_out):
    B, T, _ = x.shape
    f32 = jnp.float32
    p = x @ w_in
    q_m, k_m, v_m, o_m, i_m, f_m, q_r, k_r, v_r, g_r = jnp.split(p, IN0_SPLITS, axis=-1)
    qk_m = jax.nn.silu(causal_depthwise_conv(jnp.concatenate([q_m, k_m], -1), conv_w, conv_b))
    q_m, k_m = jnp.split(qk_m, 2, axis=-1)

    def heads(a, n):
        return a.astype(f32).reshape(B, T, n, HEAD_DIM).transpose(0, 2, 1, 3)

    scale = HEAD_DIM ** -0.5
    i_pre = (i_m + i_bias).astype(f32).transpose(0, 2, 1)
    log_f = jax.nn.log_sigmoid((f_m + f_bias).astype(f32)).transpose(0, 2, 1)
    h_m = mlstm_chunkwise(heads(q_m, MLSTM_HEADS), heads(k_m, MLSTM_HEADS) * scale,
                          heads(v_m, MLSTM_HEADS), i_pre, log_f).transpose(0, 2, 1, 3)
    h_m = jax.nn.sigmoid(o_m.astype(f32)).reshape(B, T, MLSTM_HEADS, HEAD_DIM) * h_m
    y_m = head_norm(h_m, mlstm_norm_g)
    log_gamma = jnp.log1p(-jnp.exp2(-5.0 - jnp.arange(RET_HEADS, dtype=f32)))
    h_r = retention_chunkwise(heads(q_r, RET_HEADS), heads(k_r, RET_HEADS) * scale,
                              heads(v_r, RET_HEADS), log_gamma).transpose(0, 2, 1, 3)
    y_r = head_norm(h_r, ret_norm_g) * jax.nn.silu(g_r.astype(f32))
    y = jnp.concatenate([y_m, y_r], -1).astype(x.dtype)
    return y @ w_out


def odd_mixer(x, w_in, w_out):
    B, T, _ = x.shape
    p = (x @ w_in).reshape(B, T, len(DIL_CONFIGS), 3, DIL_HEADS, DIL_DH)
    slopes = alibi_slopes(DIL_HEADS)
    outs, lses = [], []
    for g, (window, dilation) in enumerate(DIL_CONFIGS):
        o, l = dilated_band_attention(p[:, :, g, 0], p[:, :, g, 1], p[:, :, g, 2],
                                      window, dilation, slopes)
        outs.append(o)
        lses.append(l)
    wts = jax.nn.softmax(jnp.stack(lses, 0), axis=0)
    y = jnp.einsum('gbth,gbthd->bthd', wts, jnp.stack(outs, 0))
    return y.reshape(B, T, DIL_W).astype(x.dtype) @ w_out


def route(h, router_w, router_bias):
    N = h.shape[0]
    aff = jax.nn.sigmoid((h @ router_w).astype(jnp.float32))
    sel = (aff + router_bias.astype(jnp.float32)).reshape(N, N_GROUPS, EXPERTS_PER_GROUP)
    grp_score = jnp.sum(lax.top_k(sel, 2)[0], -1)
    g_best = jnp.argmax(grp_score, -1)
    in_grp = jnp.take_along_axis(sel, g_best[:, None, None], axis=1)[:, 0]
    _, local = lax.top_k(in_grp, TOP_K)
    expert_idx = g_best[:, None] * EXPERTS_PER_GROUP + local
    gate = jnp.take_along_axis(aff, expert_idx, axis=1)
    return expert_idx, gate / jnp.sum(gate, -1, keepdims=True)


def moe_ffn(h, router_w, router_bias, w_gate, w_up, w_down):
    B, T, D = h.shape
    N = B * T
    hf = h.reshape(N, D)
    expert_idx, gate = route(hf, router_w, router_bias)
    M = N * TOP_K
    e_flat = expert_idx.reshape(M)
    tok_flat = jnp.repeat(jnp.arange(N, dtype=jnp.int32), TOP_K)
    g_flat = gate.reshape(M)
    order = jnp.argsort(e_flat)
    e_s, tok_s, g_s = e_flat[order], tok_flat[order], g_flat[order]
    counts = jnp.bincount(e_flat, length=N_EXPERTS)
    padded = (counts + MOE_BLOCK - 1) // MOE_BLOCK * MOE_BLOCK
    start = jnp.cumsum(counts) - counts
    pend = jnp.cumsum(padded)
    pstart = pend - padded
    dest = pstart[e_s] + (jnp.arange(M) - start[e_s])
    P = M + N_EXPERTS * MOE_BLOCK
    slot_tok = jnp.zeros((P,), jnp.int32).at[dest].set(tok_s)
    slot_gate = jnp.zeros((P,), jnp.float32).at[dest].set(g_s)
    n_blocks = P // MOE_BLOCK
    block_e = jnp.minimum(jnp.searchsorted(pend, jnp.arange(n_blocks) * MOE_BLOCK, side='right'),
                          N_EXPERTS - 1)
    xs = hf[slot_tok].reshape(n_blocks, MOE_BLOCK, D)

    def expert_block(args):
        xb, e = args
        return (jax.nn.silu(xb @ w_gate[e]) * (xb @ w_up[e])) @ w_down[e]

    ys = lax.map(expert_block, (xs, block_e)).reshape(P, D)
    out = jnp.zeros((N, D), ys.dtype).at[slot_tok].add(ys * slot_gate[:, None].astype(ys.dtype))
    return out.reshape(B, T, D)


def setup_inputs(seed: int = 0) -> dict:
    key = jax.random.key(seed)
    ks = jax.random.split(key, 18)
    f32 = jnp.float32

    def nrm(k, shape, scale):
        return jax.random.normal(k, shape, f32) * scale

    return {
        "x": nrm(ks[0], (BATCH, SEQ, D_MODEL), 1.0),
        "w_in_even": nrm(ks[1], (N_EVEN, D_MODEL, IN0_COLS), D_MODEL ** -0.5),
        "i_bias": nrm(ks[2], (N_EVEN, MLSTM_HEADS), 0.1),
        "f_bias": jnp.linspace(3.0, 6.0, MLSTM_HEADS)[None] + nrm(ks[3], (N_EVEN, MLSTM_HEADS), 0.1),
        "conv_w": nrm(ks[4], (N_EVEN, CONV_WIDTH, 2 * MLSTM_W), CONV_WIDTH ** -0.5),
        "conv_b": nrm(ks[5], (N_EVEN, 2 * MLSTM_W), 0.02),
        "mlstm_norm_g": 1.0 + nrm(ks[6], (N_EVEN, MLSTM_W), 0.02),
        "ret_norm_g": 1.0 + nrm(ks[7], (N_EVEN, RET_W), 0.02),
        "w_out_even": nrm(ks[8], (N_EVEN, MLSTM_W + RET_W, D_MODEL), (MLSTM_W + RET_W) ** -0.5 * BETA),
        "w_in_odd": nrm(ks[9], (N_ODD, D_MODEL, IN1_COLS), D_MODEL ** -0.5),
        "w_out_odd": nrm(ks[10], (N_ODD, DIL_W, D_MODEL), DIL_W ** -0.5 * BETA),
        "router_w": nrm(ks[11], (D_MODEL, N_EXPERTS), D_MODEL ** -0.5),
        "router_bias": nrm(ks[12], (N_EXPERTS,), 0.01),
        "w_gate": nrm(ks[13], (DEPTH, N_EXPERTS, D_MODEL, D_EXPERT), D_MODEL ** -0.5),
        "w_up": nrm(ks[14], (DEPTH, N_EXPERTS, D_MODEL, D_EXPERT), D_MODEL ** -0.5),
        "w_down": nrm(ks[15], (DEPTH, N_EXPERTS, D_EXPERT, D_MODEL), D_EXPERT ** -0.5 * BETA),
        "ln_g": 1.0 + nrm(ks[16], (DEPTH, 2, D_MODEL), 0.02),
        "ln_b": nrm(ks[17], (DEPTH, 2, D_MODEL), 0.02),
    }


def reference(x, w_in_even, i_bias, f_bias, conv_w, conv_b, mlstm_norm_g, ret_norm_g,
              w_out_even, w_in_odd, w_out_odd, router_w, router_bias, w_gate, w_up,
              w_down, ln_g, ln_b):
    h = x
    for layer in range(DEPTH):
        j = layer // 2
        if layer % 2 == 0:
            mix = even_mixer(h, w_in_even[j], i_bias[j], f_bias[j], conv_w[j], conv_b[j],
                             mlstm_norm_g[j], ret_norm_g[j], w_out_even[j])
        else:
            mix = odd_mixer(h, w_in_odd[j], w_out_odd[j])
        h = layer_norm(ALPHA * h + mix, ln_g[layer, 0], ln_b[layer, 0])
        ffn = moe_ffn(h, router_w, router_bias, w_gate[layer], w_up[layer], w_down[layer])
        h = layer_norm(ALPHA * h + ffn, ln_g[layer, 1], ln_b[layer, 1])
    return h
```

```cpp
#include <hip/hip_runtime.h>
#include <cstdio>
#include <cstdint>

#ifndef MK_N_LAUNCHES
#define MK_N_LAUNCHES 0
#endif

#define LAS __attribute__((address_space(3)))
typedef unsigned short bf16;
typedef float f32x4 __attribute__((ext_vector_type(4)));
typedef unsigned u32x4 __attribute__((ext_vector_type(4)));
typedef unsigned u32x2 __attribute__((ext_vector_type(2)));
#define RLX_AGENT __ATOMIC_RELAXED, __HIP_MEMORY_SCOPE_AGENT
#define LDS_WAIT() asm volatile("s_waitcnt lgkmcnt(0)" ::: "memory")
#define VM_WAIT() asm volatile("s_waitcnt vmcnt(0)" ::: "memory")

constexpr int NWAVES = 8, NT = NWAVES * 64;
constexpr int BATCH = 2, T = 8192, D = 1024, M = BATCH * T;
constexpr int IN0 = 4104, IN1 = 4608, NP0 = 4096;
constexpr int NE = 32, DE = 256;
constexpr float ALPHA = 1.41421356237309515f;
constexpr float LN_EPS = 1e-5f;
constexpr float KSCALE = 0.08838834764831845f;
constexpr int N_PHASES = 17;

constexpr size_t MiB = 1u << 20;
constexpr size_t WS_CTL = 0, CTL_ZERO_BYTES = 1 * MiB;
constexpr size_t WS_G = 1 * MiB;
constexpr size_t WS_EIDX = WS_G + 512 * 1024;
constexpr size_t WS_GATEV = WS_EIDX + 128 * 1024;
constexpr size_t WS_WT0 = 2 * MiB;
constexpr size_t WS_WO0 = 10 * MiB;
constexpr size_t WS_WT1 = 12 * MiB;
constexpr size_t WS_WO1 = 21 * MiB;
constexpr size_t WS_SE = 22 * MiB;
constexpr size_t WS_EW = WS_SE;
constexpr size_t EW_STRIDE = 3 * MiB / 2, EW_DN = 1 * MiB;
constexpr size_t WS_LIST = WS_SE + 48 * MiB;
constexpr size_t WS_LSE = WS_SE + 50 * MiB;
constexpr size_t WS_XB = 86 * MiB;
constexpr size_t WS_Y = 118 * MiB;
constexpr size_t WS_OG = WS_XB;
constexpr size_t WS_Y2 = WS_XB + 48 * MiB;
constexpr size_t WS_P = 150 * MiB;
constexpr size_t WS_YB = WS_P;
constexpr size_t WS_HID = WS_P + 64 * MiB;
constexpr size_t WS_END = 294 * MiB;
constexpr size_t WS_QKC = WS_SE;

constexpr int CW_BAR = 4096;
constexpr int CW_CNT = 16384;

constexpr int LDS_BYTES = 147456;

__device__ __forceinline__ unsigned f2bf(float f) { unsigned u = __builtin_bit_cast(unsigned, f); return (u + 0x7fffu + ((u >> 16) & 1u)) >> 16; }
__device__ __forceinline__ unsigned pk2(float lo, float hi) { return f2bf(lo) | (f2bf(hi) << 16); }
__device__ __forceinline__ float bf2f(unsigned b) { return __builtin_bit_cast(float, b << 16); }
__device__ __forceinline__ float bflo(unsigned w) { return __builtin_bit_cast(float, w << 16); }
__device__ __forceinline__ float bfhi(unsigned w) { return __builtin_bit_cast(float, w & 0xffff0000u); }
__device__ __forceinline__ float wave_sum(float v) {
#pragma unroll
    for (int o = 1; o < 64; o <<= 1) v += __shfl_xor(v, o);
    return v;
}
__device__ __forceinline__ float sigmoidf_(float x) { return 1.f / (1.f + __expf(-x)); }
__device__ __forceinline__ float siluf_(float x) { return x / (1.f + __expf(-x)); }

#define XB_TMO      128
#define XB_XCNT(j)  (256  + 64 * (j))
#define XB_XSUB(j)  (1280 + 64 * (j))
#define XB_XGEN(j)  (2304 + 64 * (j))
#define XB_TOP      3328
#define XB_TOPGEN   3392
#define XCD_BAR_WORDS 3456
#define XB_SPIN_CAP (1u << 22)
__device__ __forceinline__ unsigned xb_ld(unsigned* p)              { return __hip_atomic_load(p, __ATOMIC_RELAXED, __HIP_MEMORY_SCOPE_AGENT); }
__device__ __forceinline__ unsigned xb_add(unsigned* p, unsigned v) { return __hip_atomic_fetch_add(p, v, __ATOMIC_RELAXED, __HIP_MEMORY_SCOPE_AGENT); }
__device__ __forceinline__ unsigned xb_xcc_id() { return (unsigned)__builtin_amdgcn_s_getreg((3 << 11) | 20) & 0xFu; }
#define XB_SPIN(cond, bar) do { unsigned _sp = 0; while (cond) { __builtin_amdgcn_s_sleep(1); \
    if ((++_sp & 255u) == 0u) { if (xb_ld(&(bar)[XB_TMO])) break; if (_sp > XB_SPIN_CAP) { atomicAdd(&(bar)[XB_TMO], 1u); break; } } } } while (0)
struct XcdBarrier { unsigned* bar; unsigned x; volatile LAS unsigned* st; };
__device__ __forceinline__ XcdBarrier xcd_barrier_post(unsigned* bar, volatile LAS unsigned* st) {
    XcdBarrier b; b.bar = bar; b.x = xb_xcc_id(); b.st = st;
    if (threadIdx.x == 0) (void)xb_add(&bar[XB_XCNT(b.x)], 1u);
    return b;
}
__device__ __forceinline__ void xcd_barrier_complete(unsigned* bar, unsigned x, unsigned& nloc, unsigned& nx) {
    const unsigned G = gridDim.x * gridDim.y * gridDim.z;
    unsigned sum, cnt, mine, sp = 0u;
    for (;;) {
        sum = 0u; cnt = 0u; mine = 0u;
#pragma unroll
        for (unsigned j = 0; j < 16; ++j) { const unsigned c = xb_ld(&bar[XB_XCNT(j)]); sum += c; cnt += (c > 0u) ? 1u : 0u; mine = (j == x) ? c : mine; }
        if (sum == G) break;
        __builtin_amdgcn_s_sleep(1);
        if ((++sp & 255u) == 0u) { if (xb_ld(&bar[XB_TMO])) break; if (sp > XB_SPIN_CAP) { atomicAdd(&bar[XB_TMO], 1u); break; } }
    }
    nloc = mine > 0u ? mine : 1u; nx = cnt > 0u ? cnt : 1u;
}
__device__ __forceinline__ void xcd_barrier(const XcdBarrier& b) {
    asm volatile("s_waitcnt vmcnt(0)" ::: "memory");
    __syncthreads();
    if (threadIdx.x == 0) {
        unsigned* bar = b.bar;
        __builtin_amdgcn_s_waitcnt(0);
        unsigned nloc = b.st[0], nx = b.st[1];
        if (nloc == 0u) { xcd_barrier_complete(bar, b.x, nloc, nx); b.st[0] = nloc; b.st[1] = nx; }
        const unsigned old = xb_add(&bar[XB_XSUB(b.x)], 1u);
        const unsigned gen = old / nloc;
        if (old + 1u == (gen + 1u) * nloc) {
            __builtin_amdgcn_fence(__ATOMIC_RELEASE, "agent");
            asm volatile("s_waitcnt vmcnt(0)" ::: "memory");
            const unsigned og = xb_add(&bar[XB_TOP], 1u);
            const unsigned tg = og / nx;
            if (og + 1u == (tg + 1u) * nx) xb_add(&bar[XB_TOPGEN], 1u);
            else XB_SPIN(xb_ld(&bar[XB_TOPGEN]) == tg, bar);
            __builtin_amdgcn_fence(__ATOMIC_ACQUIRE, "agent");
            xb_add(&bar[XB_XGEN(b.x)], 1u);
            asm volatile("s_waitcnt vmcnt(0)" ::: "memory");
        } else {
            XB_SPIN(xb_ld(&bar[XB_XGEN(b.x)]) == gen, bar);
            __builtin_amdgcn_fence(__ATOMIC_ACQUIRE, "agent");
            asm volatile("s_waitcnt vmcnt(0)" ::: "memory");
        }
    }
    __syncthreads();
}

struct Frame {
    LAS unsigned char* lds;
    unsigned* ctl;
    int tid, lane, wave, vcu, G;
    const float* in[18];
    float* out;
    unsigned char* ws;
};

template <class RowFn>
__device__ __forceinline__ void ngemm_tile(LAS float* sA, LAS float* sB, RowFn rowA, const bf16* Bt, int ldb, int K, float (&acc)[4][4]) {
    const int tid = threadIdx.x, tx = tid & 15, ty = tid >> 4;
#pragma unroll
    for (int i = 0; i < 4; ++i)
#pragma unroll
        for (int j = 0; j < 4; ++j) acc[i][j] = 0.f;
    const int ar = tid >> 2, ak = (tid & 3) * 8, br = tid >> 3, bk = (tid & 7) * 4;
    const bf16* ap = rowA(ar);
    const bf16* bp = Bt + (size_t)br * ldb;
    for (int k0 = 0; k0 < K; k0 += 32) {
        u32x4 av = (u32x4){0u, 0u, 0u, 0u};
        if (ap) av = *(const u32x4*)(ap + k0 + ak);
        const u32x2 bv = *(const u32x2*)(bp + k0 + bk);
        __syncthreads();
        LAS float* wa = sA + ar * 33 + ak;
        wa[0] = bflo(av.x); wa[1] = bfhi(av.x); wa[2] = bflo(av.y); wa[3] = bfhi(av.y); wa[4] = bflo(av.z); wa[5] = bfhi(av.z); wa[6] = bflo(av.w); wa[7] = bfhi(av.w);
        LAS float* wb = sB + br * 33 + bk;
        wb[0] = bflo(bv.x); wb[1] = bfhi(bv.x); wb[2] = bflo(bv.y); wb[3] = bfhi(bv.y);
        __syncthreads();
#pragma unroll 8
        for (int kk = 0; kk < 32; ++kk) {
            float a[4], b[4];
#pragma unroll
            for (int i = 0; i < 4; ++i) a[i] = sA[(ty * 4 + i) * 33 + kk];
#pragma unroll
            for (int j = 0; j < 4; ++j) b[j] = sB[(tx * 4 + j) * 33 + kk];
#pragma unroll
            for (int i = 0; i < 4; ++i)
#pragma unroll
                for (int j = 0; j < 4; ++j) acc[i][j] = fmaf(a[i], b[j], acc[i][j]);
        }
    }
}

__device__ __forceinline__ void tr_item(const float* W, int ldw, bf16* WT, int ldt, LAS float* scr, int kb, int nb, int lane) {
    const int k0 = 64 * kb, n0 = 32 * nb;
#pragma unroll 8
    for (int i = 0; i < 32; ++i) { const int kk = 2 * i + (lane >> 5); scr[kk * 33 + (lane & 31)] = W[(size_t)(k0 + kk) * ldw + n0 + (lane & 31)]; }
    LDS_WAIT(); asm volatile("" ::: "memory");
    const int c = lane & 7;
#pragma unroll
    for (int j = 0; j < 4; ++j) { const int n = (lane >> 3) + 8 * j; const LAS float* s = scr + (8 * c) * 33 + n;
        u32x4 o; o.x = pk2(s[0 * 33], s[1 * 33]); o.y = pk2(s[2 * 33], s[3 * 33]); o.z = pk2(s[4 * 33], s[5 * 33]); o.w = pk2(s[6 * 33], s[7 * 33]);
        *(u32x4*)(WT + (size_t)(n0 + n) * ldt + k0 + 8 * c) = o; }
    LDS_WAIT(); asm volatile("" ::: "memory");
}

__device__ __forceinline__ void ph0_convert(Frame& F) {
    LAS float* scr = (LAS float*)(F.lds + F.wave * 9216);
    LAS float* gw = (LAS float*)(F.lds + 8 * 9216);
    const float* w0 = F.in[1];
    for (int i = F.tid; i < 8 * 1024; i += NT) { const int j = i >> 10, k = i & 1023; gw[i] = w0[(size_t)k * IN0 + 2048 + j]; }
    __syncthreads();
    const int gwv = F.vcu * NWAVES + F.wave, NGW = F.G * NWAVES;
    bf16* WT0 = (bf16*)(F.ws + WS_WT0); bf16* WO0 = (bf16*)(F.ws + WS_WO0); bf16* WT1 = (bf16*)(F.ws + WS_WT1); bf16* WO1 = (bf16*)(F.ws + WS_WO1);
    constexpr int I0 = 16 * 64, I1 = 16 * 64, I2 = 16 * 32, I3 = 16 * 144, I4 = 8 * 32, NI = I0 + I1 + I2 + I3 + I4;
    for (int it = gwv; it < NI; it += NGW) {
        int r = it;
        if (r < I0) { tr_item(w0, IN0, WT0, 1024, scr, r / 64, r % 64, F.lane); continue; } r -= I0;
        if (r < I1) { tr_item(w0 + 2056, IN0, WT0 + (size_t)2048 * 1024, 1024, scr, r / 64, r % 64, F.lane); continue; } r -= I1;
        if (r < I2) { tr_item(F.in[8], 1024, WO0, 1024, scr, r / 32, r % 32, F.lane); continue; } r -= I2;
        if (r < I3) { tr_item(F.in[9], IN1, WT1, 1024, scr, r / 144, r % 144, F.lane); continue; } r -= I3;
        tr_item(F.in[10], 1024, WO1, 512, scr, r / 32, r % 32, F.lane);
    }
    const float* x = F.in[0]; bf16* XB = (bf16*)(F.ws + WS_XB); float* G = (float*)(F.ws + WS_G);
    const float* ib = F.in[2]; const float* fb = F.in[3];
    for (int m = gwv; m < M; m += NGW) {
        const f32x4* xr = (const f32x4*)(x + (size_t)m * D) + F.lane;
        f32x4 v[4];
#pragma unroll
        for (int j = 0; j < 4; ++j) v[j] = xr[64 * j];
        unsigned long long* o8 = (unsigned long long*)(XB + (size_t)m * D) + F.lane;
#pragma unroll
        for (int j = 0; j < 4; ++j) o8[64 * j] = (unsigned long long)pk2(v[j].x, v[j].y) | ((unsigned long long)pk2(v[j].z, v[j].w) << 32);
        float acc[8];
#pragma unroll
        for (int g = 0; g < 8; ++g) { float a = 0.f;
#pragma unroll
            for (int j = 0; j < 4; ++j) { const f32x4 w = *(const LAS f32x4*)(gw + g * 1024 + 4 * F.lane + 256 * j); a += v[j].x * w.x + v[j].y * w.y + v[j].z * w.z + v[j].w * w.w; }
            acc[g] = wave_sum(a); }
        if (F.lane == 0) {
#pragma unroll
            for (int g = 0; g < 4; ++g) G[(size_t)m * 8 + g] = acc[g] + ib[g];
#pragma unroll
            for (int g = 0; g < 4; ++g) { const float z = acc[4 + g] + fb[g]; G[(size_t)m * 8 + 4 + g] = fminf(z, 0.f) - log1pf(__expf(-fabsf(z))); }
        }
    }
}

__device__ __forceinline__ void convert_experts(Frame& F, int layer) {
    LAS float* scr = (LAS float*)(F.lds + F.wave * 9216);
    const int gwv = F.vcu * NWAVES + F.wave, NGW = F.G * NWAVES;
    const float* wg = F.in[13] + (size_t)layer * NE * D * DE; const float* wu = F.in[14] + (size_t)layer * NE * D * DE; const float* wd = F.in[15] + (size_t)layer * NE * DE * D;
    for (int it = gwv; it < NE * 384; it += NGW) {
        const int e = it / 384; int r = it % 384;
        bf16* GU = (bf16*)(F.ws + WS_EW + (size_t)e * EW_STRIDE); bf16* DN = (bf16*)(F.ws + WS_EW + (size_t)e * EW_STRIDE + EW_DN);
        if (r < 256) { const int job = r >> 6, q = r & 63;
            const float* src = ((job < 2) ? wg : wu) + (size_t)e * D * DE + (job & 1) * 128;
            bf16* dst = GU + (size_t)((job & 1) * 256 + (job >> 1) * 128) * 1024;
            tr_item(src, DE, dst, 1024, scr, q >> 2, q & 3, F.lane);
        } else { r -= 256;
            tr_item(wd + (size_t)e * DE * D, D, DN, DE, scr, r >> 5, r & 31, F.lane); }
    }
}

__device__ __forceinline__ void ph_inproj_naive(Frame& F, const bf16* Bt, int N) {
    LAS float* sA = (LAS float*)F.lds; LAS float* sB = sA + 128 * 33;
    const bf16* XB = (const bf16*)(F.ws + WS_XB); bf16* P = (bf16*)(F.ws + WS_P);
    const int nnb = N / 64, ntiles = (M / 128) * nnb, tx = F.tid & 15, ty = F.tid >> 4;
    for (int t = blockIdx.x; t < ntiles; t += F.G) {
        const int mb = t / nnb, nb = t % nnb; float acc[4][4];
        ngemm_tile(sA, sB, [&](int r) { return XB + (size_t)(mb * 128 + r) * D; }, Bt + (size_t)nb * 64 * D, D, D, acc);
#pragma unroll
        for (int i = 0; i < 4; ++i) { u32x2 o; o.x = pk2(acc[i][0], acc[i][1]); o.y = pk2(acc[i][2], acc[i][3]);
            *(u32x2*)(P + (size_t)(mb * 128 + ty * 4 + i) * N + nb * 64 + tx * 4) = o; }
    }
}
__device__ __forceinline__ void ph_outproj_naive(Frame& F, const bf16* A, int K, const bf16* Bt, const float* base) {
    LAS float* sA = (LAS float*)F.lds; LAS float* sB = sA + 128 * 33;
    const int nnb = D / 64, ntiles = (M / 128) * nnb, tx = F.tid & 15, ty = F.tid >> 4;
    for (int t = blockIdx.x; t < ntiles; t += F.G) {
        const int mb = t / nnb, nb = t % nnb; float acc[4][4];
        ngemm_tile(sA, sB, [&](int r) { return A + (size_t)(mb * 128 + r) * K; }, Bt + (size_t)nb * 64 * K, K, K, acc);
#pragma unroll
        for (int i = 0; i < 4; ++i) { const size_t off = (size_t)(mb * 128 + ty * 4 + i) * D + nb * 64 + tx * 4;
            const f32x4 b = *(const f32x4*)(base + off);
            *(f32x4*)(F.out + off) = (f32x4){ALPHA * b.x + acc[i][0], ALPHA * b.y + acc[i][1], ALPHA * b.z + acc[i][2], ALPHA * b.w + acc[i][3]}; }
    }
}

__device__ __forceinline__ void ph_conv_naive(Frame& F) {
    const bf16* P = (const bf16*)(F.ws + WS_P); bf16* QKC = (bf16*)(F.ws + WS_QKC);
    const float* cw = F.in[4]; const float* cb = F.in[5];
    const size_t total = (size_t)M * 1024, nth = (size_t)F.G * NT;
    for (size_t i = (size_t)blockIdx.x * NT + F.tid; i < total; i += nth) {
        const int m = (int)(i >> 10), c = (int)(i & 1023), t = m & (T - 1);
        float a = cb[c];
#pragma unroll
        for (int j = 0; j < 4; ++j) { const int tt = t - 3 + j; if (tt >= 0) a += cw[j * 1024 + c] * bf2f(P[(size_t)(m - 3 + j) * NP0 + c]); }
        QKC[i] = (bf16)f2bf(siluf_(a));
    }
}
__device__ __forceinline__ void ph_recurrent_naive(Frame& F) {
    if (blockIdx.x >= 16) return;
    const int type = blockIdx.x >> 3, b = (blockIdx.x >> 2) & 1, h = blockIdx.x & 3;
    LAS float* sin = (LAS float*)F.lds;
    LAS float* red = sin + 1024;
    LAS float* redd = red + 512;
    LAS float* sc = redd + 4;
    const bf16* P = (const bf16*)(F.ws + WS_P); const bf16* QKC = (const bf16*)(F.ws + WS_QKC); const float* G = (const float*)(F.ws + WS_G);
    bf16* Y = (bf16*)(F.ws + WS_Y);
    const float* gain = (type == 0 ? F.in[6] : F.in[7]) + h * 128;
    const int e = F.tid & 127, dg = F.tid >> 7, which = dg;
    const float gamma = 1.f - exp2f(-5.f - (float)h);
    float C[32], nn[32];
#pragma unroll
    for (int j = 0; j < 32; ++j) { C[j] = 0.f; nn[j] = 0.f; }
    const bf16* src; size_t stride;
    if (type == 0) { if (which < 2) { src = QKC + which * 512 + h * 128 + e; stride = 1024; } else { src = P + 1024 + (which - 2) * 512 + h * 128 + e; stride = NP0; } }
    else { src = P + 2048 + which * 512 + h * 128 + e; stride = NP0; }
    const float mul = (which == 1) ? KSCALE : 1.f;
    const size_t m0 = (size_t)b * T;
    float val = bf2f(src[m0 * stride]) * mul;
    float s0 = 0.f, s1 = 0.f;
    if (F.tid == 0) { if (type == 0) { s0 = __expf(G[m0 * 8 + 4 + h]); s1 = __expf(G[m0 * 8 + h]); } else { s0 = gamma; s1 = 1.f; } }
    for (int t = 0; t < T; ++t) {
        const size_t m = m0 + t; const int pb = t & 1;
        sin[pb * 512 + F.tid] = val;
        if (F.tid == 0) { sc[pb * 2] = s0; sc[pb * 2 + 1] = s1; }
        if (t + 1 < T) { val = bf2f(src[(m + 1) * stride]) * mul;
            if (F.tid == 0 && type == 0) { s0 = __expf(G[(m + 1) * 8 + 4 + h]); s1 = __expf(G[(m + 1) * 8 + h]); } }
        __syncthreads();
        const float f = sc[pb * 2], ig = sc[pb * 2 + 1];
        const LAS float* sq = sin + pb * 512; const LAS float* sk = sq + 128; const LAS float* sv = sq + 256; const LAS float* so = sq + 384;
        const float ve = sv[e] * ig;
        float pn = 0.f, pd = 0.f;
#pragma unroll
        for (int j = 0; j < 32; ++j) { const int d = dg * 32 + j; const float kd = sk[d], qd = sq[d];
            C[j] = fmaf(f, C[j], kd * ve); nn[j] = fmaf(f, nn[j], ig * kd); pn = fmaf(C[j], qd, pn); pd = fmaf(nn[j], qd, pd); }
        red[dg * 128 + e] = pn; if (e == 0) redd[dg] = pd;
        __syncthreads();
        if (F.tid < 64) {
            const int e0 = F.tid, e1 = F.tid + 64;
            float h0 = (red[e0] + red[128 + e0]) + (red[256 + e0] + red[384 + e0]);
            float h1 = (red[e1] + red[128 + e1]) + (red[256 + e1] + red[384 + e1]);
            if (type == 0) { const float den = (redd[0] + redd[1]) + (redd[2] + redd[3]); const float dn = fmaxf(fabsf(den), 1.f);
                h0 = h0 / dn * sigmoidf_(so[e0]); h1 = h1 / dn * sigmoidf_(so[e1]); }
            const float mean = wave_sum(h0 + h1) * (1.f / 128.f); const float d0 = h0 - mean, d1 = h1 - mean;
            const float rstd = 1.f / sqrtf(wave_sum(d0 * d0 + d1 * d1) * (1.f / 128.f) + LN_EPS);
            float y0 = d0 * rstd * gain[e0], y1 = d1 * rstd * gain[e1];
            if (type == 1) { y0 *= siluf_(so[e0]); y1 *= siluf_(so[e1]); }
            Y[m * 1024 + type * 512 + h * 128 + e0] = (bf16)f2bf(y0); Y[m * 1024 + type * 512 + h * 128 + e1] = (bf16)f2bf(y1);
        }
    }
}

template <int MODE, bool ROUTE, bool WRITE_XB>
__device__ __forceinline__ void ph_ln(Frame& F, int layer) {
    LAS float* rwT = (LAS float*)F.lds;
    if (ROUTE) { const float* rw = F.in[11]; for (int i = F.tid; i < 32 * 1024; i += NT) { const int e = i >> 10, k = i & 1023; rwT[i] = rw[(size_t)k * 32 + e]; } __syncthreads(); }
    const int gwv = F.vcu * NWAVES + F.wave, NGW = F.G * NWAVES;
    const float* lg = F.in[16] + (size_t)(layer * 2 + MODE) * D; const float* lb = F.in[17] + (size_t)(layer * 2 + MODE) * D;
    bf16* XB = (bf16*)(F.ws + WS_XB); const bf16* YB = (const bf16*)(F.ws + WS_YB);
    int* EIDX = (int*)(F.ws + WS_EIDX); float* GATEV = (float*)(F.ws + WS_GATEV); int* LIST = (int*)(F.ws + WS_LIST);
    unsigned* cnt = F.ctl + CW_CNT + layer * 32 * 64;
    const float* rbias = F.in[12];
    f32x4 gv[4], bv[4];
#pragma unroll
    for (int j = 0; j < 4; ++j) { gv[j] = *((const f32x4*)lg + F.lane + 64 * j); bv[j] = *((const f32x4*)lb + F.lane + 64 * j); }
    for (int m = gwv; m < M; m += NGW) {
        f32x4* orow = (f32x4*)(F.out + (size_t)m * D) + F.lane;
        f32x4 v[4]; float s = 0.f;
#pragma unroll
        for (int j = 0; j < 4; ++j) v[j] = orow[64 * j];
        if (MODE == 1) {
            const float g0 = GATEV[2 * m], g1 = GATEV[2 * m + 1];
            const u32x2* y0 = (const u32x2*)(YB + (size_t)(2 * m) * D) + F.lane; const u32x2* y1 = (const u32x2*)(YB + (size_t)(2 * m + 1) * D) + F.lane;
#pragma unroll
            for (int j = 0; j < 4; ++j) { const u32x2 a = y0[64 * j], b = y1[64 * j];
                v[j].x = ALPHA * v[j].x + g0 * bflo(a.x) + g1 * bflo(b.x); v[j].y = ALPHA * v[j].y + g0 * bfhi(a.x) + g1 * bfhi(b.x);
                v[j].z = ALPHA * v[j].z + g0 * bflo(a.y) + g1 * bflo(b.y); v[j].w = ALPHA * v[j].w + g0 * bfhi(a.y) + g1 * bfhi(b.y); }
        }
#pragma unroll
        for (int j = 0; j < 4; ++j) s += (v[j].x + v[j].y) + (v[j].z + v[j].w);
        const float mean = wave_sum(s) * (1.f / D); float s2 = 0.f;
#pragma unroll
        for (int j = 0; j < 4; ++j) { v[j] = v[j] - mean; s2 += (v[j].x * v[j].x + v[j].y * v[j].y) + (v[j].z * v[j].z + v[j].w * v[j].w); }
        const float rstd = 1.f / sqrtf(wave_sum(s2) * (1.f / D) + LN_EPS);
#pragma unroll
        for (int j = 0; j < 4; ++j) { v[j] = v[j] * rstd * gv[j] + bv[j]; orow[64 * j] = v[j]; }
        if (WRITE_XB) { unsigned long long* o8 = (unsigned long long*)(XB + (size_t)m * D) + F.lane;
#pragma unroll
            for (int j = 0; j < 4; ++j) o8[64 * j] = (unsigned long long)pk2(v[j].x, v[j].y) | ((unsigned long long)pk2(v[j].z, v[j].w) << 32); }
        if (ROUTE) {
            float mylog = 0.f;
#pragma unroll 2
            for (int e = 0; e < 32; ++e) { float a = 0.f;
#pragma unroll
                for (int j = 0; j < 4; ++j) { const f32x4 w = *(const LAS f32x4*)(rwT + e * 1024 + 4 * F.lane + 256 * j); a += v[j].x * w.x + v[j].y * w.y + v[j].z * w.z + v[j].w * w.w; }
                a = wave_sum(a); mylog = (F.lane == e) ? a : mylog; }
            const float myaff = 1.f / (1.f + expf(-mylog)), mysel = myaff + rbias[F.lane & 31];
            float m1 = -1e30f, m2 = -1e30f; int i1 = 0, i2 = 0; float a1 = 0.f, a2 = 0.f;
            const int gbase = F.lane & 24;
#pragma unroll
            for (int j = 0; j < 8; ++j) { const float sv = __shfl(mysel, gbase + j), av = __shfl(myaff, gbase + j);
                if (sv > m1) { m2 = m1; i2 = i1; a2 = a1; m1 = sv; i1 = gbase + j; a1 = av; }
                else if (sv > m2) { m2 = sv; i2 = gbase + j; a2 = av; } }
            const float score = m1 + m2;
            float bestscore = -1e30f; int bg = 0;
#pragma unroll
            for (int g = 0; g < 4; ++g) { const float sg = __shfl(score, 8 * g); if (sg > bestscore) { bestscore = sg; bg = g; } }
            const int bi0 = __shfl(i1, 8 * bg), bi1 = __shfl(i2, 8 * bg); const float ba0 = __shfl(a1, 8 * bg), ba1 = __shfl(a2, 8 * bg);
            if (F.lane == 0) {
                const float inv = 1.f / (ba0 + ba1);
                EIDX[2 * m] = bi0; EIDX[2 * m + 1] = bi1; GATEV[2 * m] = ba0 * inv; GATEV[2 * m + 1] = ba1 * inv;
                const unsigned p0 = __hip_atomic_fetch_add(cnt + bi0 * 64, 1u, RLX_AGENT); LIST[bi0 * M + p0] = 2 * m;
                const unsigned p1 = __hip_atomic_fetch_add(cnt + bi1 * 64, 1u, RLX_AGENT); LIST[bi1 * M + p1] = 2 * m + 1;
            }
        }
    }
}

struct ExpertMap { int cnt[32]; };
__device__ __forceinline__ int moe_find(Frame& F, int layer, int unit_rows, int per_row_tiles, int t, int& e_out, int& mb_out, int& nb_out, int& hb_out, int& cnt_out) {
    const unsigned* cnt = F.ctl + CW_CNT + layer * 32 * 64;
    int base = 0, hb = 0;
    for (int e = 0; e < 32; ++e) {
        const int c = (int)cnt[e * 64]; const int nmb = (c + unit_rows - 1) / unit_rows; const int nt = nmb * per_row_tiles;
        if (t < base + nt) { const int r = t - base; e_out = e; mb_out = r / per_row_tiles; nb_out = r % per_row_tiles; hb_out = hb; cnt_out = c; return 1; }
        base += nt; hb += ((c + 255) >> 8) << 8;
    }
    return 0;
}
__device__ __forceinline__ void ph_moe1_naive(Frame& F, int layer) {
    LAS float* sA = (LAS float*)F.lds; LAS float* sB = sA + 128 * 33;
    const bf16* XB = (const bf16*)(F.ws + WS_XB); bf16* HID = (bf16*)(F.ws + WS_HID); const int* LIST = (const int*)(F.ws + WS_LIST);
    const int tx = F.tid & 15, ty = F.tid >> 4;
    for (int t = blockIdx.x;; t += F.G) {
        int e, mb, nb, hb, c; if (!moe_find(F, layer, 128, 4, t, e, mb, nb, hb, c)) break;
        const bf16* GU = (const bf16*)(F.ws + WS_EW + (size_t)e * EW_STRIDE);
        const int j0 = nb * 64, rg = (j0 >> 7) * 256 + (j0 & 127);
        auto rowA = [&](int r) -> const bf16* { const int i = mb * 128 + r; return i < c ? XB + (size_t)(LIST[e * M + i] >> 1) * D : (const bf16*)nullptr; };
        float ag[4][4], au[4][4];
        ngemm_tile(sA, sB, rowA, GU + (size_t)rg * D, D, D, ag);
        ngemm_tile(sA, sB, rowA, GU + (size_t)(rg + 128) * D, D, D, au);
#pragma unroll
        for (int i = 0; i < 4; ++i) { const int ri = mb * 128 + ty * 4 + i;
            if (ri < c) { u32x2 o; o.x = pk2(siluf_(ag[i][0]) * au[i][0], siluf_(ag[i][1]) * au[i][1]); o.y = pk2(siluf_(ag[i][2]) * au[i][2], siluf_(ag[i][3]) * au[i][3]);
                *(u32x2*)(HID + (size_t)(hb + ri) * DE + j0 + tx * 4) = o; } }
    }
}
__device__ __forceinline__ void ph_moe2_naive(Frame& F, int layer) {
    LAS float* sA = (LAS float*)F.lds; LAS float* sB = sA + 128 * 33;
    const bf16* HID = (const bf16*)(F.ws + WS_HID); bf16* YB = (bf16*)(F.ws + WS_YB); const int* LIST = (const int*)(F.ws + WS_LIST);
    const int tx = F.tid & 15, ty = F.tid >> 4;
    for (int t = blockIdx.x;; t += F.G) {
        int e, mb, nb, hb, c; if (!moe_find(F, layer, 128, 16, t, e, mb, nb, hb, c)) break;
        const bf16* DN = (const bf16*)(F.ws + WS_EW + (size_t)e * EW_STRIDE + EW_DN);
        auto rowA = [&](int r) -> const bf16* { const int i = mb * 128 + r; return i < c ? HID + (size_t)(hb + i) * DE : (const bf16*)nullptr; };
        float acc[4][4];
        ngemm_tile(sA, sB, rowA, DN + (size_t)(nb * 64) * DE, DE, DE, acc);
#pragma unroll
        for (int i = 0; i < 4; ++i) { const int ri = mb * 128 + ty * 4 + i;
            if (ri < c) { const int a = LIST[e * M + ri]; u32x2 o; o.x = pk2(acc[i][0], acc[i][1]); o.y = pk2(acc[i][2], acc[i][3]);
                *(u32x2*)(YB + (size_t)a * D + nb * 64 + tx * 4) = o; } }
    }
}

__device__ __forceinline__ void ph_attn_naive(Frame& F) {
    const bf16* P = (const bf16*)(F.ws + WS_P); bf16* OG = (bf16*)(F.ws + WS_OG); float* LSE = (float*)(F.ws + WS_LSE);
    const int total = 3 * M * 8, nth = F.G * NT;
    for (int idx = blockIdx.x * NT + F.tid; idx < total; idx += nth) {
        const int h = idx & 7, m = (idx >> 3) & (M - 1), g = idx >> 17;
        const int t = m & (T - 1), dil = (g == 0) ? 1 : (g == 1 ? 4 : 16);
        const float slope = exp2f(-(float)(h + 1));
        const bf16* qp = P + (size_t)m * IN1 + g * 1536 + h * 64;
        float q[64], o[64];
#pragma unroll
        for (int c = 0; c < 8; ++c) { const u32x4 w = *(const u32x4*)(qp + 8 * c);
            q[8 * c + 0] = bflo(w.x); q[8 * c + 1] = bfhi(w.x); q[8 * c + 2] = bflo(w.y); q[8 * c + 3] = bfhi(w.y); q[8 * c + 4] = bflo(w.z); q[8 * c + 5] = bfhi(w.z); q[8 * c + 6] = bflo(w.w); q[8 * c + 7] = bfhi(w.w); }
#pragma unroll
        for (int d = 0; d < 64; ++d) o[d] = 0.f;
        float mx = -1e30f, den = 0.f;
        for (int j = 0; j <= 128; ++j) {
            const int tk = t - j * dil; if (tk < 0) break;
            const bf16* kp = P + (size_t)(m - j * dil) * IN1 + g * 1536 + 512 + h * 64; const bf16* vp = kp + 512;
            float s = 0.f;
#pragma unroll
            for (int c = 0; c < 8; ++c) { const u32x4 w = *(const u32x4*)(kp + 8 * c);
                s += q[8 * c + 0] * bflo(w.x) + q[8 * c + 1] * bfhi(w.x) + q[8 * c + 2] * bflo(w.y) + q[8 * c + 3] * bfhi(w.y) + q[8 * c + 4] * bflo(w.z) + q[8 * c + 5] * bfhi(w.z) + q[8 * c + 6] * bflo(w.w) + q[8 * c + 7] * bfhi(w.w); }
            s = s * 0.125f - slope * (float)(j * dil);
            const float mn = fmaxf(mx, s), corr = __expf(mx - mn), p = __expf(s - mn);
            den = den * corr + p; mx = mn;
#pragma unroll
            for (int c = 0; c < 8; ++c) { const u32x4 w = *(const u32x4*)(vp + 8 * c);
                o[8 * c + 0] = o[8 * c + 0] * corr + p * bflo(w.x); o[8 * c + 1] = o[8 * c + 1] * corr + p * bfhi(w.x); o[8 * c + 2] = o[8 * c + 2] * corr + p * bflo(w.y); o[8 * c + 3] = o[8 * c + 3] * corr + p * bfhi(w.y);
                o[8 * c + 4] = o[8 * c + 4] * corr + p * bflo(w.z); o[8 * c + 5] = o[8 * c + 5] * corr + p * bfhi(w.z); o[8 * c + 6] = o[8 * c + 6] * corr + p * bflo(w.w); o[8 * c + 7] = o[8 * c + 7] * corr + p * bfhi(w.w); }
        }
        const float inv = 1.f / den;
        bf16* op = OG + ((size_t)g * M + m) * 512 + h * 64;
#pragma unroll
        for (int c = 0; c < 8; ++c) { u32x4 w; w.x = pk2(o[8 * c + 0] * inv, o[8 * c + 1] * inv); w.y = pk2(o[8 * c + 2] * inv, o[8 * c + 3] * inv); w.z = pk2(o[8 * c + 4] * inv, o[8 * c + 5] * inv); w.w = pk2(o[8 * c + 6] * inv, o[8 * c + 7] * inv);
            *(u32x4*)(op + 8 * c) = w; }
        LSE[((size_t)g * M + m) * 8 + h] = mx + __logf(den);
    }
}
__device__ __forceinline__ void ph_merge(Frame& F) {
    const bf16* OG = (const bf16*)(F.ws + WS_OG); const float* LSE = (const float*)(F.ws + WS_LSE); bf16* Y2 = (bf16*)(F.ws + WS_Y2);
    const int total = M * 64, nth = F.G * NT;
    for (int idx = blockIdx.x * NT + F.tid; idx < total; idx += nth) {
        const int m = idx >> 6, c8 = idx & 63, h = c8 >> 3;
        const float l0 = LSE[((size_t)0 * M + m) * 8 + h], l1 = LSE[((size_t)1 * M + m) * 8 + h], l2 = LSE[((size_t)2 * M + m) * 8 + h];
        const float mx = fmaxf(l0, fmaxf(l1, l2)); float w0 = __expf(l0 - mx), w1 = __expf(l1 - mx), w2 = __expf(l2 - mx); const float inv = 1.f / (w0 + w1 + w2);
        w0 *= inv; w1 *= inv; w2 *= inv;
        const u32x4 a = *(const u32x4*)(OG + ((size_t)0 * M + m) * 512 + c8 * 8), b = *(const u32x4*)(OG + ((size_t)1 * M + m) * 512 + c8 * 8), c = *(const u32x4*)(OG + ((size_t)2 * M + m) * 512 + c8 * 8);
        u32x4 o;
        o.x = pk2(w0 * bflo(a.x) + w1 * bflo(b.x) + w2 * bflo(c.x), w0 * bfhi(a.x) + w1 * bfhi(b.x) + w2 * bfhi(c.x));
        o.y = pk2(w0 * bflo(a.y) + w1 * bflo(b.y) + w2 * bflo(c.y), w0 * bfhi(a.y) + w1 * bfhi(b.y) + w2 * bfhi(c.y));
        o.z = pk2(w0 * bflo(a.z) + w1 * bflo(b.z) + w2 * bflo(c.z), w0 * bfhi(a.z) + w1 * bfhi(b.z) + w2 * bfhi(c.z));
        o.w = pk2(w0 * bflo(a.w) + w1 * bflo(b.w) + w2 * bflo(c.w), w0 * bfhi(a.w) + w1 * bfhi(b.w) + w2 * bfhi(c.w));
        *(u32x4*)(Y2 + (size_t)m * 512 + c8 * 8) = o;
    }
}

struct Args { const float* in[18]; float* out; unsigned char* ws; int ph_lo, ph_hi, li, pad; };
__global__ void __launch_bounds__(NT, 2) mega_fwd(Args args) {
    extern __shared__ __attribute__((aligned(16))) unsigned char lds_raw[];
    Frame F;
    F.lds = (LAS unsigned char*)lds_raw;
    F.tid = threadIdx.x; F.lane = F.tid & 63; F.wave = __builtin_amdgcn_readfirstlane(F.tid >> 6);
    F.G = gridDim.x; { const int bx = blockIdx.x; F.vcu = (F.G % 8 == 0) ? (bx % 8) * (F.G / 8) + bx / 8 : bx; }
#pragma unroll
    for (int i = 0; i < 18; ++i) F.in[i] = args.in[i];
    F.out = args.out; F.ws = args.ws; F.ctl = (unsigned*)(args.ws + WS_CTL);
    volatile LAS unsigned* MISC = (volatile LAS unsigned*)(F.lds + LDS_BYTES - 128);
    if (F.tid < 32) MISC[F.tid] = 0u;
    __syncthreads();
    XcdBarrier bar; bar.bar = F.ctl + CW_BAR; bar.x = 0; bar.st = nullptr;
    if (MK_N_LAUNCHES == 1) bar = xcd_barrier_post(F.ctl + CW_BAR, MISC + 8);
    const int lo = args.ph_lo, hi = args.ph_hi;
#define IN(k) (lo <= (k) && (k) < hi)
#define SEAM(k) do { if (IN(k) && IN((k) + 1)) xcd_barrier(bar); } while (0)
    if (IN(0)) { ph0_convert(F); } SEAM(0);
    if (IN(1)) { ph_inproj_naive(F, (const bf16*)(F.ws + WS_WT0), NP0); } SEAM(1);
    if (IN(2)) { ph_conv_naive(F); } SEAM(2);
    if (IN(3)) { ph_recurrent_naive(F); } SEAM(3);
    if (IN(4)) { ph_outproj_naive(F, (const bf16*)(F.ws + WS_Y), D, (const bf16*)(F.ws + WS_WO0), F.in[0]); } SEAM(4);
    if (IN(5)) { convert_experts(F, 0); __syncthreads(); ph_ln<0, true, true>(F, 0); } SEAM(5);
    if (IN(6)) { ph_moe1_naive(F, 0); } SEAM(6);
    if (IN(7)) { ph_moe2_naive(F, 0); } SEAM(7);
    if (IN(8)) { ph_ln<1, false, true>(F, 0); __syncthreads(); convert_experts(F, 1); } SEAM(8);
    if (IN(9)) { ph_inproj_naive(F, (const bf16*)(F.ws + WS_WT1), IN1); } SEAM(9);
    if (IN(10)) { ph_attn_naive(F); } SEAM(10);
    if (IN(11)) { ph_merge(F); } SEAM(11);
    if (IN(12)) { ph_outproj_naive(F, (const bf16*)(F.ws + WS_Y2), 512, (const bf16*)(F.ws + WS_WO1), F.out); } SEAM(12);
    if (IN(13)) { ph_ln<0, true, true>(F, 1); } SEAM(13);
    if (IN(14)) { ph_moe1_naive(F, 1); } SEAM(14);
    if (IN(15)) { ph_moe2_naive(F, 1); } SEAM(15);
    if (IN(16)) { ph_ln<1, false, false>(F, 1); }
#undef IN
#undef SEAM
}

extern "C" void kernel_launch(void* const* d_in, const int* in_sizes, int n_in, void* d_out, int out_size, void* d_ws, size_t ws_size, hipStream_t stream) {
    static int grid = 0;
    if (grid == 0) {
        if (n_in != 18 || in_sizes[0] != M * D || out_size != M * D || ws_size < WS_END) {
            fprintf(stderr, "kernel_launch: unexpected problem (n_in %d, in0 %d, out %d, ws %zu < %zu)\n", n_in, n_in > 0 ? in_sizes[0] : -1, out_size, ws_size, (size_t)WS_END); grid = -1; return; }
        int dev = 0, cus = 0;
        if (hipGetDevice(&dev) != hipSuccess || hipDeviceGetAttribute(&cus, hipDeviceAttributeMultiprocessorCount, dev) != hipSuccess) { grid = -1; return; }
        if (hipFuncSetAttribute((const void*)mega_fwd, hipFuncAttributeMaxDynamicSharedMemorySize, LDS_BYTES) != hipSuccess) { fprintf(stderr, "kernel_launch: hipFuncSetAttribute failed\n"); grid = -1; return; }
        int per_cu = 0;
        if (hipOccupancyMaxActiveBlocksPerMultiprocessor(&per_cu, (const void*)mega_fwd, NT, LDS_BYTES) != hipSuccess || per_cu < 1) fprintf(stderr, "kernel_launch: occupancy query says %d\n", per_cu);
        (void)hipGetLastError();
        grid = cus;
    }
    if (grid < 0) return;
    (void)hipMemsetAsync((char*)d_ws + WS_CTL, 0, CTL_ZERO_BYTES, stream);
    Args a{};
    for (int i = 0; i < 18; ++i) a.in[i] = (const float*)d_in[i];
    a.out = (float*)d_out; a.ws = (unsigned char*)d_ws;
    if (MK_N_LAUNCHES == 1) {
        a.ph_lo = 0; a.ph_hi = N_PHASES; a.li = 0;
        hipLaunchKernelGGL(mega_fwd, dim3(grid), dim3(NT), LDS_BYTES, stream, a);
    } else {
        for (int p = 0; p < N_PHASES; ++p) { a.ph_lo = p; a.ph_hi = p + 1; a.li = p; hipLaunchKernelGGL(mega_fwd, dim3(grid), dim3(NT), LDS_BYTES, stream, a); }
    }
}
```

```cpp
#include <hip/hip_runtime.h>
#include <cstdio>
#include <cstdint>

#ifndef MK_N_LAUNCHES
#define MK_N_LAUNCHES 1
#endif

#define LAS __attribute__((address_space(3)))
typedef unsigned short bf16;
typedef float f32x4 __attribute__((ext_vector_type(4)));
typedef unsigned u32x4 __attribute__((ext_vector_type(4)));
typedef unsigned u32x2 __attribute__((ext_vector_type(2)));
#define RLX_AGENT __ATOMIC_RELAXED, __HIP_MEMORY_SCOPE_AGENT
#define LDS_WAIT() asm volatile("s_waitcnt lgkmcnt(0)" ::: "memory")
#define VM_WAIT() asm volatile("s_waitcnt vmcnt(0)" ::: "memory")

constexpr int NWAVES = 8, NT = NWAVES * 64;
constexpr int BATCH = 2, T = 8192, D = 1024, M = BATCH * T;
constexpr int IN0 = 4104, IN1 = 4608, NP0 = 4096;
constexpr int NE = 32, DE = 256;
constexpr float ALPHA = 1.41421356237309515f;
constexpr float LN_EPS = 1e-5f;
constexpr float KSCALE = 0.08838834764831845f;
constexpr int N_PHASES = 17;

constexpr size_t MiB = 1u << 20;
constexpr size_t WS_CTL = 0, CTL_ZERO_BYTES = 1 * MiB;
constexpr size_t WS_G = 1 * MiB;
constexpr size_t WS_EIDX = WS_G + 512 * 1024;
constexpr size_t WS_GATEV = WS_EIDX + 128 * 1024;
constexpr size_t WS_WT0 = 2 * MiB;
constexpr size_t WS_WO0 = 10 * MiB;
constexpr size_t WS_WT1 = 12 * MiB;
constexpr size_t WS_WO1 = 21 * MiB;
constexpr size_t WS_SE = 22 * MiB;
constexpr size_t WS_EW = WS_SE;
constexpr size_t EW_STRIDE = 3 * MiB / 2, EW_DN = 1 * MiB;
constexpr size_t WS_LIST = WS_SE + 48 * MiB;
constexpr size_t WS_LSE = WS_SE + 50 * MiB;
constexpr size_t WS_XB = 86 * MiB;
constexpr size_t WS_Y = 118 * MiB;
constexpr size_t WS_OG = WS_XB;
constexpr size_t WS_Y2 = WS_XB + 48 * MiB;
constexpr size_t WS_P = 150 * MiB;
constexpr size_t WS_YB = WS_P;
constexpr size_t WS_HID = WS_P + 64 * MiB;
constexpr size_t WS_END = 294 * MiB;
constexpr size_t WS_QKC = WS_SE;

constexpr int CW_BAR = 4096;
constexpr int CW_CNT = 16384;

constexpr int LDS_BYTES = 147456;

__device__ __forceinline__ unsigned f2bf(float f) { unsigned u = __builtin_bit_cast(unsigned, f); return (u + 0x7fffu + ((u >> 16) & 1u)) >> 16; }
__device__ __forceinline__ unsigned pk2(float lo, float hi) { return f2bf(lo) | (f2bf(hi) << 16); }
__device__ __forceinline__ float bf2f(unsigned b) { return __builtin_bit_cast(float, b << 16); }
__device__ __forceinline__ float bflo(unsigned w) { return __builtin_bit_cast(float, w << 16); }
__device__ __forceinline__ float bfhi(unsigned w) { return __builtin_bit_cast(float, w & 0xffff0000u); }
__device__ __forceinline__ float wave_sum(float v) {
#pragma unroll
    for (int o = 1; o < 64; o <<= 1) v += __shfl_xor(v, o);
    return v;
}
__device__ __forceinline__ float sigmoidf_(float x) { return 1.f / (1.f + __expf(-x)); }
__device__ __forceinline__ float siluf_(float x) { return x / (1.f + __expf(-x)); }

#define XB_TMO      128
#define XB_XCNT(j)  (256  + 64 * (j))
#define XB_XSUB(j)  (1280 + 64 * (j))
#define XB_XGEN(j)  (2304 + 64 * (j))
#define XB_TOP      3328
#define XB_TOPGEN   3392
#define XCD_BAR_WORDS 3456
#define XB_SPIN_CAP (1u << 22)
__device__ __forceinline__ unsigned xb_ld(unsigned* p)              { return __hip_atomic_load(p, __ATOMIC_RELAXED, __HIP_MEMORY_SCOPE_AGENT); }
__device__ __forceinline__ unsigned xb_add(unsigned* p, unsigned v) { return __hip_atomic_fetch_add(p, v, __ATOMIC_RELAXED, __HIP_MEMORY_SCOPE_AGENT); }
__device__ __forceinline__ unsigned xb_xcc_id() { return (unsigned)__builtin_amdgcn_s_getreg((3 << 11) | 20) & 0xFu; }
#define XB_SPIN(cond, bar) do { unsigned _sp = 0; while (cond) { __builtin_amdgcn_s_sleep(1); \
    if ((++_sp & 255u) == 0u) { if (xb_ld(&(bar)[XB_TMO])) break; if (_sp > XB_SPIN_CAP) { atomicAdd(&(bar)[XB_TMO], 1u); break; } } } } while (0)
struct XcdBarrier { unsigned* bar; unsigned x; volatile LAS unsigned* st; };
__device__ __forceinline__ XcdBarrier xcd_barrier_post(unsigned* bar, volatile LAS unsigned* st) {
    XcdBarrier b; b.bar = bar; b.x = xb_xcc_id(); b.st = st;
    if (threadIdx.x == 0) (void)xb_add(&bar[XB_XCNT(b.x)], 1u);
    return b;
}
__device__ __forceinline__ void xcd_barrier_complete(unsigned* bar, unsigned x, unsigned& nloc, unsigned& nx) {
    const unsigned G = gridDim.x * gridDim.y * gridDim.z;
    unsigned sum, cnt, mine, sp = 0u;
    for (;;) {
        sum = 0u; cnt = 0u; mine = 0u;
#pragma unroll
        for (unsigned j = 0; j < 16; ++j) { const unsigned c = xb_ld(&bar[XB_XCNT(j)]); sum += c; cnt += (c > 0u) ? 1u : 0u; mine = (j == x) ? c : mine; }
        if (sum == G) break;
        __builtin_amdgcn_s_sleep(1);
        if ((++sp & 255u) == 0u) { if (xb_ld(&bar[XB_TMO])) break; if (sp > XB_SPIN_CAP) { atomicAdd(&bar[XB_TMO], 1u); break; } }
    }
    nloc = mine > 0u ? mine : 1u; nx = cnt > 0u ? cnt : 1u;
}
__device__ __forceinline__ void xcd_barrier(const XcdBarrier& b) {
    asm volatile("s_waitcnt vmcnt(0)" ::: "memory");
    __syncthreads();
    if (threadIdx.x == 0) {
        unsigned* bar = b.bar;
        __builtin_amdgcn_s_waitcnt(0);
        unsigned nloc = b.st[0], nx = b.st[1];
        if (nloc == 0u) { xcd_barrier_complete(bar, b.x, nloc, nx); b.st[0] = nloc; b.st[1] = nx; }
        const unsigned old = xb_add(&bar[XB_XSUB(b.x)], 1u);
        const unsigned gen = old / nloc;
        if (old + 1u == (gen + 1u) * nloc) {
            __builtin_amdgcn_fence(__ATOMIC_RELEASE, "agent");
            asm volatile("s_waitcnt vmcnt(0)" ::: "memory");
            const unsigned og = xb_add(&bar[XB_TOP], 1u);
            const unsigned tg = og / nx;
            if (og + 1u == (tg + 1u) * nx) xb_add(&bar[XB_TOPGEN], 1u);
            else XB_SPIN(xb_ld(&bar[XB_TOPGEN]) == tg, bar);
            __builtin_amdgcn_fence(__ATOMIC_ACQUIRE, "agent");
            xb_add(&bar[XB_XGEN(b.x)], 1u);
            asm volatile("s_waitcnt vmcnt(0)" ::: "memory");
        } else {
            XB_SPIN(xb_ld(&bar[XB_XGEN(b.x)]) == gen, bar);
            __builtin_amdgcn_fence(__ATOMIC_ACQUIRE, "agent");
            asm volatile("s_waitcnt vmcnt(0)" ::: "memory");
        }
    }
    __syncthreads();
}

struct Frame {
    LAS unsigned char* lds;
    unsigned* ctl;
    int tid, lane, wave, vcu, G;
    const float* in[18];
    float* out;
    unsigned char* ws;
};

template <class RowFn>
__device__ __forceinline__ void ngemm_tile(LAS float* sA, LAS float* sB, RowFn rowA, const bf16* Bt, int ldb, int K, float (&acc)[4][4]) {
    const int tid = threadIdx.x, tx = tid & 15, ty = tid >> 4;
#pragma unroll
    for (int i = 0; i < 4; ++i)
#pragma unroll
        for (int j = 0; j < 4; ++j) acc[i][j] = 0.f;
    const int ar = tid >> 2, ak = (tid & 3) * 8, br = tid >> 3, bk = (tid & 7) * 4;
    const bf16* ap = rowA(ar);
    const bf16* bp = Bt + (size_t)br * ldb;
    for (int k0 = 0; k0 < K; k0 += 32) {
        u32x4 av = (u32x4){0u, 0u, 0u, 0u};
        if (ap) av = *(const u32x4*)(ap + k0 + ak);
        const u32x2 bv = *(const u32x2*)(bp + k0 + bk);
        __syncthreads();
        LAS float* wa = sA + ar * 33 + ak;
        wa[0] = bflo(av.x); wa[1] = bfhi(av.x); wa[2] = bflo(av.y); wa[3] = bfhi(av.y); wa[4] = bflo(av.z); wa[5] = bfhi(av.z); wa[6] = bflo(av.w); wa[7] = bfhi(av.w);
        LAS float* wb = sB + br * 33 + bk;
        wb[0] = bflo(bv.x); wb[1] = bfhi(bv.x); wb[2] = bflo(bv.y); wb[3] = bfhi(bv.y);
        __syncthreads();
#pragma unroll 8
        for (int kk = 0; kk < 32; ++kk) {
            float a[4], b[4];
#pragma unroll
            for (int i = 0; i < 4; ++i) a[i] = sA[(ty * 4 + i) * 33 + kk];
#pragma unroll
            for (int j = 0; j < 4; ++j) b[j] = sB[(tx * 4 + j) * 33 + kk];
#pragma unroll
            for (int i = 0; i < 4; ++i)
#pragma unroll
                for (int j = 0; j < 4; ++j) acc[i][j] = fmaf(a[i], b[j], acc[i][j]);
        }
    }
}

__device__ __forceinline__ void tr_item(const float* W, int ldw, bf16* WT, int ldt, LAS float* scr, int kb, int nb, int lane) {
    const int k0 = 64 * kb, n0 = 32 * nb;
#pragma unroll 8
    for (int i = 0; i < 32; ++i) { const int kk = 2 * i + (lane >> 5); scr[kk * 33 + (lane & 31)] = W[(size_t)(k0 + kk) * ldw + n0 + (lane & 31)]; }
    LDS_WAIT(); asm volatile("" ::: "memory");
    const int c = lane & 7;
#pragma unroll
    for (int j = 0; j < 4; ++j) { const int n = (lane >> 3) + 8 * j; const LAS float* s = scr + (8 * c) * 33 + n;
        u32x4 o; o.x = pk2(s[0 * 33], s[1 * 33]); o.y = pk2(s[2 * 33], s[3 * 33]); o.z = pk2(s[4 * 33], s[5 * 33]); o.w = pk2(s[6 * 33], s[7 * 33]);
        *(u32x4*)(WT + (size_t)(n0 + n) * ldt + k0 + 8 * c) = o; }
    LDS_WAIT(); asm volatile("" ::: "memory");
}

__device__ __forceinline__ void ph0_convert(Frame& F) {
    LAS float* scr = (LAS float*)(F.lds + F.wave * 9216);
    LAS float* gw = (LAS float*)(F.lds + 8 * 9216);
    const float* w0 = F.in[1];
    for (int i = F.tid; i < 8 * 1024; i += NT) { const int j = i >> 10, k = i & 1023; gw[i] = w0[(size_t)k * IN0 + 2048 + j]; }
    __syncthreads();
    const int gwv = F.vcu * NWAVES + F.wave, NGW = F.G * NWAVES;
    bf16* WT0 = (bf16*)(F.ws + WS_WT0); bf16* WO0 = (bf16*)(F.ws + WS_WO0); bf16* WT1 = (bf16*)(F.ws + WS_WT1); bf16* WO1 = (bf16*)(F.ws + WS_WO1);
    constexpr int I0 = 16 * 64, I1 = 16 * 64, I2 = 16 * 32, I3 = 16 * 144, I4 = 8 * 32, NI = I0 + I1 + I2 + I3 + I4;
    for (int it = gwv; it < NI; it += NGW) {
        int r = it;
        if (r < I0) { tr_item(w0, IN0, WT0, 1024, scr, r / 64, r % 64, F.lane); continue; } r -= I0;
        if (r < I1) { tr_item(w0 + 2056, IN0, WT0 + (size_t)2048 * 1024, 1024, scr, r / 64, r % 64, F.lane); continue; } r -= I1;
        if (r < I2) { tr_item(F.in[8], 1024, WO0, 1024, scr, r / 32, r % 32, F.lane); continue; } r -= I2;
        if (r < I3) { tr_item(F.in[9], IN1, WT1, 1024, scr, r / 144, r % 144, F.lane); continue; } r -= I3;
        tr_item(F.in[10], 1024, WO1, 512, scr, r / 32, r % 32, F.lane);
    }
    const float* x = F.in[0]; bf16* XB = (bf16*)(F.ws + WS_XB); float* G = (float*)(F.ws + WS_G);
    const float* ib = F.in[2]; const float* fb = F.in[3];
    for (int m = gwv; m < M; m += NGW) {
        const f32x4* xr = (const f32x4*)(x + (size_t)m * D) + F.lane;
        f32x4 v[4];
#pragma unroll
        for (int j = 0; j < 4; ++j) v[j] = xr[64 * j];
        unsigned long long* o8 = (unsigned long long*)(XB + (size_t)m * D) + F.lane;
#pragma unroll
        for (int j = 0; j < 4; ++j) o8[64 * j] = (unsigned long long)pk2(v[j].x, v[j].y) | ((unsigned long long)pk2(v[j].z, v[j].w) << 32);
        float acc[8];
#pragma unroll
        for (int g = 0; g < 8; ++g) { float a = 0.f;
#pragma unroll
            for (int j = 0; j < 4; ++j) { const f32x4 w = *(const LAS f32x4*)(gw + g * 1024 + 4 * F.lane + 256 * j); a += v[j].x * w.x + v[j].y * w.y + v[j].z * w.z + v[j].w * w.w; }
            acc[g] = wave_sum(a); }
        if (F.lane == 0) {
#pragma unroll
            for (int g = 0; g < 4; ++g) G[(size_t)m * 8 + g] = acc[g] + ib[g];
#pragma unroll
            for (int g = 0; g < 4; ++g) { const float z = acc[4 + g] + fb[g]; G[(size_t)m * 8 + 4 + g] = fminf(z, 0.f) - log1pf(__expf(-fabsf(z))); }
        }
    }
}

__device__ __forceinline__ void convert_experts(Frame& F, int layer) {
    LAS float* scr = (LAS float*)(F.lds + F.wave * 9216);
    const int gwv = F.vcu * NWAVES + F.wave, NGW = F.G * NWAVES;
    const float* wg = F.in[13] + (size_t)layer * NE * D * DE; const float* wu = F.in[14] + (size_t)layer * NE * D * DE; const float* wd = F.in[15] + (size_t)layer * NE * DE * D;
    for (int it = gwv; it < NE * 384; it += NGW) {
        const int e = it / 384; int r = it % 384;
        bf16* GU = (bf16*)(F.ws + WS_EW + (size_t)e * EW_STRIDE); bf16* DN = (bf16*)(F.ws + WS_EW + (size_t)e * EW_STRIDE + EW_DN);
        if (r < 256) { const int job = r >> 6, q = r & 63;
            const float* src = ((job < 2) ? wg : wu) + (size_t)e * D * DE + (job & 1) * 128;
            bf16* dst = GU + (size_t)((job & 1) * 256 + (job >> 1) * 128) * 1024;
            tr_item(src, DE, dst, 1024, scr, q >> 2, q & 3, F.lane);
        } else { r -= 256;
            tr_item(wd + (size_t)e * DE * D, D, DN, DE, scr, r >> 5, r & 31, F.lane); }
    }
}

__device__ __forceinline__ void ph_inproj_naive(Frame& F, const bf16* Bt, int N) {
    LAS float* sA = (LAS float*)F.lds; LAS float* sB = sA + 128 * 33;
    const bf16* XB = (const bf16*)(F.ws + WS_XB); bf16* P = (bf16*)(F.ws + WS_P);
    const int nnb = N / 64, ntiles = (M / 128) * nnb, tx = F.tid & 15, ty = F.tid >> 4;
    for (int t = blockIdx.x; t < ntiles; t += F.G) {
        const int mb = t / nnb, nb = t % nnb; float acc[4][4];
        ngemm_tile(sA, sB, [&](int r) { return XB + (size_t)(mb * 128 + r) * D; }, Bt + (size_t)nb * 64 * D, D, D, acc);
#pragma unroll
        for (int i = 0; i < 4; ++i) { u32x2 o; o.x = pk2(acc[i][0], acc[i][1]); o.y = pk2(acc[i][2], acc[i][3]);
            *(u32x2*)(P + (size_t)(mb * 128 + ty * 4 + i) * N + nb * 64 + tx * 4) = o; }
    }
}
__device__ __forceinline__ void ph_outproj_naive(Frame& F, const bf16* A, int K, const bf16* Bt, const float* base) {
    LAS float* sA = (LAS float*)F.lds; LAS float* sB = sA + 128 * 33;
    const int nnb = D / 64, ntiles = (M / 128) * nnb, tx = F.tid & 15, ty = F.tid >> 4;
    for (int t = blockIdx.x; t < ntiles; t += F.G) {
        const int mb = t / nnb, nb = t % nnb; float acc[4][4];
        ngemm_tile(sA, sB, [&](int r) { return A + (size_t)(mb * 128 + r) * K; }, Bt + (size_t)nb * 64 * K, K, K, acc);
#pragma unroll
        for (int i = 0; i < 4; ++i) { const size_t off = (size_t)(mb * 128 + ty * 4 + i) * D + nb * 64 + tx * 4;
            const f32x4 b = *(const f32x4*)(base + off);
            *(f32x4*)(F.out + off) = (f32x4){ALPHA * b.x + acc[i][0], ALPHA * b.y + acc[i][1], ALPHA * b.z + acc[i][2], ALPHA * b.w + acc[i][3]}; }
    }
}

__device__ __forceinline__ void ph_conv_naive(Frame& F) {
    const bf16* P = (const bf16*)(F.ws + WS_P); bf16* QKC = (bf16*)(F.ws + WS_QKC);
    const float* cw = F.in[4]; const float* cb = F.in[5];
    const size_t total = (size_t)M * 1024, nth = (size_t)F.G * NT;
    for (size_t i = (size_t)blockIdx.x * NT + F.tid; i < total; i += nth) {
        const int m = (int)(i >> 10), c = (int)(i & 1023), t = m & (T - 1);
        float a = cb[c];
#pragma unroll
        for (int j = 0; j < 4; ++j) { const int tt = t - 3 + j; if (tt >= 0) a += cw[j * 1024 + c] * bf2f(P[(size_t)(m - 3 + j) * NP0 + c]); }
        QKC[i] = (bf16)f2bf(siluf_(a));
    }
}
__device__ __forceinline__ void ph_recurrent_naive(Frame& F) {
    if (blockIdx.x >= 16) return;
    const int type = blockIdx.x >> 3, b = (blockIdx.x >> 2) & 1, h = blockIdx.x & 3;
    LAS float* sin = (LAS float*)F.lds;
    LAS float* red = sin + 1024;
    LAS float* redd = red + 512;
    LAS float* sc = redd + 4;
    const bf16* P = (const bf16*)(F.ws + WS_P); const bf16* QKC = (const bf16*)(F.ws + WS_QKC); const float* G = (const float*)(F.ws + WS_G);
    bf16* Y = (bf16*)(F.ws + WS_Y);
    const float* gain = (type == 0 ? F.in[6] : F.in[7]) + h * 128;
    const int e = F.tid & 127, dg = F.tid >> 7, which = dg;
    const float gamma = 1.f - exp2f(-5.f - (float)h);
    float C[32], nn[32];
#pragma unroll
    for (int j = 0; j < 32; ++j) { C[j] = 0.f; nn[j] = 0.f; }
    const bf16* src; size_t stride;
    if (type == 0) { if (which < 2) { src = QKC + which * 512 + h * 128 + e; stride = 1024; } else { src = P + 1024 + (which - 2) * 512 + h * 128 + e; stride = NP0; } }
    else { src = P + 2048 + which * 512 + h * 128 + e; stride = NP0; }
    const float mul = (which == 1) ? KSCALE : 1.f;
    const size_t m0 = (size_t)b * T;
    float val = bf2f(src[m0 * stride]) * mul;
    float s0 = 0.f, s1 = 0.f;
    if (F.tid == 0) { if (type == 0) { s0 = __expf(G[m0 * 8 + 4 + h]); s1 = __expf(G[m0 * 8 + h]); } else { s0 = gamma; s1 = 1.f; } }
    for (int t = 0; t < T; ++t) {
        const size_t m = m0 + t; const int pb = t & 1;
        sin[pb * 512 + F.tid] = val;
        if (F.tid == 0) { sc[pb * 2] = s0; sc[pb * 2 + 1] = s1; }
        if (t + 1 < T) { val = bf2f(src[(m + 1) * stride]) * mul;
            if (F.tid == 0 && type == 0) { s0 = __expf(G[(m + 1) * 8 + 4 + h]); s1 = __expf(G[(m + 1) * 8 + h]); } }
        __syncthreads();
        const float f = sc[pb * 2], ig = sc[pb * 2 + 1];
        const LAS float* sq = sin + pb * 512; const LAS float* sk = sq + 128; const LAS float* sv = sq + 256; const LAS float* so = sq + 384;
        const float ve = sv[e] * ig;
        float pn = 0.f, pd = 0.f;
#pragma unroll
        for (int j = 0; j < 32; ++j) { const int d = dg * 32 + j; const float kd = sk[d], qd = sq[d];
            C[j] = fmaf(f, C[j], kd * ve); nn[j] = fmaf(f, nn[j], ig * kd); pn = fmaf(C[j], qd, pn); pd = fmaf(nn[j], qd, pd); }
        red[dg * 128 + e] = pn; if (e == 0) redd[dg] = pd;
        __syncthreads();
        if (F.tid < 64) {
            const int e0 = F.tid, e1 = F.tid + 64;
            float h0 = (red[e0] + red[128 + e0]) + (red[256 + e0] + red[384 + e0]);
            float h1 = (red[e1] + red[128 + e1]) + (red[256 + e1] + red[384 + e1]);
            if (type == 0) { const float den = (redd[0] + redd[1]) + (redd[2] + redd[3]); const float dn = fmaxf(fabsf(den), 1.f);
                h0 = h0 / dn * sigmoidf_(so[e0]); h1 = h1 / dn * sigmoidf_(so[e1]); }
            const float mean = wave_sum(h0 + h1) * (1.f / 128.f); const float d0 = h0 - mean, d1 = h1 - mean;
            const float rstd = 1.f / sqrtf(wave_sum(d0 * d0 + d1 * d1) * (1.f / 128.f) + LN_EPS);
            float y0 = d0 * rstd * gain[e0], y1 = d1 * rstd * gain[e1];
            if (type == 1) { y0 *= siluf_(so[e0]); y1 *= siluf_(so[e1]); }
            Y[m * 1024 + type * 512 + h * 128 + e0] = (bf16)f2bf(y0); Y[m * 1024 + type * 512 + h * 128 + e1] = (bf16)f2bf(y1);
        }
    }
}

template <int MODE, bool ROUTE, bool WRITE_XB>
__device__ __forceinline__ void ph_ln(Frame& F, int layer) {
    LAS float* rwT = (LAS float*)F.lds;
    if (ROUTE) { const float* rw = F.in[11]; for (int i = F.tid; i < 32 * 1024; i += NT) { const int e = i >> 10, k = i & 1023; rwT[i] = rw[(size_t)k * 32 + e]; } __syncthreads(); }
    const int gwv = F.vcu * NWAVES + F.wave, NGW = F.G * NWAVES;
    const float* lg = F.in[16] + (size_t)(layer * 2 + MODE) * D; const float* lb = F.in[17] + (size_t)(layer * 2 + MODE) * D;
    bf16* XB = (bf16*)(F.ws + WS_XB); const bf16* YB = (const bf16*)(F.ws + WS_YB);
    int* EIDX = (int*)(F.ws + WS_EIDX); float* GATEV = (float*)(F.ws + WS_GATEV); int* LIST = (int*)(F.ws + WS_LIST);
    unsigned* cnt = F.ctl + CW_CNT + layer * 32 * 64;
    const float* rbias = F.in[12];
    f32x4 gv[4], bv[4];
#pragma unroll
    for (int j = 0; j < 4; ++j) { gv[j] = *((const f32x4*)lg + F.lane + 64 * j); bv[j] = *((const f32x4*)lb + F.lane + 64 * j); }
    for (int m = gwv; m < M; m += NGW) {
        f32x4* orow = (f32x4*)(F.out + (size_t)m * D) + F.lane;
        f32x4 v[4]; float s = 0.f;
#pragma unroll
        for (int j = 0; j < 4; ++j) v[j] = orow[64 * j];
        if (MODE == 1) {
            const float g0 = GATEV[2 * m], g1 = GATEV[2 * m + 1];
            const u32x2* y0 = (const u32x2*)(YB + (size_t)(2 * m) * D) + F.lane; const u32x2* y1 = (const u32x2*)(YB + (size_t)(2 * m + 1) * D) + F.lane;
#pragma unroll
            for (int j = 0; j < 4; ++j) { const u32x2 a = y0[64 * j], b = y1[64 * j];
                v[j].x = ALPHA * v[j].x + g0 * bflo(a.x) + g1 * bflo(b.x); v[j].y = ALPHA * v[j].y + g0 * bfhi(a.x) + g1 * bfhi(b.x);
                v[j].z = ALPHA * v[j].z + g0 * bflo(a.y) + g1 * bflo(b.y); v[j].w = ALPHA * v[j].w + g0 * bfhi(a.y) + g1 * bfhi(b.y); }
        }
#pragma unroll
        for (int j = 0; j < 4; ++j) s += (v[j].x + v[j].y) + (v[j].z + v[j].w);
        const float mean = wave_sum(s) * (1.f / D); float s2 = 0.f;
#pragma unroll
        for (int j = 0; j < 4; ++j) { v[j] = v[j] - mean; s2 += (v[j].x * v[j].x + v[j].y * v[j].y) + (v[j].z * v[j].z + v[j].w * v[j].w); }
        const float rstd = 1.f / sqrtf(wave_sum(s2) * (1.f / D) + LN_EPS);
#pragma unroll
        for (int j = 0; j < 4; ++j) { v[j] = v[j] * rstd * gv[j] + bv[j]; orow[64 * j] = v[j]; }
        if (WRITE_XB) { unsigned long long* o8 = (unsigned long long*)(XB + (size_t)m * D) + F.lane;
#pragma unroll
            for (int j = 0; j < 4; ++j) o8[64 * j] = (unsigned long long)pk2(v[j].x, v[j].y) | ((unsigned long long)pk2(v[j].z, v[j].w) << 32); }
        if (ROUTE) {
            float mylog = 0.f;
#pragma unroll 2
            for (int e = 0; e < 32; ++e) { float a = 0.f;
#pragma unroll
                for (int j = 0; j < 4; ++j) { const f32x4 w = *(const LAS f32x4*)(rwT + e * 1024 + 4 * F.lane + 256 * j); a += v[j].x * w.x + v[j].y * w.y + v[j].z * w.z + v[j].w * w.w; }
                a = wave_sum(a); mylog = (F.lane == e) ? a : mylog; }
            const float myaff = 1.f / (1.f + expf(-mylog)), mysel = myaff + rbias[F.lane & 31];
            float m1 = -1e30f, m2 = -1e30f; int i1 = 0, i2 = 0; float a1 = 0.f, a2 = 0.f;
            const int gbase = F.lane & 24;
#pragma unroll
            for (int j = 0; j < 8; ++j) { const float sv = __shfl(mysel, gbase + j), av = __shfl(myaff, gbase + j);
                if (sv > m1) { m2 = m1; i2 = i1; a2 = a1; m1 = sv; i1 = gbase + j; a1 = av; }
                else if (sv > m2) { m2 = sv; i2 = gbase + j; a2 = av; } }
            const float score = m1 + m2;
            float bestscore = -1e30f; int bg = 0;
#pragma unroll
            for (int g = 0; g < 4; ++g) { const float sg = __shfl(score, 8 * g); if (sg > bestscore) { bestscore = sg; bg = g; } }
            const int bi0 = __shfl(i1, 8 * bg), bi1 = __shfl(i2, 8 * bg); const float ba0 = __shfl(a1, 8 * bg), ba1 = __shfl(a2, 8 * bg);
            if (F.lane == 0) {
                const float inv = 1.f / (ba0 + ba1);
                EIDX[2 * m] = bi0; EIDX[2 * m + 1] = bi1; GATEV[2 * m] = ba0 * inv; GATEV[2 * m + 1] = ba1 * inv;
                const unsigned p0 = __hip_atomic_fetch_add(cnt + bi0 * 64, 1u, RLX_AGENT); LIST[bi0 * M + p0] = 2 * m;
                const unsigned p1 = __hip_atomic_fetch_add(cnt + bi1 * 64, 1u, RLX_AGENT); LIST[bi1 * M + p1] = 2 * m + 1;
            }
        }
    }
}

struct ExpertMap { int cnt[32]; };
__device__ __forceinline__ int moe_find(Frame& F, int layer, int unit_rows, int per_row_tiles, int t, int& e_out, int& mb_out, int& nb_out, int& hb_out, int& cnt_out) {
    const unsigned* cnt = F.ctl + CW_CNT + layer * 32 * 64;
    int base = 0, hb = 0;
    for (int e = 0; e < 32; ++e) {
        const int c = (int)cnt[e * 64]; const int nmb = (c + unit_rows - 1) / unit_rows; const int nt = nmb * per_row_tiles;
        if (t < base + nt) { const int r = t - base; e_out = e; mb_out = r / per_row_tiles; nb_out = r % per_row_tiles; hb_out = hb; cnt_out = c; return 1; }
        base += nt; hb += ((c + 255) >> 8) << 8;
    }
    return 0;
}
__device__ __forceinline__ void ph_moe1_naive(Frame& F, int layer) {
    LAS float* sA = (LAS float*)F.lds; LAS float* sB = sA + 128 * 33;
    const bf16* XB = (const bf16*)(F.ws + WS_XB); bf16* HID = (bf16*)(F.ws + WS_HID); const int* LIST = (const int*)(F.ws + WS_LIST);
    const int tx = F.tid & 15, ty = F.tid >> 4;
    for (int t = blockIdx.x;; t += F.G) {
        int e, mb, nb, hb, c; if (!moe_find(F, layer, 128, 4, t, e, mb, nb, hb, c)) break;
        const bf16* GU = (const bf16*)(F.ws + WS_EW + (size_t)e * EW_STRIDE);
        const int j0 = nb * 64, rg = (j0 >> 7) * 256 + (j0 & 127);
        auto rowA = [&](int r) -> const bf16* { const int i = mb * 128 + r; return i < c ? XB + (size_t)(LIST[e * M + i] >> 1) * D : (const bf16*)nullptr; };
        float ag[4][4], au[4][4];
        ngemm_tile(sA, sB, rowA, GU + (size_t)rg * D, D, D, ag);
        ngemm_tile(sA, sB, rowA, GU + (size_t)(rg + 128) * D, D, D, au);
#pragma unroll
        for (int i = 0; i < 4; ++i) { const int ri = mb * 128 + ty * 4 + i;
            if (ri < c) { u32x2 o; o.x = pk2(siluf_(ag[i][0]) * au[i][0], siluf_(ag[i][1]) * au[i][1]); o.y = pk2(siluf_(ag[i][2]) * au[i][2], siluf_(ag[i][3]) * au[i][3]);
                *(u32x2*)(HID + (size_t)(hb + ri) * DE + j0 + tx * 4) = o; } }
    }
}
__device__ __forceinline__ void ph_moe2_naive(Frame& F, int layer) {
    LAS float* sA = (LAS float*)F.lds; LAS float* sB = sA + 128 * 33;
    const bf16* HID = (const bf16*)(F.ws + WS_HID); bf16* YB = (bf16*)(F.ws + WS_YB); const int* LIST = (const int*)(F.ws + WS_LIST);
    const int tx = F.tid & 15, ty = F.tid >> 4;
    for (int t = blockIdx.x;; t += F.G) {
        int e, mb, nb, hb, c; if (!moe_find(F, layer, 128, 16, t, e, mb, nb, hb, c)) break;
        const bf16* DN = (const bf16*)(F.ws + WS_EW + (size_t)e * EW_STRIDE + EW_DN);
        auto rowA = [&](int r) -> const bf16* { const int i = mb * 128 + r; return i < c ? HID + (size_t)(hb + i) * DE : (const bf16*)nullptr; };
        float acc[4][4];
        ngemm_tile(sA, sB, rowA, DN + (size_t)(nb * 64) * DE, DE, DE, acc);
#pragma unroll
        for (int i = 0; i < 4; ++i) { const int ri = mb * 128 + ty * 4 + i;
            if (ri < c) { const int a = LIST[e * M + ri]; u32x2 o; o.x = pk2(acc[i][0], acc[i][1]); o.y = pk2(acc[i][2], acc[i][3]);
                *(u32x2*)(YB + (size_t)a * D + nb * 64 + tx * 4) = o; } }
    }
}

__device__ __forceinline__ void ph_attn_naive(Frame& F) {
    const bf16* P = (const bf16*)(F.ws + WS_P); bf16* OG = (bf16*)(F.ws + WS_OG); float* LSE = (float*)(F.ws + WS_LSE);
    const int total = 3 * M * 8, nth = F.G * NT;
    for (int idx = blockIdx.x * NT + F.tid; idx < total; idx += nth) {
        const int h = idx & 7, m = (idx >> 3) & (M - 1), g = idx >> 17;
        const int t = m & (T - 1), dil = (g == 0) ? 1 : (g == 1 ? 4 : 16);
        const float slope = exp2f(-(float)(h + 1));
        const bf16* qp = P + (size_t)m * IN1 + g * 1536 + h * 64;
        float q[64], o[64];
#pragma unroll
        for (int c = 0; c < 8; ++c) { const u32x4 w = *(const u32x4*)(qp + 8 * c);
            q[8 * c + 0] = bflo(w.x); q[8 * c + 1] = bfhi(w.x); q[8 * c + 2] = bflo(w.y); q[8 * c + 3] = bfhi(w.y); q[8 * c + 4] = bflo(w.z); q[8 * c + 5] = bfhi(w.z); q[8 * c + 6] = bflo(w.w); q[8 * c + 7] = bfhi(w.w); }
#pragma unroll
        for (int d = 0; d < 64; ++d) o[d] = 0.f;
        float mx = -1e30f, den = 0.f;
        for (int j = 0; j <= 128; ++j) {
            const int tk = t - j * dil; if (tk < 0) break;
            const bf16* kp = P + (size_t)(m - j * dil) * IN1 + g * 1536 + 512 + h * 64; const bf16* vp = kp + 512;
            float s = 0.f;
#pragma unroll
            for (int c = 0; c < 8; ++c) { const u32x4 w = *(const u32x4*)(kp + 8 * c);
                s += q[8 * c + 0] * bflo(w.x) + q[8 * c + 1] * bfhi(w.x) + q[8 * c + 2] * bflo(w.y) + q[8 * c + 3] * bfhi(w.y) + q[8 * c + 4] * bflo(w.z) + q[8 * c + 5] * bfhi(w.z) + q[8 * c + 6] * bflo(w.w) + q[8 * c + 7] * bfhi(w.w); }
            s = s * 0.125f - slope * (float)(j * dil);
            const float mn = fmaxf(mx, s), corr = __expf(mx - mn), p = __expf(s - mn);
            den = den * corr + p; mx = mn;
#pragma unroll
            for (int c = 0; c < 8; ++c) { const u32x4 w = *(const u32x4*)(vp + 8 * c);
                o[8 * c + 0] = o[8 * c + 0] * corr + p * bflo(w.x); o[8 * c + 1] = o[8 * c + 1] * corr + p * bfhi(w.x); o[8 * c + 2] = o[8 * c + 2] * corr + p * bflo(w.y); o[8 * c + 3] = o[8 * c + 3] * corr + p * bfhi(w.y);
                o[8 * c + 4] = o[8 * c + 4] * corr + p * bflo(w.z); o[8 * c + 5] = o[8 * c + 5] * corr + p * bfhi(w.z); o[8 * c + 6] = o[8 * c + 6] * corr + p * bflo(w.w); o[8 * c + 7] = o[8 * c + 7] * corr + p * bfhi(w.w); }
        }
        const float inv = 1.f / den;
        bf16* op = OG + ((size_t)g * M + m) * 512 + h * 64;
#pragma unroll
        for (int c = 0; c < 8; ++c) { u32x4 w; w.x = pk2(o[8 * c + 0] * inv, o[8 * c + 1] * inv); w.y = pk2(o[8 * c + 2] * inv, o[8 * c + 3] * inv); w.z = pk2(o[8 * c + 4] * inv, o[8 * c + 5] * inv); w.w = pk2(o[8 * c + 6] * inv, o[8 * c + 7] * inv);
            *(u32x4*)(op + 8 * c) = w; }
        LSE[((size_t)g * M + m) * 8 + h] = mx + __logf(den);
    }
}
__device__ __forceinline__ void ph_merge(Frame& F) {
    const bf16* OG = (const bf16*)(F.ws + WS_OG); const float* LSE = (const float*)(F.ws + WS_LSE); bf16* Y2 = (bf16*)(F.ws + WS_Y2);
    const int total = M * 64, nth = F.G * NT;
    for (int idx = blockIdx.x * NT + F.tid; idx < total; idx += nth) {
        const int m = idx >> 6, c8 = idx & 63, h = c8 >> 3;
        const float l0 = LSE[((size_t)0 * M + m) * 8 + h], l1 = LSE[((size_t)1 * M + m) * 8 + h], l2 = LSE[((size_t)2 * M + m) * 8 + h];
        const float mx = fmaxf(l0, fmaxf(l1, l2)); float w0 = __expf(l0 - mx), w1 = __expf(l1 - mx), w2 = __expf(l2 - mx); const float inv = 1.f / (w0 + w1 + w2);
        w0 *= inv; w1 *= inv; w2 *= inv;
        const u32x4 a = *(const u32x4*)(OG + ((size_t)0 * M + m) * 512 + c8 * 8), b = *(const u32x4*)(OG + ((size_t)1 * M + m) * 512 + c8 * 8), c = *(const u32x4*)(OG + ((size_t)2 * M + m) * 512 + c8 * 8);
        u32x4 o;
        o.x = pk2(w0 * bflo(a.x) + w1 * bflo(b.x) + w2 * bflo(c.x), w0 * bfhi(a.x) + w1 * bfhi(b.x) + w2 * bfhi(c.x));
        o.y = pk2(w0 * bflo(a.y) + w1 * bflo(b.y) + w2 * bflo(c.y), w0 * bfhi(a.y) + w1 * bfhi(b.y) + w2 * bfhi(c.y));
        o.z = pk2(w0 * bflo(a.z) + w1 * bflo(b.z) + w2 * bflo(c.z), w0 * bfhi(a.z) + w1 * bfhi(b.z) + w2 * bfhi(c.z));
        o.w = pk2(w0 * bflo(a.w) + w1 * bflo(b.w) + w2 * bflo(c.w), w0 * bfhi(a.w) + w1 * bfhi(b.w) + w2 * bfhi(c.w));
        *(u32x4*)(Y2 + (size_t)m * 512 + c8 * 8) = o;
    }
}

struct Args { const float* in[18]; float* out; unsigned char* ws; int ph_lo, ph_hi, li, pad; };
__global__ void __launch_bounds__(NT, 2) mega_fwd(Args args) {
    extern __shared__ __attribute__((aligned(16))) unsigned char lds_raw[];
    Frame F;
    F.lds = (LAS unsigned char*)lds_raw;
    F.tid = threadIdx.x; F.lane = F.tid & 63; F.wave = __builtin_amdgcn_readfirstlane(F.tid >> 6);
    F.G = gridDim.x; { const int bx = blockIdx.x; F.vcu = (F.G % 8 == 0) ? (bx % 8) * (F.G / 8) + bx / 8 : bx; }
#pragma unroll
    for (int i = 0; i < 18; ++i) F.in[i] = args.in[i];
    F.out = args.out; F.ws = args.ws; F.ctl = (unsigned*)(args.ws + WS_CTL);
    volatile LAS unsigned* MISC = (volatile LAS unsigned*)(F.lds + LDS_BYTES - 128);
    if (F.tid < 32) MISC[F.tid] = 0u;
    __syncthreads();
    XcdBarrier bar; bar.bar = F.ctl + CW_BAR; bar.x = 0; bar.st = nullptr;
    if (MK_N_LAUNCHES == 1) bar = xcd_barrier_post(F.ctl + CW_BAR, MISC + 8);
    const int lo = args.ph_lo, hi = args.ph_hi;
#define IN(k) (lo <= (k) && (k) < hi)
#define SEAM(k) do { if (IN(k) && IN((k) + 1)) xcd_barrier(bar); } while (0)
    if (IN(0)) { ph0_convert(F); } SEAM(0);
    if (IN(1)) { ph_inproj_naive(F, (const bf16*)(F.ws + WS_WT0), NP0); } SEAM(1);
    if (IN(2)) { ph_conv_naive(F); } SEAM(2);
    if (IN(3)) { ph_recurrent_naive(F); } SEAM(3);
    if (IN(4)) { ph_outproj_naive(F, (const bf16*)(F.ws + WS_Y), D, (const bf16*)(F.ws + WS_WO0), F.in[0]); } SEAM(4);
    if (IN(5)) { convert_experts(F, 0); __syncthreads(); ph_ln<0, true, true>(F, 0); } SEAM(5);
    if (IN(6)) { ph_moe1_naive(F, 0); } SEAM(6);
    if (IN(7)) { ph_moe2_naive(F, 0); } SEAM(7);
    if (IN(8)) { ph_ln<1, false, true>(F, 0); __syncthreads(); convert_experts(F, 1); } SEAM(8);
    if (IN(9)) { ph_inproj_naive(F, (const bf16*)(F.ws + WS_WT1), IN1); } SEAM(9);
    if (IN(10)) { ph_attn_naive(F); } SEAM(10);
    if (IN(11)) { ph_merge(F); } SEAM(11);
    if (IN(12)) { ph_outproj_naive(F, (const bf16*)(F.ws + WS_Y2), 512, (const bf16*)(F.ws + WS_WO1), F.out); } SEAM(12);
    if (IN(13)) { ph_ln<0, true, true>(F, 1); } SEAM(13);
    if (IN(14)) { ph_moe1_naive(F, 1); } SEAM(14);
    if (IN(15)) { ph_moe2_naive(F, 1); } SEAM(15);
    if (IN(16)) { ph_ln<1, false, false>(F, 1); }
#undef IN
#undef SEAM
}

extern "C" void kernel_launch(void* const* d_in, const int* in_sizes, int n_in, void* d_out, int out_size, void* d_ws, size_t ws_size, hipStream_t stream) {
    static int grid = 0;
    if (grid == 0) {
        if (n_in != 18 || in_sizes[0] != M * D || out_size != M * D || ws_size < WS_END) {
            fprintf(stderr, "kernel_launch: unexpected problem (n_in %d, in0 %d, out %d, ws %zu < %zu)\n", n_in, n_in > 0 ? in_sizes[0] : -1, out_size, ws_size, (size_t)WS_END); grid = -1; return; }
        int dev = 0, cus = 0;
        if (hipGetDevice(&dev) != hipSuccess || hipDeviceGetAttribute(&cus, hipDeviceAttributeMultiprocessorCount, dev) != hipSuccess) { grid = -1; return; }
        if (hipFuncSetAttribute((const void*)mega_fwd, hipFuncAttributeMaxDynamicSharedMemorySize, LDS_BYTES) != hipSuccess) { fprintf(stderr, "kernel_launch: hipFuncSetAttribute failed\n"); grid = -1; return; }
        int per_cu = 0;
        if (hipOccupancyMaxActiveBlocksPerMultiprocessor(&per_cu, (const void*)mega_fwd, NT, LDS_BYTES) != hipSuccess || per_cu < 1) fprintf(stderr, "kernel_launch: occupancy query says %d\n", per_cu);
        (void)hipGetLastError();
        grid = cus;
    }
    if (grid < 0) return;
    (void)hipMemsetAsync((char*)d_ws + WS_CTL, 0, CTL_ZERO_BYTES, stream);
    Args a{};
    for (int i = 0; i < 18; ++i) a.in[i] = (const float*)d_in[i];
    a.out = (float*)d_out; a.ws = (unsigned char*)d_ws;
    if (MK_N_LAUNCHES == 1) {
        a.ph_lo = 0; a.ph_hi = N_PHASES; a.li = 0;
        hipLaunchKernelGGL(mega_fwd, dim3(grid), dim3(NT), LDS_BYTES, stream, a);
    } else {
        for (int p = 0; p < N_PHASES; ++p) { a.ph_lo = p; a.ph_hi = p + 1; a.li = p; hipLaunchKernelGGL(mega_fwd, dim3(grid), dim3(NT), LDS_BYTES, stream, a); }
    }
}
```

```cpp
#include <hip/hip_runtime.h>
#include <cstdio>
#include <cstdint>

#ifndef MK_N_LAUNCHES
#define MK_N_LAUNCHES 1
#endif

#define LAS __attribute__((address_space(3)))
typedef unsigned short bf16;
typedef float f32x4 __attribute__((ext_vector_type(4)));
typedef unsigned u32x4 __attribute__((ext_vector_type(4)));
typedef unsigned u32x2 __attribute__((ext_vector_type(2)));
#define RLX_AGENT __ATOMIC_RELAXED, __HIP_MEMORY_SCOPE_AGENT
#define LDS_WAIT() asm volatile("s_waitcnt lgkmcnt(0)" ::: "memory")
#define VM_WAIT() asm volatile("s_waitcnt vmcnt(0)" ::: "memory")

constexpr int NWAVES = 8, NT = NWAVES * 64;
constexpr int BATCH = 2, T = 8192, D = 1024, M = BATCH * T;
constexpr int IN0 = 4104, IN1 = 4608, NP0 = 4096;
constexpr int NE = 32, DE = 256;
constexpr float ALPHA = 1.41421356237309515f;
constexpr float LN_EPS = 1e-5f;
constexpr float KSCALE = 0.08838834764831845f;
constexpr int N_PHASES = 17;

constexpr size_t MiB = 1u << 20;
constexpr size_t WS_CTL = 0, CTL_ZERO_BYTES = 1 * MiB;
constexpr size_t WS_G = 1 * MiB;
constexpr size_t WS_EIDX = WS_G + 512 * 1024;
constexpr size_t WS_GATEV = WS_EIDX + 128 * 1024;
constexpr size_t WS_WT0 = 2 * MiB;
constexpr size_t WS_WO0 = 10 * MiB;
constexpr size_t WS_WT1 = 12 * MiB;
constexpr size_t WS_WO1 = 21 * MiB;
constexpr size_t WS_SE = 22 * MiB;
constexpr size_t WS_EW = WS_SE;
constexpr size_t EW_STRIDE = 3 * MiB / 2, EW_DN = 1 * MiB;
constexpr size_t WS_LIST = WS_SE + 48 * MiB;
constexpr size_t WS_LSE = WS_SE + 50 * MiB;
constexpr size_t WS_XB = 86 * MiB;
constexpr size_t WS_Y = 118 * MiB;
constexpr size_t WS_OG = WS_XB;
constexpr size_t WS_Y2 = WS_XB + 48 * MiB;
constexpr size_t WS_P = 150 * MiB;
constexpr size_t WS_YB = WS_P;
constexpr size_t WS_HID = WS_P + 64 * MiB;
constexpr size_t WS_END = 294 * MiB;
constexpr size_t WS_QKC = WS_SE;

constexpr int CW_BAR = 4096;
constexpr int CW_CNT = 16384;

constexpr int LDS_BYTES = 147456;

__device__ __forceinline__ unsigned f2bf(float f) { unsigned u = __builtin_bit_cast(unsigned, f); return (u + 0x7fffu + ((u >> 16) & 1u)) >> 16; }
__device__ __forceinline__ unsigned pk2(float lo, float hi) { return f2bf(lo) | (f2bf(hi) << 16); }
__device__ __forceinline__ float bf2f(unsigned b) { return __builtin_bit_cast(float, b << 16); }
__device__ __forceinline__ float bflo(unsigned w) { return __builtin_bit_cast(float, w << 16); }
__device__ __forceinline__ float bfhi(unsigned w) { return __builtin_bit_cast(float, w & 0xffff0000u); }
__device__ __forceinline__ float wave_sum(float v) {
#pragma unroll
    for (int o = 1; o < 64; o <<= 1) v += __shfl_xor(v, o);
    return v;
}
__device__ __forceinline__ float sigmoidf_(float x) { return 1.f / (1.f + __expf(-x)); }
__device__ __forceinline__ float siluf_(float x) { return x / (1.f + __expf(-x)); }

#define XB_TMO      128
#define XB_XCNT(j)  (256  + 64 * (j))
#define XB_XSUB(j)  (1280 + 64 * (j))
#define XB_XGEN(j)  (2304 + 64 * (j))
#define XB_TOP      3328
#define XB_TOPGEN   3392
#define XCD_BAR_WORDS 3456
#define XB_SPIN_CAP (1u << 22)
__device__ __forceinline__ unsigned xb_ld(unsigned* p)              { return __hip_atomic_load(p, __ATOMIC_RELAXED, __HIP_MEMORY_SCOPE_AGENT); }
__device__ __forceinline__ unsigned xb_add(unsigned* p, unsigned v) { return __hip_atomic_fetch_add(p, v, __ATOMIC_RELAXED, __HIP_MEMORY_SCOPE_AGENT); }
__device__ __forceinline__ unsigned xb_xcc_id() { return (unsigned)__builtin_amdgcn_s_getreg((3 << 11) | 20) & 0xFu; }
#define XB_SPIN(cond, bar) do { unsigned _sp = 0; while (cond) { __builtin_amdgcn_s_sleep(1); \
    if ((++_sp & 255u) == 0u) { if (xb_ld(&(bar)[XB_TMO])) break; if (_sp > XB_SPIN_CAP) { atomicAdd(&(bar)[XB_TMO], 1u); break; } } } } while (0)
struct XcdBarrier { unsigned* bar; unsigned x; volatile LAS unsigned* st; };
__device__ __forceinline__ XcdBarrier xcd_barrier_post(unsigned* bar, volatile LAS unsigned* st) {
    XcdBarrier b; b.bar = bar; b.x = xb_xcc_id(); b.st = st;
    if (threadIdx.x == 0) (void)xb_add(&bar[XB_XCNT(b.x)], 1u);
    return b;
}
__device__ __forceinline__ void xcd_barrier_complete(unsigned* bar, unsigned x, unsigned& nloc, unsigned& nx) {
    const unsigned G = gridDim.x * gridDim.y * gridDim.z;
    unsigned sum, cnt, mine, sp = 0u;
    for (;;) {
        sum = 0u; cnt = 0u; mine = 0u;
#pragma unroll
        for (unsigned j = 0; j < 16; ++j) { const unsigned c = xb_ld(&bar[XB_XCNT(j)]); sum += c; cnt += (c > 0u) ? 1u : 0u; mine = (j == x) ? c : mine; }
        if (sum == G) break;
        __builtin_amdgcn_s_sleep(1);
        if ((++sp & 255u) == 0u) { if (xb_ld(&bar[XB_TMO])) break; if (sp > XB_SPIN_CAP) { atomicAdd(&bar[XB_TMO], 1u); break; } }
    }
    nloc = mine > 0u ? mine : 1u; nx = cnt > 0u ? cnt : 1u;
}
__device__ __forceinline__ void xcd_barrier(const XcdBarrier& b) {
    asm volatile("s_waitcnt vmcnt(0)" ::: "memory");
    __syncthreads();
    if (threadIdx.x == 0) {
        unsigned* bar = b.bar;
        __builtin_amdgcn_s_waitcnt(0);
        unsigned nloc = b.st[0], nx = b.st[1];
        if (nloc == 0u) { xcd_barrier_complete(bar, b.x, nloc, nx); b.st[0] = nloc; b.st[1] = nx; }
        const unsigned old = xb_add(&bar[XB_XSUB(b.x)], 1u);
        const unsigned gen = old / nloc;
        if (old + 1u == (gen + 1u) * nloc) {
            __builtin_amdgcn_fence(__ATOMIC_RELEASE, "agent");
            asm volatile("s_waitcnt vmcnt(0)" ::: "memory");
            const unsigned og = xb_add(&bar[XB_TOP], 1u);
            const unsigned tg = og / nx;
            if (og + 1u == (tg + 1u) * nx) xb_add(&bar[XB_TOPGEN], 1u);
            else XB_SPIN(xb_ld(&bar[XB_TOPGEN]) == tg, bar);
            __builtin_amdgcn_fence(__ATOMIC_ACQUIRE, "agent");
            xb_add(&bar[XB_XGEN(b.x)], 1u);
            asm volatile("s_waitcnt vmcnt(0)" ::: "memory");
        } else {
            XB_SPIN(xb_ld(&bar[XB_XGEN(b.x)]) == gen, bar);
            __builtin_amdgcn_fence(__ATOMIC_ACQUIRE, "agent");
            asm volatile("s_waitcnt vmcnt(0)" ::: "memory");
        }
    }
    __syncthreads();
}

struct Frame {
    LAS unsigned char* lds;
    unsigned* ctl;
    int tid, lane, wave, vcu, G;
    const float* in[18];
    float* out;
    unsigned char* ws;
};

namespace pg8 {
typedef short bf16x8 __attribute__((ext_vector_type(8)));
constexpr int BM = 256, BK = 64, HALF = 128, HTB = HALF * BK * 2, STAGE_BYTES = 8 * HTB, NXCD = 8, WGM = 8;
__host__ __device__ __forceinline__ int lds_byte(int r, int c) { const int st = (r >> 4) * 2 + (c >> 5), rr = r & 15, cc = c & 31, ob = rr * 64 + cc * 2; return st * 1024 + (ob ^ (((ob >> 9) & 1) << 5)); }
__host__ __device__ __forceinline__ void stage_rc(int b, int& R, int& C) { const int st = b / 1024, sb = b % 1024, swz = sb ^ (((sb >> 9) & 1) << 5); R = (st >> 1) * 16 + swz / 64; C = (st & 1) * 32 + (swz % 64) / 2; }
__host__ __device__ __forceinline__ int perm32(int rho) { const int n = rho >> 4, i = rho & 15; return 8 * (i >> 2) + 4 * n + (i & 3); }
struct Unit { int pm, pn, e, cnt, hb; };
__device__ __forceinline__ unsigned cvt_pk_bf16(float lo, float hi) { unsigned r; asm volatile("v_cvt_pk_bf16_f32 %0, %1, %2" : "=v"(r) : "v"(lo), "v"(hi)); return r; }

struct StaticOrder {
    int nM, nN, nwg, G, c, K; const char* A; const char* Bt;
    __device__ void init(const void* A_, const void* Bt_, int M_, int N_, int K_, int G_, int c_) { A = (const char*)A_; Bt = (const char*)Bt_; nM = M_ / BM; nN = N_ / BM; nwg = nM * nN; G = G_; c = c_; K = K_; }
    __device__ bool next(int i, Unit& u) const {
        const long L = (long)i * G + c; if (L >= nwg) return false;
        int wgid = (int)L; { const int q = nwg / NXCD, r = nwg % NXCD, xcd = wgid % NXCD, off = wgid / NXCD; wgid = (xcd < r ? xcd * (q + 1) : r * (q + 1) + (xcd - r) * q) + off; }
        const int nig = WGM * nN, gid = wgid / nig, fm = gid * WGM, gsz = (nM - fm) < WGM ? (nM - fm) : WGM;
        u.pm = fm + ((wgid % nig) % gsz); u.pn = (wgid % nig) / gsz; u.e = 0; u.cnt = 0; u.hb = 0; return true;
    }
    __device__ __forceinline__ void base(const Unit& u, const char*& cA, const char*& cB) const { cA = A + (size_t)u.pm * BM * K * 2; cB = Bt + (size_t)u.pn * BM * K * 2; }
    __device__ __forceinline__ unsigned rowoff(const Unit&, int) const { return 0u; }
};

struct EpiBf16 {
    static constexpr bool PERM = true;
    bf16* O; int ldc;
    __device__ __forceinline__ void operator()(const f32x4 (&acc)[2][2][4][2], const Unit& u, int wr, int wc, int fr, int fq) const {
        const int row0 = u.pm * BM + wr * 64 + fr, col0 = u.pn * BM + wc * 32 + 8 * fq;
#pragma unroll
        for (int ai = 0; ai < 2; ++ai)
#pragma unroll
            for (int m = 0; m < 4; ++m) { bf16* rowp = O + (size_t)(row0 + ai * HALF + m * 16) * ldc + col0;
#pragma unroll
                for (int bj = 0; bj < 2; ++bj) { const f32x4 v0 = acc[ai][bj][m][0], v1 = acc[ai][bj][m][1];
                    u32x4 w; w.x = cvt_pk_bf16(v0[0], v0[1]); w.y = cvt_pk_bf16(v0[2], v0[3]); w.z = cvt_pk_bf16(v1[0], v1[1]); w.w = cvt_pk_bf16(v1[2], v1[3]);
                    *(u32x4*)(rowp + bj * HALF) = w; } }
    }
};
struct EpiResF32 {
    static constexpr bool PERM = false;
    const float* base; float* out; float alpha;
    __device__ __forceinline__ void operator()(const f32x4 (&acc)[2][2][4][2], const Unit& u, int wr, int wc, int fr, int fq) const {
        const int col0 = u.pn * BM + wc * 32 + 4 * fq;
#pragma unroll
        for (int ai = 0; ai < 2; ++ai)
#pragma unroll
            for (int m = 0; m < 4; ++m) { const size_t off = (size_t)(u.pm * BM + ai * HALF + wr * 64 + m * 16 + fr) * 1024 + col0;
#pragma unroll
                for (int bj = 0; bj < 2; ++bj)
#pragma unroll
                    for (int n = 0; n < 2; ++n) { const f32x4 b = *(const f32x4*)(base + off + bj * HALF + n * 16); *(f32x4*)(out + off + bj * HALF + n * 16) = b * alpha + acc[ai][bj][m][n]; } }
    }
};

template <class Epi, class Sched, bool ALIGN_EPI, bool GATHER>
__device__ __forceinline__ void gemm_phase(LAS unsigned char* lds, const int K, const Sched& S, const Epi& E) {
    const int tid = threadIdx.x, wid = __builtin_amdgcn_readfirstlane(tid >> 6), lane = tid & 63, wr = wid >> 2, wc = wid & 3, fr = lane & 15, fq = lane >> 4;
    const int nt = K / BK;
    int Rr[2], Cc[2]; unsigned voffB[2];
#pragma unroll
    for (int i = 0; i < 2; ++i) { int R, C; stage_rc(tid * 16 + i * 8192, R, C); const int Rb = Epi::PERM ? ((R & ~31) + perm32(R & 31)) : R; Rr[i] = R; Cc[i] = C; voffB[i] = (unsigned)(Rb * K + C) * 2u; }
    const size_t kstep = (size_t)(BK * 2);
    const size_t hstep = (size_t)HALF * K * 2;
    const unsigned ldsw = (unsigned)wid * 1024u;
    const int aoff = lds_byte(wr * 64 + fr, fq * 8), boff = lds_byte(wc * 32 + fr, fq * 8);
#define PG8_SA(b, h) (((b) * 2 + (h)) * HTB)
#define PG8_SB(b, h) ((4 + (b) * 2 + (h)) * HTB)
#define PG8_STAGE(bufoff, gbase, voff) do { _Pragma("unroll") for (int _i = 0; _i < 2; ++_i) \
        __builtin_amdgcn_global_load_lds((const unsigned*)((const char*)(gbase) + (voff)[_i]), (LAS unsigned*)(lds + (bufoff) + ldsw + _i * 8192), 16, 0, 0); } while (0)
#define PG8_STAGE_A(bufoff, gbase, o0, o1) do { \
        __builtin_amdgcn_global_load_lds((const unsigned*)((const char*)(gbase) + (o0)), (LAS unsigned*)(lds + (bufoff) + ldsw), 16, 0, 0); \
        __builtin_amdgcn_global_load_lds((const unsigned*)((const char*)(gbase) + (o1)), (LAS unsigned*)(lds + (bufoff) + ldsw + 8192), 16, 0, 0); } while (0)
#define PG8_LDA(dst, b, h) do { _Pragma("unroll") for (int m = 0; m < 4; ++m) _Pragma("unroll") for (int k = 0; k < 2; ++k) dst[m][k] = *(const LAS bf16x8*)(lds + PG8_SA(b, h) + aoff + m * 2048 + k * 1024); } while (0)
#define PG8_LDB(dst, b, h) do { _Pragma("unroll") for (int n = 0; n < 2; ++n) _Pragma("unroll") for (int k = 0; k < 2; ++k) dst[n][k] = *(const LAS bf16x8*)(lds + PG8_SB(b, h) + boff + n * 2048 + k * 1024); } while (0)
#define PG8_MMA(ai, bj, At, Bt) do { __builtin_amdgcn_s_setprio(1); _Pragma("unroll") for (int m = 0; m < 4; ++m) _Pragma("unroll") for (int n = 0; n < 2; ++n) _Pragma("unroll") for (int k = 0; k < 2; ++k) \
        acc[ai][bj][m][n] = __builtin_amdgcn_mfma_f32_16x16x32_bf16(Bt[n][k], At[m][k], acc[ai][bj][m][n], 0, 0, 0); __builtin_amdgcn_s_setprio(0); } while (0)
#define PG8_WAIT_V(n) asm volatile("s_waitcnt vmcnt(" #n ")" ::: "memory")
#define PG8_WAIT_L(n) asm volatile("s_waitcnt lgkmcnt(" #n ")" ::: "memory")
#define PG8_BAR __builtin_amdgcn_s_barrier()
#define PG8_SCHED __builtin_amdgcn_sched_barrier(0)
#define PG8_CALC_VA(u, v) do { _Pragma("unroll") for (int _h = 0; _h < 2; ++_h) _Pragma("unroll") for (int _i = 0; _i < 2; ++_i) \
        v[_h][_i] = GATHER ? (S.rowoff(u, _h * HALF + Rr[_i]) + (unsigned)Cc[_i] * 2u) : (unsigned)((_h * HALF + Rr[_i]) * K + Cc[_i]) * 2u; } while (0)
    Unit cur, nxt; int ui = 0;
    if (!S.next(0, cur)) return;
    f32x4 acc[2][2][4][2];
#pragma unroll
    for (int a = 0; a < 2; ++a)
#pragma unroll
        for (int b = 0; b < 2; ++b)
#pragma unroll
            for (int m = 0; m < 4; ++m)
#pragma unroll
                for (int n = 0; n < 2; ++n) acc[a][b][m][n] = (f32x4){0.f, 0.f, 0.f, 0.f};
    bf16x8 At[4][2], B0[2][2], B1[2][2];
    const char* cA; const char* cB; S.base(cur, cA, cB);
    unsigned cvA[2][2], nvA[2][2];
    PG8_CALC_VA(cur, cvA);
    PG8_STAGE(PG8_SB(0, 0), cB, voffB); PG8_STAGE(PG8_SB(0, 1), cB + hstep, voffB); PG8_STAGE_A(PG8_SA(0, 0), cA, cvA[0][0], cvA[0][1]); PG8_STAGE_A(PG8_SA(0, 1), cA, cvA[1][0], cvA[1][1]);
    if (wr == 1) PG8_BAR;
    PG8_WAIT_V(2); PG8_BAR;
    PG8_STAGE(PG8_SB(1, 0), cB + kstep, voffB); PG8_STAGE_A(PG8_SA(1, 0), cA + kstep, cvA[0][0], cvA[0][1]); PG8_STAGE(PG8_SB(1, 1), cB + hstep + kstep, voffB);
    PG8_WAIT_V(6); PG8_BAR;
    for (;;) {
        const bool has_next = S.next(ui + 1, nxt);
        const char* nA = cA; const char* nB = cB;
        if (has_next) { S.base(nxt, nA, nB); PG8_CALC_VA(nxt, nvA); }
        else {
#pragma unroll
            for (int h = 0; h < 2; ++h)
#pragma unroll
                for (int i = 0; i < 2; ++i) nvA[h][i] = cvA[h][i]; }
        if (GATHER) { asm volatile("s_waitcnt vmcnt(0)" ::: "memory"); asm volatile("" : "+v"(nvA[0][0]), "+v"(nvA[0][1]), "+v"(nvA[1][0]), "+v"(nvA[1][1])); }
        for (int t = 0; t < nt; t += 2) {
            const bool last = (t == nt - 2);
            const char* a1 = cA + (size_t)(t + 1) * kstep;
            const char* a2 = last ? nA : cA + (size_t)(t + 2) * kstep; const char* b2 = last ? nB : cB + (size_t)(t + 2) * kstep;
            const char* a3 = a2 + kstep; const char* b3 = b2 + kstep;
            const unsigned x00 = last ? nvA[0][0] : cvA[0][0], x01 = last ? nvA[0][1] : cvA[0][1], x10 = last ? nvA[1][0] : cvA[1][0], x11 = last ? nvA[1][1] : cvA[1][1];
            PG8_LDB(B0, 0, 0); PG8_LDB(B1, 0, 1); PG8_SCHED; PG8_LDA(At, 0, 0); PG8_STAGE_A(PG8_SA(1, 1), a1, cvA[1][0], cvA[1][1]);
            PG8_WAIT_V(8); PG8_WAIT_L(0); PG8_BAR; PG8_MMA(0, 0, At, B0); PG8_MMA(0, 1, At, B1); PG8_BAR; PG8_SCHED;
            PG8_LDA(At, 0, 1); PG8_STAGE(PG8_SB(0, 0), b2, voffB); PG8_STAGE(PG8_SB(0, 1), b2 + hstep, voffB); PG8_STAGE_A(PG8_SA(0, 0), a2, x00, x01);
            PG8_WAIT_V(8); PG8_WAIT_L(0); PG8_BAR; PG8_MMA(1, 0, At, B0); PG8_MMA(1, 1, At, B1); PG8_BAR; PG8_SCHED;
            PG8_LDB(B0, 1, 0); PG8_LDB(B1, 1, 1); PG8_SCHED; PG8_LDA(At, 1, 0); PG8_STAGE_A(PG8_SA(0, 1), a2, x10, x11);
            PG8_WAIT_V(8); PG8_WAIT_L(0); PG8_BAR; PG8_MMA(0, 0, At, B0); PG8_MMA(0, 1, At, B1); PG8_BAR; PG8_SCHED;
            PG8_LDA(At, 1, 1); PG8_STAGE(PG8_SB(1, 0), b3, voffB); PG8_STAGE(PG8_SB(1, 1), b3 + hstep, voffB); PG8_STAGE_A(PG8_SA(1, 0), a3, x00, x01);
            PG8_WAIT_V(8); PG8_WAIT_L(0); PG8_BAR; PG8_MMA(1, 0, At, B0); PG8_MMA(1, 1, At, B1); PG8_BAR; PG8_SCHED;
        }
        if constexpr (ALIGN_EPI) { if (wr == 0) PG8_BAR; }
        E(acc, cur, wr, wc, fr, fq);
        if (!has_next) break;
#pragma unroll
        for (int a = 0; a < 2; ++a)
#pragma unroll
            for (int b = 0; b < 2; ++b)
#pragma unroll
                for (int m = 0; m < 4; ++m)
#pragma unroll
                    for (int n = 0; n < 2; ++n) acc[a][b][m][n] = (f32x4){0.f, 0.f, 0.f, 0.f};
        cur = nxt; cA = nA; cB = nB; ++ui;
#pragma unroll
        for (int h = 0; h < 2; ++h)
#pragma unroll
            for (int i = 0; i < 2; ++i) cvA[h][i] = nvA[h][i];
        if constexpr (ALIGN_EPI) { if (wr == 1) PG8_BAR; }
    }
    PG8_WAIT_V(0);
    if constexpr (!ALIGN_EPI) { if (wr == 0) PG8_BAR; }
    PG8_BAR;
#undef PG8_SA
#undef PG8_SB
#undef PG8_STAGE
#undef PG8_STAGE_A
#undef PG8_LDA
#undef PG8_LDB
#undef PG8_MMA
#undef PG8_WAIT_V
#undef PG8_WAIT_L
#undef PG8_BAR
#undef PG8_SCHED
#undef PG8_CALC_VA
}
}

template <class RowFn>
__device__ __forceinline__ void ngemm_tile(LAS float* sA, LAS float* sB, RowFn rowA, const bf16* Bt, int ldb, int K, float (&acc)[4][4]) {
    const int tid = threadIdx.x, tx = tid & 15, ty = tid >> 4;
#pragma unroll
    for (int i = 0; i < 4; ++i)
#pragma unroll
        for (int j = 0; j < 4; ++j) acc[i][j] = 0.f;
    const int ar = tid >> 2, ak = (tid & 3) * 8, br = tid >> 3, bk = (tid & 7) * 4;
    const bf16* ap = rowA(ar);
    const bf16* bp = Bt + (size_t)br * ldb;
    for (int k0 = 0; k0 < K; k0 += 32) {
        u32x4 av = (u32x4){0u, 0u, 0u, 0u};
        if (ap) av = *(const u32x4*)(ap + k0 + ak);
        const u32x2 bv = *(const u32x2*)(bp + k0 + bk);
        __syncthreads();
        LAS float* wa = sA + ar * 33 + ak;
        wa[0] = bflo(av.x); wa[1] = bfhi(av.x); wa[2] = bflo(av.y); wa[3] = bfhi(av.y); wa[4] = bflo(av.z); wa[5] = bfhi(av.z); wa[6] = bflo(av.w); wa[7] = bfhi(av.w);
        LAS float* wb = sB + br * 33 + bk;
        wb[0] = bflo(bv.x); wb[1] = bfhi(bv.x); wb[2] = bflo(bv.y); wb[3] = bfhi(bv.y);
        __syncthreads();
#pragma unroll 8
        for (int kk = 0; kk < 32; ++kk) {
            float a[4], b[4];
#pragma unroll
            for (int i = 0; i < 4; ++i) a[i] = sA[(ty * 4 + i) * 33 + kk];
#pragma unroll
            for (int j = 0; j < 4; ++j) b[j] = sB[(tx * 4 + j) * 33 + kk];
#pragma unroll
            for (int i = 0; i < 4; ++i)
#pragma unroll
                for (int j = 0; j < 4; ++j) acc[i][j] = fmaf(a[i], b[j], acc[i][j]);
        }
    }
}

__device__ __forceinline__ void tr_item(const float* W, int ldw, bf16* WT, int ldt, LAS float* scr, int kb, int nb, int lane) {
    const int k0 = 64 * kb, n0 = 32 * nb;
#pragma unroll 8
    for (int i = 0; i < 32; ++i) { const int kk = 2 * i + (lane >> 5); scr[kk * 33 + (lane & 31)] = W[(size_t)(k0 + kk) * ldw + n0 + (lane & 31)]; }
    LDS_WAIT(); asm volatile("" ::: "memory");
    const int c = lane & 7;
#pragma unroll
    for (int j = 0; j < 4; ++j) { const int n = (lane >> 3) + 8 * j; const LAS float* s = scr + (8 * c) * 33 + n;
        u32x4 o; o.x = pk2(s[0 * 33], s[1 * 33]); o.y = pk2(s[2 * 33], s[3 * 33]); o.z = pk2(s[4 * 33], s[5 * 33]); o.w = pk2(s[6 * 33], s[7 * 33]);
        *(u32x4*)(WT + (size_t)(n0 + n) * ldt + k0 + 8 * c) = o; }
    LDS_WAIT(); asm volatile("" ::: "memory");
}

__device__ __forceinline__ void ph0_convert(Frame& F) {
    LAS float* scr = (LAS float*)(F.lds + F.wave * 9216);
    LAS float* gw = (LAS float*)(F.lds + 8 * 9216);
    const float* w0 = F.in[1];
    for (int i = F.tid; i < 8 * 1024; i += NT) { const int j = i >> 10, k = i & 1023; gw[i] = w0[(size_t)k * IN0 + 2048 + j]; }
    __syncthreads();
    const int gwv = F.vcu * NWAVES + F.wave, NGW = F.G * NWAVES;
    bf16* WT0 = (bf16*)(F.ws + WS_WT0); bf16* WO0 = (bf16*)(F.ws + WS_WO0); bf16* WT1 = (bf16*)(F.ws + WS_WT1); bf16* WO1 = (bf16*)(F.ws + WS_WO1);
    constexpr int I0 = 16 * 64, I1 = 16 * 64, I2 = 16 * 32, I3 = 16 * 144, I4 = 8 * 32, NI = I0 + I1 + I2 + I3 + I4;
    for (int it = gwv; it < NI; it += NGW) {
        int r = it;
        if (r < I0) { tr_item(w0, IN0, WT0, 1024, scr, r / 64, r % 64, F.lane); continue; } r -= I0;
        if (r < I1) { tr_item(w0 + 2056, IN0, WT0 + (size_t)2048 * 1024, 1024, scr, r / 64, r % 64, F.lane); continue; } r -= I1;
        if (r < I2) { tr_item(F.in[8], 1024, WO0, 1024, scr, r / 32, r % 32, F.lane); continue; } r -= I2;
        if (r < I3) { tr_item(F.in[9], IN1, WT1, 1024, scr, r / 144, r % 144, F.lane); continue; } r -= I3;
        tr_item(F.in[10], 1024, WO1, 512, scr, r / 32, r % 32, F.lane);
    }
    const float* x = F.in[0]; bf16* XB = (bf16*)(F.ws + WS_XB); float* G = (float*)(F.ws + WS_G);
    const float* ib = F.in[2]; const float* fb = F.in[3];
    for (int m = gwv; m < M; m += NGW) {
        const f32x4* xr = (const f32x4*)(x + (size_t)m * D) + F.lane;
        f32x4 v[4];
#pragma unroll
        for (int j = 0; j < 4; ++j) v[j] = xr[64 * j];
        unsigned long long* o8 = (unsigned long long*)(XB + (size_t)m * D) + F.lane;
#pragma unroll
        for (int j = 0; j < 4; ++j) o8[64 * j] = (unsigned long long)pk2(v[j].x, v[j].y) | ((unsigned long long)pk2(v[j].z, v[j].w) << 32);
        float acc[8];
#pragma unroll
        for (int g = 0; g < 8; ++g) { float a = 0.f;
#pragma unroll
            for (int j = 0; j < 4; ++j) { const f32x4 w = *(const LAS f32x4*)(gw + g * 1024 + 4 * F.lane + 256 * j); a += v[j].x * w.x + v[j].y * w.y + v[j].z * w.z + v[j].w * w.w; }
            acc[g] = wave_sum(a); }
        if (F.lane == 0) {
#pragma unroll
            for (int g = 0; g < 4; ++g) G[(size_t)m * 8 + g] = acc[g] + ib[g];
#pragma unroll
            for (int g = 0; g < 4; ++g) { const float z = acc[4 + g] + fb[g]; G[(size_t)m * 8 + 4 + g] = fminf(z, 0.f) - log1pf(__expf(-fabsf(z))); }
        }
    }
}

__device__ __forceinline__ void convert_experts(Frame& F, int layer) {
    LAS float* scr = (LAS float*)(F.lds + F.wave * 9216);
    const int gwv = F.vcu * NWAVES + F.wave, NGW = F.G * NWAVES;
    const float* wg = F.in[13] + (size_t)layer * NE * D * DE; const float* wu = F.in[14] + (size_t)layer * NE * D * DE; const float* wd = F.in[15] + (size_t)layer * NE * DE * D;
    for (int it = gwv; it < NE * 384; it += NGW) {
        const int e = it / 384; int r = it % 384;
        bf16* GU = (bf16*)(F.ws + WS_EW + (size_t)e * EW_STRIDE); bf16* DN = (bf16*)(F.ws + WS_EW + (size_t)e * EW_STRIDE + EW_DN);
        if (r < 256) { const int job = r >> 6, q = r & 63;
            const float* src = ((job < 2) ? wg : wu) + (size_t)e * D * DE + (job & 1) * 128;
            bf16* dst = GU + (size_t)((job & 1) * 256 + (job >> 1) * 128) * 1024;
            tr_item(src, DE, dst, 1024, scr, q >> 2, q & 3, F.lane);
        } else { r -= 256;
            tr_item(wd + (size_t)e * DE * D, D, DN, DE, scr, r >> 5, r & 31, F.lane); }
    }
}

__device__ __forceinline__ void ph_inproj_naive(Frame& F, const bf16* Bt, int N) {
    LAS float* sA = (LAS float*)F.lds; LAS float* sB = sA + 128 * 33;
    const bf16* XB = (const bf16*)(F.ws + WS_XB); bf16* P = (bf16*)(F.ws + WS_P);
    const int nnb = N / 64, ntiles = (M / 128) * nnb, tx = F.tid & 15, ty = F.tid >> 4;
    for (int t = blockIdx.x; t < ntiles; t += F.G) {
        const int mb = t / nnb, nb = t % nnb; float acc[4][4];
        ngemm_tile(sA, sB, [&](int r) { return XB + (size_t)(mb * 128 + r) * D; }, Bt + (size_t)nb * 64 * D, D, D, acc);
#pragma unroll
        for (int i = 0; i < 4; ++i) { u32x2 o; o.x = pk2(acc[i][0], acc[i][1]); o.y = pk2(acc[i][2], acc[i][3]);
            *(u32x2*)(P + (size_t)(mb * 128 + ty * 4 + i) * N + nb * 64 + tx * 4) = o; }
    }
}
__device__ __forceinline__ void ph_outproj_naive(Frame& F, const bf16* A, int K, const bf16* Bt, const float* base) {
    LAS float* sA = (LAS float*)F.lds; LAS float* sB = sA + 128 * 33;
    const int nnb = D / 64, ntiles = (M / 128) * nnb, tx = F.tid & 15, ty = F.tid >> 4;
    for (int t = blockIdx.x; t < ntiles; t += F.G) {
        const int mb = t / nnb, nb = t % nnb; float acc[4][4];
        ngemm_tile(sA, sB, [&](int r) { return A + (size_t)(mb * 128 + r) * K; }, Bt + (size_t)nb * 64 * K, K, K, acc);
#pragma unroll
        for (int i = 0; i < 4; ++i) { const size_t off = (size_t)(mb * 128 + ty * 4 + i) * D + nb * 64 + tx * 4;
            const f32x4 b = *(const f32x4*)(base + off);
            *(f32x4*)(F.out + off) = (f32x4){ALPHA * b.x + acc[i][0], ALPHA * b.y + acc[i][1], ALPHA * b.z + acc[i][2], ALPHA * b.w + acc[i][3]}; }
    }
}

__device__ __forceinline__ void ph_conv_naive(Frame& F) {
    const bf16* P = (const bf16*)(F.ws + WS_P); bf16* QKC = (bf16*)(F.ws + WS_QKC);
    const float* cw = F.in[4]; const float* cb = F.in[5];
    const size_t total = (size_t)M * 1024, nth = (size_t)F.G * NT;
    for (size_t i = (size_t)blockIdx.x * NT + F.tid; i < total; i += nth) {
        const int m = (int)(i >> 10), c = (int)(i & 1023), t = m & (T - 1);
        float a = cb[c];
#pragma unroll
        for (int j = 0; j < 4; ++j) { const int tt = t - 3 + j; if (tt >= 0) a += cw[j * 1024 + c] * bf2f(P[(size_t)(m - 3 + j) * NP0 + c]); }
        QKC[i] = (bf16)f2bf(siluf_(a));
    }
}
__device__ __forceinline__ void ph_recurrent_naive(Frame& F) {
    if (blockIdx.x >= 16) return;
    const int type = blockIdx.x >> 3, b = (blockIdx.x >> 2) & 1, h = blockIdx.x & 3;
    LAS float* sin = (LAS float*)F.lds;
    LAS float* red = sin + 1024;
    LAS float* redd = red + 512;
    LAS float* sc = redd + 4;
    const bf16* P = (const bf16*)(F.ws + WS_P); const bf16* QKC = (const bf16*)(F.ws + WS_QKC); const float* G = (const float*)(F.ws + WS_G);
    bf16* Y = (bf16*)(F.ws + WS_Y);
    const float* gain = (type == 0 ? F.in[6] : F.in[7]) + h * 128;
    const int e = F.tid & 127, dg = F.tid >> 7, which = dg;
    const float gamma = 1.f - exp2f(-5.f - (float)h);
    float C[32], nn[32];
#pragma unroll
    for (int j = 0; j < 32; ++j) { C[j] = 0.f; nn[j] = 0.f; }
    const bf16* src; size_t stride;
    if (type == 0) { if (which < 2) { src = QKC + which * 512 + h * 128 + e; stride = 1024; } else { src = P + 1024 + (which - 2) * 512 + h * 128 + e; stride = NP0; } }
    else { src = P + 2048 + which * 512 + h * 128 + e; stride = NP0; }
    const float mul = (which == 1) ? KSCALE : 1.f;
    const size_t m0 = (size_t)b * T;
    float val = bf2f(src[m0 * stride]) * mul;
    float s0 = 0.f, s1 = 0.f;
    if (F.tid == 0) { if (type == 0) { s0 = __expf(G[m0 * 8 + 4 + h]); s1 = __expf(G[m0 * 8 + h]); } else { s0 = gamma; s1 = 1.f; } }
    for (int t = 0; t < T; ++t) {
        const size_t m = m0 + t; const int pb = t & 1;
        sin[pb * 512 + F.tid] = val;
        if (F.tid == 0) { sc[pb * 2] = s0; sc[pb * 2 + 1] = s1; }
        if (t + 1 < T) { val = bf2f(src[(m + 1) * stride]) * mul;
            if (F.tid == 0 && type == 0) { s0 = __expf(G[(m + 1) * 8 + 4 + h]); s1 = __expf(G[(m + 1) * 8 + h]); } }
        __syncthreads();
        const float f = sc[pb * 2], ig = sc[pb * 2 + 1];
        const LAS float* sq = sin + pb * 512; const LAS float* sk = sq + 128; const LAS float* sv = sq + 256; const LAS float* so = sq + 384;
        const float ve = sv[e] * ig;
        float pn = 0.f, pd = 0.f;
#pragma unroll
        for (int j = 0; j < 32; ++j) { const int d = dg * 32 + j; const float kd = sk[d], qd = sq[d];
            C[j] = fmaf(f, C[j], kd * ve); nn[j] = fmaf(f, nn[j], ig * kd); pn = fmaf(C[j], qd, pn); pd = fmaf(nn[j], qd, pd); }
        red[dg * 128 + e] = pn; if (e == 0) redd[dg] = pd;
        __syncthreads();
        if (F.tid < 64) {
            const int e0 = F.tid, e1 = F.tid + 64;
            float h0 = (red[e0] + red[128 + e0]) + (red[256 + e0] + red[384 + e0]);
            float h1 = (red[e1] + red[128 + e1]) + (red[256 + e1] + red[384 + e1]);
            if (type == 0) { const float den = (redd[0] + redd[1]) + (redd[2] + redd[3]); const float dn = fmaxf(fabsf(den), 1.f);
                h0 = h0 / dn * sigmoidf_(so[e0]); h1 = h1 / dn * sigmoidf_(so[e1]); }
            const float mean = wave_sum(h0 + h1) * (1.f / 128.f); const float d0 = h0 - mean, d1 = h1 - mean;
            const float rstd = 1.f / sqrtf(wave_sum(d0 * d0 + d1 * d1) * (1.f / 128.f) + LN_EPS);
            float y0 = d0 * rstd * gain[e0], y1 = d1 * rstd * gain[e1];
            if (type == 1) { y0 *= siluf_(so[e0]); y1 *= siluf_(so[e1]); }
            Y[m * 1024 + type * 512 + h * 128 + e0] = (bf16)f2bf(y0); Y[m * 1024 + type * 512 + h * 128 + e1] = (bf16)f2bf(y1);
        }
    }
}

template <int MODE, bool ROUTE, bool WRITE_XB>
__device__ __forceinline__ void ph_ln(Frame& F, int layer) {
    LAS float* rwT = (LAS float*)F.lds;
    if (ROUTE) { const float* rw = F.in[11]; for (int i = F.tid; i < 32 * 1024; i += NT) { const int e = i >> 10, k = i & 1023; rwT[i] = rw[(size_t)k * 32 + e]; } __syncthreads(); }
    const int gwv = F.vcu * NWAVES + F.wave, NGW = F.G * NWAVES;
    const float* lg = F.in[16] + (size_t)(layer * 2 + MODE) * D; const float* lb = F.in[17] + (size_t)(layer * 2 + MODE) * D;
    bf16* XB = (bf16*)(F.ws + WS_XB); const bf16* YB = (const bf16*)(F.ws + WS_YB);
    int* EIDX = (int*)(F.ws + WS_EIDX); float* GATEV = (float*)(F.ws + WS_GATEV); int* LIST = (int*)(F.ws + WS_LIST);
    unsigned* cnt = F.ctl + CW_CNT + layer * 32 * 64;
    const float* rbias = F.in[12];
    f32x4 gv[4], bv[4];
#pragma unroll
    for (int j = 0; j < 4; ++j) { gv[j] = *((const f32x4*)lg + F.lane + 64 * j); bv[j] = *((const f32x4*)lb + F.lane + 64 * j); }
    for (int m = gwv; m < M; m += NGW) {
        f32x4* orow = (f32x4*)(F.out + (size_t)m * D) + F.lane;
        f32x4 v[4]; float s = 0.f;
#pragma unroll
        for (int j = 0; j < 4; ++j) v[j] = orow[64 * j];
        if (MODE == 1) {
            const float g0 = GATEV[2 * m], g1 = GATEV[2 * m + 1];
            const u32x2* y0 = (const u32x2*)(YB + (size_t)(2 * m) * D) + F.lane; const u32x2* y1 = (const u32x2*)(YB + (size_t)(2 * m + 1) * D) + F.lane;
#pragma unroll
            for (int j = 0; j < 4; ++j) { const u32x2 a = y0[64 * j], b = y1[64 * j];
                v[j].x = ALPHA * v[j].x + g0 * bflo(a.x) + g1 * bflo(b.x); v[j].y = ALPHA * v[j].y + g0 * bfhi(a.x) + g1 * bfhi(b.x);
                v[j].z = ALPHA * v[j].z + g0 * bflo(a.y) + g1 * bflo(b.y); v[j].w = ALPHA * v[j].w + g0 * bfhi(a.y) + g1 * bfhi(b.y); }
        }
#pragma unroll
        for (int j = 0; j < 4; ++j) s += (v[j].x + v[j].y) + (v[j].z + v[j].w);
        const float mean = wave_sum(s) * (1.f / D); float s2 = 0.f;
#pragma unroll
        for (int j = 0; j < 4; ++j) { v[j] = v[j] - mean; s2 += (v[j].x * v[j].x + v[j].y * v[j].y) + (v[j].z * v[j].z + v[j].w * v[j].w); }
        const float rstd = 1.f / sqrtf(wave_sum(s2) * (1.f / D) + LN_EPS);
#pragma unroll
        for (int j = 0; j < 4; ++j) { v[j] = v[j] * rstd * gv[j] + bv[j]; orow[64 * j] = v[j]; }
        if (WRITE_XB) { unsigned long long* o8 = (unsigned long long*)(XB + (size_t)m * D) + F.lane;
#pragma unroll
            for (int j = 0; j < 4; ++j) o8[64 * j] = (unsigned long long)pk2(v[j].x, v[j].y) | ((unsigned long long)pk2(v[j].z, v[j].w) << 32); }
        if (ROUTE) {
            float mylog = 0.f;
#pragma unroll 2
            for (int e = 0; e < 32; ++e) { float a = 0.f;
#pragma unroll
                for (int j = 0; j < 4; ++j) { const f32x4 w = *(const LAS f32x4*)(rwT + e * 1024 + 4 * F.lane + 256 * j); a += v[j].x * w.x + v[j].y * w.y + v[j].z * w.z + v[j].w * w.w; }
                a = wave_sum(a); mylog = (F.lane == e) ? a : mylog; }
            const float myaff = 1.f / (1.f + expf(-mylog)), mysel = myaff + rbias[F.lane & 31];
            float m1 = -1e30f, m2 = -1e30f; int i1 = 0, i2 = 0; float a1 = 0.f, a2 = 0.f;
            const int gbase = F.lane & 24;
#pragma unroll
            for (int j = 0; j < 8; ++j) { const float sv = __shfl(mysel, gbase + j), av = __shfl(myaff, gbase + j);
                if (sv > m1) { m2 = m1; i2 = i1; a2 = a1; m1 = sv; i1 = gbase + j; a1 = av; }
                else if (sv > m2) { m2 = sv; i2 = gbase + j; a2 = av; } }
            const float score = m1 + m2;
            float bestscore = -1e30f; int bg = 0;
#pragma unroll
            for (int g = 0; g < 4; ++g) { const float sg = __shfl(score, 8 * g); if (sg > bestscore) { bestscore = sg; bg = g; } }
            const int bi0 = __shfl(i1, 8 * bg), bi1 = __shfl(i2, 8 * bg); const float ba0 = __shfl(a1, 8 * bg), ba1 = __shfl(a2, 8 * bg);
            if (F.lane == 0) {
                const float inv = 1.f / (ba0 + ba1);
                EIDX[2 * m] = bi0; EIDX[2 * m + 1] = bi1; GATEV[2 * m] = ba0 * inv; GATEV[2 * m + 1] = ba1 * inv;
                const unsigned p0 = __hip_atomic_fetch_add(cnt + bi0 * 64, 1u, RLX_AGENT); LIST[bi0 * M + p0] = 2 * m;
                const unsigned p1 = __hip_atomic_fetch_add(cnt + bi1 * 64, 1u, RLX_AGENT); LIST[bi1 * M + p1] = 2 * m + 1;
            }
        }
    }
}

struct ExpertMap { int cnt[32]; };
__device__ __forceinline__ int moe_find(Frame& F, int layer, int unit_rows, int per_row_tiles, int t, int& e_out, int& mb_out, int& nb_out, int& hb_out, int& cnt_out) {
    const unsigned* cnt = F.ctl + CW_CNT + layer * 32 * 64;
    int base = 0, hb = 0;
    for (int e = 0; e < 32; ++e) {
        const int c = (int)cnt[e * 64]; const int nmb = (c + unit_rows - 1) / unit_rows; const int nt = nmb * per_row_tiles;
        if (t < base + nt) { const int r = t - base; e_out = e; mb_out = r / per_row_tiles; nb_out = r % per_row_tiles; hb_out = hb; cnt_out = c; return 1; }
        base += nt; hb += ((c + 255) >> 8) << 8;
    }
    return 0;
}
__device__ __forceinline__ void ph_moe1_naive(Frame& F, int layer) {
    LAS float* sA = (LAS float*)F.lds; LAS float* sB = sA + 128 * 33;
    const bf16* XB = (const bf16*)(F.ws + WS_XB); bf16* HID = (bf16*)(F.ws + WS_HID); const int* LIST = (const int*)(F.ws + WS_LIST);
    const int tx = F.tid & 15, ty = F.tid >> 4;
    for (int t = blockIdx.x;; t += F.G) {
        int e, mb, nb, hb, c; if (!moe_find(F, layer, 128, 4, t, e, mb, nb, hb, c)) break;
        const bf16* GU = (const bf16*)(F.ws + WS_EW + (size_t)e * EW_STRIDE);
        const int j0 = nb * 64, rg = (j0 >> 7) * 256 + (j0 & 127);
        auto rowA = [&](int r) -> const bf16* { const int i = mb * 128 + r; return i < c ? XB + (size_t)(LIST[e * M + i] >> 1) * D : (const bf16*)nullptr; };
        float ag[4][4], au[4][4];
        ngemm_tile(sA, sB, rowA, GU + (size_t)rg * D, D, D, ag);
        ngemm_tile(sA, sB, rowA, GU + (size_t)(rg + 128) * D, D, D, au);
#pragma unroll
        for (int i = 0; i < 4; ++i) { const int ri = mb * 128 + ty * 4 + i;
            if (ri < c) { u32x2 o; o.x = pk2(siluf_(ag[i][0]) * au[i][0], siluf_(ag[i][1]) * au[i][1]); o.y = pk2(siluf_(ag[i][2]) * au[i][2], siluf_(ag[i][3]) * au[i][3]);
                *(u32x2*)(HID + (size_t)(hb + ri) * DE + j0 + tx * 4) = o; } }
    }
}
__device__ __forceinline__ void ph_moe2_naive(Frame& F, int layer) {
    LAS float* sA = (LAS float*)F.lds; LAS float* sB = sA + 128 * 33;
    const bf16* HID = (const bf16*)(F.ws + WS_HID); bf16* YB = (bf16*)(F.ws + WS_YB); const int* LIST = (const int*)(F.ws + WS_LIST);
    const int tx = F.tid & 15, ty = F.tid >> 4;
    for (int t = blockIdx.x;; t += F.G) {
        int e, mb, nb, hb, c; if (!moe_find(F, layer, 128, 16, t, e, mb, nb, hb, c)) break;
        const bf16* DN = (const bf16*)(F.ws + WS_EW + (size_t)e * EW_STRIDE + EW_DN);
        auto rowA = [&](int r) -> const bf16* { const int i = mb * 128 + r; return i < c ? HID + (size_t)(hb + i) * DE : (const bf16*)nullptr; };
        float acc[4][4];
        ngemm_tile(sA, sB, rowA, DN + (size_t)(nb * 64) * DE, DE, DE, acc);
#pragma unroll
        for (int i = 0; i < 4; ++i) { const int ri = mb * 128 + ty * 4 + i;
            if (ri < c) { const int a = LIST[e * M + ri]; u32x2 o; o.x = pk2(acc[i][0], acc[i][1]); o.y = pk2(acc[i][2], acc[i][3]);
                *(u32x2*)(YB + (size_t)a * D + nb * 64 + tx * 4) = o; } }
    }
}

__device__ __forceinline__ void ph_attn_naive(Frame& F) {
    const bf16* P = (const bf16*)(F.ws + WS_P); bf16* OG = (bf16*)(F.ws + WS_OG); float* LSE = (float*)(F.ws + WS_LSE);
    const int total = 3 * M * 8, nth = F.G * NT;
    for (int idx = blockIdx.x * NT + F.tid; idx < total; idx += nth) {
        const int h = idx & 7, m = (idx >> 3) & (M - 1), g = idx >> 17;
        const int t = m & (T - 1), dil = (g == 0) ? 1 : (g == 1 ? 4 : 16);
        const float slope = exp2f(-(float)(h + 1));
        const bf16* qp = P + (size_t)m * IN1 + g * 1536 + h * 64;
        float q[64], o[64];
#pragma unroll
        for (int c = 0; c < 8; ++c) { const u32x4 w = *(const u32x4*)(qp + 8 * c);
            q[8 * c + 0] = bflo(w.x); q[8 * c + 1] = bfhi(w.x); q[8 * c + 2] = bflo(w.y); q[8 * c + 3] = bfhi(w.y); q[8 * c + 4] = bflo(w.z); q[8 * c + 5] = bfhi(w.z); q[8 * c + 6] = bflo(w.w); q[8 * c + 7] = bfhi(w.w); }
#pragma unroll
        for (int d = 0; d < 64; ++d) o[d] = 0.f;
        float mx = -1e30f, den = 0.f;
        for (int j = 0; j <= 128; ++j) {
            const int tk = t - j * dil; if (tk < 0) break;
            const bf16* kp = P + (size_t)(m - j * dil) * IN1 + g * 1536 + 512 + h * 64; const bf16* vp = kp + 512;
            float s = 0.f;
#pragma unroll
            for (int c = 0; c < 8; ++c) { const u32x4 w = *(const u32x4*)(kp + 8 * c);
                s += q[8 * c + 0] * bflo(w.x) + q[8 * c + 1] * bfhi(w.x) + q[8 * c + 2] * bflo(w.y) + q[8 * c + 3] * bfhi(w.y) + q[8 * c + 4] * bflo(w.z) + q[8 * c + 5] * bfhi(w.z) + q[8 * c + 6] * bflo(w.w) + q[8 * c + 7] * bfhi(w.w); }
            s = s * 0.125f - slope * (float)(j * dil);
            const float mn = fmaxf(mx, s), corr = __expf(mx - mn), p = __expf(s - mn);
            den = den * corr + p; mx = mn;
#pragma unroll
            for (int c = 0; c < 8; ++c) { const u32x4 w = *(const u32x4*)(vp + 8 * c);
                o[8 * c + 0] = o[8 * c + 0] * corr + p * bflo(w.x); o[8 * c + 1] = o[8 * c + 1] * corr + p * bfhi(w.x); o[8 * c + 2] = o[8 * c + 2] * corr + p * bflo(w.y); o[8 * c + 3] = o[8 * c + 3] * corr + p * bfhi(w.y);
                o[8 * c + 4] = o[8 * c + 4] * corr + p * bflo(w.z); o[8 * c + 5] = o[8 * c + 5] * corr + p * bfhi(w.z); o[8 * c + 6] = o[8 * c + 6] * corr + p * bflo(w.w); o[8 * c + 7] = o[8 * c + 7] * corr + p * bfhi(w.w); }
        }
        const float inv = 1.f / den;
        bf16* op = OG + ((size_t)g * M + m) * 512 + h * 64;
#pragma unroll
        for (int c = 0; c < 8; ++c) { u32x4 w; w.x = pk2(o[8 * c + 0] * inv, o[8 * c + 1] * inv); w.y = pk2(o[8 * c + 2] * inv, o[8 * c + 3] * inv); w.z = pk2(o[8 * c + 4] * inv, o[8 * c + 5] * inv); w.w = pk2(o[8 * c + 6] * inv, o[8 * c + 7] * inv);
            *(u32x4*)(op + 8 * c) = w; }
        LSE[((size_t)g * M + m) * 8 + h] = mx + __logf(den);
    }
}
__device__ __forceinline__ void ph_merge(Frame& F) {
    const bf16* OG = (const bf16*)(F.ws + WS_OG); const float* LSE = (const float*)(F.ws + WS_LSE); bf16* Y2 = (bf16*)(F.ws + WS_Y2);
    const int total = M * 64, nth = F.G * NT;
    for (int idx = blockIdx.x * NT + F.tid; idx < total; idx += nth) {
        const int m = idx >> 6, c8 = idx & 63, h = c8 >> 3;
        const float l0 = LSE[((size_t)0 * M + m) * 8 + h], l1 = LSE[((size_t)1 * M + m) * 8 + h], l2 = LSE[((size_t)2 * M + m) * 8 + h];
        const float mx = fmaxf(l0, fmaxf(l1, l2)); float w0 = __expf(l0 - mx), w1 = __expf(l1 - mx), w2 = __expf(l2 - mx); const float inv = 1.f / (w0 + w1 + w2);
        w0 *= inv; w1 *= inv; w2 *= inv;
        const u32x4 a = *(const u32x4*)(OG + ((size_t)0 * M + m) * 512 + c8 * 8), b = *(const u32x4*)(OG + ((size_t)1 * M + m) * 512 + c8 * 8), c = *(const u32x4*)(OG + ((size_t)2 * M + m) * 512 + c8 * 8);
        u32x4 o;
        o.x = pk2(w0 * bflo(a.x) + w1 * bflo(b.x) + w2 * bflo(c.x), w0 * bfhi(a.x) + w1 * bfhi(b.x) + w2 * bfhi(c.x));
        o.y = pk2(w0 * bflo(a.y) + w1 * bflo(b.y) + w2 * bflo(c.y), w0 * bfhi(a.y) + w1 * bfhi(b.y) + w2 * bfhi(c.y));
        o.z = pk2(w0 * bflo(a.z) + w1 * bflo(b.z) + w2 * bflo(c.z), w0 * bfhi(a.z) + w1 * bfhi(b.z) + w2 * bfhi(c.z));
        o.w = pk2(w0 * bflo(a.w) + w1 * bflo(b.w) + w2 * bflo(c.w), w0 * bfhi(a.w) + w1 * bfhi(b.w) + w2 * bfhi(c.w));
        *(u32x4*)(Y2 + (size_t)m * 512 + c8 * 8) = o;
    }
}

struct Args { const float* in[18]; float* out; unsigned char* ws; int ph_lo, ph_hi, li, pad; };
__global__ void __launch_bounds__(NT, 2) mega_fwd(Args args) {
    extern __shared__ __attribute__((aligned(16))) unsigned char lds_raw[];
    Frame F;
    F.lds = (LAS unsigned char*)lds_raw;
    F.tid = threadIdx.x; F.lane = F.tid & 63; F.wave = __builtin_amdgcn_readfirstlane(F.tid >> 6);
    F.G = gridDim.x; { const int bx = blockIdx.x; F.vcu = (F.G % 8 == 0) ? (bx % 8) * (F.G / 8) + bx / 8 : bx; }
#pragma unroll
    for (int i = 0; i < 18; ++i) F.in[i] = args.in[i];
    F.out = args.out; F.ws = args.ws; F.ctl = (unsigned*)(args.ws + WS_CTL);
    volatile LAS unsigned* MISC = (volatile LAS unsigned*)(F.lds + LDS_BYTES - 128);
    if (F.tid < 32) MISC[F.tid] = 0u;
    __syncthreads();
    XcdBarrier bar; bar.bar = F.ctl + CW_BAR; bar.x = 0; bar.st = nullptr;
    if (MK_N_LAUNCHES == 1) bar = xcd_barrier_post(F.ctl + CW_BAR, MISC + 8);
    const int lo = args.ph_lo, hi = args.ph_hi;
#define IN(k) (lo <= (k) && (k) < hi)
#define SEAM(k) do { if (IN(k) && IN((k) + 1)) xcd_barrier(bar); } while (0)
    if (IN(0)) { ph0_convert(F); } SEAM(0);
    if (IN(1)) { pg8::StaticOrder S; S.init(F.ws + WS_XB, F.ws + WS_WT0, M, NP0, D, F.G, (int)blockIdx.x); pg8::EpiBf16 E{(bf16*)(F.ws + WS_P), NP0};
        pg8::gemm_phase<pg8::EpiBf16, pg8::StaticOrder, true, false>(F.lds, D, S, E); } SEAM(1);
    if (IN(2)) { ph_conv_naive(F); } SEAM(2);
    if (IN(3)) { ph_recurrent_naive(F); } SEAM(3);
    if (IN(4)) { pg8::StaticOrder S; S.init(F.ws + WS_Y, F.ws + WS_WO0, M, D, D, F.G, (int)blockIdx.x); pg8::EpiResF32 E{F.in[0], F.out, ALPHA};
        pg8::gemm_phase<pg8::EpiResF32, pg8::StaticOrder, false, false>(F.lds, D, S, E); } SEAM(4);
    if (IN(5)) { convert_experts(F, 0); __syncthreads(); ph_ln<0, true, true>(F, 0); } SEAM(5);
    if (IN(6)) { ph_moe1_naive(F, 0); } SEAM(6);
    if (IN(7)) { ph_moe2_naive(F, 0); } SEAM(7);
    if (IN(8)) { ph_ln<1, false, true>(F, 0); __syncthreads(); convert_experts(F, 1); } SEAM(8);
    if (IN(9)) { pg8::StaticOrder S; S.init(F.ws + WS_XB, F.ws + WS_WT1, M, IN1, D, F.G, (int)blockIdx.x); pg8::EpiBf16 E{(bf16*)(F.ws + WS_P), IN1};
        pg8::gemm_phase<pg8::EpiBf16, pg8::StaticOrder, true, false>(F.lds, D, S, E); } SEAM(9);
    if (IN(10)) { ph_attn_naive(F); } SEAM(10);
    if (IN(11)) { ph_merge(F); } SEAM(11);
    if (IN(12)) { pg8::StaticOrder S; S.init(F.ws + WS_Y2, F.ws + WS_WO1, M, D, 512, F.G, (int)blockIdx.x); pg8::EpiResF32 E{F.out, F.out, ALPHA};
        pg8::gemm_phase<pg8::EpiResF32, pg8::StaticOrder, false, false>(F.lds, 512, S, E); } SEAM(12);
    if (IN(13)) { ph_ln<0, true, true>(F, 1); } SEAM(13);
    if (IN(14)) { ph_moe1_naive(F, 1); } SEAM(14);
    if (IN(15)) { ph_moe2_naive(F, 1); } SEAM(15);
    if (IN(16)) { ph_ln<1, false, false>(F, 1); }
#undef IN
#undef SEAM
}

extern "C" void kernel_launch(void* const* d_in, const int* in_sizes, int n_in, void* d_out, int out_size, void* d_ws, size_t ws_size, hipStream_t stream) {
    static int grid = 0;
    if (grid == 0) {
        if (n_in != 18 || in_sizes[0] != M * D || out_size != M * D || ws_size < WS_END) {
            fprintf(stderr, "kernel_launch: unexpected problem (n_in %d, in0 %d, out %d, ws %zu < %zu)\n", n_in, n_in > 0 ? in_sizes[0] : -1, out_size, ws_size, (size_t)WS_END); grid = -1; return; }
        int dev = 0, cus = 0;
        if (hipGetDevice(&dev) != hipSuccess || hipDeviceGetAttribute(&cus, hipDeviceAttributeMultiprocessorCount, dev) != hipSuccess) { grid = -1; return; }
        if (hipFuncSetAttribute((const void*)mega_fwd, hipFuncAttributeMaxDynamicSharedMemorySize, LDS_BYTES) != hipSuccess) { fprintf(stderr, "kernel_launch: hipFuncSetAttribute failed\n"); grid = -1; return; }
        int per_cu = 0;
        if (hipOccupancyMaxActiveBlocksPerMultiprocessor(&per_cu, (const void*)mega_fwd, NT, LDS_BYTES) != hipSuccess || per_cu < 1) fprintf(stderr, "kernel_launch: occupancy query says %d\n", per_cu);
        (void)hipGetLastError();
        grid = cus;
    }
    if (grid < 0) return;
    (void)hipMemsetAsync((char*)d_ws + WS_CTL, 0, CTL_ZERO_BYTES, stream);
    Args a{};
    for (int i = 0; i < 18; ++i) a.in[i] = (const float*)d_in[i];
    a.out = (float*)d_out; a.ws = (unsigned char*)d_ws;
    if (MK_N_LAUNCHES == 1) {
        a.ph_lo = 0; a.ph_hi = N_PHASES; a.li = 0;
        hipLaunchKernelGGL(mega_fwd, dim3(grid), dim3(NT), LDS_BYTES, stream, a);
    } else {
        for (int p = 0; p < N_PHASES; ++p) { a.ph_lo = p; a.ph_hi = p + 1; a.li = p; hipLaunchKernelGGL(mega_fwd, dim3(grid), dim3(NT), LDS_BYTES, stream, a); }
    }
}
```

```cpp
#include <hip/hip_runtime.h>
#include <cstdio>
#include <cstdint>

#ifndef MK_N_LAUNCHES
#define MK_N_LAUNCHES 1
#endif

#define LAS __attribute__((address_space(3)))
typedef unsigned short bf16;
typedef float f32x4 __attribute__((ext_vector_type(4)));
typedef unsigned u32x4 __attribute__((ext_vector_type(4)));
typedef unsigned u32x2 __attribute__((ext_vector_type(2)));
#define RLX_AGENT __ATOMIC_RELAXED, __HIP_MEMORY_SCOPE_AGENT
#define LDS_WAIT() asm volatile("s_waitcnt lgkmcnt(0)" ::: "memory")
#define VM_WAIT() asm volatile("s_waitcnt vmcnt(0)" ::: "memory")

constexpr int NWAVES = 8, NT = NWAVES * 64;
constexpr int BATCH = 2, T = 8192, D = 1024, M = BATCH * T;
constexpr int IN0 = 4104, IN1 = 4608, NP0 = 4096;
constexpr int NE = 32, DE = 256;
constexpr float ALPHA = 1.41421356237309515f;
constexpr float LN_EPS = 1e-5f;
constexpr float KSCALE = 0.08838834764831845f;
constexpr int N_PHASES = 17;

constexpr size_t MiB = 1u << 20;
constexpr size_t WS_CTL = 0, CTL_ZERO_BYTES = 1 * MiB;
constexpr size_t WS_G = 1 * MiB;
constexpr size_t WS_EIDX = WS_G + 512 * 1024;
constexpr size_t WS_GATEV = WS_EIDX + 128 * 1024;
constexpr size_t WS_WT0 = 2 * MiB;
constexpr size_t WS_WO0 = 10 * MiB;
constexpr size_t WS_WT1 = 12 * MiB;
constexpr size_t WS_WO1 = 21 * MiB;
constexpr size_t WS_SE = 22 * MiB;
constexpr size_t WS_EW = WS_SE;
constexpr size_t EW_STRIDE = 3 * MiB / 2, EW_DN = 1 * MiB;
constexpr size_t WS_LIST = WS_SE + 48 * MiB;
constexpr size_t WS_LSE = WS_SE + 50 * MiB;
constexpr size_t WS_XB = 86 * MiB;
constexpr size_t WS_Y = 118 * MiB;
constexpr size_t WS_OG = WS_XB;
constexpr size_t WS_Y2 = WS_XB + 48 * MiB;
constexpr size_t WS_P = 150 * MiB;
constexpr size_t WS_YB = WS_P;
constexpr size_t WS_HID = WS_P + 64 * MiB;
constexpr size_t WS_END = 294 * MiB;
constexpr size_t WS_QKC = WS_SE;

constexpr int CW_BAR = 4096;
constexpr int CW_CNT = 16384;

constexpr int LDS_BYTES = 147456;

__device__ __forceinline__ unsigned f2bf(float f) { unsigned u = __builtin_bit_cast(unsigned, f); return (u + 0x7fffu + ((u >> 16) & 1u)) >> 16; }
__device__ __forceinline__ unsigned pk2(float lo, float hi) { return f2bf(lo) | (f2bf(hi) << 16); }
__device__ __forceinline__ float bf2f(unsigned b) { return __builtin_bit_cast(float, b << 16); }
__device__ __forceinline__ float bflo(unsigned w) { return __builtin_bit_cast(float, w << 16); }
__device__ __forceinline__ float bfhi(unsigned w) { return __builtin_bit_cast(float, w & 0xffff0000u); }
__device__ __forceinline__ float wave_sum(float v) {
#pragma unroll
    for (int o = 1; o < 64; o <<= 1) v += __shfl_xor(v, o);
    return v;
}
__device__ __forceinline__ float sigmoidf_(float x) { return 1.f / (1.f + __expf(-x)); }
__device__ __forceinline__ float siluf_(float x) { return x / (1.f + __expf(-x)); }

#define XB_TMO      128
#define XB_XCNT(j)  (256  + 64 * (j))
#define XB_XSUB(j)  (1280 + 64 * (j))
#define XB_XGEN(j)  (2304 + 64 * (j))
#define XB_TOP      3328
#define XB_TOPGEN   3392
#define XCD_BAR_WORDS 3456
#define XB_SPIN_CAP (1u << 22)
__device__ __forceinline__ unsigned xb_ld(unsigned* p)              { return __hip_atomic_load(p, __ATOMIC_RELAXED, __HIP_MEMORY_SCOPE_AGENT); }
__device__ __forceinline__ unsigned xb_add(unsigned* p, unsigned v) { return __hip_atomic_fetch_add(p, v, __ATOMIC_RELAXED, __HIP_MEMORY_SCOPE_AGENT); }
__device__ __forceinline__ unsigned xb_xcc_id() { return (unsigned)__builtin_amdgcn_s_getreg((3 << 11) | 20) & 0xFu; }
#define XB_SPIN(cond, bar) do { unsigned _sp = 0; while (cond) { __builtin_amdgcn_s_sleep(1); \
    if ((++_sp & 255u) == 0u) { if (xb_ld(&(bar)[XB_TMO])) break; if (_sp > XB_SPIN_CAP) { atomicAdd(&(bar)[XB_TMO], 1u); break; } } } } while (0)
struct XcdBarrier { unsigned* bar; unsigned x; volatile LAS unsigned* st; };
__device__ __forceinline__ XcdBarrier xcd_barrier_post(unsigned* bar, volatile LAS unsigned* st) {
    XcdBarrier b; b.bar = bar; b.x = xb_xcc_id(); b.st = st;
    if (threadIdx.x == 0) (void)xb_add(&bar[XB_XCNT(b.x)], 1u);
    return b;
}
__device__ __forceinline__ void xcd_barrier_complete(unsigned* bar, unsigned x, unsigned& nloc, unsigned& nx) {
    const unsigned G = gridDim.x * gridDim.y * gridDim.z;
    unsigned sum, cnt, mine, sp = 0u;
    for (;;) {
        sum = 0u; cnt = 0u; mine = 0u;
#pragma unroll
        for (unsigned j = 0; j < 16; ++j) { const unsigned c = xb_ld(&bar[XB_XCNT(j)]); sum += c; cnt += (c > 0u) ? 1u : 0u; mine = (j == x) ? c : mine; }
        if (sum == G) break;
        __builtin_amdgcn_s_sleep(1);
        if ((++sp & 255u) == 0u) { if (xb_ld(&bar[XB_TMO])) break; if (sp > XB_SPIN_CAP) { atomicAdd(&bar[XB_TMO], 1u); break; } }
    }
    nloc = mine > 0u ? mine : 1u; nx = cnt > 0u ? cnt : 1u;
}
__device__ __forceinline__ void xcd_barrier(const XcdBarrier& b) {
    asm volatile("s_waitcnt vmcnt(0)" ::: "memory");
    __syncthreads();
    if (threadIdx.x == 0) {
        unsigned* bar = b.bar;
        __builtin_amdgcn_s_waitcnt(0);
        unsigned nloc = b.st[0], nx = b.st[1];
        if (nloc == 0u) { xcd_barrier_complete(bar, b.x, nloc, nx); b.st[0] = nloc; b.st[1] = nx; }
        const unsigned old = xb_add(&bar[XB_XSUB(b.x)], 1u);
        const unsigned gen = old / nloc;
        if (old + 1u == (gen + 1u) * nloc) {
            __builtin_amdgcn_fence(__ATOMIC_RELEASE, "agent");
            asm volatile("s_waitcnt vmcnt(0)" ::: "memory");
            const unsigned og = xb_add(&bar[XB_TOP], 1u);
            const unsigned tg = og / nx;
            if (og + 1u == (tg + 1u) * nx) xb_add(&bar[XB_TOPGEN], 1u);
            else XB_SPIN(xb_ld(&bar[XB_TOPGEN]) == tg, bar);
            __builtin_amdgcn_fence(__ATOMIC_ACQUIRE, "agent");
            xb_add(&bar[XB_XGEN(b.x)], 1u);
            asm volatile("s_waitcnt vmcnt(0)" ::: "memory");
        } else {
            XB_SPIN(xb_ld(&bar[XB_XGEN(b.x)]) == gen, bar);
            __builtin_amdgcn_fence(__ATOMIC_ACQUIRE, "agent");
            asm volatile("s_waitcnt vmcnt(0)" ::: "memory");
        }
    }
    __syncthreads();
}

struct Frame {
    LAS unsigned char* lds;
    unsigned* ctl;
    int tid, lane, wave, vcu, G;
    const float* in[18];
    float* out;
    unsigned char* ws;
};

namespace pg8 {
typedef short bf16x8 __attribute__((ext_vector_type(8)));
constexpr int BM = 256, BK = 64, HALF = 128, HTB = HALF * BK * 2, STAGE_BYTES = 8 * HTB, NXCD = 8, WGM = 8;
__host__ __device__ __forceinline__ int lds_byte(int r, int c) { const int st = (r >> 4) * 2 + (c >> 5), rr = r & 15, cc = c & 31, ob = rr * 64 + cc * 2; return st * 1024 + (ob ^ (((ob >> 9) & 1) << 5)); }
__host__ __device__ __forceinline__ void stage_rc(int b, int& R, int& C) { const int st = b / 1024, sb = b % 1024, swz = sb ^ (((sb >> 9) & 1) << 5); R = (st >> 1) * 16 + swz / 64; C = (st & 1) * 32 + (swz % 64) / 2; }
__host__ __device__ __forceinline__ int perm32(int rho) { const int n = rho >> 4, i = rho & 15; return 8 * (i >> 2) + 4 * n + (i & 3); }
struct Unit { int pm, pn, e, cnt, hb; };
__device__ __forceinline__ unsigned cvt_pk_bf16(float lo, float hi) { unsigned r; asm volatile("v_cvt_pk_bf16_f32 %0, %1, %2" : "=v"(r) : "v"(lo), "v"(hi)); return r; }

struct StaticOrder {
    int nM, nN, nwg, G, c, K; const char* A; const char* Bt;
    __device__ void init(const void* A_, const void* Bt_, int M_, int N_, int K_, int G_, int c_) { A = (const char*)A_; Bt = (const char*)Bt_; nM = M_ / BM; nN = N_ / BM; nwg = nM * nN; G = G_; c = c_; K = K_; }
    __device__ bool next(int i, Unit& u) const {
        const long L = (long)i * G + c; if (L >= nwg) return false;
        int wgid = (int)L; { const int q = nwg / NXCD, r = nwg % NXCD, xcd = wgid % NXCD, off = wgid / NXCD; wgid = (xcd < r ? xcd * (q + 1) : r * (q + 1) + (xcd - r) * q) + off; }
        const int nig = WGM * nN, gid = wgid / nig, fm = gid * WGM, gsz = (nM - fm) < WGM ? (nM - fm) : WGM;
        u.pm = fm + ((wgid % nig) % gsz); u.pn = (wgid % nig) / gsz; u.e = 0; u.cnt = 0; u.hb = 0; return true;
    }
    __device__ __forceinline__ void base(const Unit& u, const char*& cA, const char*& cB) const { cA = A + (size_t)u.pm * BM * K * 2; cB = Bt + (size_t)u.pn * BM * K * 2; }
    __device__ __forceinline__ unsigned rowoff(const Unit&, int) const { return 0u; }
};

struct EpiBf16 {
    static constexpr bool PERM = true;
    bf16* O; int ldc;
    __device__ __forceinline__ void operator()(const f32x4 (&acc)[2][2][4][2], const Unit& u, int wr, int wc, int fr, int fq) const {
        const int row0 = u.pm * BM + wr * 64 + fr, col0 = u.pn * BM + wc * 32 + 8 * fq;
#pragma unroll
        for (int ai = 0; ai < 2; ++ai)
#pragma unroll
            for (int m = 0; m < 4; ++m) { bf16* rowp = O + (size_t)(row0 + ai * HALF + m * 16) * ldc + col0;
#pragma unroll
                for (int bj = 0; bj < 2; ++bj) { const f32x4 v0 = acc[ai][bj][m][0], v1 = acc[ai][bj][m][1];
                    u32x4 w; w.x = cvt_pk_bf16(v0[0], v0[1]); w.y = cvt_pk_bf16(v0[2], v0[3]); w.z = cvt_pk_bf16(v1[0], v1[1]); w.w = cvt_pk_bf16(v1[2], v1[3]);
                    *(u32x4*)(rowp + bj * HALF) = w; } }
    }
};
struct EpiResF32 {
    static constexpr bool PERM = false;
    const float* base; float* out; float alpha;
    __device__ __forceinline__ void operator()(const f32x4 (&acc)[2][2][4][2], const Unit& u, int wr, int wc, int fr, int fq) const {
        const int col0 = u.pn * BM + wc * 32 + 4 * fq;
#pragma unroll
        for (int ai = 0; ai < 2; ++ai)
#pragma unroll
            for (int m = 0; m < 4; ++m) { const size_t off = (size_t)(u.pm * BM + ai * HALF + wr * 64 + m * 16 + fr) * 1024 + col0;
#pragma unroll
                for (int bj = 0; bj < 2; ++bj)
#pragma unroll
                    for (int n = 0; n < 2; ++n) { const f32x4 b = *(const f32x4*)(base + off + bj * HALF + n * 16); *(f32x4*)(out + off + bj * HALF + n * 16) = b * alpha + acc[ai][bj][m][n]; } }
    }
};

struct MoeOrder {
    const unsigned* cnt; const int* LIST; const char* A; const char* B; int NTN, G, c, K, mode;
    __device__ bool next(int i, Unit& u) const {
        const int L = i * G + c; int base = 0, hb = 0;
        for (int e = 0; e < 32; ++e) { const int cc = (int)cnt[e * 64]; const int nmb = (cc + 255) >> 8; const int ntl = nmb * NTN;
            if (L < base + ntl) { const int r = L - base; u.e = e; u.pm = r / NTN; u.pn = r % NTN; u.cnt = cc; u.hb = hb; return true; }
            base += ntl; hb += nmb << 8; }
        return false;
    }
    __device__ __forceinline__ void base(const Unit& u, const char*& cA, const char*& cB) const {
        cA = mode == 0 ? A : A + (size_t)(u.hb + u.pm * 256) * K * 2; cB = B + (size_t)u.e * EW_STRIDE + (size_t)u.pn * 256 * K * 2; }
    __device__ __forceinline__ unsigned rowoff(const Unit& u, int r) const { int i = u.pm * 256 + r; i = i < u.cnt ? i : 0; return (unsigned)(LIST[u.e * M + i] >> 1) * 2048u; }
};
struct EpiSwiGLU {
    static constexpr bool PERM = true;
    bf16* HID;
    __device__ __forceinline__ void operator()(const f32x4 (&acc)[2][2][4][2], const Unit& u, int wr, int wc, int fr, int fq) const {
#pragma unroll
        for (int ai = 0; ai < 2; ++ai)
#pragma unroll
            for (int m = 0; m < 4; ++m) { const int i = u.pm * 256 + ai * HALF + wr * 64 + m * 16 + fr;
                if (i < u.cnt) { const f32x4 g0 = acc[ai][0][m][0], g1 = acc[ai][0][m][1], u0 = acc[ai][1][m][0], u1 = acc[ai][1][m][1];
                    u32x4 w; w.x = cvt_pk_bf16(siluf_(g0[0]) * u0[0], siluf_(g0[1]) * u0[1]); w.y = cvt_pk_bf16(siluf_(g0[2]) * u0[2], siluf_(g0[3]) * u0[3]);
                    w.z = cvt_pk_bf16(siluf_(g1[0]) * u1[0], siluf_(g1[1]) * u1[1]); w.w = cvt_pk_bf16(siluf_(g1[2]) * u1[2], siluf_(g1[3]) * u1[3]);
                    *(u32x4*)(HID + (size_t)(u.hb + i) * DE + u.pn * 128 + wc * 32 + 8 * fq) = w; } }
    }
};
struct EpiMoeOut {
    static constexpr bool PERM = true;
    bf16* YB; const int* LIST;
    __device__ __forceinline__ void operator()(const f32x4 (&acc)[2][2][4][2], const Unit& u, int wr, int wc, int fr, int fq) const {
#pragma unroll
        for (int ai = 0; ai < 2; ++ai)
#pragma unroll
            for (int m = 0; m < 4; ++m) { const int i = u.pm * 256 + ai * HALF + wr * 64 + m * 16 + fr;
                if (i < u.cnt) { const int a = LIST[u.e * M + i]; bf16* rowp = YB + (size_t)a * D + u.pn * 256 + wc * 32 + 8 * fq;
#pragma unroll
                    for (int bj = 0; bj < 2; ++bj) { const f32x4 v0 = acc[ai][bj][m][0], v1 = acc[ai][bj][m][1];
                        u32x4 w; w.x = cvt_pk_bf16(v0[0], v0[1]); w.y = cvt_pk_bf16(v0[2], v0[3]); w.z = cvt_pk_bf16(v1[0], v1[1]); w.w = cvt_pk_bf16(v1[2], v1[3]);
                        *(u32x4*)(rowp + bj * HALF) = w; } }
                asm volatile("" ::: "memory"); }
    }
};

template <class Epi, class Sched, bool ALIGN_EPI, bool GATHER>
__device__ __forceinline__ void gemm_phase(LAS unsigned char* lds, const int K, const Sched& S, const Epi& E) {
    const int tid = threadIdx.x, wid = __builtin_amdgcn_readfirstlane(tid >> 6), lane = tid & 63, wr = wid >> 2, wc = wid & 3, fr = lane & 15, fq = lane >> 4;
    const int nt = K / BK;
    int Rr[2], Cc[2]; unsigned voffB[2];
#pragma unroll
    for (int i = 0; i < 2; ++i) { int R, C; stage_rc(tid * 16 + i * 8192, R, C); const int Rb = Epi::PERM ? ((R & ~31) + perm32(R & 31)) : R; Rr[i] = R; Cc[i] = C; voffB[i] = (unsigned)(Rb * K + C) * 2u; }
    const size_t kstep = (size_t)(BK * 2);
    const size_t hstep = (size_t)HALF * K * 2;
    const unsigned ldsw = (unsigned)wid * 1024u;
    const int aoff = lds_byte(wr * 64 + fr, fq * 8), boff = lds_byte(wc * 32 + fr, fq * 8);
#define PG8_SA(b, h) (((b) * 2 + (h)) * HTB)
#define PG8_SB(b, h) ((4 + (b) * 2 + (h)) * HTB)
#define PG8_STAGE(bufoff, gbase, voff) do { _Pragma("unroll") for (int _i = 0; _i < 2; ++_i) \
        __builtin_amdgcn_global_load_lds((const unsigned*)((const char*)(gbase) + (voff)[_i]), (LAS unsigned*)(lds + (bufoff) + ldsw + _i * 8192), 16, 0, 0); } while (0)
#define PG8_STAGE_A(bufoff, gbase, o0, o1) do { \
        __builtin_amdgcn_global_load_lds((const unsigned*)((const char*)(gbase) + (o0)), (LAS unsigned*)(lds + (bufoff) + ldsw), 16, 0, 0); \
        __builtin_amdgcn_global_load_lds((const unsigned*)((const char*)(gbase) + (o1)), (LAS unsigned*)(lds + (bufoff) + ldsw + 8192), 16, 0, 0); } while (0)
#define PG8_LDA(dst, b, h) do { _Pragma("unroll") for (int m = 0; m < 4; ++m) _Pragma("unroll") for (int k = 0; k < 2; ++k) dst[m][k] = *(const LAS bf16x8*)(lds + PG8_SA(b, h) + aoff + m * 2048 + k * 1024); } while (0)
#define PG8_LDB(dst, b, h) do { _Pragma("unroll") for (int n = 0; n < 2; ++n) _Pragma("unroll") for (int k = 0; k < 2; ++k) dst[n][k] = *(const LAS bf16x8*)(lds + PG8_SB(b, h) + boff + n * 2048 + k * 1024); } while (0)
#define PG8_MMA(ai, bj, At, Bt) do { __builtin_amdgcn_s_setprio(1); _Pragma("unroll") for (int m = 0; m < 4; ++m) _Pragma("unroll") for (int n = 0; n < 2; ++n) _Pragma("unroll") for (int k = 0; k < 2; ++k) \
        acc[ai][bj][m][n] = __builtin_amdgcn_mfma_f32_16x16x32_bf16(Bt[n][k], At[m][k], acc[ai][bj][m][n], 0, 0, 0); __builtin_amdgcn_s_setprio(0); } while (0)
#define PG8_WAIT_V(n) asm volatile("s_waitcnt vmcnt(" #n ")" ::: "memory")
#define PG8_WAIT_L(n) asm volatile("s_waitcnt lgkmcnt(" #n ")" ::: "memory")
#define PG8_BAR __builtin_amdgcn_s_barrier()
#define PG8_SCHED __builtin_amdgcn_sched_barrier(0)
#define PG8_CALC_VA(u, v) do { _Pragma("unroll") for (int _h = 0; _h < 2; ++_h) _Pragma("unroll") for (int _i = 0; _i < 2; ++_i) \
        v[_h][_i] = GATHER ? (S.rowoff(u, _h * HALF + Rr[_i]) + (unsigned)Cc[_i] * 2u) : (unsigned)((_h * HALF + Rr[_i]) * K + Cc[_i]) * 2u; } while (0)
    Unit cur, nxt; int ui = 0;
    if (!S.next(0, cur)) return;
    f32x4 acc[2][2][4][2];
#pragma unroll
    for (int a = 0; a < 2; ++a)
#pragma unroll
        for (int b = 0; b < 2; ++b)
#pragma unroll
            for (int m = 0; m < 4; ++m)
#pragma unroll
                for (int n = 0; n < 2; ++n) acc[a][b][m][n] = (f32x4){0.f, 0.f, 0.f, 0.f};
    bf16x8 At[4][2], B0[2][2], B1[2][2];
    const char* cA; const char* cB; S.base(cur, cA, cB);
    unsigned cvA[2][2], nvA[2][2];
    PG8_CALC_VA(cur, cvA);
    PG8_STAGE(PG8_SB(0, 0), cB, voffB); PG8_STAGE(PG8_SB(0, 1), cB + hstep, voffB); PG8_STAGE_A(PG8_SA(0, 0), cA, cvA[0][0], cvA[0][1]); PG8_STAGE_A(PG8_SA(0, 1), cA, cvA[1][0], cvA[1][1]);
    if (wr == 1) PG8_BAR;
    PG8_WAIT_V(2); PG8_BAR;
    PG8_STAGE(PG8_SB(1, 0), cB + kstep, voffB); PG8_STAGE_A(PG8_SA(1, 0), cA + kstep, cvA[0][0], cvA[0][1]); PG8_STAGE(PG8_SB(1, 1), cB + hstep + kstep, voffB);
    PG8_WAIT_V(6); PG8_BAR;
    for (;;) {
        const bool has_next = S.next(ui + 1, nxt);
        const char* nA = cA; const char* nB = cB;
        if (has_next) { S.base(nxt, nA, nB); PG8_CALC_VA(nxt, nvA); }
        else {
#pragma unroll
            for (int h = 0; h < 2; ++h)
#pragma unroll
                for (int i = 0; i < 2; ++i) nvA[h][i] = cvA[h][i]; }
        if (GATHER) { asm volatile("s_waitcnt vmcnt(0)" ::: "memory"); asm volatile("" : "+v"(nvA[0][0]), "+v"(nvA[0][1]), "+v"(nvA[1][0]), "+v"(nvA[1][1])); }
#pragma unroll 1
        for (int t = 0; t < nt; t += 2) {
            const bool last = (t == nt - 2);
            const char* a1 = cA + (size_t)(t + 1) * kstep;
            const char* a2 = last ? nA : cA + (size_t)(t + 2) * kstep; const char* b2 = last ? nB : cB + (size_t)(t + 2) * kstep;
            const char* a3 = a2 + kstep; const char* b3 = b2 + kstep;
            const unsigned x00 = last ? nvA[0][0] : cvA[0][0], x01 = last ? nvA[0][1] : cvA[0][1], x10 = last ? nvA[1][0] : cvA[1][0], x11 = last ? nvA[1][1] : cvA[1][1];
            PG8_LDB(B0, 0, 0); PG8_LDB(B1, 0, 1); PG8_SCHED; PG8_LDA(At, 0, 0); PG8_STAGE_A(PG8_SA(1, 1), a1, cvA[1][0], cvA[1][1]);
            PG8_WAIT_V(8); PG8_WAIT_L(0); PG8_BAR; PG8_MMA(0, 0, At, B0); PG8_MMA(0, 1, At, B1); PG8_BAR; PG8_SCHED;
            PG8_LDA(At, 0, 1); PG8_STAGE(PG8_SB(0, 0), b2, voffB); PG8_STAGE(PG8_SB(0, 1), b2 + hstep, voffB); PG8_STAGE_A(PG8_SA(0, 0), a2, x00, x01);
            PG8_WAIT_V(8); PG8_WAIT_L(0); PG8_BAR; PG8_MMA(1, 0, At, B0); PG8_MMA(1, 1, At, B1); PG8_BAR; PG8_SCHED;
            PG8_LDB(B0, 1, 0); PG8_LDB(B1, 1, 1); PG8_SCHED; PG8_LDA(At, 1, 0); PG8_STAGE_A(PG8_SA(0, 1), a2, x10, x11);
            PG8_WAIT_V(8); PG8_WAIT_L(0); PG8_BAR; PG8_MMA(0, 0, At, B0); PG8_MMA(0, 1, At, B1); PG8_BAR; PG8_SCHED;
            PG8_LDA(At, 1, 1); PG8_STAGE(PG8_SB(1, 0), b3, voffB); PG8_STAGE(PG8_SB(1, 1), b3 + hstep, voffB); PG8_STAGE_A(PG8_SA(1, 0), a3, x00, x01);
            PG8_WAIT_V(8); PG8_WAIT_L(0); PG8_BAR; PG8_MMA(1, 0, At, B0); PG8_MMA(1, 1, At, B1); PG8_BAR; PG8_SCHED;
        }
        if constexpr (ALIGN_EPI) { if (wr == 0) PG8_BAR; }
        E(acc, cur, wr, wc, fr, fq);
        if (!has_next) break;
#pragma unroll
        for (int a = 0; a < 2; ++a)
#pragma unroll
            for (int b = 0; b < 2; ++b)
#pragma unroll
                for (int m = 0; m < 4; ++m)
#pragma unroll
                    for (int n = 0; n < 2; ++n) acc[a][b][m][n] = (f32x4){0.f, 0.f, 0.f, 0.f};
        cur = nxt; cA = nA; cB = nB; ++ui;
#pragma unroll
        for (int h = 0; h < 2; ++h)
#pragma unroll
            for (int i = 0; i < 2; ++i) cvA[h][i] = nvA[h][i];
        if constexpr (ALIGN_EPI) { if (wr == 1) PG8_BAR; }
    }
    PG8_WAIT_V(0);
    if constexpr (!ALIGN_EPI) { if (wr == 0) PG8_BAR; }
    PG8_BAR;
#undef PG8_SA
#undef PG8_SB
#undef PG8_STAGE
#undef PG8_STAGE_A
#undef PG8_LDA
#undef PG8_LDB
#undef PG8_MMA
#undef PG8_WAIT_V
#undef PG8_WAIT_L
#undef PG8_BAR
#undef PG8_SCHED
#undef PG8_CALC_VA
}
}

template <class RowFn>
__device__ __forceinline__ void ngemm_tile(LAS float* sA, LAS float* sB, RowFn rowA, const bf16* Bt, int ldb, int K, float (&acc)[4][4]) {
    const int tid = threadIdx.x, tx = tid & 15, ty = tid >> 4;
#pragma unroll
    for (int i = 0; i < 4; ++i)
#pragma unroll
        for (int j = 0; j < 4; ++j) acc[i][j] = 0.f;
    const int ar = tid >> 2, ak = (tid & 3) * 8, br = tid >> 3, bk = (tid & 7) * 4;
    const bf16* ap = rowA(ar);
    const bf16* bp = Bt + (size_t)br * ldb;
    for (int k0 = 0; k0 < K; k0 += 32) {
        u32x4 av = (u32x4){0u, 0u, 0u, 0u};
        if (ap) av = *(const u32x4*)(ap + k0 + ak);
        const u32x2 bv = *(const u32x2*)(bp + k0 + bk);
        __syncthreads();
        LAS float* wa = sA + ar * 33 + ak;
        wa[0] = bflo(av.x); wa[1] = bfhi(av.x); wa[2] = bflo(av.y); wa[3] = bfhi(av.y); wa[4] = bflo(av.z); wa[5] = bfhi(av.z); wa[6] = bflo(av.w); wa[7] = bfhi(av.w);
        LAS float* wb = sB + br * 33 + bk;
        wb[0] = bflo(bv.x); wb[1] = bfhi(bv.x); wb[2] = bflo(bv.y); wb[3] = bfhi(bv.y);
        __syncthreads();
#pragma unroll 8
        for (int kk = 0; kk < 32; ++kk) {
            float a[4], b[4];
#pragma unroll
            for (int i = 0; i < 4; ++i) a[i] = sA[(ty * 4 + i) * 33 + kk];
#pragma unroll
            for (int j = 0; j < 4; ++j) b[j] = sB[(tx * 4 + j) * 33 + kk];
#pragma unroll
            for (int i = 0; i < 4; ++i)
#pragma unroll
                for (int j = 0; j < 4; ++j) acc[i][j] = fmaf(a[i], b[j], acc[i][j]);
        }
    }
}

__device__ __forceinline__ void tr_item(const float* W, int ldw, bf16* WT, int ldt, LAS float* scr, int kb, int nb, int lane) {
    const int k0 = 64 * kb, n0 = 32 * nb;
#pragma unroll 8
    for (int i = 0; i < 32; ++i) { const int kk = 2 * i + (lane >> 5); scr[kk * 33 + (lane & 31)] = W[(size_t)(k0 + kk) * ldw + n0 + (lane & 31)]; }
    LDS_WAIT(); asm volatile("" ::: "memory");
    const int c = lane & 7;
#pragma unroll
    for (int j = 0; j < 4; ++j) { const int n = (lane >> 3) + 8 * j; const LAS float* s = scr + (8 * c) * 33 + n;
        u32x4 o; o.x = pk2(s[0 * 33], s[1 * 33]); o.y = pk2(s[2 * 33], s[3 * 33]); o.z = pk2(s[4 * 33], s[5 * 33]); o.w = pk2(s[6 * 33], s[7 * 33]);
        *(u32x4*)(WT + (size_t)(n0 + n) * ldt + k0 + 8 * c) = o; }
    LDS_WAIT(); asm volatile("" ::: "memory");
}

__device__ __forceinline__ void ph0_convert(Frame& F) {
    LAS float* scr = (LAS float*)(F.lds + F.wave * 9216);
    LAS float* gw = (LAS float*)(F.lds + 8 * 9216);
    const float* w0 = F.in[1];
    for (int i = F.tid; i < 8 * 1024; i += NT) { const int j = i >> 10, k = i & 1023; gw[i] = w0[(size_t)k * IN0 + 2048 + j]; }
    __syncthreads();
    const int gwv = F.vcu * NWAVES + F.wave, NGW = F.G * NWAVES;
    bf16* WT0 = (bf16*)(F.ws + WS_WT0); bf16* WO0 = (bf16*)(F.ws + WS_WO0); bf16* WT1 = (bf16*)(F.ws + WS_WT1); bf16* WO1 = (bf16*)(F.ws + WS_WO1);
    constexpr int I0 = 16 * 64, I1 = 16 * 64, I2 = 16 * 32, I3 = 16 * 144, I4 = 8 * 32, NI = I0 + I1 + I2 + I3 + I4;
    for (int it = gwv; it < NI; it += NGW) {
        int r = it;
        if (r < I0) { tr_item(w0, IN0, WT0, 1024, scr, r / 64, r % 64, F.lane); continue; } r -= I0;
        if (r < I1) { tr_item(w0 + 2056, IN0, WT0 + (size_t)2048 * 1024, 1024, scr, r / 64, r % 64, F.lane); continue; } r -= I1;
        if (r < I2) { tr_item(F.in[8], 1024, WO0, 1024, scr, r / 32, r % 32, F.lane); continue; } r -= I2;
        if (r < I3) { tr_item(F.in[9], IN1, WT1, 1024, scr, r / 144, r % 144, F.lane); continue; } r -= I3;
        tr_item(F.in[10], 1024, WO1, 512, scr, r / 32, r % 32, F.lane);
    }
    const float* x = F.in[0]; bf16* XB = (bf16*)(F.ws + WS_XB); float* G = (float*)(F.ws + WS_G);
    const float* ib = F.in[2]; const float* fb = F.in[3];
    for (int m = gwv; m < M; m += NGW) {
        const f32x4* xr = (const f32x4*)(x + (size_t)m * D) + F.lane;
        f32x4 v[4];
#pragma unroll
        for (int j = 0; j < 4; ++j) v[j] = xr[64 * j];
        unsigned long long* o8 = (unsigned long long*)(XB + (size_t)m * D) + F.lane;
#pragma unroll
        for (int j = 0; j < 4; ++j) o8[64 * j] = (unsigned long long)pk2(v[j].x, v[j].y) | ((unsigned long long)pk2(v[j].z, v[j].w) << 32);
        float acc[8];
#pragma unroll
        for (int g = 0; g < 8; ++g) { float a = 0.f;
#pragma unroll
            for (int j = 0; j < 4; ++j) { const f32x4 w = *(const LAS f32x4*)(gw + g * 1024 + 4 * F.lane + 256 * j); a += v[j].x * w.x + v[j].y * w.y + v[j].z * w.z + v[j].w * w.w; }
            acc[g] = wave_sum(a); }
        if (F.lane == 0) {
#pragma unroll
            for (int g = 0; g < 4; ++g) G[(size_t)m * 8 + g] = acc[g] + ib[g];
#pragma unroll
            for (int g = 0; g < 4; ++g) { const float z = acc[4 + g] + fb[g]; G[(size_t)m * 8 + 4 + g] = fminf(z, 0.f) - log1pf(__expf(-fabsf(z))); }
        }
    }
}

__device__ __forceinline__ void convert_experts(Frame& F, int layer) {
    LAS float* scr = (LAS float*)(F.lds + F.wave * 9216);
    const int gwv = F.vcu * NWAVES + F.wave, NGW = F.G * NWAVES;
    const float* wg = F.in[13] + (size_t)layer * NE * D * DE; const float* wu = F.in[14] + (size_t)layer * NE * D * DE; const float* wd = F.in[15] + (size_t)layer * NE * DE * D;
    for (int it = gwv; it < NE * 384; it += NGW) {
        const int e = it / 384; int r = it % 384;
        bf16* GU = (bf16*)(F.ws + WS_EW + (size_t)e * EW_STRIDE); bf16* DN = (bf16*)(F.ws + WS_EW + (size_t)e * EW_STRIDE + EW_DN);
        if (r < 256) { const int job = r >> 6, q = r & 63;
            const float* src = ((job < 2) ? wg : wu) + (size_t)e * D * DE + (job & 1) * 128;
            bf16* dst = GU + (size_t)((job & 1) * 256 + (job >> 1) * 128) * 1024;
            tr_item(src, DE, dst, 1024, scr, q >> 2, q & 3, F.lane);
        } else { r -= 256;
            tr_item(wd + (size_t)e * DE * D, D, DN, DE, scr, r >> 5, r & 31, F.lane); }
    }
}

__device__ __forceinline__ void ph_inproj_naive(Frame& F, const bf16* Bt, int N) {
    LAS float* sA = (LAS float*)F.lds; LAS float* sB = sA + 128 * 33;
    const bf16* XB = (const bf16*)(F.ws + WS_XB); bf16* P = (bf16*)(F.ws + WS_P);
    const int nnb = N / 64, ntiles = (M / 128) * nnb, tx = F.tid & 15, ty = F.tid >> 4;
    for (int t = blockIdx.x; t < ntiles; t += F.G) {
        const int mb = t / nnb, nb = t % nnb; float acc[4][4];
        ngemm_tile(sA, sB, [&](int r) { return XB + (size_t)(mb * 128 + r) * D; }, Bt + (size_t)nb * 64 * D, D, D, acc);
#pragma unroll
        for (int i = 0; i < 4; ++i) { u32x2 o; o.x = pk2(acc[i][0], acc[i][1]); o.y = pk2(acc[i][2], acc[i][3]);
            *(u32x2*)(P + (size_t)(mb * 128 + ty * 4 + i) * N + nb * 64 + tx * 4) = o; }
    }
}
__device__ __forceinline__ void ph_outproj_naive(Frame& F, const bf16* A, int K, const bf16* Bt, const float* base) {
    LAS float* sA = (LAS float*)F.lds; LAS float* sB = sA + 128 * 33;
    const int nnb = D / 64, ntiles = (M / 128) * nnb, tx = F.tid & 15, ty = F.tid >> 4;
    for (int t = blockIdx.x; t < ntiles; t += F.G) {
        const int mb = t / nnb, nb = t % nnb; float acc[4][4];
        ngemm_tile(sA, sB, [&](int r) { return A + (size_t)(mb * 128 + r) * K; }, Bt + (size_t)nb * 64 * K, K, K, acc);
#pragma unroll
        for (int i = 0; i < 4; ++i) { const size_t off = (size_t)(mb * 128 + ty * 4 + i) * D + nb * 64 + tx * 4;
            const f32x4 b = *(const f32x4*)(base + off);
            *(f32x4*)(F.out + off) = (f32x4){ALPHA * b.x + acc[i][0], ALPHA * b.y + acc[i][1], ALPHA * b.z + acc[i][2], ALPHA * b.w + acc[i][3]}; }
    }
}

__device__ __forceinline__ void ph_conv_naive(Frame& F) {
    const bf16* P = (const bf16*)(F.ws + WS_P); bf16* QKC = (bf16*)(F.ws + WS_QKC);
    const float* cw = F.in[4]; const float* cb = F.in[5];
    const size_t total = (size_t)M * 1024, nth = (size_t)F.G * NT;
    for (size_t i = (size_t)blockIdx.x * NT + F.tid; i < total; i += nth) {
        const int m = (int)(i >> 10), c = (int)(i & 1023), t = m & (T - 1);
        float a = cb[c];
#pragma unroll
        for (int j = 0; j < 4; ++j) { const int tt = t - 3 + j; if (tt >= 0) a += cw[j * 1024 + c] * bf2f(P[(size_t)(m - 3 + j) * NP0 + c]); }
        QKC[i] = (bf16)f2bf(siluf_(a));
    }
}
__device__ __forceinline__ void ph_recurrent_naive(Frame& F) {
    if (blockIdx.x >= 16) return;
    const int type = blockIdx.x >> 3, b = (blockIdx.x >> 2) & 1, h = blockIdx.x & 3;
    LAS float* sin = (LAS float*)F.lds;
    LAS float* red = sin + 1024;
    LAS float* redd = red + 512;
    LAS float* sc = redd + 4;
    const bf16* P = (const bf16*)(F.ws + WS_P); const bf16* QKC = (const bf16*)(F.ws + WS_QKC); const float* G = (const float*)(F.ws + WS_G);
    bf16* Y = (bf16*)(F.ws + WS_Y);
    const float* gain = (type == 0 ? F.in[6] : F.in[7]) + h * 128;
    const int e = F.tid & 127, dg = F.tid >> 7, which = dg;
    const float gamma = 1.f - exp2f(-5.f - (float)h);
    float C[32], nn[32];
#pragma unroll
    for (int j = 0; j < 32; ++j) { C[j] = 0.f; nn[j] = 0.f; }
    const bf16* src; size_t stride;
    if (type == 0) { if (which < 2) { src = QKC + which * 512 + h * 128 + e; stride = 1024; } else { src = P + 1024 + (which - 2) * 512 + h * 128 + e; stride = NP0; } }
    else { src = P + 2048 + which * 512 + h * 128 + e; stride = NP0; }
    const float mul = (which == 1) ? KSCALE : 1.f;
    const size_t m0 = (size_t)b * T;
    float val = bf2f(src[m0 * stride]) * mul;
    float s0 = 0.f, s1 = 0.f;
    if (F.tid == 0) { if (type == 0) { s0 = __expf(G[m0 * 8 + 4 + h]); s1 = __expf(G[m0 * 8 + h]); } else { s0 = gamma; s1 = 1.f; } }
    for (int t = 0; t < T; ++t) {
        const size_t m = m0 + t; const int pb = t & 1;
        sin[pb * 512 + F.tid] = val;
        if (F.tid == 0) { sc[pb * 2] = s0; sc[pb * 2 + 1] = s1; }
        if (t + 1 < T) { val = bf2f(src[(m + 1) * stride]) * mul;
            if (F.tid == 0 && type == 0) { s0 = __expf(G[(m + 1) * 8 + 4 + h]); s1 = __expf(G[(m + 1) * 8 + h]); } }
        __syncthreads();
        const float f = sc[pb * 2], ig = sc[pb * 2 + 1];
        const LAS float* sq = sin + pb * 512; const LAS float* sk = sq + 128; const LAS float* sv = sq + 256; const LAS float* so = sq + 384;
        const float ve = sv[e] * ig;
        float pn = 0.f, pd = 0.f;
#pragma unroll
        for (int j = 0; j < 32; ++j) { const int d = dg * 32 + j; const float kd = sk[d], qd = sq[d];
            C[j] = fmaf(f, C[j], kd * ve); nn[j] = fmaf(f, nn[j], ig * kd); pn = fmaf(C[j], qd, pn); pd = fmaf(nn[j], qd, pd); }
        red[dg * 128 + e] = pn; if (e == 0) redd[dg] = pd;
        __syncthreads();
        if (F.tid < 64) {
            const int e0 = F.tid, e1 = F.tid + 64;
            float h0 = (red[e0] + red[128 + e0]) + (red[256 + e0] + red[384 + e0]);
            float h1 = (red[e1] + red[128 + e1]) + (red[256 + e1] + red[384 + e1]);
            if (type == 0) { const float den = (redd[0] + redd[1]) + (redd[2] + redd[3]); const float dn = fmaxf(fabsf(den), 1.f);
                h0 = h0 / dn * sigmoidf_(so[e0]); h1 = h1 / dn * sigmoidf_(so[e1]); }
            const float mean = wave_sum(h0 + h1) * (1.f / 128.f); const float d0 = h0 - mean, d1 = h1 - mean;
            const float rstd = 1.f / sqrtf(wave_sum(d0 * d0 + d1 * d1) * (1.f / 128.f) + LN_EPS);
            float y0 = d0 * rstd * gain[e0], y1 = d1 * rstd * gain[e1];
            if (type == 1) { y0 *= siluf_(so[e0]); y1 *= siluf_(so[e1]); }
            Y[m * 1024 + type * 512 + h * 128 + e0] = (bf16)f2bf(y0); Y[m * 1024 + type * 512 + h * 128 + e1] = (bf16)f2bf(y1);
        }
    }
}

template <int MODE, bool ROUTE, bool WRITE_XB>
__device__ __forceinline__ void ph_ln(Frame& F, int layer) {
    LAS float* rwT = (LAS float*)F.lds;
    if (ROUTE) { const float* rw = F.in[11]; for (int i = F.tid; i < 32 * 1024; i += NT) { const int e = i >> 10, k = i & 1023; rwT[i] = rw[(size_t)k * 32 + e]; } __syncthreads(); }
    const int gwv = F.vcu * NWAVES + F.wave, NGW = F.G * NWAVES;
    const float* lg = F.in[16] + (size_t)(layer * 2 + MODE) * D; const float* lb = F.in[17] + (size_t)(layer * 2 + MODE) * D;
    bf16* XB = (bf16*)(F.ws + WS_XB); const bf16* YB = (const bf16*)(F.ws + WS_YB);
    int* EIDX = (int*)(F.ws + WS_EIDX); float* GATEV = (float*)(F.ws + WS_GATEV); int* LIST = (int*)(F.ws + WS_LIST);
    unsigned* cnt = F.ctl + CW_CNT + layer * 32 * 64;
    const float* rbias = F.in[12];
    f32x4 gv[4], bv[4];
#pragma unroll
    for (int j = 0; j < 4; ++j) { gv[j] = *((const f32x4*)lg + F.lane + 64 * j); bv[j] = *((const f32x4*)lb + F.lane + 64 * j); }
    for (int m = gwv; m < M; m += NGW) {
        f32x4* orow = (f32x4*)(F.out + (size_t)m * D) + F.lane;
        f32x4 v[4]; float s = 0.f;
#pragma unroll
        for (int j = 0; j < 4; ++j) v[j] = orow[64 * j];
        if (MODE == 1) {
            const float g0 = GATEV[2 * m], g1 = GATEV[2 * m + 1];
            const u32x2* y0 = (const u32x2*)(YB + (size_t)(2 * m) * D) + F.lane; const u32x2* y1 = (const u32x2*)(YB + (size_t)(2 * m + 1) * D) + F.lane;
#pragma unroll
            for (int j = 0; j < 4; ++j) { const u32x2 a = y0[64 * j], b = y1[64 * j];
                v[j].x = ALPHA * v[j].x + g0 * bflo(a.x) + g1 * bflo(b.x); v[j].y = ALPHA * v[j].y + g0 * bfhi(a.x) + g1 * bfhi(b.x);
                v[j].z = ALPHA * v[j].z + g0 * bflo(a.y) + g1 * bflo(b.y); v[j].w = ALPHA * v[j].w + g0 * bfhi(a.y) + g1 * bfhi(b.y); }
        }
#pragma unroll
        for (int j = 0; j < 4; ++j) s += (v[j].x + v[j].y) + (v[j].z + v[j].w);
        const float mean = wave_sum(s) * (1.f / D); float s2 = 0.f;
#pragma unroll
        for (int j = 0; j < 4; ++j) { v[j] = v[j] - mean; s2 += (v[j].x * v[j].x + v[j].y * v[j].y) + (v[j].z * v[j].z + v[j].w * v[j].w); }
        const float rstd = 1.f / sqrtf(wave_sum(s2) * (1.f / D) + LN_EPS);
#pragma unroll
        for (int j = 0; j < 4; ++j) { v[j] = v[j] * rstd * gv[j] + bv[j]; orow[64 * j] = v[j]; }
        if (WRITE_XB) { unsigned long long* o8 = (unsigned long long*)(XB + (size_t)m * D) + F.lane;
#pragma unroll
            for (int j = 0; j < 4; ++j) o8[64 * j] = (unsigned long long)pk2(v[j].x, v[j].y) | ((unsigned long long)pk2(v[j].z, v[j].w) << 32); }
        if (ROUTE) {
            float mylog = 0.f;
#pragma unroll 2
            for (int e = 0; e < 32; ++e) { float a = 0.f;
#pragma unroll
                for (int j = 0; j < 4; ++j) { const f32x4 w = *(const LAS f32x4*)(rwT + e * 1024 + 4 * F.lane + 256 * j); a += v[j].x * w.x + v[j].y * w.y + v[j].z * w.z + v[j].w * w.w; }
                a = wave_sum(a); mylog = (F.lane == e) ? a : mylog; }
            const float myaff = 1.f / (1.f + expf(-mylog)), mysel = myaff + rbias[F.lane & 31];
            float m1 = -1e30f, m2 = -1e30f; int i1 = 0, i2 = 0; float a1 = 0.f, a2 = 0.f;
            const int gbase = F.lane & 24;
#pragma unroll
            for (int j = 0; j < 8; ++j) { const float sv = __shfl(mysel, gbase + j), av = __shfl(myaff, gbase + j);
                if (sv > m1) { m2 = m1; i2 = i1; a2 = a1; m1 = sv; i1 = gbase + j; a1 = av; }
                else if (sv > m2) { m2 = sv; i2 = gbase + j; a2 = av; } }
            const float score = m1 + m2;
            float bestscore = -1e30f; int bg = 0;
#pragma unroll
            for (int g = 0; g < 4; ++g) { const float sg = __shfl(score, 8 * g); if (sg > bestscore) { bestscore = sg; bg = g; } }
            const int bi0 = __shfl(i1, 8 * bg), bi1 = __shfl(i2, 8 * bg); const float ba0 = __shfl(a1, 8 * bg), ba1 = __shfl(a2, 8 * bg);
            if (F.lane == 0) {
                const float inv = 1.f / (ba0 + ba1);
                EIDX[2 * m] = bi0; EIDX[2 * m + 1] = bi1; GATEV[2 * m] = ba0 * inv; GATEV[2 * m + 1] = ba1 * inv;
                const unsigned p0 = __hip_atomic_fetch_add(cnt + bi0 * 64, 1u, RLX_AGENT); LIST[bi0 * M + p0] = 2 * m;
                const unsigned p1 = __hip_atomic_fetch_add(cnt + bi1 * 64, 1u, RLX_AGENT); LIST[bi1 * M + p1] = 2 * m + 1;
            }
        }
    }
}

struct ExpertMap { int cnt[32]; };
__device__ __forceinline__ int moe_find(Frame& F, int layer, int unit_rows, int per_row_tiles, int t, int& e_out, int& mb_out, int& nb_out, int& hb_out, int& cnt_out) {
    const unsigned* cnt = F.ctl + CW_CNT + layer * 32 * 64;
    int base = 0, hb = 0;
    for (int e = 0; e < 32; ++e) {
        const int c = (int)cnt[e * 64]; const int nmb = (c + unit_rows - 1) / unit_rows; const int nt = nmb * per_row_tiles;
        if (t < base + nt) { const int r = t - base; e_out = e; mb_out = r / per_row_tiles; nb_out = r % per_row_tiles; hb_out = hb; cnt_out = c; return 1; }
        base += nt; hb += ((c + 255) >> 8) << 8;
    }
    return 0;
}
__device__ __forceinline__ void ph_moe1_naive(Frame& F, int layer) {
    LAS float* sA = (LAS float*)F.lds; LAS float* sB = sA + 128 * 33;
    const bf16* XB = (const bf16*)(F.ws + WS_XB); bf16* HID = (bf16*)(F.ws + WS_HID); const int* LIST = (const int*)(F.ws + WS_LIST);
    const int tx = F.tid & 15, ty = F.tid >> 4;
    for (int t = blockIdx.x;; t += F.G) {
        int e, mb, nb, hb, c; if (!moe_find(F, layer, 128, 4, t, e, mb, nb, hb, c)) break;
        const bf16* GU = (const bf16*)(F.ws + WS_EW + (size_t)e * EW_STRIDE);
        const int j0 = nb * 64, rg = (j0 >> 7) * 256 + (j0 & 127);
        auto rowA = [&](int r) -> const bf16* { const int i = mb * 128 + r; return i < c ? XB + (size_t)(LIST[e * M + i] >> 1) * D : (const bf16*)nullptr; };
        float ag[4][4], au[4][4];
        ngemm_tile(sA, sB, rowA, GU + (size_t)rg * D, D, D, ag);
        ngemm_tile(sA, sB, rowA, GU + (size_t)(rg + 128) * D, D, D, au);
#pragma unroll
        for (int i = 0; i < 4; ++i) { const int ri = mb * 128 + ty * 4 + i;
            if (ri < c) { u32x2 o; o.x = pk2(siluf_(ag[i][0]) * au[i][0], siluf_(ag[i][1]) * au[i][1]); o.y = pk2(siluf_(ag[i][2]) * au[i][2], siluf_(ag[i][3]) * au[i][3]);
                *(u32x2*)(HID + (size_t)(hb + ri) * DE + j0 + tx * 4) = o; } }
    }
}
__device__ __forceinline__ void ph_moe2_naive(Frame& F, int layer) {
    LAS float* sA = (LAS float*)F.lds; LAS float* sB = sA + 128 * 33;
    const bf16* HID = (const bf16*)(F.ws + WS_HID); bf16* YB = (bf16*)(F.ws + WS_YB); const int* LIST = (const int*)(F.ws + WS_LIST);
    const int tx = F.tid & 15, ty = F.tid >> 4;
    for (int t = blockIdx.x;; t += F.G) {
        int e, mb, nb, hb, c; if (!moe_find(F, layer, 128, 16, t, e, mb, nb, hb, c)) break;
        const bf16* DN = (const bf16*)(F.ws + WS_EW + (size_t)e * EW_STRIDE + EW_DN);
        auto rowA = [&](int r) -> const bf16* { const int i = mb * 128 + r; return i < c ? HID + (size_t)(hb + i) * DE : (const bf16*)nullptr; };
        float acc[4][4];
        ngemm_tile(sA, sB, rowA, DN + (size_t)(nb * 64) * DE, DE, DE, acc);
#pragma unroll
        for (int i = 0; i < 4; ++i) { const int ri = mb * 128 + ty * 4 + i;
            if (ri < c) { const int a = LIST[e * M + ri]; u32x2 o; o.x = pk2(acc[i][0], acc[i][1]); o.y = pk2(acc[i][2], acc[i][3]);
                *(u32x2*)(YB + (size_t)a * D + nb * 64 + tx * 4) = o; } }
    }
}

__device__ __forceinline__ void ph_attn_naive(Frame& F) {
    const bf16* P = (const bf16*)(F.ws + WS_P); bf16* OG = (bf16*)(F.ws + WS_OG); float* LSE = (float*)(F.ws + WS_LSE);
    const int total = 3 * M * 8, nth = F.G * NT;
    for (int idx = blockIdx.x * NT + F.tid; idx < total; idx += nth) {
        const int h = idx & 7, m = (idx >> 3) & (M - 1), g = idx >> 17;
        const int t = m & (T - 1), dil = (g == 0) ? 1 : (g == 1 ? 4 : 16);
        const float slope = exp2f(-(float)(h + 1));
        const bf16* qp = P + (size_t)m * IN1 + g * 1536 + h * 64;
        float q[64], o[64];
#pragma unroll
        for (int c = 0; c < 8; ++c) { const u32x4 w = *(const u32x4*)(qp + 8 * c);
            q[8 * c + 0] = bflo(w.x); q[8 * c + 1] = bfhi(w.x); q[8 * c + 2] = bflo(w.y); q[8 * c + 3] = bfhi(w.y); q[8 * c + 4] = bflo(w.z); q[8 * c + 5] = bfhi(w.z); q[8 * c + 6] = bflo(w.w); q[8 * c + 7] = bfhi(w.w); }
#pragma unroll
        for (int d = 0; d < 64; ++d) o[d] = 0.f;
        float mx = -1e30f, den = 0.f;
        for (int j = 0; j <= 128; ++j) {
            const int tk = t - j * dil; if (tk < 0) break;
            const bf16* kp = P + (size_t)(m - j * dil) * IN1 + g * 1536 + 512 + h * 64; const bf16* vp = kp + 512;
            float s = 0.f;
#pragma unroll
            for (int c = 0; c < 8; ++c) { const u32x4 w = *(const u32x4*)(kp + 8 * c);
                s += q[8 * c + 0] * bflo(w.x) + q[8 * c + 1] * bfhi(w.x) + q[8 * c + 2] * bflo(w.y) + q[8 * c + 3] * bfhi(w.y) + q[8 * c + 4] * bflo(w.z) + q[8 * c + 5] * bfhi(w.z) + q[8 * c + 6] * bflo(w.w) + q[8 * c + 7] * bfhi(w.w); }
            s = s * 0.125f - slope * (float)(j * dil);
            const float mn = fmaxf(mx, s), corr = __expf(mx - mn), p = __expf(s - mn);
            den = den * corr + p; mx = mn;
#pragma unroll
            for (int c = 0; c < 8; ++c) { const u32x4 w = *(const u32x4*)(vp + 8 * c);
                o[8 * c + 0] = o[8 * c + 0] * corr + p * bflo(w.x); o[8 * c + 1] = o[8 * c + 1] * corr + p * bfhi(w.x); o[8 * c + 2] = o[8 * c + 2] * corr + p * bflo(w.y); o[8 * c + 3] = o[8 * c + 3] * corr + p * bfhi(w.y);
                o[8 * c + 4] = o[8 * c + 4] * corr + p * bflo(w.z); o[8 * c + 5] = o[8 * c + 5] * corr + p * bfhi(w.z); o[8 * c + 6] = o[8 * c + 6] * corr + p * bflo(w.w); o[8 * c + 7] = o[8 * c + 7] * corr + p * bfhi(w.w); }
        }
        const float inv = 1.f / den;
        bf16* op = OG + ((size_t)g * M + m) * 512 + h * 64;
#pragma unroll
        for (int c = 0; c < 8; ++c) { u32x4 w; w.x = pk2(o[8 * c + 0] * inv, o[8 * c + 1] * inv); w.y = pk2(o[8 * c + 2] * inv, o[8 * c + 3] * inv); w.z = pk2(o[8 * c + 4] * inv, o[8 * c + 5] * inv); w.w = pk2(o[8 * c + 6] * inv, o[8 * c + 7] * inv);
            *(u32x4*)(op + 8 * c) = w; }
        LSE[((size_t)g * M + m) * 8 + h] = mx + __logf(den);
    }
}
__device__ __forceinline__ void ph_merge(Frame& F) {
    const bf16* OG = (const bf16*)(F.ws + WS_OG); const float* LSE = (const float*)(F.ws + WS_LSE); bf16* Y2 = (bf16*)(F.ws + WS_Y2);
    const int total = M * 64, nth = F.G * NT;
    for (int idx = blockIdx.x * NT + F.tid; idx < total; idx += nth) {
        const int m = idx >> 6, c8 = idx & 63, h = c8 >> 3;
        const float l0 = LSE[((size_t)0 * M + m) * 8 + h], l1 = LSE[((size_t)1 * M + m) * 8 + h], l2 = LSE[((size_t)2 * M + m) * 8 + h];
        const float mx = fmaxf(l0, fmaxf(l1, l2)); float w0 = __expf(l0 - mx), w1 = __expf(l1 - mx), w2 = __expf(l2 - mx); const float inv = 1.f / (w0 + w1 + w2);
        w0 *= inv; w1 *= inv; w2 *= inv;
        const u32x4 a = *(const u32x4*)(OG + ((size_t)0 * M + m) * 512 + c8 * 8), b = *(const u32x4*)(OG + ((size_t)1 * M + m) * 512 + c8 * 8), c = *(const u32x4*)(OG + ((size_t)2 * M + m) * 512 + c8 * 8);
        u32x4 o;
        o.x = pk2(w0 * bflo(a.x) + w1 * bflo(b.x) + w2 * bflo(c.x), w0 * bfhi(a.x) + w1 * bfhi(b.x) + w2 * bfhi(c.x));
        o.y = pk2(w0 * bflo(a.y) + w1 * bflo(b.y) + w2 * bflo(c.y), w0 * bfhi(a.y) + w1 * bfhi(b.y) + w2 * bfhi(c.y));
        o.z = pk2(w0 * bflo(a.z) + w1 * bflo(b.z) + w2 * bflo(c.z), w0 * bfhi(a.z) + w1 * bfhi(b.z) + w2 * bfhi(c.z));
        o.w = pk2(w0 * bflo(a.w) + w1 * bflo(b.w) + w2 * bflo(c.w), w0 * bfhi(a.w) + w1 * bfhi(b.w) + w2 * bfhi(c.w));
        *(u32x4*)(Y2 + (size_t)m * 512 + c8 * 8) = o;
    }
}

struct Args { const float* in[18]; float* out; unsigned char* ws; int ph_lo, ph_hi, li, pad; };
__global__ void __launch_bounds__(NT, 2) mega_fwd(Args args) {
    extern __shared__ __attribute__((aligned(16))) unsigned char lds_raw[];
    Frame F;
    F.lds = (LAS unsigned char*)lds_raw;
    F.tid = threadIdx.x; F.lane = F.tid & 63; F.wave = __builtin_amdgcn_readfirstlane(F.tid >> 6);
    F.G = gridDim.x; { const int bx = blockIdx.x; F.vcu = (F.G % 8 == 0) ? (bx % 8) * (F.G / 8) + bx / 8 : bx; }
#pragma unroll
    for (int i = 0; i < 18; ++i) F.in[i] = args.in[i];
    F.out = args.out; F.ws = args.ws; F.ctl = (unsigned*)(args.ws + WS_CTL);
    volatile LAS unsigned* MISC = (volatile LAS unsigned*)(F.lds + LDS_BYTES - 128);
    if (F.tid < 32) MISC[F.tid] = 0u;
    __syncthreads();
    XcdBarrier bar; bar.bar = F.ctl + CW_BAR; bar.x = 0; bar.st = nullptr;
    if (MK_N_LAUNCHES == 1) bar = xcd_barrier_post(F.ctl + CW_BAR, MISC + 8);
    const int lo = args.ph_lo, hi = args.ph_hi;
#define IN(k) (lo <= (k) && (k) < hi)
#define SEAM(k) do { if (IN(k) && IN((k) + 1)) xcd_barrier(bar); } while (0)
    if (IN(0)) { ph0_convert(F); } SEAM(0);
    if (IN(1)) { pg8::StaticOrder S; S.init(F.ws + WS_XB, F.ws + WS_WT0, M, NP0, D, F.G, (int)blockIdx.x); pg8::EpiBf16 E{(bf16*)(F.ws + WS_P), NP0};
        pg8::gemm_phase<pg8::EpiBf16, pg8::StaticOrder, true, false>(F.lds, D, S, E); } SEAM(1);
    if (IN(2)) { ph_conv_naive(F); } SEAM(2);
    if (IN(3)) { ph_recurrent_naive(F); } SEAM(3);
    if (IN(4)) { pg8::StaticOrder S; S.init(F.ws + WS_Y, F.ws + WS_WO0, M, D, D, F.G, (int)blockIdx.x); pg8::EpiResF32 E{F.in[0], F.out, ALPHA};
        pg8::gemm_phase<pg8::EpiResF32, pg8::StaticOrder, false, false>(F.lds, D, S, E); } SEAM(4);
    if (IN(5)) { convert_experts(F, 0); __syncthreads(); ph_ln<0, true, true>(F, 0); } SEAM(5);
    if (IN(6)) { pg8::MoeOrder S{F.ctl + CW_CNT + 0 * 32 * 64, (const int*)(F.ws + WS_LIST), (const char*)(F.ws + WS_XB), (const char*)(F.ws + WS_EW), 2, F.G, (int)blockIdx.x, D, 0};
        pg8::EpiSwiGLU E{(bf16*)(F.ws + WS_HID)}; pg8::gemm_phase<pg8::EpiSwiGLU, pg8::MoeOrder, true, true>(F.lds, D, S, E); } SEAM(6);
    if (IN(7)) { pg8::MoeOrder S{F.ctl + CW_CNT + 0 * 32 * 64, (const int*)(F.ws + WS_LIST), (const char*)(F.ws + WS_HID), (const char*)(F.ws + WS_EW + EW_DN), 4, F.G, (int)blockIdx.x, DE, 1};
        pg8::EpiMoeOut E{(bf16*)(F.ws + WS_YB), (const int*)(F.ws + WS_LIST)}; pg8::gemm_phase<pg8::EpiMoeOut, pg8::MoeOrder, true, false>(F.lds, DE, S, E); } SEAM(7);
    if (IN(8)) { ph_ln<1, false, true>(F, 0); __syncthreads(); convert_experts(F, 1); } SEAM(8);
    if (IN(9)) { pg8::StaticOrder S; S.init(F.ws + WS_XB, F.ws + WS_WT1, M, IN1, D, F.G, (int)blockIdx.x); pg8::EpiBf16 E{(bf16*)(F.ws + WS_P), IN1};
        pg8::gemm_phase<pg8::EpiBf16, pg8::StaticOrder, true, false>(F.lds, D, S, E); } SEAM(9);
    if (IN(10)) { ph_attn_naive(F); } SEAM(10);
    if (IN(11)) { ph_merge(F); } SEAM(11);
    if (IN(12)) { pg8::StaticOrder S; S.init(F.ws + WS_Y2, F.ws + WS_WO1, M, D, 512, F.G, (int)blockIdx.x); pg8::EpiResF32 E{F.out, F.out, ALPHA};
        pg8::gemm_phase<pg8::EpiResF32, pg8::StaticOrder, false, false>(F.lds, 512, S, E); } SEAM(12);
    if (IN(13)) { ph_ln<0, true, true>(F, 1); } SEAM(13);
    if (IN(14)) { pg8::MoeOrder S{F.ctl + CW_CNT + 1 * 32 * 64, (const int*)(F.ws + WS_LIST), (const char*)(F.ws + WS_XB), (const char*)(F.ws + WS_EW), 2, F.G, (int)blockIdx.x, D, 0};
        pg8::EpiSwiGLU E{(bf16*)(F.ws + WS_HID)}; pg8::gemm_phase<pg8::EpiSwiGLU, pg8::MoeOrder, true, true>(F.lds, D, S, E); } SEAM(14);
    if (IN(15)) { pg8::MoeOrder S{F.ctl + CW_CNT + 1 * 32 * 64, (const int*)(F.ws + WS_LIST), (const char*)(F.ws + WS_HID), (const char*)(F.ws + WS_EW + EW_DN), 4, F.G, (int)blockIdx.x, DE, 1};
        pg8::EpiMoeOut E{(bf16*)(F.ws + WS_YB), (const int*)(F.ws + WS_LIST)}; pg8::gemm_phase<pg8::EpiMoeOut, pg8::MoeOrder, true, false>(F.lds, DE, S, E); } SEAM(15);
    if (IN(16)) { ph_ln<1, false, false>(F, 1); }
#undef IN
#undef SEAM
}

extern "C" void kernel_launch(void* const* d_in, const int* in_sizes, int n_in, void* d_out, int out_size, void* d_ws, size_t ws_size, hipStream_t stream) {
    static int grid = 0;
    if (grid == 0) {
        if (n_in != 18 || in_sizes[0] != M * D || out_size != M * D || ws_size < WS_END) {
            fprintf(stderr, "kernel_launch: unexpected problem (n_in %d, in0 %d, out %d, ws %zu < %zu)\n", n_in, n_in > 0 ? in_sizes[0] : -1, out_size, ws_size, (size_t)WS_END); grid = -1; return; }
        int dev = 0, cus = 0;
        if (hipGetDevice(&dev) != hipSuccess || hipDeviceGetAttribute(&cus, hipDeviceAttributeMultiprocessorCount, dev) != hipSuccess) { grid = -1; return; }
        if (hipFuncSetAttribute((const void*)mega_fwd, hipFuncAttributeMaxDynamicSharedMemorySize, LDS_BYTES) != hipSuccess) { fprintf(stderr, "kernel_launch: hipFuncSetAttribute failed\n"); grid = -1; return; }
        int per_cu = 0;
        if (hipOccupancyMaxActiveBlocksPerMultiprocessor(&per_cu, (const void*)mega_fwd, NT, LDS_BYTES) != hipSuccess || per_cu < 1) fprintf(stderr, "kernel_launch: occupancy query says %d\n", per_cu);
        (void)hipGetLastError();
        grid = cus;
    }
    if (grid < 0) return;
    (void)hipMemsetAsync((char*)d_ws + WS_CTL, 0, CTL_ZERO_BYTES, stream);
    Args a{};
    for (int i = 0; i < 18; ++i) a.in[i] = (const float*)d_in[i];
    a.out = (float*)d_out; a.ws = (unsigned char*)d_ws;
    if (MK_N_LAUNCHES == 1) {
        a.ph_lo = 0; a.ph_hi = N_PHASES; a.li = 0;
        hipLaunchKernelGGL(mega_fwd, dim3(grid), dim3(NT), LDS_BYTES, stream, a);
    } else {
        for (int p = 0; p < N_PHASES; ++p) { a.ph_lo = p; a.ph_hi = p + 1; a.li = p; hipLaunchKernelGGL(mega_fwd, dim3(grid), dim3(NT), LDS_BYTES, stream, a); }
    }
}
```

```cpp
#include <hip/hip_runtime.h>
#include <cstdio>
#include <cstdint>

#ifndef MK_N_LAUNCHES
#define MK_N_LAUNCHES 1
#endif

#define LAS __attribute__((address_space(3)))
typedef unsigned short bf16;
typedef float f32x4 __attribute__((ext_vector_type(4)));
typedef unsigned u32x4 __attribute__((ext_vector_type(4)));
typedef unsigned u32x2 __attribute__((ext_vector_type(2)));
#define RLX_AGENT __ATOMIC_RELAXED, __HIP_MEMORY_SCOPE_AGENT
#define LDS_WAIT() asm volatile("s_waitcnt lgkmcnt(0)" ::: "memory")
#define VM_WAIT() asm volatile("s_waitcnt vmcnt(0)" ::: "memory")

constexpr int NWAVES = 8, NT = NWAVES * 64;
constexpr int BATCH = 2, T = 8192, D = 1024, M = BATCH * T;
constexpr int IN0 = 4104, IN1 = 4608, NP0 = 4096;
constexpr int NE = 32, DE = 256;
constexpr float ALPHA = 1.41421356237309515f;
constexpr float LN_EPS = 1e-5f;
constexpr float KSCALE = 0.08838834764831845f;
constexpr int N_PHASES = 17;

constexpr size_t MiB = 1u << 20;
constexpr size_t WS_CTL = 0, CTL_ZERO_BYTES = 1 * MiB;
constexpr size_t WS_G = 1 * MiB;
constexpr size_t WS_EIDX = WS_G + 512 * 1024;
constexpr size_t WS_GATEV = WS_EIDX + 128 * 1024;
constexpr size_t WS_WT0 = 2 * MiB;
constexpr size_t WS_WO0 = 10 * MiB;
constexpr size_t WS_WT1 = 12 * MiB;
constexpr size_t WS_WO1 = 21 * MiB;
constexpr size_t WS_SE = 22 * MiB;
constexpr size_t WS_EW = WS_SE;
constexpr size_t EW_STRIDE = 3 * MiB / 2, EW_DN = 1 * MiB;
constexpr size_t WS_LIST = WS_SE + 48 * MiB;
constexpr size_t WS_LSE = WS_SE + 50 * MiB;
constexpr size_t WS_XB = 86 * MiB;
constexpr size_t WS_Y = 118 * MiB;
constexpr size_t WS_OG = WS_XB;
constexpr size_t WS_Y2 = WS_XB + 48 * MiB;
constexpr size_t WS_P = 150 * MiB;
constexpr size_t WS_YB = WS_P;
constexpr size_t WS_HID = WS_P + 64 * MiB;
constexpr size_t WS_END = 294 * MiB;
constexpr size_t WS_QKC = WS_SE;

constexpr int CW_BAR = 4096;
constexpr int CW_CNT = 16384;

constexpr int LDS_BYTES = 147456;

__device__ __forceinline__ unsigned f2bf(float f) { unsigned u = __builtin_bit_cast(unsigned, f); return (u + 0x7fffu + ((u >> 16) & 1u)) >> 16; }
__device__ __forceinline__ unsigned pk2(float lo, float hi) { return f2bf(lo) | (f2bf(hi) << 16); }
__device__ __forceinline__ float bf2f(unsigned b) { return __builtin_bit_cast(float, b << 16); }
__device__ __forceinline__ float bflo(unsigned w) { return __builtin_bit_cast(float, w << 16); }
__device__ __forceinline__ float bfhi(unsigned w) { return __builtin_bit_cast(float, w & 0xffff0000u); }
__device__ __forceinline__ float wave_sum(float v) {
#pragma unroll
    for (int o = 1; o < 64; o <<= 1) v += __shfl_xor(v, o);
    return v;
}
__device__ __forceinline__ float sigmoidf_(float x) { return 1.f / (1.f + __expf(-x)); }
__device__ __forceinline__ float siluf_(float x) { return x / (1.f + __expf(-x)); }

#define XB_TMO      128
#define XB_XCNT(j)  (256  + 64 * (j))
#define XB_XSUB(j)  (1280 + 64 * (j))
#define XB_XGEN(j)  (2304 + 64 * (j))
#define XB_TOP      3328
#define XB_TOPGEN   3392
#define XCD_BAR_WORDS 3456
#define XB_SPIN_CAP (1u << 22)
__device__ __forceinline__ unsigned xb_ld(unsigned* p)              { return __hip_atomic_load(p, __ATOMIC_RELAXED, __HIP_MEMORY_SCOPE_AGENT); }
__device__ __forceinline__ unsigned xb_add(unsigned* p, unsigned v) { return __hip_atomic_fetch_add(p, v, __ATOMIC_RELAXED, __HIP_MEMORY_SCOPE_AGENT); }
__device__ __forceinline__ unsigned xb_xcc_id() { return (unsigned)__builtin_amdgcn_s_getreg((3 << 11) | 20) & 0xFu; }
#define XB_SPIN(cond, bar) do { unsigned _sp = 0; while (cond) { __builtin_amdgcn_s_sleep(1); \
    if ((++_sp & 255u) == 0u) { if (xb_ld(&(bar)[XB_TMO])) break; if (_sp > XB_SPIN_CAP) { atomicAdd(&(bar)[XB_TMO], 1u); break; } } } } while (0)
struct XcdBarrier { unsigned* bar; unsigned x; volatile LAS unsigned* st; };
__device__ __forceinline__ XcdBarrier xcd_barrier_post(unsigned* bar, volatile LAS unsigned* st) {
    XcdBarrier b; b.bar = bar; b.x = xb_xcc_id(); b.st = st;
    if (threadIdx.x == 0) (void)xb_add(&bar[XB_XCNT(b.x)], 1u);
    return b;
}
__device__ __forceinline__ void xcd_barrier_complete(unsigned* bar, unsigned x, unsigned& nloc, unsigned& nx) {
    const unsigned G = gridDim.x * gridDim.y * gridDim.z;
    unsigned sum, cnt, mine, sp = 0u;
    for (;;) {
        sum = 0u; cnt = 0u; mine = 0u;
#pragma unroll
        for (unsigned j = 0; j < 16; ++j) { const unsigned c = xb_ld(&bar[XB_XCNT(j)]); sum += c; cnt += (c > 0u) ? 1u : 0u; mine = (j == x) ? c : mine; }
        if (sum == G) break;
        __builtin_amdgcn_s_sleep(1);
        if ((++sp & 255u) == 0u) { if (xb_ld(&bar[XB_TMO])) break; if (sp > XB_SPIN_CAP) { atomicAdd(&bar[XB_TMO], 1u); break; } }
    }
    nloc = mine > 0u ? mine : 1u; nx = cnt > 0u ? cnt : 1u;
}
__device__ __forceinline__ void xcd_barrier(const XcdBarrier& b) {
    asm volatile("s_waitcnt vmcnt(0)" ::: "memory");
    __syncthreads();
    if (threadIdx.x == 0) {
        unsigned* bar = b.bar;
        __builtin_amdgcn_s_waitcnt(0);
        unsigned nloc = b.st[0], nx = b.st[1];
        if (nloc == 0u) { xcd_barrier_complete(bar, b.x, nloc, nx); b.st[0] = nloc; b.st[1] = nx; }
        const unsigned old = xb_add(&bar[XB_XSUB(b.x)], 1u);
        const unsigned gen = old / nloc;
        if (old + 1u == (gen + 1u) * nloc) {
            __builtin_amdgcn_fence(__ATOMIC_RELEASE, "agent");
            asm volatile("s_waitcnt vmcnt(0)" ::: "memory");
            const unsigned og = xb_add(&bar[XB_TOP], 1u);
            const unsigned tg = og / nx;
            if (og + 1u == (tg + 1u) * nx) xb_add(&bar[XB_TOPGEN], 1u);
            else XB_SPIN(xb_ld(&bar[XB_TOPGEN]) == tg, bar);
            __builtin_amdgcn_fence(__ATOMIC_ACQUIRE, "agent");
            xb_add(&bar[XB_XGEN(b.x)], 1u);
            asm volatile("s_waitcnt vmcnt(0)" ::: "memory");
        } else {
            XB_SPIN(xb_ld(&bar[XB_XGEN(b.x)]) == gen, bar);
            __builtin_amdgcn_fence(__ATOMIC_ACQUIRE, "agent");
            asm volatile("s_waitcnt vmcnt(0)" ::: "memory");
        }
    }
    __syncthreads();
}

struct Frame {
    LAS unsigned char* lds;
    unsigned* ctl;
    int tid, lane, wave, vcu, G;
    const float* in[18];
    float* out;
    unsigned char* ws;
};

namespace pg8 {
typedef short bf16x8 __attribute__((ext_vector_type(8)));
constexpr int BM = 256, BK = 64, HALF = 128, HTB = HALF * BK * 2, STAGE_BYTES = 8 * HTB, NXCD = 8, WGM = 8;
__host__ __device__ __forceinline__ int lds_byte(int r, int c) { const int st = (r >> 4) * 2 + (c >> 5), rr = r & 15, cc = c & 31, ob = rr * 64 + cc * 2; return st * 1024 + (ob ^ (((ob >> 9) & 1) << 5)); }
__host__ __device__ __forceinline__ void stage_rc(int b, int& R, int& C) { const int st = b / 1024, sb = b % 1024, swz = sb ^ (((sb >> 9) & 1) << 5); R = (st >> 1) * 16 + swz / 64; C = (st & 1) * 32 + (swz % 64) / 2; }
__host__ __device__ __forceinline__ int perm32(int rho) { const int n = rho >> 4, i = rho & 15; return 8 * (i >> 2) + 4 * n + (i & 3); }
struct Unit { int pm, pn, e, cnt, hb; };
__device__ __forceinline__ unsigned cvt_pk_bf16(float lo, float hi) { unsigned r; asm volatile("v_cvt_pk_bf16_f32 %0, %1, %2" : "=v"(r) : "v"(lo), "v"(hi)); return r; }

struct StaticOrder {
    int nM, nN, nwg, G, c, K; const char* A; const char* Bt;
    __device__ void init(const void* A_, const void* Bt_, int M_, int N_, int K_, int G_, int c_) { A = (const char*)A_; Bt = (const char*)Bt_; nM = M_ / BM; nN = N_ / BM; nwg = nM * nN; G = G_; c = c_; K = K_; }
    __device__ bool next(int i, Unit& u) const {
        const long L = (long)i * G + c; if (L >= nwg) return false;
        int wgid = (int)L; { const int q = nwg / NXCD, r = nwg % NXCD, xcd = wgid % NXCD, off = wgid / NXCD; wgid = (xcd < r ? xcd * (q + 1) : r * (q + 1) + (xcd - r) * q) + off; }
        const int nig = WGM * nN, gid = wgid / nig, fm = gid * WGM, gsz = (nM - fm) < WGM ? (nM - fm) : WGM;
        u.pm = fm + ((wgid % nig) % gsz); u.pn = (wgid % nig) / gsz; u.e = 0; u.cnt = 0; u.hb = 0; return true;
    }
    __device__ __forceinline__ void base(const Unit& u, const char*& cA, const char*& cB) const { cA = A + (size_t)u.pm * BM * K * 2; cB = Bt + (size_t)u.pn * BM * K * 2; }
    __device__ __forceinline__ unsigned rowoff(const Unit&, int) const { return 0u; }
};

struct EpiBf16 {
    static constexpr bool PERM = true;
    bf16* O; int ldc;
    __device__ __forceinline__ void operator()(const f32x4 (&acc)[2][2][4][2], const Unit& u, int wr, int wc, int fr, int fq) const {
        const int row0 = u.pm * BM + wr * 64 + fr, col0 = u.pn * BM + wc * 32 + 8 * fq;
#pragma unroll
        for (int ai = 0; ai < 2; ++ai)
#pragma unroll
            for (int m = 0; m < 4; ++m) { bf16* rowp = O + (size_t)(row0 + ai * HALF + m * 16) * ldc + col0;
#pragma unroll
                for (int bj = 0; bj < 2; ++bj) { const f32x4 v0 = acc[ai][bj][m][0], v1 = acc[ai][bj][m][1];
                    u32x4 w; w.x = cvt_pk_bf16(v0[0], v0[1]); w.y = cvt_pk_bf16(v0[2], v0[3]); w.z = cvt_pk_bf16(v1[0], v1[1]); w.w = cvt_pk_bf16(v1[2], v1[3]);
                    *(u32x4*)(rowp + bj * HALF) = w; } }
    }
};
struct EpiResF32 {
    static constexpr bool PERM = false;
    const float* base; float* out; float alpha;
    __device__ __forceinline__ void operator()(const f32x4 (&acc)[2][2][4][2], const Unit& u, int wr, int wc, int fr, int fq) const {
        const int col0 = u.pn * BM + wc * 32 + 4 * fq;
#pragma unroll
        for (int ai = 0; ai < 2; ++ai)
#pragma unroll
            for (int m = 0; m < 4; ++m) { const size_t off = (size_t)(u.pm * BM + ai * HALF + wr * 64 + m * 16 + fr) * 1024 + col0;
#pragma unroll
                for (int bj = 0; bj < 2; ++bj)
#pragma unroll
                    for (int n = 0; n < 2; ++n) { const f32x4 b = *(const f32x4*)(base + off + bj * HALF + n * 16); *(f32x4*)(out + off + bj * HALF + n * 16) = b * alpha + acc[ai][bj][m][n]; } }
    }
};

struct MoeOrder {
    const unsigned* cnt; const int* LIST; const char* A; const char* B; int NTN, G, c, K, mode;
    __device__ bool next(int i, Unit& u) const {
        const int L = i * G + c; int base = 0, hb = 0;
        for (int e = 0; e < 32; ++e) { const int cc = (int)cnt[e * 64]; const int nmb = (cc + 255) >> 8; const int ntl = nmb * NTN;
            if (L < base + ntl) { const int r = L - base; u.e = e; u.pm = r / NTN; u.pn = r % NTN; u.cnt = cc; u.hb = hb; return true; }
            base += ntl; hb += nmb << 8; }
        return false;
    }
    __device__ __forceinline__ void base(const Unit& u, const char*& cA, const char*& cB) const {
        cA = mode == 0 ? A : A + (size_t)(u.hb + u.pm * 256) * K * 2; cB = B + (size_t)u.e * EW_STRIDE + (size_t)u.pn * 256 * K * 2; }
    __device__ __forceinline__ unsigned rowoff(const Unit& u, int r) const { int i = u.pm * 256 + r; i = i < u.cnt ? i : 0; return (unsigned)(LIST[u.e * M + i] >> 1) * 2048u; }
};
struct EpiSwiGLU {
    static constexpr bool PERM = true;
    bf16* HID;
    __device__ __forceinline__ void operator()(const f32x4 (&acc)[2][2][4][2], const Unit& u, int wr, int wc, int fr, int fq) const {
#pragma unroll
        for (int ai = 0; ai < 2; ++ai)
#pragma unroll
            for (int m = 0; m < 4; ++m) { const int i = u.pm * 256 + ai * HALF + wr * 64 + m * 16 + fr;
                if (i < u.cnt) { const f32x4 g0 = acc[ai][0][m][0], g1 = acc[ai][0][m][1], u0 = acc[ai][1][m][0], u1 = acc[ai][1][m][1];
                    u32x4 w; w.x = cvt_pk_bf16(siluf_(g0[0]) * u0[0], siluf_(g0[1]) * u0[1]); w.y = cvt_pk_bf16(siluf_(g0[2]) * u0[2], siluf_(g0[3]) * u0[3]);
                    w.z = cvt_pk_bf16(siluf_(g1[0]) * u1[0], siluf_(g1[1]) * u1[1]); w.w = cvt_pk_bf16(siluf_(g1[2]) * u1[2], siluf_(g1[3]) * u1[3]);
                    *(u32x4*)(HID + (size_t)(u.hb + i) * DE + u.pn * 128 + wc * 32 + 8 * fq) = w; } }
    }
};
struct EpiMoeOut {
    static constexpr bool PERM = true;
    bf16* YB; const int* LIST;
    __device__ __forceinline__ void operator()(const f32x4 (&acc)[2][2][4][2], const Unit& u, int wr, int wc, int fr, int fq) const {
#pragma unroll
        for (int ai = 0; ai < 2; ++ai)
#pragma unroll
            for (int m = 0; m < 4; ++m) { const int i = u.pm * 256 + ai * HALF + wr * 64 + m * 16 + fr;
                if (i < u.cnt) { const int a = LIST[u.e * M + i]; bf16* rowp = YB + (size_t)a * D + u.pn * 256 + wc * 32 + 8 * fq;
#pragma unroll
                    for (int bj = 0; bj < 2; ++bj) { const f32x4 v0 = acc[ai][bj][m][0], v1 = acc[ai][bj][m][1];
                        u32x4 w; w.x = cvt_pk_bf16(v0[0], v0[1]); w.y = cvt_pk_bf16(v0[2], v0[3]); w.z = cvt_pk_bf16(v1[0], v1[1]); w.w = cvt_pk_bf16(v1[2], v1[3]);
                        *(u32x4*)(rowp + bj * HALF) = w; } }
                asm volatile("" ::: "memory"); }
    }
};

template <class Epi, class Sched, bool ALIGN_EPI, bool GATHER>
__device__ __forceinline__ void gemm_phase(LAS unsigned char* lds, const int K, const Sched& S, const Epi& E) {
    const int tid = threadIdx.x, wid = __builtin_amdgcn_readfirstlane(tid >> 6), lane = tid & 63, wr = wid >> 2, wc = wid & 3, fr = lane & 15, fq = lane >> 4;
    const int nt = K / BK;
    int Rr[2], Cc[2]; unsigned voffB[2];
#pragma unroll
    for (int i = 0; i < 2; ++i) { int R, C; stage_rc(tid * 16 + i * 8192, R, C); const int Rb = Epi::PERM ? ((R & ~31) + perm32(R & 31)) : R; Rr[i] = R; Cc[i] = C; voffB[i] = (unsigned)(Rb * K + C) * 2u; }
    const size_t kstep = (size_t)(BK * 2);
    const size_t hstep = (size_t)HALF * K * 2;
    const unsigned ldsw = (unsigned)wid * 1024u;
    const int aoff = lds_byte(wr * 64 + fr, fq * 8), boff = lds_byte(wc * 32 + fr, fq * 8);
#define PG8_SA(b, h) (((b) * 2 + (h)) * HTB)
#define PG8_SB(b, h) ((4 + (b) * 2 + (h)) * HTB)
#define PG8_STAGE(bufoff, gbase, voff) do { _Pragma("unroll") for (int _i = 0; _i < 2; ++_i) \
        __builtin_amdgcn_global_load_lds((const unsigned*)((const char*)(gbase) + (voff)[_i]), (LAS unsigned*)(lds + (bufoff) + ldsw + _i * 8192), 16, 0, 0); } while (0)
#define PG8_STAGE_A(bufoff, gbase, o0, o1) do { \
        __builtin_amdgcn_global_load_lds((const unsigned*)((const char*)(gbase) + (o0)), (LAS unsigned*)(lds + (bufoff) + ldsw), 16, 0, 0); \
        __builtin_amdgcn_global_load_lds((const unsigned*)((const char*)(gbase) + (o1)), (LAS unsigned*)(lds + (bufoff) + ldsw + 8192), 16, 0, 0); } while (0)
#define PG8_LDA(dst, b, h) do { _Pragma("unroll") for (int m = 0; m < 4; ++m) _Pragma("unroll") for (int k = 0; k < 2; ++k) dst[m][k] = *(const LAS bf16x8*)(lds + PG8_SA(b, h) + aoff + m * 2048 + k * 1024); } while (0)
#define PG8_LDB(dst, b, h) do { _Pragma("unroll") for (int n = 0; n < 2; ++n) _Pragma("unroll") for (int k = 0; k < 2; ++k) dst[n][k] = *(const LAS bf16x8*)(lds + PG8_SB(b, h) + boff + n * 2048 + k * 1024); } while (0)
#define PG8_MMA(ai, bj, At, Bt) do { __builtin_amdgcn_s_setprio(1); _Pragma("unroll") for (int m = 0; m < 4; ++m) _Pragma("unroll") for (int n = 0; n < 2; ++n) _Pragma("unroll") for (int k = 0; k < 2; ++k) \
        acc[ai][bj][m][n] = __builtin_amdgcn_mfma_f32_16x16x32_bf16(Bt[n][k], At[m][k], acc[ai][bj][m][n], 0, 0, 0); __builtin_amdgcn_s_setprio(0); } while (0)
#define PG8_WAIT_V(n) asm volatile("s_waitcnt vmcnt(" #n ")" ::: "memory")
#define PG8_WAIT_L(n) asm volatile("s_waitcnt lgkmcnt(" #n ")" ::: "memory")
#define PG8_BAR __builtin_amdgcn_s_barrier()
#define PG8_SCHED __builtin_amdgcn_sched_barrier(0)
#define PG8_CALC_VA(u, v) do { _Pragma("unroll") for (int _h = 0; _h < 2; ++_h) _Pragma("unroll") for (int _i = 0; _i < 2; ++_i) \
        v[_h][_i] = GATHER ? (S.rowoff(u, _h * HALF + Rr[_i]) + (unsigned)Cc[_i] * 2u) : (unsigned)((_h * HALF + Rr[_i]) * K + Cc[_i]) * 2u; } while (0)
    Unit cur, nxt; int ui = 0;
    if (!S.next(0, cur)) return;
    f32x4 acc[2][2][4][2];
#pragma unroll
    for (int a = 0; a < 2; ++a)
#pragma unroll
        for (int b = 0; b < 2; ++b)
#pragma unroll
            for (int m = 0; m < 4; ++m)
#pragma unroll
                for (int n = 0; n < 2; ++n) acc[a][b][m][n] = (f32x4){0.f, 0.f, 0.f, 0.f};
    bf16x8 At[4][2], B0[2][2], B1[2][2];
    const char* cA; const char* cB; S.base(cur, cA, cB);
    unsigned cvA[2][2], nvA[2][2];
    PG8_CALC_VA(cur, cvA);
    PG8_STAGE(PG8_SB(0, 0), cB, voffB); PG8_STAGE(PG8_SB(0, 1), cB + hstep, voffB); PG8_STAGE_A(PG8_SA(0, 0), cA, cvA[0][0], cvA[0][1]); PG8_STAGE_A(PG8_SA(0, 1), cA, cvA[1][0], cvA[1][1]);
    if (wr == 1) PG8_BAR;
    PG8_WAIT_V(2); PG8_BAR;
    PG8_STAGE(PG8_SB(1, 0), cB + kstep, voffB); PG8_STAGE_A(PG8_SA(1, 0), cA + kstep, cvA[0][0], cvA[0][1]); PG8_STAGE(PG8_SB(1, 1), cB + hstep + kstep, voffB);
    PG8_WAIT_V(6); PG8_BAR;
    for (;;) {
        const bool has_next = S.next(ui + 1, nxt);
        const char* nA = cA; const char* nB = cB;
        if (has_next) { S.base(nxt, nA, nB); PG8_CALC_VA(nxt, nvA); }
        else {
#pragma unroll
            for (int h = 0; h < 2; ++h)
#pragma unroll
                for (int i = 0; i < 2; ++i) nvA[h][i] = cvA[h][i]; }
        if (GATHER) { asm volatile("s_waitcnt vmcnt(0)" ::: "memory"); asm volatile("" : "+v"(nvA[0][0]), "+v"(nvA[0][1]), "+v"(nvA[1][0]), "+v"(nvA[1][1])); }
#pragma unroll 1
        for (int t = 0; t < nt; t += 2) {
            const bool last = (t == nt - 2);
            const char* a1 = cA + (size_t)(t + 1) * kstep;
            const char* a2 = last ? nA : cA + (size_t)(t + 2) * kstep; const char* b2 = last ? nB : cB + (size_t)(t + 2) * kstep;
            const char* a3 = a2 + kstep; const char* b3 = b2 + kstep;
            const unsigned x00 = last ? nvA[0][0] : cvA[0][0], x01 = last ? nvA[0][1] : cvA[0][1], x10 = last ? nvA[1][0] : cvA[1][0], x11 = last ? nvA[1][1] : cvA[1][1];
            PG8_LDB(B0, 0, 0); PG8_LDB(B1, 0, 1); PG8_SCHED; PG8_LDA(At, 0, 0); PG8_STAGE_A(PG8_SA(1, 1), a1, cvA[1][0], cvA[1][1]);
            PG8_WAIT_V(8); PG8_WAIT_L(0); PG8_BAR; PG8_MMA(0, 0, At, B0); PG8_MMA(0, 1, At, B1); PG8_BAR; PG8_SCHED;
            PG8_LDA(At, 0, 1); PG8_STAGE(PG8_SB(0, 0), b2, voffB); PG8_STAGE(PG8_SB(0, 1), b2 + hstep, voffB); PG8_STAGE_A(PG8_SA(0, 0), a2, x00, x01);
            PG8_WAIT_V(8); PG8_WAIT_L(0); PG8_BAR; PG8_MMA(1, 0, At, B0); PG8_MMA(1, 1, At, B1); PG8_BAR; PG8_SCHED;
            PG8_LDB(B0, 1, 0); PG8_LDB(B1, 1, 1); PG8_SCHED; PG8_LDA(At, 1, 0); PG8_STAGE_A(PG8_SA(0, 1), a2, x10, x11);
            PG8_WAIT_V(8); PG8_WAIT_L(0); PG8_BAR; PG8_MMA(0, 0, At, B0); PG8_MMA(0, 1, At, B1); PG8_BAR; PG8_SCHED;
            PG8_LDA(At, 1, 1); PG8_STAGE(PG8_SB(1, 0), b3, voffB); PG8_STAGE(PG8_SB(1, 1), b3 + hstep, voffB); PG8_STAGE_A(PG8_SA(1, 0), a3, x00, x01);
            PG8_WAIT_V(8); PG8_WAIT_L(0); PG8_BAR; PG8_MMA(1, 0, At, B0); PG8_MMA(1, 1, At, B1); PG8_BAR; PG8_SCHED;
        }
        if constexpr (ALIGN_EPI) { if (wr == 0) PG8_BAR; }
        E(acc, cur, wr, wc, fr, fq);
        if (!has_next) break;
#pragma unroll
        for (int a = 0; a < 2; ++a)
#pragma unroll
            for (int b = 0; b < 2; ++b)
#pragma unroll
                for (int m = 0; m < 4; ++m)
#pragma unroll
                    for (int n = 0; n < 2; ++n) acc[a][b][m][n] = (f32x4){0.f, 0.f, 0.f, 0.f};
        cur = nxt; cA = nA; cB = nB; ++ui;
#pragma unroll
        for (int h = 0; h < 2; ++h)
#pragma unroll
            for (int i = 0; i < 2; ++i) cvA[h][i] = nvA[h][i];
        if constexpr (ALIGN_EPI) { if (wr == 1) PG8_BAR; }
    }
    PG8_WAIT_V(0);
    if constexpr (!ALIGN_EPI) { if (wr == 0) PG8_BAR; }
    PG8_BAR;
#undef PG8_SA
#undef PG8_SB
#undef PG8_STAGE
#undef PG8_STAGE_A
#undef PG8_LDA
#undef PG8_LDB
#undef PG8_MMA
#undef PG8_WAIT_V
#undef PG8_WAIT_L
#undef PG8_BAR
#undef PG8_SCHED
#undef PG8_CALC_VA
}
}

template <class RowFn>
__device__ __forceinline__ void ngemm_tile(LAS float* sA, LAS float* sB, RowFn rowA, const bf16* Bt, int ldb, int K, float (&acc)[4][4]) {
    const int tid = threadIdx.x, tx = tid & 15, ty = tid >> 4;
#pragma unroll
    for (int i = 0; i < 4; ++i)
#pragma unroll
        for (int j = 0; j < 4; ++j) acc[i][j] = 0.f;
    const int ar = tid >> 2, ak = (tid & 3) * 8, br = tid >> 3, bk = (tid & 7) * 4;
    const bf16* ap = rowA(ar);
    const bf16* bp = Bt + (size_t)br * ldb;
    for (int k0 = 0; k0 < K; k0 += 32) {
        u32x4 av = (u32x4){0u, 0u, 0u, 0u};
        if (ap) av = *(const u32x4*)(ap + k0 + ak);
        const u32x2 bv = *(const u32x2*)(bp + k0 + bk);
        __syncthreads();
        LAS float* wa = sA + ar * 33 + ak;
        wa[0] = bflo(av.x); wa[1] = bfhi(av.x); wa[2] = bflo(av.y); wa[3] = bfhi(av.y); wa[4] = bflo(av.z); wa[5] = bfhi(av.z); wa[6] = bflo(av.w); wa[7] = bfhi(av.w);
        LAS float* wb = sB + br * 33 + bk;
        wb[0] = bflo(bv.x); wb[1] = bfhi(bv.x); wb[2] = bflo(bv.y); wb[3] = bfhi(bv.y);
        __syncthreads();
#pragma unroll 8
        for (int kk = 0; kk < 32; ++kk) {
            float a[4], b[4];
#pragma unroll
            for (int i = 0; i < 4; ++i) a[i] = sA[(ty * 4 + i) * 33 + kk];
#pragma unroll
            for (int j = 0; j < 4; ++j) b[j] = sB[(tx * 4 + j) * 33 + kk];
#pragma unroll
            for (int i = 0; i < 4; ++i)
#pragma unroll
                for (int j = 0; j < 4; ++j) acc[i][j] = fmaf(a[i], b[j], acc[i][j]);
        }
    }
}

__device__ __forceinline__ void tr_item(const float* W, int ldw, bf16* WT, int ldt, LAS float* scr, int kb, int nb, int lane) {
    const int k0 = 64 * kb, n0 = 32 * nb;
#pragma unroll 8
    for (int i = 0; i < 32; ++i) { const int kk = 2 * i + (lane >> 5); scr[kk * 33 + (lane & 31)] = W[(size_t)(k0 + kk) * ldw + n0 + (lane & 31)]; }
    LDS_WAIT(); asm volatile("" ::: "memory");
    const int c = lane & 7;
#pragma unroll
    for (int j = 0; j < 4; ++j) { const int n = (lane >> 3) + 8 * j; const LAS float* s = scr + (8 * c) * 33 + n;
        u32x4 o; o.x = pk2(s[0 * 33], s[1 * 33]); o.y = pk2(s[2 * 33], s[3 * 33]); o.z = pk2(s[4 * 33], s[5 * 33]); o.w = pk2(s[6 * 33], s[7 * 33]);
        *(u32x4*)(WT + (size_t)(n0 + n) * ldt + k0 + 8 * c) = o; }
    LDS_WAIT(); asm volatile("" ::: "memory");
}

__device__ __forceinline__ void ph0_convert(Frame& F) {
    LAS float* scr = (LAS float*)(F.lds + F.wave * 9216);
    LAS float* gw = (LAS float*)(F.lds + 8 * 9216);
    const float* w0 = F.in[1];
    for (int i = F.tid; i < 8 * 1024; i += NT) { const int j = i >> 10, k = i & 1023; gw[i] = w0[(size_t)k * IN0 + 2048 + j]; }
    __syncthreads();
    const int gwv = F.vcu * NWAVES + F.wave, NGW = F.G * NWAVES;
    bf16* WT0 = (bf16*)(F.ws + WS_WT0); bf16* WO0 = (bf16*)(F.ws + WS_WO0); bf16* WT1 = (bf16*)(F.ws + WS_WT1); bf16* WO1 = (bf16*)(F.ws + WS_WO1);
    constexpr int I0 = 16 * 64, I1 = 16 * 64, I2 = 16 * 32, I3 = 16 * 144, I4 = 8 * 32, NI = I0 + I1 + I2 + I3 + I4;
    for (int it = gwv; it < NI; it += NGW) {
        int r = it;
        if (r < I0) { tr_item(w0, IN0, WT0, 1024, scr, r / 64, r % 64, F.lane); continue; } r -= I0;
        if (r < I1) { tr_item(w0 + 2056, IN0, WT0 + (size_t)2048 * 1024, 1024, scr, r / 64, r % 64, F.lane); continue; } r -= I1;
        if (r < I2) { tr_item(F.in[8], 1024, WO0, 1024, scr, r / 32, r % 32, F.lane); continue; } r -= I2;
        if (r < I3) { tr_item(F.in[9], IN1, WT1, 1024, scr, r / 144, r % 144, F.lane); continue; } r -= I3;
        tr_item(F.in[10], 1024, WO1, 512, scr, r / 32, r % 32, F.lane);
    }
    const float* x = F.in[0]; bf16* XB = (bf16*)(F.ws + WS_XB); float* G = (float*)(F.ws + WS_G);
    const float* ib = F.in[2]; const float* fb = F.in[3];
    for (int m = gwv; m < M; m += NGW) {
        const f32x4* xr = (const f32x4*)(x + (size_t)m * D) + F.lane;
        f32x4 v[4];
#pragma unroll
        for (int j = 0; j < 4; ++j) v[j] = xr[64 * j];
        unsigned long long* o8 = (unsigned long long*)(XB + (size_t)m * D) + F.lane;
#pragma unroll
        for (int j = 0; j < 4; ++j) o8[64 * j] = (unsigned long long)pk2(v[j].x, v[j].y) | ((unsigned long long)pk2(v[j].z, v[j].w) << 32);
        float acc[8];
#pragma unroll
        for (int g = 0; g < 8; ++g) { float a = 0.f;
#pragma unroll
            for (int j = 0; j < 4; ++j) { const f32x4 w = *(const LAS f32x4*)(gw + g * 1024 + 4 * F.lane + 256 * j); a += v[j].x * w.x + v[j].y * w.y + v[j].z * w.z + v[j].w * w.w; }
            acc[g] = wave_sum(a); }
        if (F.lane == 0) {
#pragma unroll
            for (int g = 0; g < 4; ++g) G[(size_t)m * 8 + g] = acc[g] + ib[g];
#pragma unroll
            for (int g = 0; g < 4; ++g) { const float z = acc[4 + g] + fb[g]; G[(size_t)m * 8 + 4 + g] = fminf(z, 0.f) - log1pf(__expf(-fabsf(z))); }
        }
    }
}

__device__ __forceinline__ void convert_experts(Frame& F, int layer) {
    LAS float* scr = (LAS float*)(F.lds + F.wave * 9216);
    const int gwv = F.vcu * NWAVES + F.wave, NGW = F.G * NWAVES;
    const float* wg = F.in[13] + (size_t)layer * NE * D * DE; const float* wu = F.in[14] + (size_t)layer * NE * D * DE; const float* wd = F.in[15] + (size_t)layer * NE * DE * D;
    for (int it = gwv; it < NE * 384; it += NGW) {
        const int e = it / 384; int r = it % 384;
        bf16* GU = (bf16*)(F.ws + WS_EW + (size_t)e * EW_STRIDE); bf16* DN = (bf16*)(F.ws + WS_EW + (size_t)e * EW_STRIDE + EW_DN);
        if (r < 256) { const int job = r >> 6, q = r & 63;
            const float* src = ((job < 2) ? wg : wu) + (size_t)e * D * DE + (job & 1) * 128;
            bf16* dst = GU + (size_t)((job & 1) * 256 + (job >> 1) * 128) * 1024;
            tr_item(src, DE, dst, 1024, scr, q >> 2, q & 3, F.lane);
        } else { r -= 256;
            tr_item(wd + (size_t)e * DE * D, D, DN, DE, scr, r >> 5, r & 31, F.lane); }
    }
}

__device__ __forceinline__ void ph_inproj_naive(Frame& F, const bf16* Bt, int N) {
    LAS float* sA = (LAS float*)F.lds; LAS float* sB = sA + 128 * 33;
    const bf16* XB = (const bf16*)(F.ws + WS_XB); bf16* P = (bf16*)(F.ws + WS_P);
    const int nnb = N / 64, ntiles = (M / 128) * nnb, tx = F.tid & 15, ty = F.tid >> 4;
    for (int t = blockIdx.x; t < ntiles; t += F.G) {
        const int mb = t / nnb, nb = t % nnb; float acc[4][4];
        ngemm_tile(sA, sB, [&](int r) { return XB + (size_t)(mb * 128 + r) * D; }, Bt + (size_t)nb * 64 * D, D, D, acc);
#pragma unroll
        for (int i = 0; i < 4; ++i) { u32x2 o; o.x = pk2(acc[i][0], acc[i][1]); o.y = pk2(acc[i][2], acc[i][3]);
            *(u32x2*)(P + (size_t)(mb * 128 + ty * 4 + i) * N + nb * 64 + tx * 4) = o; }
    }
}
__device__ __forceinline__ void ph_outproj_naive(Frame& F, const bf16* A, int K, const bf16* Bt, const float* base) {
    LAS float* sA = (LAS float*)F.lds; LAS float* sB = sA + 128 * 33;
    const int nnb = D / 64, ntiles = (M / 128) * nnb, tx = F.tid & 15, ty = F.tid >> 4;
    for (int t = blockIdx.x; t < ntiles; t += F.G) {
        const int mb = t / nnb, nb = t % nnb; float acc[4][4];
        ngemm_tile(sA, sB, [&](int r) { return A + (size_t)(mb * 128 + r) * K; }, Bt + (size_t)nb * 64 * K, K, K, acc);
#pragma unroll
        for (int i = 0; i < 4; ++i) { const size_t off = (size_t)(mb * 128 + ty * 4 + i) * D + nb * 64 + tx * 4;
            const f32x4 b = *(const f32x4*)(base + off);
            *(f32x4*)(F.out + off) = (f32x4){ALPHA * b.x + acc[i][0], ALPHA * b.y + acc[i][1], ALPHA * b.z + acc[i][2], ALPHA * b.w + acc[i][3]}; }
    }
}

__device__ __forceinline__ void ph_conv_naive(Frame& F) {
    const bf16* P = (const bf16*)(F.ws + WS_P); bf16* QKC = (bf16*)(F.ws + WS_QKC);
    const float* cw = F.in[4]; const float* cb = F.in[5];
    const size_t total = (size_t)M * 1024, nth = (size_t)F.G * NT;
    for (size_t i = (size_t)blockIdx.x * NT + F.tid; i < total; i += nth) {
        const int m = (int)(i >> 10), c = (int)(i & 1023), t = m & (T - 1);
        float a = cb[c];
#pragma unroll
        for (int j = 0; j < 4; ++j) { const int tt = t - 3 + j; if (tt >= 0) a += cw[j * 1024 + c] * bf2f(P[(size_t)(m - 3 + j) * NP0 + c]); }
        QKC[i] = (bf16)f2bf(siluf_(a));
    }
}
__device__ __forceinline__ void ph_recurrent_naive(Frame& F) {
    if (blockIdx.x >= 16) return;
    const int type = blockIdx.x >> 3, b = (blockIdx.x >> 2) & 1, h = blockIdx.x & 3;
    LAS float* sin = (LAS float*)F.lds;
    LAS float* red = sin + 1024;
    LAS float* redd = red + 512;
    LAS float* sc = redd + 4;
    const bf16* P = (const bf16*)(F.ws + WS_P); const bf16* QKC = (const bf16*)(F.ws + WS_QKC); const float* G = (const float*)(F.ws + WS_G);
    bf16* Y = (bf16*)(F.ws + WS_Y);
    const float* gain = (type == 0 ? F.in[6] : F.in[7]) + h * 128;
    const int e = F.tid & 127, dg = F.tid >> 7, which = dg;
    const float gamma = 1.f - exp2f(-5.f - (float)h);
    float C[32], nn[32];
#pragma unroll
    for (int j = 0; j < 32; ++j) { C[j] = 0.f; nn[j] = 0.f; }
    const bf16* src; size_t stride;
    if (type == 0) { if (which < 2) { src = QKC + which * 512 + h * 128 + e; stride = 1024; } else { src = P + 1024 + (which - 2) * 512 + h * 128 + e; stride = NP0; } }
    else { src = P + 2048 + which * 512 + h * 128 + e; stride = NP0; }
    const float mul = (which == 1) ? KSCALE : 1.f;
    const size_t m0 = (size_t)b * T;
    float val = bf2f(src[m0 * stride]) * mul;
    float s0 = 0.f, s1 = 0.f;
    if (F.tid == 0) { if (type == 0) { s0 = __expf(G[m0 * 8 + 4 + h]); s1 = __expf(G[m0 * 8 + h]); } else { s0 = gamma; s1 = 1.f; } }
    for (int t = 0; t < T; ++t) {
        const size_t m = m0 + t; const int pb = t & 1;
        sin[pb * 512 + F.tid] = val;
        if (F.tid == 0) { sc[pb * 2] = s0; sc[pb * 2 + 1] = s1; }
        if (t + 1 < T) { val = bf2f(src[(m + 1) * stride]) * mul;
            if (F.tid == 0 && type == 0) { s0 = __expf(G[(m + 1) * 8 + 4 + h]); s1 = __expf(G[(m + 1) * 8 + h]); } }
        __syncthreads();
        const float f = sc[pb * 2], ig = sc[pb * 2 + 1];
        const LAS float* sq = sin + pb * 512; const LAS float* sk = sq + 128; const LAS float* sv = sq + 256; const LAS float* so = sq + 384;
        const float ve = sv[e] * ig;
        float pn = 0.f, pd = 0.f;
#pragma unroll
        for (int j = 0; j < 32; ++j) { const int d = dg * 32 + j; const float kd = sk[d], qd = sq[d];
            C[j] = fmaf(f, C[j], kd * ve); nn[j] = fmaf(f, nn[j], ig * kd); pn = fmaf(C[j], qd, pn); pd = fmaf(nn[j], qd, pd); }
        red[dg * 128 + e] = pn; if (e == 0) redd[dg] = pd;
        __syncthreads();
        if (F.tid < 64) {
            const int e0 = F.tid, e1 = F.tid + 64;
            float h0 = (red[e0] + red[128 + e0]) + (red[256 + e0] + red[384 + e0]);
            float h1 = (red[e1] + red[128 + e1]) + (red[256 + e1] + red[384 + e1]);
            if (type == 0) { const float den = (redd[0] + redd[1]) + (redd[2] + redd[3]); const float dn = fmaxf(fabsf(den), 1.f);
                h0 = h0 / dn * sigmoidf_(so[e0]); h1 = h1 / dn * sigmoidf_(so[e1]); }
            const float mean = wave_sum(h0 + h1) * (1.f / 128.f); const float d0 = h0 - mean, d1 = h1 - mean;
            const float rstd = 1.f / sqrtf(wave_sum(d0 * d0 + d1 * d1) * (1.f / 128.f) + LN_EPS);
            float y0 = d0 * rstd * gain[e0], y1 = d1 * rstd * gain[e1];
            if (type == 1) { y0 *= siluf_(so[e0]); y1 *= siluf_(so[e1]); }
            Y[m * 1024 + type * 512 + h * 128 + e0] = (bf16)f2bf(y0); Y[m * 1024 + type * 512 + h * 128 + e1] = (bf16)f2bf(y1);
        }
    }
}

template <int MODE, bool ROUTE, bool WRITE_XB>
__device__ __forceinline__ void ph_ln(Frame& F, int layer) {
    LAS float* rwT = (LAS float*)F.lds;
    if (ROUTE) { const float* rw = F.in[11]; for (int i = F.tid; i < 32 * 1024; i += NT) { const int e = i >> 10, k = i & 1023; rwT[i] = rw[(size_t)k * 32 + e]; } __syncthreads(); }
    const int gwv = F.vcu * NWAVES + F.wave, NGW = F.G * NWAVES;
    const float* lg = F.in[16] + (size_t)(layer * 2 + MODE) * D; const float* lb = F.in[17] + (size_t)(layer * 2 + MODE) * D;
    bf16* XB = (bf16*)(F.ws + WS_XB); const bf16* YB = (const bf16*)(F.ws + WS_YB);
    int* EIDX = (int*)(F.ws + WS_EIDX); float* GATEV = (float*)(F.ws + WS_GATEV); int* LIST = (int*)(F.ws + WS_LIST);
    unsigned* cnt = F.ctl + CW_CNT + layer * 32 * 64;
    const float* rbias = F.in[12];
    f32x4 gv[4], bv[4];
#pragma unroll
    for (int j = 0; j < 4; ++j) { gv[j] = *((const f32x4*)lg + F.lane + 64 * j); bv[j] = *((const f32x4*)lb + F.lane + 64 * j); }
    for (int m = gwv; m < M; m += NGW) {
        f32x4* orow = (f32x4*)(F.out + (size_t)m * D) + F.lane;
        f32x4 v[4]; float s = 0.f;
#pragma unroll
        for (int j = 0; j < 4; ++j) v[j] = orow[64 * j];
        if (MODE == 1) {
            const float g0 = GATEV[2 * m], g1 = GATEV[2 * m + 1];
            const u32x2* y0 = (const u32x2*)(YB + (size_t)(2 * m) * D) + F.lane; const u32x2* y1 = (const u32x2*)(YB + (size_t)(2 * m + 1) * D) + F.lane;
#pragma unroll
            for (int j = 0; j < 4; ++j) { const u32x2 a = y0[64 * j], b = y1[64 * j];
                v[j].x = ALPHA * v[j].x + g0 * bflo(a.x) + g1 * bflo(b.x); v[j].y = ALPHA * v[j].y + g0 * bfhi(a.x) + g1 * bfhi(b.x);
                v[j].z = ALPHA * v[j].z + g0 * bflo(a.y) + g1 * bflo(b.y); v[j].w = ALPHA * v[j].w + g0 * bfhi(a.y) + g1 * bfhi(b.y); }
        }
#pragma unroll
        for (int j = 0; j < 4; ++j) s += (v[j].x + v[j].y) + (v[j].z + v[j].w);
        const float mean = wave_sum(s) * (1.f / D); float s2 = 0.f;
#pragma unroll
        for (int j = 0; j < 4; ++j) { v[j] = v[j] - mean; s2 += (v[j].x * v[j].x + v[j].y * v[j].y) + (v[j].z * v[j].z + v[j].w * v[j].w); }
        const float rstd = 1.f / sqrtf(wave_sum(s2) * (1.f / D) + LN_EPS);
#pragma unroll
        for (int j = 0; j < 4; ++j) { v[j] = v[j] * rstd * gv[j] + bv[j]; orow[64 * j] = v[j]; }
        if (WRITE_XB) { unsigned long long* o8 = (unsigned long long*)(XB + (size_t)m * D) + F.lane;
#pragma unroll
            for (int j = 0; j < 4; ++j) o8[64 * j] = (unsigned long long)pk2(v[j].x, v[j].y) | ((unsigned long long)pk2(v[j].z, v[j].w) << 32); }
        if (ROUTE) {
            float mylog = 0.f;
#pragma unroll 2
            for (int e = 0; e < 32; ++e) { float a = 0.f;
#pragma unroll
                for (int j = 0; j < 4; ++j) { const f32x4 w = *(const LAS f32x4*)(rwT + e * 1024 + 4 * F.lane + 256 * j); a += v[j].x * w.x + v[j].y * w.y + v[j].z * w.z + v[j].w * w.w; }
                a = wave_sum(a); mylog = (F.lane == e) ? a : mylog; }
            const float myaff = 1.f / (1.f + expf(-mylog)), mysel = myaff + rbias[F.lane & 31];
            float m1 = -1e30f, m2 = -1e30f; int i1 = 0, i2 = 0; float a1 = 0.f, a2 = 0.f;
            const int gbase = F.lane & 24;
#pragma unroll
            for (int j = 0; j < 8; ++j) { const float sv = __shfl(mysel, gbase + j), av = __shfl(myaff, gbase + j);
                if (sv > m1) { m2 = m1; i2 = i1; a2 = a1; m1 = sv; i1 = gbase + j; a1 = av; }
                else if (sv > m2) { m2 = sv; i2 = gbase + j; a2 = av; } }
            const float score = m1 + m2;
            float bestscore = -1e30f; int bg = 0;
#pragma unroll
            for (int g = 0; g < 4; ++g) { const float sg = __shfl(score, 8 * g); if (sg > bestscore) { bestscore = sg; bg = g; } }
            const int bi0 = __shfl(i1, 8 * bg), bi1 = __shfl(i2, 8 * bg); const float ba0 = __shfl(a1, 8 * bg), ba1 = __shfl(a2, 8 * bg);
            if (F.lane == 0) {
                const float inv = 1.f / (ba0 + ba1);
                EIDX[2 * m] = bi0; EIDX[2 * m + 1] = bi1; GATEV[2 * m] = ba0 * inv; GATEV[2 * m + 1] = ba1 * inv;
                const unsigned p0 = __hip_atomic_fetch_add(cnt + bi0 * 64, 1u, RLX_AGENT); LIST[bi0 * M + p0] = 2 * m;
                const unsigned p1 = __hip_atomic_fetch_add(cnt + bi1 * 64, 1u, RLX_AGENT); LIST[bi1 * M + p1] = 2 * m + 1;
            }
        }
    }
}

struct ExpertMap { int cnt[32]; };
__device__ __forceinline__ int moe_find(Frame& F, int layer, int unit_rows, int per_row_tiles, int t, int& e_out, int& mb_out, int& nb_out, int& hb_out, int& cnt_out) {
    const unsigned* cnt = F.ctl + CW_CNT + layer * 32 * 64;
    int base = 0, hb = 0;
    for (int e = 0; e < 32; ++e) {
        const int c = (int)cnt[e * 64]; const int nmb = (c + unit_rows - 1) / unit_rows; const int nt = nmb * per_row_tiles;
        if (t < base + nt) { const int r = t - base; e_out = e; mb_out = r / per_row_tiles; nb_out = r % per_row_tiles; hb_out = hb; cnt_out = c; return 1; }
        base += nt; hb += ((c + 255) >> 8) << 8;
    }
    return 0;
}
__device__ __forceinline__ void ph_moe1_naive(Frame& F, int layer) {
    LAS float* sA = (LAS float*)F.lds; LAS float* sB = sA + 128 * 33;
    const bf16* XB = (const bf16*)(F.ws + WS_XB); bf16* HID = (bf16*)(F.ws + WS_HID); const int* LIST = (const int*)(F.ws + WS_LIST);
    const int tx = F.tid & 15, ty = F.tid >> 4;
    for (int t = blockIdx.x;; t += F.G) {
        int e, mb, nb, hb, c; if (!moe_find(F, layer, 128, 4, t, e, mb, nb, hb, c)) break;
        const bf16* GU = (const bf16*)(F.ws + WS_EW + (size_t)e * EW_STRIDE);
        const int j0 = nb * 64, rg = (j0 >> 7) * 256 + (j0 & 127);
        auto rowA = [&](int r) -> const bf16* { const int i = mb * 128 + r; return i < c ? XB + (size_t)(LIST[e * M + i] >> 1) * D : (const bf16*)nullptr; };
        float ag[4][4], au[4][4];
        ngemm_tile(sA, sB, rowA, GU + (size_t)rg * D, D, D, ag);
        ngemm_tile(sA, sB, rowA, GU + (size_t)(rg + 128) * D, D, D, au);
#pragma unroll
        for (int i = 0; i < 4; ++i) { const int ri = mb * 128 + ty * 4 + i;
            if (ri < c) { u32x2 o; o.x = pk2(siluf_(ag[i][0]) * au[i][0], siluf_(ag[i][1]) * au[i][1]); o.y = pk2(siluf_(ag[i][2]) * au[i][2], siluf_(ag[i][3]) * au[i][3]);
                *(u32x2*)(HID + (size_t)(hb + ri) * DE + j0 + tx * 4) = o; } }
    }
}
__device__ __forceinline__ void ph_moe2_naive(Frame& F, int layer) {
    LAS float* sA = (LAS float*)F.lds; LAS float* sB = sA + 128 * 33;
    const bf16* HID = (const bf16*)(F.ws + WS_HID); bf16* YB = (bf16*)(F.ws + WS_YB); const int* LIST = (const int*)(F.ws + WS_LIST);
    const int tx = F.tid & 15, ty = F.tid >> 4;
    for (int t = blockIdx.x;; t += F.G) {
        int e, mb, nb, hb, c; if (!moe_find(F, layer, 128, 16, t, e, mb, nb, hb, c)) break;
        const bf16* DN = (const bf16*)(F.ws + WS_EW + (size_t)e * EW_STRIDE + EW_DN);
        auto rowA = [&](int r) -> const bf16* { const int i = mb * 128 + r; return i < c ? HID + (size_t)(hb + i) * DE : (const bf16*)nullptr; };
        float acc[4][4];
        ngemm_tile(sA, sB, rowA, DN + (size_t)(nb * 64) * DE, DE, DE, acc);
#pragma unroll
        for (int i = 0; i < 4; ++i) { const int ri = mb * 128 + ty * 4 + i;
            if (ri < c) { const int a = LIST[e * M + ri]; u32x2 o; o.x = pk2(acc[i][0], acc[i][1]); o.y = pk2(acc[i][2], acc[i][3]);
                *(u32x2*)(YB + (size_t)a * D + nb * 64 + tx * 4) = o; } }
    }
}

__device__ __forceinline__ void ph_attn_naive(Frame& F) {
    const bf16* P = (const bf16*)(F.ws + WS_P); bf16* OG = (bf16*)(F.ws + WS_OG); float* LSE = (float*)(F.ws + WS_LSE);
    const int total = 3 * M * 8, nth = F.G * NT;
    for (int idx = blockIdx.x * NT + F.tid; idx < total; idx += nth) {
        const int h = idx & 7, m = (idx >> 3) & (M - 1), g = idx >> 17;
        const int t = m & (T - 1), dil = (g == 0) ? 1 : (g == 1 ? 4 : 16);
        const float slope = exp2f(-(float)(h + 1));
        const bf16* qp = P + (size_t)m * IN1 + g * 1536 + h * 64;
        float q[64], o[64];
#pragma unroll
        for (int c = 0; c < 8; ++c) { const u32x4 w = *(const u32x4*)(qp + 8 * c);
            q[8 * c + 0] = bflo(w.x); q[8 * c + 1] = bfhi(w.x); q[8 * c + 2] = bflo(w.y); q[8 * c + 3] = bfhi(w.y); q[8 * c + 4] = bflo(w.z); q[8 * c + 5] = bfhi(w.z); q[8 * c + 6] = bflo(w.w); q[8 * c + 7] = bfhi(w.w); }
#pragma unroll
        for (int d = 0; d < 64; ++d) o[d] = 0.f;
        float mx = -1e30f, den = 0.f;
        for (int j = 0; j <= 128; ++j) {
            const int tk = t - j * dil; if (tk < 0) break;
            const bf16* kp = P + (size_t)(m - j * dil) * IN1 + g * 1536 + 512 + h * 64; const bf16* vp = kp + 512;
            float s = 0.f;
#pragma unroll
            for (int c = 0; c < 8; ++c) { const u32x4 w = *(const u32x4*)(kp + 8 * c);
                s += q[8 * c + 0] * bflo(w.x) + q[8 * c + 1] * bfhi(w.x) + q[8 * c + 2] * bflo(w.y) + q[8 * c + 3] * bfhi(w.y) + q[8 * c + 4] * bflo(w.z) + q[8 * c + 5] * bfhi(w.z) + q[8 * c + 6] * bflo(w.w) + q[8 * c + 7] * bfhi(w.w); }
            s = s * 0.125f - slope * (float)(j * dil);
            const float mn = fmaxf(mx, s), corr = __expf(mx - mn), p = __expf(s - mn);
            den = den * corr + p; mx = mn;
#pragma unroll
            for (int c = 0; c < 8; ++c) { const u32x4 w = *(const u32x4*)(vp + 8 * c);
                o[8 * c + 0] = o[8 * c + 0] * corr + p * bflo(w.x); o[8 * c + 1] = o[8 * c + 1] * corr + p * bfhi(w.x); o[8 * c + 2] = o[8 * c + 2] * corr + p * bflo(w.y); o[8 * c + 3] = o[8 * c + 3] * corr + p * bfhi(w.y);
                o[8 * c + 4] = o[8 * c + 4] * corr + p * bflo(w.z); o[8 * c + 5] = o[8 * c + 5] * corr + p * bfhi(w.z); o[8 * c + 6] = o[8 * c + 6] * corr + p * bflo(w.w); o[8 * c + 7] = o[8 * c + 7] * corr + p * bfhi(w.w); }
        }
        const float inv = 1.f / den;
        bf16* op = OG + ((size_t)g * M + m) * 512 + h * 64;
#pragma unroll
        for (int c = 0; c < 8; ++c) { u32x4 w; w.x = pk2(o[8 * c + 0] * inv, o[8 * c + 1] * inv); w.y = pk2(o[8 * c + 2] * inv, o[8 * c + 3] * inv); w.z = pk2(o[8 * c + 4] * inv, o[8 * c + 5] * inv); w.w = pk2(o[8 * c + 6] * inv, o[8 * c + 7] * inv);
            *(u32x4*)(op + 8 * c) = w; }
        LSE[((size_t)g * M + m) * 8 + h] = mx + __logf(den);
    }
}
typedef short bf16x8_t __attribute__((ext_vector_type(8)));
__device__ __forceinline__ void ph_attn_mfma(Frame& F) {
    const bf16* P = (const bf16*)(F.ws + WS_P); bf16* OG = (bf16*)(F.ws + WS_OG); float* LSE = (float*)(F.ws + WS_LSE);
    LAS bf16* Vl = (LAS bf16*)F.lds;
    const int tid = F.tid, lane = F.lane, w = F.wave, fr = lane & 15, fq = lane >> 4;
    const int ct0 = 2 * (w >> 1);
    const unsigned vaddr0 = (unsigned)(size_t)(F.lds) + (unsigned)(((16 * ct0 + 4 * fq + (fr >> 2)) * 72 + 4 * (fr & 3)) * 2);
    for (int u = blockIdx.x; u < 3072; u += F.G) {
        const int g = u >> 10, rem = u & 1023, b = rem >> 9, h = (rem >> 6) & 7, x = rem & 63;
        const int dil = (g == 0) ? 1 : (g == 1 ? 4 : 16), nnb = 64 / dil, nb = x % nnb, r = x / nnb;
        const long rowbase = (long)b * T + (long)nb * 128 * dil + r;
        const bf16* Qp = P + g * 1536 + h * 64; const bf16* Kp = Qp + 512; const bf16* Vp = Qp + 1024;
        const float sl = exp2f(-(float)(h + 1)) * (float)dil;
        __syncthreads();
#pragma unroll
        for (int it = 0; it < 4; ++it) { const int kr = (tid >> 3) + 64 * it, ch = tid & 7; u32x4 v = (u32x4){0u, 0u, 0u, 0u};
            if (nb > 0 || kr >= 128) v = *(const u32x4*)(Vp + (size_t)(rowbase + (long)(kr - 128) * dil) * IN1 + ch * 8);
            *(LAS u32x4*)(Vl + kr * 72 + ch * 8) = v; }
        bf16x8_t qf[2];
        { const bf16* qrow = Qp + (size_t)(rowbase + (long)(16 * w + fr) * dil) * IN1 + 8 * fq; qf[0] = *(const bf16x8_t*)qrow; qf[1] = *(const bf16x8_t*)(qrow + 32); }
        f32x4 s[10];
#pragma unroll
        for (int c = 0; c < 10; ++c) { const int kr = 16 * (ct0 + c) + fr; bf16x8_t k0 = (bf16x8_t){0, 0, 0, 0, 0, 0, 0, 0}, k1 = k0;
            if (nb > 0 || kr >= 128) { const bf16* krow = Kp + (size_t)(rowbase + (long)(kr - 128) * dil) * IN1 + 8 * fq; k0 = *(const bf16x8_t*)krow; k1 = *(const bf16x8_t*)(krow + 32); }
            s[c] = __builtin_amdgcn_mfma_f32_16x16x32_bf16(k0, qf[0], (f32x4){0.f, 0.f, 0.f, 0.f}, 0, 0, 0);
            s[c] = __builtin_amdgcn_mfma_f32_16x16x32_bf16(k1, qf[1], s[c], 0, 0, 0); }
        const int l = 16 * w + fr;
        float mx = -1e30f;
#pragma unroll
        for (int c = 0; c < 10; ++c)
#pragma unroll
            for (int rg = 0; rg < 4; ++rg) { const int kr = 16 * (ct0 + c) + 4 * fq + rg, steps = l + 128 - kr;
                const bool ok = steps >= 0 && steps <= 128 && (nb > 0 || kr >= 128);
                const float v = ok ? s[c][rg] * 0.125f - sl * (float)steps : -1e30f; s[c][rg] = v; mx = fmaxf(mx, v); }
        mx = fmaxf(mx, __shfl_xor(mx, 16)); mx = fmaxf(mx, __shfl_xor(mx, 32));
        float den = 0.f;
#pragma unroll
        for (int c = 0; c < 10; ++c)
#pragma unroll
            for (int rg = 0; rg < 4; ++rg) { const float p = (s[c][rg] > -1e29f) ? __expf(s[c][rg] - mx) : 0.f; s[c][rg] = p; den += p; }
        den += __shfl_xor(den, 16); den += __shfl_xor(den, 32);
        bf16x8_t pf[5];
#pragma unroll
        for (int k = 0; k < 5; ++k) { u32x4 wv; wv.x = pg8::cvt_pk_bf16(s[2 * k][0], s[2 * k][1]); wv.y = pg8::cvt_pk_bf16(s[2 * k][2], s[2 * k][3]);
            wv.z = pg8::cvt_pk_bf16(s[2 * k + 1][0], s[2 * k + 1][1]); wv.w = pg8::cvt_pk_bf16(s[2 * k + 1][2], s[2 * k + 1][3]); pf[k] = __builtin_bit_cast(bf16x8_t, wv); }
        __syncthreads();
        f32x4 o[4];
#pragma unroll
        for (int dt = 0; dt < 4; ++dt) o[dt] = (f32x4){0.f, 0.f, 0.f, 0.f};
#pragma unroll
        for (int k = 0; k < 5; ++k) {
            u32x2 a0, a1, a2, a3, a4, a5, a6, a7; const unsigned va = vaddr0 + (unsigned)(k * 32 * 72 * 2);
            asm volatile("ds_read_b64_tr_b16 %0, %8\n\tds_read_b64_tr_b16 %1, %8 offset:2304\n\tds_read_b64_tr_b16 %2, %8 offset:32\n\tds_read_b64_tr_b16 %3, %8 offset:2336\n\t"
                         "ds_read_b64_tr_b16 %4, %8 offset:64\n\tds_read_b64_tr_b16 %5, %8 offset:2368\n\tds_read_b64_tr_b16 %6, %8 offset:96\n\tds_read_b64_tr_b16 %7, %8 offset:2400\n\ts_waitcnt lgkmcnt(0)"
                         : "=&v"(a0), "=&v"(a1), "=&v"(a2), "=&v"(a3), "=&v"(a4), "=&v"(a5), "=&v"(a6), "=&v"(a7) : "v"(va) : "memory");
            __builtin_amdgcn_sched_barrier(0);
            o[0] = __builtin_amdgcn_mfma_f32_16x16x32_bf16(__builtin_bit_cast(bf16x8_t, (u32x4){a0.x, a0.y, a1.x, a1.y}), pf[k], o[0], 0, 0, 0);
            o[1] = __builtin_amdgcn_mfma_f32_16x16x32_bf16(__builtin_bit_cast(bf16x8_t, (u32x4){a2.x, a2.y, a3.x, a3.y}), pf[k], o[1], 0, 0, 0);
            o[2] = __builtin_amdgcn_mfma_f32_16x16x32_bf16(__builtin_bit_cast(bf16x8_t, (u32x4){a4.x, a4.y, a5.x, a5.y}), pf[k], o[2], 0, 0, 0);
            o[3] = __builtin_amdgcn_mfma_f32_16x16x32_bf16(__builtin_bit_cast(bf16x8_t, (u32x4){a6.x, a6.y, a7.x, a7.y}), pf[k], o[3], 0, 0, 0);
        }
        const float inv = 1.f / den; const size_t tok = (size_t)(rowbase + (long)l * dil);
        bf16* op = OG + ((size_t)g * M + tok) * 512 + h * 64 + 4 * fq;
#pragma unroll
        for (int dt = 0; dt < 4; ++dt) { u32x2 wv; wv.x = pg8::cvt_pk_bf16(o[dt][0] * inv, o[dt][1] * inv); wv.y = pg8::cvt_pk_bf16(o[dt][2] * inv, o[dt][3] * inv); *(u32x2*)(op + 16 * dt) = wv; }
        if (fq == 0) LSE[((size_t)g * M + tok) * 8 + h] = mx + __logf(den);
    }
}

__device__ __forceinline__ void ph_merge(Frame& F) {
    const bf16* OG = (const bf16*)(F.ws + WS_OG); const float* LSE = (const float*)(F.ws + WS_LSE); bf16* Y2 = (bf16*)(F.ws + WS_Y2);
    const int total = M * 64, nth = F.G * NT;
    for (int idx = blockIdx.x * NT + F.tid; idx < total; idx += nth) {
        const int m = idx >> 6, c8 = idx & 63, h = c8 >> 3;
        const float l0 = LSE[((size_t)0 * M + m) * 8 + h], l1 = LSE[((size_t)1 * M + m) * 8 + h], l2 = LSE[((size_t)2 * M + m) * 8 + h];
        const float mx = fmaxf(l0, fmaxf(l1, l2)); float w0 = __expf(l0 - mx), w1 = __expf(l1 - mx), w2 = __expf(l2 - mx); const float inv = 1.f / (w0 + w1 + w2);
        w0 *= inv; w1 *= inv; w2 *= inv;
        const u32x4 a = *(const u32x4*)(OG + ((size_t)0 * M + m) * 512 + c8 * 8), b = *(const u32x4*)(OG + ((size_t)1 * M + m) * 512 + c8 * 8), c = *(const u32x4*)(OG + ((size_t)2 * M + m) * 512 + c8 * 8);
        u32x4 o;
        o.x = pk2(w0 * bflo(a.x) + w1 * bflo(b.x) + w2 * bflo(c.x), w0 * bfhi(a.x) + w1 * bfhi(b.x) + w2 * bfhi(c.x));
        o.y = pk2(w0 * bflo(a.y) + w1 * bflo(b.y) + w2 * bflo(c.y), w0 * bfhi(a.y) + w1 * bfhi(b.y) + w2 * bfhi(c.y));
        o.z = pk2(w0 * bflo(a.z) + w1 * bflo(b.z) + w2 * bflo(c.z), w0 * bfhi(a.z) + w1 * bfhi(b.z) + w2 * bfhi(c.z));
        o.w = pk2(w0 * bflo(a.w) + w1 * bflo(b.w) + w2 * bflo(c.w), w0 * bfhi(a.w) + w1 * bfhi(b.w) + w2 * bfhi(c.w));
        *(u32x4*)(Y2 + (size_t)m * 512 + c8 * 8) = o;
    }
}

struct Args { const float* in[18]; float* out; unsigned char* ws; int ph_lo, ph_hi, li, pad; };
__global__ void __launch_bounds__(NT, 2) mega_fwd(Args args) {
    extern __shared__ __attribute__((aligned(16))) unsigned char lds_raw[];
    Frame F;
    F.lds = (LAS unsigned char*)lds_raw;
    F.tid = threadIdx.x; F.lane = F.tid & 63; F.wave = __builtin_amdgcn_readfirstlane(F.tid >> 6);
    F.G = gridDim.x; { const int bx = blockIdx.x; F.vcu = (F.G % 8 == 0) ? (bx % 8) * (F.G / 8) + bx / 8 : bx; }
#pragma unroll
    for (int i = 0; i < 18; ++i) F.in[i] = args.in[i];
    F.out = args.out; F.ws = args.ws; F.ctl = (unsigned*)(args.ws + WS_CTL);
    volatile LAS unsigned* MISC = (volatile LAS unsigned*)(F.lds + LDS_BYTES - 128);
    if (F.tid < 32) MISC[F.tid] = 0u;
    __syncthreads();
    XcdBarrier bar; bar.bar = F.ctl + CW_BAR; bar.x = 0; bar.st = nullptr;
    if (MK_N_LAUNCHES == 1) bar = xcd_barrier_post(F.ctl + CW_BAR, MISC + 8);
    const int lo = args.ph_lo, hi = args.ph_hi;
#define IN(k) (lo <= (k) && (k) < hi)
#define SEAM(k) do { if (IN(k) && IN((k) + 1)) xcd_barrier(bar); } while (0)
    if (IN(0)) { ph0_convert(F); } SEAM(0);
    if (IN(1)) { pg8::StaticOrder S; S.init(F.ws + WS_XB, F.ws + WS_WT0, M, NP0, D, F.G, (int)blockIdx.x); pg8::EpiBf16 E{(bf16*)(F.ws + WS_P), NP0};
        pg8::gemm_phase<pg8::EpiBf16, pg8::StaticOrder, true, false>(F.lds, D, S, E); } SEAM(1);
    if (IN(2)) { ph_conv_naive(F); } SEAM(2);
    if (IN(3)) { ph_recurrent_naive(F); } SEAM(3);
    if (IN(4)) { pg8::StaticOrder S; S.init(F.ws + WS_Y, F.ws + WS_WO0, M, D, D, F.G, (int)blockIdx.x); pg8::EpiResF32 E{F.in[0], F.out, ALPHA};
        pg8::gemm_phase<pg8::EpiResF32, pg8::StaticOrder, false, false>(F.lds, D, S, E); } SEAM(4);
    if (IN(5)) { convert_experts(F, 0); __syncthreads(); ph_ln<0, true, true>(F, 0); } SEAM(5);
    if (IN(6)) { pg8::MoeOrder S{F.ctl + CW_CNT + 0 * 32 * 64, (const int*)(F.ws + WS_LIST), (const char*)(F.ws + WS_XB), (const char*)(F.ws + WS_EW), 2, F.G, (int)blockIdx.x, D, 0};
        pg8::EpiSwiGLU E{(bf16*)(F.ws + WS_HID)}; pg8::gemm_phase<pg8::EpiSwiGLU, pg8::MoeOrder, true, true>(F.lds, D, S, E); } SEAM(6);
    if (IN(7)) { pg8::MoeOrder S{F.ctl + CW_CNT + 0 * 32 * 64, (const int*)(F.ws + WS_LIST), (const char*)(F.ws + WS_HID), (const char*)(F.ws + WS_EW + EW_DN), 4, F.G, (int)blockIdx.x, DE, 1};
        pg8::EpiMoeOut E{(bf16*)(F.ws + WS_YB), (const int*)(F.ws + WS_LIST)}; pg8::gemm_phase<pg8::EpiMoeOut, pg8::MoeOrder, true, false>(F.lds, DE, S, E); } SEAM(7);
    if (IN(8)) { ph_ln<1, false, true>(F, 0); __syncthreads(); convert_experts(F, 1); } SEAM(8);
    if (IN(9)) { pg8::StaticOrder S; S.init(F.ws + WS_XB, F.ws + WS_WT1, M, IN1, D, F.G, (int)blockIdx.x); pg8::EpiBf16 E{(bf16*)(F.ws + WS_P), IN1};
        pg8::gemm_phase<pg8::EpiBf16, pg8::StaticOrder, true, false>(F.lds, D, S, E); } SEAM(9);
    if (IN(10)) { ph_attn_mfma(F); } SEAM(10);
    if (IN(11)) { ph_merge(F); } SEAM(11);
    if (IN(12)) { pg8::StaticOrder S; S.init(F.ws + WS_Y2, F.ws + WS_WO1, M, D, 512, F.G, (int)blockIdx.x); pg8::EpiResF32 E{F.out, F.out, ALPHA};
        pg8::gemm_phase<pg8::EpiResF32, pg8::StaticOrder, false, false>(F.lds, 512, S, E); } SEAM(12);
    if (IN(13)) { ph_ln<0, true, true>(F, 1); } SEAM(13);
    if (IN(14)) { pg8::MoeOrder S{F.ctl + CW_CNT + 1 * 32 * 64, (const int*)(F.ws + WS_LIST), (const char*)(F.ws + WS_XB), (const char*)(F.ws + WS_EW), 2, F.G, (int)blockIdx.x, D, 0};
        pg8::EpiSwiGLU E{(bf16*)(F.ws + WS_HID)}; pg8::gemm_phase<pg8::EpiSwiGLU, pg8::MoeOrder, true, true>(F.lds, D, S, E); } SEAM(14);
    if (IN(15)) { pg8::MoeOrder S{F.ctl + CW_CNT + 1 * 32 * 64, (const int*)(F.ws + WS_LIST), (const char*)(F.ws + WS_HID), (const char*)(F.ws + WS_EW + EW_DN), 4, F.G, (int)blockIdx.x, DE, 1};
        pg8::EpiMoeOut E{(bf16*)(F.ws + WS_YB), (const int*)(F.ws + WS_LIST)}; pg8::gemm_phase<pg8::EpiMoeOut, pg8::MoeOrder, true, false>(F.lds, DE, S, E); } SEAM(15);
    if (IN(16)) { ph_ln<1, false, false>(F, 1); }
#undef IN
#undef SEAM
}

extern "C" void kernel_launch(void* const* d_in, const int* in_sizes, int n_in, void* d_out, int out_size, void* d_ws, size_t ws_size, hipStream_t stream) {
    static int grid = 0;
    if (grid == 0) {
        if (n_in != 18 || in_sizes[0] != M * D || out_size != M * D || ws_size < WS_END) {
            fprintf(stderr, "kernel_launch: unexpected problem (n_in %d, in0 %d, out %d, ws %zu < %zu)\n", n_in, n_in > 0 ? in_sizes[0] : -1, out_size, ws_size, (size_t)WS_END); grid = -1; return; }
        int dev = 0, cus = 0;
        if (hipGetDevice(&dev) != hipSuccess || hipDeviceGetAttribute(&cus, hipDeviceAttributeMultiprocessorCount, dev) != hipSuccess) { grid = -1; return; }
        if (hipFuncSetAttribute((const void*)mega_fwd, hipFuncAttributeMaxDynamicSharedMemorySize, LDS_BYTES) != hipSuccess) { fprintf(stderr, "kernel_launch: hipFuncSetAttribute failed\n"); grid = -1; return; }
        int per_cu = 0;
        if (hipOccupancyMaxActiveBlocksPerMultiprocessor(&per_cu, (const void*)mega_fwd, NT, LDS_BYTES) != hipSuccess || per_cu < 1) fprintf(stderr, "kernel_launch: occupancy query says %d\n", per_cu);
        (void)hipGetLastError();
        grid = cus;
    }
    if (grid < 0) return;
    (void)hipMemsetAsync((char*)d_ws + WS_CTL, 0, CTL_ZERO_BYTES, stream);
    Args a{};
    for (int i = 0; i < 18; ++i) a.in[i] = (const float*)d_in[i];
    a.out = (float*)d_out; a.ws = (unsigned char*)d_ws;
    if (MK_N_LAUNCHES == 1) {
        a.ph_lo = 0; a.ph_hi = N_PHASES; a.li = 0;
        hipLaunchKernelGGL(mega_fwd, dim3(grid), dim3(NT), LDS_BYTES, stream, a);
    } else {
        for (int p = 0; p < N_PHASES; ++p) { a.ph_lo = p; a.ph_hi = p + 1; a.li = p; hipLaunchKernelGGL(mega_fwd, dim3(grid), dim3(NT), LDS_BYTES, stream, a); }
    }
}
```

```cpp
#include <hip/hip_runtime.h>
#include <cstdio>
#include <cstdint>

#ifndef MK_N_LAUNCHES
#define MK_N_LAUNCHES 1
#endif

#define LAS __attribute__((address_space(3)))
typedef unsigned short bf16;
typedef float f32x4 __attribute__((ext_vector_type(4)));
typedef unsigned u32x4 __attribute__((ext_vector_type(4)));
typedef unsigned u32x2 __attribute__((ext_vector_type(2)));
typedef short bf16x8_t __attribute__((ext_vector_type(8)));
#define RLX_AGENT __ATOMIC_RELAXED, __HIP_MEMORY_SCOPE_AGENT
#define LDS_WAIT() asm volatile("s_waitcnt lgkmcnt(0)" ::: "memory")
#define VM_WAIT() asm volatile("s_waitcnt vmcnt(0)" ::: "memory")

constexpr int NWAVES = 8, NT = NWAVES * 64;
constexpr int BATCH = 2, T = 8192, D = 1024, M = BATCH * T;
constexpr int IN0 = 4104, IN1 = 4608, NP0 = 4096;
constexpr int NE = 32, DE = 256;
constexpr float ALPHA = 1.41421356237309515f;
constexpr float LN_EPS = 1e-5f;
constexpr float KSCALE = 0.08838834764831845f;
constexpr int N_PHASES = 17;

constexpr size_t MiB = 1u << 20;
constexpr size_t WS_CTL = 0, CTL_ZERO_BYTES = 1 * MiB;
constexpr size_t WS_G = 1 * MiB;
constexpr size_t WS_EIDX = WS_G + 512 * 1024;
constexpr size_t WS_GATEV = WS_EIDX + 128 * 1024;
constexpr size_t WS_WT0 = 2 * MiB;
constexpr size_t WS_WO0 = 10 * MiB;
constexpr size_t WS_WT1 = 12 * MiB;
constexpr size_t WS_WO1 = 21 * MiB;
constexpr size_t WS_SE = 22 * MiB;
constexpr size_t WS_EW = WS_SE;
constexpr size_t EW_STRIDE = 3 * MiB / 2, EW_DN = 1 * MiB;
constexpr size_t WS_LIST = WS_SE + 48 * MiB;
constexpr size_t WS_LSE = WS_SE + 50 * MiB;
constexpr size_t WS_XB = 86 * MiB;
constexpr size_t WS_Y = 118 * MiB;
constexpr size_t WS_OG = WS_XB;
constexpr size_t WS_Y2 = WS_XB + 48 * MiB;
constexpr size_t WS_P = 150 * MiB;
constexpr size_t WS_YB = WS_P;
constexpr size_t WS_HID = WS_P + 64 * MiB;
constexpr size_t WS_END = 294 * MiB;
constexpr size_t WS_QKC = WS_SE;

constexpr int CW_BAR = 4096;
constexpr int CW_CNT = 16384;

constexpr int LDS_BYTES = 147456;

__device__ __forceinline__ unsigned f2bf(float f) { unsigned u = __builtin_bit_cast(unsigned, f); return (u + 0x7fffu + ((u >> 16) & 1u)) >> 16; }
__device__ __forceinline__ unsigned pk2(float lo, float hi) { return f2bf(lo) | (f2bf(hi) << 16); }
__device__ __forceinline__ float bf2f(unsigned b) { return __builtin_bit_cast(float, b << 16); }
__device__ __forceinline__ float bflo(unsigned w) { return __builtin_bit_cast(float, w << 16); }
__device__ __forceinline__ float bfhi(unsigned w) { return __builtin_bit_cast(float, w & 0xffff0000u); }
__device__ __forceinline__ float wave_sum(float v) {
#pragma unroll
    for (int o = 1; o < 64; o <<= 1) v += __shfl_xor(v, o);
    return v;
}
__device__ __forceinline__ float sigmoidf_(float x) { return 1.f / (1.f + __expf(-x)); }
__device__ __forceinline__ float siluf_(float x) { return x / (1.f + __expf(-x)); }

#define XB_TMO      128
#define XB_XCNT(j)  (256  + 64 * (j))
#define XB_XSUB(j)  (1280 + 64 * (j))
#define XB_XGEN(j)  (2304 + 64 * (j))
#define XB_TOP      3328
#define XB_TOPGEN   3392
#define XCD_BAR_WORDS 3456
#define XB_SPIN_CAP (1u << 22)
__device__ __forceinline__ unsigned xb_ld(unsigned* p)              { return __hip_atomic_load(p, __ATOMIC_RELAXED, __HIP_MEMORY_SCOPE_AGENT); }
__device__ __forceinline__ unsigned xb_add(unsigned* p, unsigned v) { return __hip_atomic_fetch_add(p, v, __ATOMIC_RELAXED, __HIP_MEMORY_SCOPE_AGENT); }
__device__ __forceinline__ unsigned xb_xcc_id() { return (unsigned)__builtin_amdgcn_s_getreg((3 << 11) | 20) & 0xFu; }
#define XB_SPIN(cond, bar) do { unsigned _sp = 0; while (cond) { __builtin_amdgcn_s_sleep(1); \
    if ((++_sp & 255u) == 0u) { if (xb_ld(&(bar)[XB_TMO])) break; if (_sp > XB_SPIN_CAP) { atomicAdd(&(bar)[XB_TMO], 1u); break; } } } } while (0)
struct XcdBarrier { unsigned* bar; unsigned x; volatile LAS unsigned* st; };
__device__ __forceinline__ XcdBarrier xcd_barrier_post(unsigned* bar, volatile LAS unsigned* st) {
    XcdBarrier b; b.bar = bar; b.x = xb_xcc_id(); b.st = st;
    if (threadIdx.x == 0) (void)xb_add(&bar[XB_XCNT(b.x)], 1u);
    return b;
}
__device__ __forceinline__ void xcd_barrier_complete(unsigned* bar, unsigned x, unsigned& nloc, unsigned& nx) {
    const unsigned G = gridDim.x * gridDim.y * gridDim.z;
    unsigned sum, cnt, mine, sp = 0u;
    for (;;) {
        sum = 0u; cnt = 0u; mine = 0u;
#pragma unroll
        for (unsigned j = 0; j < 16; ++j) { const unsigned c = xb_ld(&bar[XB_XCNT(j)]); sum += c; cnt += (c > 0u) ? 1u : 0u; mine = (j == x) ? c : mine; }
        if (sum == G) break;
        __builtin_amdgcn_s_sleep(1);
        if ((++sp & 255u) == 0u) { if (xb_ld(&bar[XB_TMO])) break; if (sp > XB_SPIN_CAP) { atomicAdd(&bar[XB_TMO], 1u); break; } }
    }
    nloc = mine > 0u ? mine : 1u; nx = cnt > 0u ? cnt : 1u;
}
__device__ __forceinline__ void xcd_barrier(const XcdBarrier& b) {
    asm volatile("s_waitcnt vmcnt(0)" ::: "memory");
    __syncthreads();
    if (threadIdx.x == 0) {
        unsigned* bar = b.bar;
        __builtin_amdgcn_s_waitcnt(0);
        unsigned nloc = b.st[0], nx = b.st[1];
        if (nloc == 0u) { xcd_barrier_complete(bar, b.x, nloc, nx); b.st[0] = nloc; b.st[1] = nx; }
        const unsigned old = xb_add(&bar[XB_XSUB(b.x)], 1u);
        const unsigned gen = old / nloc;
        if (old + 1u == (gen + 1u) * nloc) {
            __builtin_amdgcn_fence(__ATOMIC_RELEASE, "agent");
            asm volatile("s_waitcnt vmcnt(0)" ::: "memory");
            const unsigned og = xb_add(&bar[XB_TOP], 1u);
            const unsigned tg = og / nx;
            if (og + 1u == (tg + 1u) * nx) xb_add(&bar[XB_TOPGEN], 1u);
            else XB_SPIN(xb_ld(&bar[XB_TOPGEN]) == tg, bar);
            __builtin_amdgcn_fence(__ATOMIC_ACQUIRE, "agent");
            xb_add(&bar[XB_XGEN(b.x)], 1u);
            asm volatile("s_waitcnt vmcnt(0)" ::: "memory");
        } else {
            XB_SPIN(xb_ld(&bar[XB_XGEN(b.x)]) == gen, bar);
            __builtin_amdgcn_fence(__ATOMIC_ACQUIRE, "agent");
            asm volatile("s_waitcnt vmcnt(0)" ::: "memory");
        }
    }
    __syncthreads();
}

struct Frame {
    LAS unsigned char* lds;
    unsigned* ctl;
    int tid, lane, wave, vcu, G;
    const float* in[18];
    float* out;
    unsigned char* ws;
};

namespace pg8 {
typedef short bf16x8 __attribute__((ext_vector_type(8)));
constexpr int BM = 256, BK = 64, HALF = 128, HTB = HALF * BK * 2, STAGE_BYTES = 8 * HTB, NXCD = 8, WGM = 8;
__host__ __device__ __forceinline__ int lds_byte(int r, int c) { const int st = (r >> 4) * 2 + (c >> 5), rr = r & 15, cc = c & 31, ob = rr * 64 + cc * 2; return st * 1024 + (ob ^ (((ob >> 9) & 1) << 5)); }
__host__ __device__ __forceinline__ void stage_rc(int b, int& R, int& C) { const int st = b / 1024, sb = b % 1024, swz = sb ^ (((sb >> 9) & 1) << 5); R = (st >> 1) * 16 + swz / 64; C = (st & 1) * 32 + (swz % 64) / 2; }
__host__ __device__ __forceinline__ int perm32(int rho) { const int n = rho >> 4, i = rho & 15; return 8 * (i >> 2) + 4 * n + (i & 3); }
struct Unit { int pm, pn, e, cnt, hb; };
__device__ __forceinline__ unsigned cvt_pk_bf16(float lo, float hi) { unsigned r; asm volatile("v_cvt_pk_bf16_f32 %0, %1, %2" : "=v"(r) : "v"(lo), "v"(hi)); return r; }

struct StaticOrder {
    int nM, nN, nwg, G, c, K; const char* A; const char* Bt;
    __device__ void init(const void* A_, const void* Bt_, int M_, int N_, int K_, int G_, int c_) { A = (const char*)A_; Bt = (const char*)Bt_; nM = M_ / BM; nN = N_ / BM; nwg = nM * nN; G = G_; c = c_; K = K_; }
    __device__ bool next(int i, Unit& u) const {
        const long L = (long)i * G + c; if (L >= nwg) return false;
        int wgid = (int)L; { const int q = nwg / NXCD, r = nwg % NXCD, xcd = wgid % NXCD, off = wgid / NXCD; wgid = (xcd < r ? xcd * (q + 1) : r * (q + 1) + (xcd - r) * q) + off; }
        const int nig = WGM * nN, gid = wgid / nig, fm = gid * WGM, gsz = (nM - fm) < WGM ? (nM - fm) : WGM;
        u.pm = fm + ((wgid % nig) % gsz); u.pn = (wgid % nig) / gsz; u.e = 0; u.cnt = 0; u.hb = 0; return true;
    }
    __device__ __forceinline__ void base(const Unit& u, const char*& cA, const char*& cB) const { cA = A + (size_t)u.pm * BM * K * 2; cB = Bt + (size_t)u.pn * BM * K * 2; }
    __device__ __forceinline__ unsigned rowoff(const Unit&, int) const { return 0u; }
};

struct EpiBf16 {
    static constexpr bool PERM = true;
    bf16* O; int ldc;
    __device__ __forceinline__ void operator()(const f32x4 (&acc)[2][2][4][2], const Unit& u, int wr, int wc, int fr, int fq) const {
        const int row0 = u.pm * BM + wr * 64 + fr, col0 = u.pn * BM + wc * 32 + 8 * fq;
#pragma unroll
        for (int ai = 0; ai < 2; ++ai)
#pragma unroll
            for (int m = 0; m < 4; ++m) { bf16* rowp = O + (size_t)(row0 + ai * HALF + m * 16) * ldc + col0;
#pragma unroll
                for (int bj = 0; bj < 2; ++bj) { const f32x4 v0 = acc[ai][bj][m][0], v1 = acc[ai][bj][m][1];
                    u32x4 w; w.x = cvt_pk_bf16(v0[0], v0[1]); w.y = cvt_pk_bf16(v0[2], v0[3]); w.z = cvt_pk_bf16(v1[0], v1[1]); w.w = cvt_pk_bf16(v1[2], v1[3]);
                    *(u32x4*)(rowp + bj * HALF) = w; } }
    }
};
struct EpiResF32 {
    static constexpr bool PERM = false;
    const float* base; float* out; float alpha;
    __device__ __forceinline__ void operator()(const f32x4 (&acc)[2][2][4][2], const Unit& u, int wr, int wc, int fr, int fq) const {
        const int col0 = u.pn * BM + wc * 32 + 4 * fq;
#pragma unroll
        for (int ai = 0; ai < 2; ++ai)
#pragma unroll
            for (int m = 0; m < 4; ++m) { const size_t off = (size_t)(u.pm * BM + ai * HALF + wr * 64 + m * 16 + fr) * 1024 + col0;
#pragma unroll
                for (int bj = 0; bj < 2; ++bj)
#pragma unroll
                    for (int n = 0; n < 2; ++n) { const f32x4 b = *(const f32x4*)(base + off + bj * HALF + n * 16); *(f32x4*)(out + off + bj * HALF + n * 16) = b * alpha + acc[ai][bj][m][n]; } }
    }
};

struct MoeOrder {
    const unsigned* cnt; const int* LIST; const char* A; const char* B; int NTN, G, c, K, mode;
    __device__ bool next(int i, Unit& u) const {
        const int L = i * G + c; int base = 0, hb = 0;
        for (int e = 0; e < 32; ++e) { const int cc = (int)cnt[e * 64]; const int nmb = (cc + 255) >> 8; const int ntl = nmb * NTN;
            if (L < base + ntl) { const int r = L - base; u.e = e; u.pm = r / NTN; u.pn = r % NTN; u.cnt = cc; u.hb = hb; return true; }
            base += ntl; hb += nmb << 8; }
        return false;
    }
    __device__ __forceinline__ void base(const Unit& u, const char*& cA, const char*& cB) const {
        cA = mode == 0 ? A : A + (size_t)(u.hb + u.pm * 256) * K * 2; cB = B + (size_t)u.e * EW_STRIDE + (size_t)u.pn * 256 * K * 2; }
    __device__ __forceinline__ unsigned rowoff(const Unit& u, int r) const { int i = u.pm * 256 + r; i = i < u.cnt ? i : 0; return (unsigned)(LIST[u.e * M + i] >> 1) * 2048u; }
};
struct EpiSwiGLU {
    static constexpr bool PERM = true;
    bf16* HID;
    __device__ __forceinline__ void operator()(const f32x4 (&acc)[2][2][4][2], const Unit& u, int wr, int wc, int fr, int fq) const {
#pragma unroll
        for (int ai = 0; ai < 2; ++ai)
#pragma unroll
            for (int m = 0; m < 4; ++m) { const int i = u.pm * 256 + ai * HALF + wr * 64 + m * 16 + fr;
                if (i < u.cnt) { const f32x4 g0 = acc[ai][0][m][0], g1 = acc[ai][0][m][1], u0 = acc[ai][1][m][0], u1 = acc[ai][1][m][1];
                    u32x4 w; w.x = cvt_pk_bf16(siluf_(g0[0]) * u0[0], siluf_(g0[1]) * u0[1]); w.y = cvt_pk_bf16(siluf_(g0[2]) * u0[2], siluf_(g0[3]) * u0[3]);
                    w.z = cvt_pk_bf16(siluf_(g1[0]) * u1[0], siluf_(g1[1]) * u1[1]); w.w = cvt_pk_bf16(siluf_(g1[2]) * u1[2], siluf_(g1[3]) * u1[3]);
                    *(u32x4*)(HID + (size_t)(u.hb + i) * DE + u.pn * 128 + wc * 32 + 8 * fq) = w; } }
    }
};
struct EpiMoeOut {
    static constexpr bool PERM = true;
    bf16* YB; const int* LIST;
    __device__ __forceinline__ void operator()(const f32x4 (&acc)[2][2][4][2], const Unit& u, int wr, int wc, int fr, int fq) const {
#pragma unroll
        for (int ai = 0; ai < 2; ++ai)
#pragma unroll
            for (int m = 0; m < 4; ++m) { const int i = u.pm * 256 + ai * HALF + wr * 64 + m * 16 + fr;
                if (i < u.cnt) { const int a = LIST[u.e * M + i]; bf16* rowp = YB + (size_t)a * D + u.pn * 256 + wc * 32 + 8 * fq;
#pragma unroll
                    for (int bj = 0; bj < 2; ++bj) { const f32x4 v0 = acc[ai][bj][m][0], v1 = acc[ai][bj][m][1];
                        u32x4 w; w.x = cvt_pk_bf16(v0[0], v0[1]); w.y = cvt_pk_bf16(v0[2], v0[3]); w.z = cvt_pk_bf16(v1[0], v1[1]); w.w = cvt_pk_bf16(v1[2], v1[3]);
                        *(u32x4*)(rowp + bj * HALF) = w; } }
                asm volatile("" ::: "memory"); }
    }
};

template <class Epi, class Sched, bool ALIGN_EPI, bool GATHER>
__device__ __forceinline__ void gemm_phase(LAS unsigned char* lds, const int K, const Sched& S, const Epi& E) {
    const int tid = threadIdx.x, wid = __builtin_amdgcn_readfirstlane(tid >> 6), lane = tid & 63, wr = wid >> 2, wc = wid & 3, fr = lane & 15, fq = lane >> 4;
    const int nt = K / BK;
    int Rr[2], Cc[2]; unsigned voffB[2];
#pragma unroll
    for (int i = 0; i < 2; ++i) { int R, C; stage_rc(tid * 16 + i * 8192, R, C); const int Rb = Epi::PERM ? ((R & ~31) + perm32(R & 31)) : R; Rr[i] = R; Cc[i] = C; voffB[i] = (unsigned)(Rb * K + C) * 2u; }
    const size_t kstep = (size_t)(BK * 2);
    const size_t hstep = (size_t)HALF * K * 2;
    const unsigned ldsw = (unsigned)wid * 1024u;
    const int aoff = lds_byte(wr * 64 + fr, fq * 8), boff = lds_byte(wc * 32 + fr, fq * 8);
#define PG8_SA(b, h) (((b) * 2 + (h)) * HTB)
#define PG8_SB(b, h) ((4 + (b) * 2 + (h)) * HTB)
#define PG8_STAGE(bufoff, gbase, voff) do { _Pragma("unroll") for (int _i = 0; _i < 2; ++_i) \
        __builtin_amdgcn_global_load_lds((const unsigned*)((const char*)(gbase) + (voff)[_i]), (LAS unsigned*)(lds + (bufoff) + ldsw + _i * 8192), 16, 0, 0); } while (0)
#define PG8_STAGE_A(bufoff, gbase, o0, o1) do { \
        __builtin_amdgcn_global_load_lds((const unsigned*)((const char*)(gbase) + (o0)), (LAS unsigned*)(lds + (bufoff) + ldsw), 16, 0, 0); \
        __builtin_amdgcn_global_load_lds((const unsigned*)((const char*)(gbase) + (o1)), (LAS unsigned*)(lds + (bufoff) + ldsw + 8192), 16, 0, 0); } while (0)
#define PG8_LDA(dst, b, h) do { _Pragma("unroll") for (int m = 0; m < 4; ++m) _Pragma("unroll") for (int k = 0; k < 2; ++k) dst[m][k] = *(const LAS bf16x8*)(lds + PG8_SA(b, h) + aoff + m * 2048 + k * 1024); } while (0)
#define PG8_LDB(dst, b, h) do { _Pragma("unroll") for (int n = 0; n < 2; ++n) _Pragma("unroll") for (int k = 0; k < 2; ++k) dst[n][k] = *(const LAS bf16x8*)(lds + PG8_SB(b, h) + boff + n * 2048 + k * 1024); } while (0)
#define PG8_MMA(ai, bj, At, Bt) do { __builtin_amdgcn_s_setprio(1); _Pragma("unroll") for (int m = 0; m < 4; ++m) _Pragma("unroll") for (int n = 0; n < 2; ++n) _Pragma("unroll") for (int k = 0; k < 2; ++k) \
        acc[ai][bj][m][n] = __builtin_amdgcn_mfma_f32_16x16x32_bf16(Bt[n][k], At[m][k], acc[ai][bj][m][n], 0, 0, 0); __builtin_amdgcn_s_setprio(0); } while (0)
#define PG8_WAIT_V(n) asm volatile("s_waitcnt vmcnt(" #n ")" ::: "memory")
#define PG8_WAIT_L(n) asm volatile("s_waitcnt lgkmcnt(" #n ")" ::: "memory")
#define PG8_BAR __builtin_amdgcn_s_barrier()
#define PG8_SCHED __builtin_amdgcn_sched_barrier(0)
#define PG8_CALC_VA(u, v) do { _Pragma("unroll") for (int _h = 0; _h < 2; ++_h) _Pragma("unroll") for (int _i = 0; _i < 2; ++_i) \
        v[_h][_i] = GATHER ? (S.rowoff(u, _h * HALF + Rr[_i]) + (unsigned)Cc[_i] * 2u) : (unsigned)((_h * HALF + Rr[_i]) * K + Cc[_i]) * 2u; } while (0)
    Unit cur, nxt; int ui = 0;
    if (!S.next(0, cur)) return;
    f32x4 acc[2][2][4][2];
#pragma unroll
    for (int a = 0; a < 2; ++a)
#pragma unroll
        for (int b = 0; b < 2; ++b)
#pragma unroll
            for (int m = 0; m < 4; ++m)
#pragma unroll
                for (int n = 0; n < 2; ++n) acc[a][b][m][n] = (f32x4){0.f, 0.f, 0.f, 0.f};
    bf16x8 At[4][2], B0[2][2], B1[2][2];
    const char* cA; const char* cB; S.base(cur, cA, cB);
    unsigned cvA[2][2], nvA[2][2];
    PG8_CALC_VA(cur, cvA);
    PG8_STAGE(PG8_SB(0, 0), cB, voffB); PG8_STAGE(PG8_SB(0, 1), cB + hstep, voffB); PG8_STAGE_A(PG8_SA(0, 0), cA, cvA[0][0], cvA[0][1]); PG8_STAGE_A(PG8_SA(0, 1), cA, cvA[1][0], cvA[1][1]);
    if (wr == 1) PG8_BAR;
    PG8_WAIT_V(2); PG8_BAR;
    PG8_STAGE(PG8_SB(1, 0), cB + kstep, voffB); PG8_STAGE_A(PG8_SA(1, 0), cA + kstep, cvA[0][0], cvA[0][1]); PG8_STAGE(PG8_SB(1, 1), cB + hstep + kstep, voffB);
    PG8_WAIT_V(6); PG8_BAR;
    for (;;) {
        const bool has_next = S.next(ui + 1, nxt);
        const char* nA = cA; const char* nB = cB;
        if (has_next) { S.base(nxt, nA, nB); PG8_CALC_VA(nxt, nvA); }
        else {
#pragma unroll
            for (int h = 0; h < 2; ++h)
#pragma unroll
                for (int i = 0; i < 2; ++i) nvA[h][i] = cvA[h][i]; }
        if (GATHER) { asm volatile("s_waitcnt vmcnt(0)" ::: "memory"); asm volatile("" : "+v"(nvA[0][0]), "+v"(nvA[0][1]), "+v"(nvA[1][0]), "+v"(nvA[1][1])); }
#pragma unroll 1
        for (int t = 0; t < nt; t += 2) {
            const bool last = (t == nt - 2);
            const char* a1 = cA + (size_t)(t + 1) * kstep;
            const char* a2 = last ? nA : cA + (size_t)(t + 2) * kstep; const char* b2 = last ? nB : cB + (size_t)(t + 2) * kstep;
            const char* a3 = a2 + kstep; const char* b3 = b2 + kstep;
            const unsigned x00 = last ? nvA[0][0] : cvA[0][0], x01 = last ? nvA[0][1] : cvA[0][1], x10 = last ? nvA[1][0] : cvA[1][0], x11 = last ? nvA[1][1] : cvA[1][1];
            PG8_LDB(B0, 0, 0); PG8_LDB(B1, 0, 1); PG8_SCHED; PG8_LDA(At, 0, 0); PG8_STAGE_A(PG8_SA(1, 1), a1, cvA[1][0], cvA[1][1]);
            PG8_WAIT_V(8); PG8_WAIT_L(0); PG8_BAR; PG8_MMA(0, 0, At, B0); PG8_MMA(0, 1, At, B1); PG8_BAR; PG8_SCHED;
            PG8_LDA(At, 0, 1); PG8_STAGE(PG8_SB(0, 0), b2, voffB); PG8_STAGE(PG8_SB(0, 1), b2 + hstep, voffB); PG8_STAGE_A(PG8_SA(0, 0), a2, x00, x01);
            PG8_WAIT_V(8); PG8_WAIT_L(0); PG8_BAR; PG8_MMA(1, 0, At, B0); PG8_MMA(1, 1, At, B1); PG8_BAR; PG8_SCHED;
            PG8_LDB(B0, 1, 0); PG8_LDB(B1, 1, 1); PG8_SCHED; PG8_LDA(At, 1, 0); PG8_STAGE_A(PG8_SA(0, 1), a2, x10, x11);
            PG8_WAIT_V(8); PG8_WAIT_L(0); PG8_BAR; PG8_MMA(0, 0, At, B0); PG8_MMA(0, 1, At, B1); PG8_BAR; PG8_SCHED;
            PG8_LDA(At, 1, 1); PG8_STAGE(PG8_SB(1, 0), b3, voffB); PG8_STAGE(PG8_SB(1, 1), b3 + hstep, voffB); PG8_STAGE_A(PG8_SA(1, 0), a3, x00, x01);
            PG8_WAIT_V(8); PG8_WAIT_L(0); PG8_BAR; PG8_MMA(1, 0, At, B0); PG8_MMA(1, 1, At, B1); PG8_BAR; PG8_SCHED;
        }
        if constexpr (ALIGN_EPI) { if (wr == 0) PG8_BAR; }
        E(acc, cur, wr, wc, fr, fq);
        if (!has_next) break;
#pragma unroll
        for (int a = 0; a < 2; ++a)
#pragma unroll
            for (int b = 0; b < 2; ++b)
#pragma unroll
                for (int m = 0; m < 4; ++m)
#pragma unroll
                    for (int n = 0; n < 2; ++n) acc[a][b][m][n] = (f32x4){0.f, 0.f, 0.f, 0.f};
        cur = nxt; cA = nA; cB = nB; ++ui;
#pragma unroll
        for (int h = 0; h < 2; ++h)
#pragma unroll
            for (int i = 0; i < 2; ++i) cvA[h][i] = nvA[h][i];
        if constexpr (ALIGN_EPI) { if (wr == 1) PG8_BAR; }
    }
    PG8_WAIT_V(0);
    if constexpr (!ALIGN_EPI) { if (wr == 0) PG8_BAR; }
    PG8_BAR;
#undef PG8_SA
#undef PG8_SB
#undef PG8_STAGE
#undef PG8_STAGE_A
#undef PG8_LDA
#undef PG8_LDB
#undef PG8_MMA
#undef PG8_WAIT_V
#undef PG8_WAIT_L
#undef PG8_BAR
#undef PG8_SCHED
#undef PG8_CALC_VA
}
}

template <class RowFn>
__device__ __forceinline__ void ngemm_tile(LAS float* sA, LAS float* sB, RowFn rowA, const bf16* Bt, int ldb, int K, float (&acc)[4][4]) {
    const int tid = threadIdx.x, tx = tid & 15, ty = tid >> 4;
#pragma unroll
    for (int i = 0; i < 4; ++i)
#pragma unroll
        for (int j = 0; j < 4; ++j) acc[i][j] = 0.f;
    const int ar = tid >> 2, ak = (tid & 3) * 8, br = tid >> 3, bk = (tid & 7) * 4;
    const bf16* ap = rowA(ar);
    const bf16* bp = Bt + (size_t)br * ldb;
    for (int k0 = 0; k0 < K; k0 += 32) {
        u32x4 av = (u32x4){0u, 0u, 0u, 0u};
        if (ap) av = *(const u32x4*)(ap + k0 + ak);
        const u32x2 bv = *(const u32x2*)(bp + k0 + bk);
        __syncthreads();
        LAS float* wa = sA + ar * 33 + ak;
        wa[0] = bflo(av.x); wa[1] = bfhi(av.x); wa[2] = bflo(av.y); wa[3] = bfhi(av.y); wa[4] = bflo(av.z); wa[5] = bfhi(av.z); wa[6] = bflo(av.w); wa[7] = bfhi(av.w);
        LAS float* wb = sB + br * 33 + bk;
        wb[0] = bflo(bv.x); wb[1] = bfhi(bv.x); wb[2] = bflo(bv.y); wb[3] = bfhi(bv.y);
        __syncthreads();
#pragma unroll 8
        for (int kk = 0; kk < 32; ++kk) {
            float a[4], b[4];
#pragma unroll
            for (int i = 0; i < 4; ++i) a[i] = sA[(ty * 4 + i) * 33 + kk];
#pragma unroll
            for (int j = 0; j < 4; ++j) b[j] = sB[(tx * 4 + j) * 33 + kk];
#pragma unroll
            for (int i = 0; i < 4; ++i)
#pragma unroll
                for (int j = 0; j < 4; ++j) acc[i][j] = fmaf(a[i], b[j], acc[i][j]);
        }
    }
}

__device__ __forceinline__ void tr_item(const float* W, int ldw, bf16* WT, int ldt, LAS float* scr, int kb, int nb, int lane) {
    const int k0 = 64 * kb, n0 = 32 * nb;
#pragma unroll 8
    for (int i = 0; i < 32; ++i) { const int kk = 2 * i + (lane >> 5); scr[kk * 33 + (lane & 31)] = W[(size_t)(k0 + kk) * ldw + n0 + (lane & 31)]; }
    LDS_WAIT(); asm volatile("" ::: "memory");
    const int c = lane & 7;
#pragma unroll
    for (int j = 0; j < 4; ++j) { const int n = (lane >> 3) + 8 * j; const LAS float* s = scr + (8 * c) * 33 + n;
        u32x4 o; o.x = pk2(s[0 * 33], s[1 * 33]); o.y = pk2(s[2 * 33], s[3 * 33]); o.z = pk2(s[4 * 33], s[5 * 33]); o.w = pk2(s[6 * 33], s[7 * 33]);
        *(u32x4*)(WT + (size_t)(n0 + n) * ldt + k0 + 8 * c) = o; }
    LDS_WAIT(); asm volatile("" ::: "memory");
}

__device__ __forceinline__ void ph0_convert(Frame& F) {
    LAS float* scr = (LAS float*)(F.lds + F.wave * 9216);
    LAS float* gw = (LAS float*)(F.lds + 8 * 9216);
    const float* w0 = F.in[1];
    for (int i = F.tid; i < 8 * 1024; i += NT) { const int j = i >> 10, k = i & 1023; gw[i] = w0[(size_t)k * IN0 + 2048 + j]; }
    __syncthreads();
    const int gwv = F.vcu * NWAVES + F.wave, NGW = F.G * NWAVES;
    bf16* WT0 = (bf16*)(F.ws + WS_WT0); bf16* WO0 = (bf16*)(F.ws + WS_WO0); bf16* WT1 = (bf16*)(F.ws + WS_WT1); bf16* WO1 = (bf16*)(F.ws + WS_WO1);
    constexpr int I0 = 16 * 64, I1 = 16 * 64, I2 = 16 * 32, I3 = 16 * 144, I4 = 8 * 32, NI = I0 + I1 + I2 + I3 + I4;
    for (int it = gwv; it < NI; it += NGW) {
        int r = it;
        if (r < I0) { tr_item(w0, IN0, WT0, 1024, scr, r / 64, r % 64, F.lane); continue; } r -= I0;
        if (r < I1) { tr_item(w0 + 2056, IN0, WT0 + (size_t)2048 * 1024, 1024, scr, r / 64, r % 64, F.lane); continue; } r -= I1;
        if (r < I2) { tr_item(F.in[8], 1024, WO0, 1024, scr, r / 32, r % 32, F.lane); continue; } r -= I2;
        if (r < I3) { tr_item(F.in[9], IN1, WT1, 1024, scr, r / 144, r % 144, F.lane); continue; } r -= I3;
        tr_item(F.in[10], 1024, WO1, 512, scr, r / 32, r % 32, F.lane);
    }
    const float* x = F.in[0]; bf16* XB = (bf16*)(F.ws + WS_XB); float* G = (float*)(F.ws + WS_G);
    const float* ib = F.in[2]; const float* fb = F.in[3];
    for (int m = gwv; m < M; m += NGW) {
        const f32x4* xr = (const f32x4*)(x + (size_t)m * D) + F.lane;
        f32x4 v[4];
#pragma unroll
        for (int j = 0; j < 4; ++j) v[j] = xr[64 * j];
        unsigned long long* o8 = (unsigned long long*)(XB + (size_t)m * D) + F.lane;
#pragma unroll
        for (int j = 0; j < 4; ++j) o8[64 * j] = (unsigned long long)pk2(v[j].x, v[j].y) | ((unsigned long long)pk2(v[j].z, v[j].w) << 32);
        float acc[8];
#pragma unroll
        for (int g = 0; g < 8; ++g) { float a = 0.f;
#pragma unroll
            for (int j = 0; j < 4; ++j) { const f32x4 w = *(const LAS f32x4*)(gw + g * 1024 + 4 * F.lane + 256 * j); a += v[j].x * w.x + v[j].y * w.y + v[j].z * w.z + v[j].w * w.w; }
            acc[g] = wave_sum(a); }
        if (F.lane == 0) {
#pragma unroll
            for (int g = 0; g < 4; ++g) G[(size_t)m * 8 + g] = acc[g] + ib[g];
#pragma unroll
            for (int g = 0; g < 4; ++g) { const float z = acc[4 + g] + fb[g]; G[(size_t)m * 8 + 4 + g] = fminf(z, 0.f) - log1pf(__expf(-fabsf(z))); }
        }
    }
}

__device__ __forceinline__ void convert_experts(Frame& F, int layer) {
    LAS float* scr = (LAS float*)(F.lds + F.wave * 9216);
    const int gwv = F.vcu * NWAVES + F.wave, NGW = F.G * NWAVES;
    const float* wg = F.in[13] + (size_t)layer * NE * D * DE; const float* wu = F.in[14] + (size_t)layer * NE * D * DE; const float* wd = F.in[15] + (size_t)layer * NE * DE * D;
    for (int it = gwv; it < NE * 384; it += NGW) {
        const int e = it / 384; int r = it % 384;
        bf16* GU = (bf16*)(F.ws + WS_EW + (size_t)e * EW_STRIDE); bf16* DN = (bf16*)(F.ws + WS_EW + (size_t)e * EW_STRIDE + EW_DN);
        if (r < 256) { const int job = r >> 6, q = r & 63;
            const float* src = ((job < 2) ? wg : wu) + (size_t)e * D * DE + (job & 1) * 128;
            bf16* dst = GU + (size_t)((job & 1) * 256 + (job >> 1) * 128) * 1024;
            tr_item(src, DE, dst, 1024, scr, q >> 2, q & 3, F.lane);
        } else { r -= 256;
            tr_item(wd + (size_t)e * DE * D, D, DN, DE, scr, r >> 5, r & 31, F.lane); }
    }
}

__device__ __forceinline__ void ph_inproj_naive(Frame& F, const bf16* Bt, int N) {
    LAS float* sA = (LAS float*)F.lds; LAS float* sB = sA + 128 * 33;
    const bf16* XB = (const bf16*)(F.ws + WS_XB); bf16* P = (bf16*)(F.ws + WS_P);
    const int nnb = N / 64, ntiles = (M / 128) * nnb, tx = F.tid & 15, ty = F.tid >> 4;
    for (int t = blockIdx.x; t < ntiles; t += F.G) {
        const int mb = t / nnb, nb = t % nnb; float acc[4][4];
        ngemm_tile(sA, sB, [&](int r) { return XB + (size_t)(mb * 128 + r) * D; }, Bt + (size_t)nb * 64 * D, D, D, acc);
#pragma unroll
        for (int i = 0; i < 4; ++i) { u32x2 o; o.x = pk2(acc[i][0], acc[i][1]); o.y = pk2(acc[i][2], acc[i][3]);
            *(u32x2*)(P + (size_t)(mb * 128 + ty * 4 + i) * N + nb * 64 + tx * 4) = o; }
    }
}
__device__ __forceinline__ void ph_outproj_naive(Frame& F, const bf16* A, int K, const bf16* Bt, const float* base) {
    LAS float* sA = (LAS float*)F.lds; LAS float* sB = sA + 128 * 33;
    const int nnb = D / 64, ntiles = (M / 128) * nnb, tx = F.tid & 15, ty = F.tid >> 4;
    for (int t = blockIdx.x; t < ntiles; t += F.G) {
        const int mb = t / nnb, nb = t % nnb; float acc[4][4];
        ngemm_tile(sA, sB, [&](int r) { return A + (size_t)(mb * 128 + r) * K; }, Bt + (size_t)nb * 64 * K, K, K, acc);
#pragma unroll
        for (int i = 0; i < 4; ++i) { const size_t off = (size_t)(mb * 128 + ty * 4 + i) * D + nb * 64 + tx * 4;
            const f32x4 b = *(const f32x4*)(base + off);
            *(f32x4*)(F.out + off) = (f32x4){ALPHA * b.x + acc[i][0], ALPHA * b.y + acc[i][1], ALPHA * b.z + acc[i][2], ALPHA * b.w + acc[i][3]}; }
    }
}

__device__ __forceinline__ void ph_conv_naive(Frame& F) {
    const bf16* P = (const bf16*)(F.ws + WS_P); bf16* QKC = (bf16*)(F.ws + WS_QKC);
    const float* cw = F.in[4]; const float* cb = F.in[5];
    const size_t total = (size_t)M * 1024, nth = (size_t)F.G * NT;
    for (size_t i = (size_t)blockIdx.x * NT + F.tid; i < total; i += nth) {
        const int m = (int)(i >> 10), c = (int)(i & 1023), t = m & (T - 1);
        float a = cb[c];
#pragma unroll
        for (int j = 0; j < 4; ++j) { const int tt = t - 3 + j; if (tt >= 0) a += cw[j * 1024 + c] * bf2f(P[(size_t)(m - 3 + j) * NP0 + c]); }
        QKC[i] = (bf16)f2bf(siluf_(a));
    }
}
__device__ __forceinline__ void ph_recurrent_naive(Frame& F) {
    if (blockIdx.x >= 16) return;
    const int type = blockIdx.x >> 3, b = (blockIdx.x >> 2) & 1, h = blockIdx.x & 3;
    LAS float* sin = (LAS float*)F.lds;
    LAS float* red = sin + 1024;
    LAS float* redd = red + 512;
    LAS float* sc = redd + 4;
    const bf16* P = (const bf16*)(F.ws + WS_P); const bf16* QKC = (const bf16*)(F.ws + WS_QKC); const float* G = (const float*)(F.ws + WS_G);
    bf16* Y = (bf16*)(F.ws + WS_Y);
    const float* gain = (type == 0 ? F.in[6] : F.in[7]) + h * 128;
    const int e = F.tid & 127, dg = F.tid >> 7, which = dg;
    const float gamma = 1.f - exp2f(-5.f - (float)h);
    float C[32], nn[32];
#pragma unroll
    for (int j = 0; j < 32; ++j) { C[j] = 0.f; nn[j] = 0.f; }
    const bf16* src; size_t stride;
    if (type == 0) { if (which < 2) { src = QKC + which * 512 + h * 128 + e; stride = 1024; } else { src = P + 1024 + (which - 2) * 512 + h * 128 + e; stride = NP0; } }
    else { src = P + 2048 + which * 512 + h * 128 + e; stride = NP0; }
    const float mul = (which == 1) ? KSCALE : 1.f;
    const size_t m0 = (size_t)b * T;
    float val = bf2f(src[m0 * stride]) * mul;
    float s0 = 0.f, s1 = 0.f;
    if (F.tid == 0) { if (type == 0) { s0 = __expf(G[m0 * 8 + 4 + h]); s1 = __expf(G[m0 * 8 + h]); } else { s0 = gamma; s1 = 1.f; } }
    for (int t = 0; t < T; ++t) {
        const size_t m = m0 + t; const int pb = t & 1;
        sin[pb * 512 + F.tid] = val;
        if (F.tid == 0) { sc[pb * 2] = s0; sc[pb * 2 + 1] = s1; }
        if (t + 1 < T) { val = bf2f(src[(m + 1) * stride]) * mul;
            if (F.tid == 0 && type == 0) { s0 = __expf(G[(m + 1) * 8 + 4 + h]); s1 = __expf(G[(m + 1) * 8 + h]); } }
        __syncthreads();
        const float f = sc[pb * 2], ig = sc[pb * 2 + 1];
        const LAS float* sq = sin + pb * 512; const LAS float* sk = sq + 128; const LAS float* sv = sq + 256; const LAS float* so = sq + 384;
        const float ve = sv[e] * ig;
        float pn = 0.f, pd = 0.f;
#pragma unroll
        for (int j = 0; j < 32; ++j) { const int d = dg * 32 + j; const float kd = sk[d], qd = sq[d];
            C[j] = fmaf(f, C[j], kd * ve); nn[j] = fmaf(f, nn[j], ig * kd); pn = fmaf(C[j], qd, pn); pd = fmaf(nn[j], qd, pd); }
        red[dg * 128 + e] = pn; if (e == 0) redd[dg] = pd;
        __syncthreads();
        if (F.tid < 64) {
            const int e0 = F.tid, e1 = F.tid + 64;
            float h0 = (red[e0] + red[128 + e0]) + (red[256 + e0] + red[384 + e0]);
            float h1 = (red[e1] + red[128 + e1]) + (red[256 + e1] + red[384 + e1]);
            if (type == 0) { const float den = (redd[0] + redd[1]) + (redd[2] + redd[3]); const float dn = fmaxf(fabsf(den), 1.f);
                h0 = h0 / dn * sigmoidf_(so[e0]); h1 = h1 / dn * sigmoidf_(so[e1]); }
            const float mean = wave_sum(h0 + h1) * (1.f / 128.f); const float d0 = h0 - mean, d1 = h1 - mean;
            const float rstd = 1.f / sqrtf(wave_sum(d0 * d0 + d1 * d1) * (1.f / 128.f) + LN_EPS);
            float y0 = d0 * rstd * gain[e0], y1 = d1 * rstd * gain[e1];
            if (type == 1) { y0 *= siluf_(so[e0]); y1 *= siluf_(so[e1]); }
            Y[m * 1024 + type * 512 + h * 128 + e0] = (bf16)f2bf(y0); Y[m * 1024 + type * 512 + h * 128 + e1] = (bf16)f2bf(y1);
        }
    }
}

constexpr size_t WS_S = WS_SE;
constexpr size_t WS_DN = WS_G + 768 * 1024;
constexpr int CB_GL = 512 * 1024, CB_MSC = 520 * 1024;
constexpr int TRS = 144, RWS = 136;
template <int O0, int O1>
__device__ __forceinline__ void tr2(unsigned a, u32x2& r0, u32x2& r1) {
    asm volatile("ds_read_b64_tr_b16 %0, %2 offset:%3\n\tds_read_b64_tr_b16 %1, %2 offset:%4\n\ts_waitcnt lgkmcnt(0)" : "=&v"(r0), "=&v"(r1) : "v"(a), "i"(O0), "i"(O1) : "memory");
}
template <int B, int H>
__device__ __forceinline__ void tr8(unsigned a, u32x2& r0, u32x2& r1, u32x2& r2, u32x2& r3, u32x2& r4, u32x2& r5, u32x2& r6, u32x2& r7) {
    asm volatile("ds_read_b64_tr_b16 %0, %8 offset:%9\n\tds_read_b64_tr_b16 %1, %8 offset:%10\n\tds_read_b64_tr_b16 %2, %8 offset:%11\n\tds_read_b64_tr_b16 %3, %8 offset:%12\n\t"
                 "ds_read_b64_tr_b16 %4, %8 offset:%13\n\tds_read_b64_tr_b16 %5, %8 offset:%14\n\tds_read_b64_tr_b16 %6, %8 offset:%15\n\tds_read_b64_tr_b16 %7, %8 offset:%16\n\ts_waitcnt lgkmcnt(0)"
                 : "=&v"(r0), "=&v"(r1), "=&v"(r2), "=&v"(r3), "=&v"(r4), "=&v"(r5), "=&v"(r6), "=&v"(r7)
                 : "v"(a), "i"(B), "i"(B + H), "i"(B + 32), "i"(B + 32 + H), "i"(B + 64), "i"(B + 64 + H), "i"(B + 96), "i"(B + 96 + H) : "memory");
}
__device__ __forceinline__ bf16x8_t pack_frag(u32x2 a, u32x2 b) { return __builtin_bit_cast(bf16x8_t, (u32x4){a.x, a.y, b.x, b.y}); }
__device__ __forceinline__ void scan128_sum(float& x0, float& x1, int lane) {
#pragma unroll
    for (int o = 1; o < 64; o <<= 1) { const float t0 = __shfl_up(x0, o), t1 = __shfl_up(x1, o); if (lane >= o) { x0 += t0; x1 += t1; } }
    x1 += __shfl(x0, 63);
}
__device__ __forceinline__ void scan128_max(float& x0, float& x1, int lane) {
#pragma unroll
    for (int o = 1; o < 64; o <<= 1) { const float t0 = __shfl_up(x0, o), t1 = __shfl_up(x1, o); if (lane >= o) { x0 = fmaxf(x0, t0); x1 = fmaxf(x1, t1); } }
    x1 = fmaxf(x1, __shfl(x0, 63));
}
__device__ __forceinline__ float wave_max(float v) {
#pragma unroll
    for (int o = 1; o < 64; o <<= 1) v = fmaxf(v, __shfl_xor(v, o));
    return v;
}
__device__ __forceinline__ void conv8(const bf16* Pc, int row, int tpos0, const LAS float* cwp, float (&o)[8]) {
    { const f32x4 b0 = *(const LAS f32x4*)(cwp + 512), b1 = *(const LAS f32x4*)(cwp + 516); o[0] = b0.x; o[1] = b0.y; o[2] = b0.z; o[3] = b0.w; o[4] = b1.x; o[5] = b1.y; o[6] = b1.z; o[7] = b1.w; }
#pragma unroll
    for (int j = 0; j < 4; ++j) { const int r = row - 3 + j;
        if (tpos0 + r >= 0) { const u32x4 x = *(const u32x4*)(Pc + (long)r * NP0); const f32x4 w0 = *(const LAS f32x4*)(cwp + j * 128), w1 = *(const LAS f32x4*)(cwp + j * 128 + 4);
            o[0] += w0.x * bflo(x.x); o[1] += w0.y * bfhi(x.x); o[2] += w0.z * bflo(x.y); o[3] += w0.w * bfhi(x.y); o[4] += w1.x * bflo(x.z); o[5] += w1.y * bfhi(x.z); o[6] += w1.z * bflo(x.w); o[7] += w1.w * bfhi(x.w); } }
#pragma unroll
    for (int e = 0; e < 8; ++e) o[e] = siluf_(o[e]);
}
__device__ __forceinline__ u32x4 pack8(const float (&o)[8], float sc) {
    u32x4 w; w.x = pg8::cvt_pk_bf16(o[0] * sc, o[1] * sc); w.y = pg8::cvt_pk_bf16(o[2] * sc, o[3] * sc); w.z = pg8::cvt_pk_bf16(o[4] * sc, o[5] * sc); w.w = pg8::cvt_pk_bf16(o[6] * sc, o[7] * sc); return w; }
__device__ __forceinline__ void unpack8(u32x4 x, float (&o)[8]) { o[0] = bflo(x.x); o[1] = bfhi(x.x); o[2] = bflo(x.y); o[3] = bfhi(x.y); o[4] = bflo(x.z); o[5] = bfhi(x.z); o[6] = bflo(x.w); o[7] = bfhi(x.w); }

__device__ __forceinline__ void ph_mix_a(Frame& F) {
    LAS bf16* Vl = (LAS bf16*)F.lds;
    LAS bf16* Kl = Vl + 128 * TRS;
    LAS float* cwl = (LAS float*)(Kl + 128 * TRS);
    LAS float* wl = cwl + 640;
    const bf16* P = (const bf16*)(F.ws + WS_P); const float* G = (const float*)(F.ws + WS_G); float* S = (float*)(F.ws + WS_S); float* DN = (float*)(F.ws + WS_DN);
    float* GL = (float*)((char*)F.ctl + CB_GL);
    const float* cw = F.in[4]; const float* cb = F.in[5];
    const int tid = F.tid, lane = F.lane, w = F.wave, fr = lane & 15, fq = lane >> 4;
    const unsigned vaddr = (unsigned)(size_t)Vl + (unsigned)(((4 * fq + (fr >> 2)) * TRS + 16 * w + 4 * (fr & 3)) * 2);
    const unsigned kaddr = (unsigned)(size_t)Kl + (unsigned)(((4 * fq + (fr >> 2)) * TRS + 4 * (fr & 3)) * 2);
    for (int u = blockIdx.x; u < 1024; u += F.G) {
        const int type = u >> 9, b = (u >> 8) & 1, h = (u >> 6) & 3, c = u & 63, chain = type * 8 + b * 4 + h;
        const size_t m0 = (size_t)b * T + c * 128;
        const int kcol = (type == 0 ? 512 : 2560) + h * 128, vcol = (type == 0 ? 1024 : 3072) + h * 128;
        __syncthreads();
        if (type == 0) for (int i = tid; i < 640; i += NT) { const int j = i >> 7, d = i & 127; cwl[i] = j < 4 ? cw[j * 1024 + 512 + h * 128 + d] : cb[512 + h * 128 + d]; }
        if (w == 0) {
            float w0, w1;
            if (type == 0) {
                const float i0 = G[(m0 + lane) * 8 + h], i1 = G[(m0 + lane + 64) * 8 + h];
                float b0 = G[(m0 + lane) * 8 + 4 + h], b1 = G[(m0 + lane + 64) * 8 + 4 + h];
                scan128_sum(b0, b1, lane);
                const float g = __shfl(b1, 63), lw0 = g - b0 + i0, lw1 = g - b1 + i1, ml = wave_max(fmaxf(lw0, lw1));
                w0 = __expf(lw0 - ml); w1 = __expf(lw1 - ml);
                if (lane == 0) { GL[(chain * 64 + c) * 2] = g; GL[(chain * 64 + c) * 2 + 1] = ml; }
            } else { const float lg = log1pf(-exp2f(-5.f - (float)h)); w0 = __expf(lg * (float)(127 - lane)); w1 = __expf(lg * (float)(63 - lane)); }
            wl[lane] = w0 * KSCALE; wl[lane + 64] = w1 * KSCALE;
        }
#pragma unroll
        for (int it = 0; it < 4; ++it) { const int s = (tid >> 4) + 32 * it, ch = tid & 15;
            *(LAS u32x4*)(Vl + s * TRS + ch * 8) = *(const u32x4*)(P + (m0 + s) * NP0 + vcol + ch * 8); }
        __syncthreads();
#pragma unroll
        for (int it = 0; it < 4; ++it) { const int s = (tid >> 4) + 32 * it, ch = tid & 15; float o[8];
            if (type == 0) conv8(P + m0 * NP0 + kcol + ch * 8, s, c * 128, cwl + ch * 8, o);
            else unpack8(*(const u32x4*)(P + (m0 + s) * NP0 + kcol + ch * 8), o);
            *(LAS u32x4*)(Kl + s * TRS + ch * 8) = pack8(o, wl[s]); }
        __syncthreads();
        f32x4 acc[8], accn = (f32x4){0.f, 0.f, 0.f, 0.f};
#pragma unroll
        for (int dt = 0; dt < 8; ++dt) acc[dt] = (f32x4){0.f, 0.f, 0.f, 0.f};
        const bf16x8_t ones = (bf16x8_t){0x3F80, 0x3F80, 0x3F80, 0x3F80, 0x3F80, 0x3F80, 0x3F80, 0x3F80};
#pragma unroll
        for (int ks = 0; ks < 4; ++ks) {
            u32x2 a0, a1, n0, n1, b0, b1, b2, b3, b4, b5, b6, b7, c0, c1, c2, c3, c4, c5, c6, c7;
            tr2<0, 16 * TRS * 2>(vaddr + ks * 32 * TRS * 2, a0, a1);
            tr2<0, 16 * TRS * 2>(kaddr + ks * 32 * TRS * 2 + 32 * w, n0, n1);
            tr8<0, 16 * TRS * 2>(kaddr + ks * 32 * TRS * 2, b0, b1, b2, b3, b4, b5, b6, b7);
            tr8<128, 16 * TRS * 2>(kaddr + ks * 32 * TRS * 2, c0, c1, c2, c3, c4, c5, c6, c7);
            __builtin_amdgcn_sched_barrier(0);
            const bf16x8_t A = pack_frag(a0, a1);
            acc[0] = __builtin_amdgcn_mfma_f32_16x16x32_bf16(A, pack_frag(b0, b1), acc[0], 0, 0, 0);
            acc[1] = __builtin_amdgcn_mfma_f32_16x16x32_bf16(A, pack_frag(b2, b3), acc[1], 0, 0, 0);
            acc[2] = __builtin_amdgcn_mfma_f32_16x16x32_bf16(A, pack_frag(b4, b5), acc[2], 0, 0, 0);
            acc[3] = __builtin_amdgcn_mfma_f32_16x16x32_bf16(A, pack_frag(b6, b7), acc[3], 0, 0, 0);
            acc[4] = __builtin_amdgcn_mfma_f32_16x16x32_bf16(A, pack_frag(c0, c1), acc[4], 0, 0, 0);
            acc[5] = __builtin_amdgcn_mfma_f32_16x16x32_bf16(A, pack_frag(c2, c3), acc[5], 0, 0, 0);
            acc[6] = __builtin_amdgcn_mfma_f32_16x16x32_bf16(A, pack_frag(c4, c5), acc[6], 0, 0, 0);
            acc[7] = __builtin_amdgcn_mfma_f32_16x16x32_bf16(A, pack_frag(c6, c7), acc[7], 0, 0, 0);
            accn = __builtin_amdgcn_mfma_f32_16x16x32_bf16(ones, pack_frag(n0, n1), accn, 0, 0, 0);
        }
        float* Sp = S + ((size_t)(chain * 64 + c) * 128 + 16 * w + 4 * fq) * 128 + fr;
#pragma unroll
        for (int dt = 0; dt < 8; ++dt)
#pragma unroll
            for (int rg = 0; rg < 4; ++rg) Sp[rg * 128 + 16 * dt] = acc[dt][rg];
        if (type == 0 && fq == 0) DN[(size_t)(chain * 64 + c) * 128 + 16 * w + fr] = accn[0];
    }
}

__device__ __forceinline__ void ph_mix_b(Frame& F) {
    LAS float* gl = (LAS float*)F.lds; LAS float* dec = gl + 1024; LAS float* scl = dec + 512;
    const float* GL = (const float*)((char*)F.ctl + CB_GL); float* MSC = (float*)((char*)F.ctl + CB_MSC);
    float* S = (float*)(F.ws + WS_S); float* DN = (float*)(F.ws + WS_DN);
    for (int i = F.tid; i < 1024; i += NT) gl[i] = GL[i];
    __syncthreads();
    if (F.tid < 8) { float m = 0.f;
        for (int c = 0; c < 64; ++c) { const float g = gl[(F.tid * 64 + c) * 2], ml = gl[(F.tid * 64 + c) * 2 + 1];
            if (blockIdx.x == 0) MSC[F.tid * 64 + c] = m;
            const float mn = fmaxf(g + m, ml); dec[F.tid * 64 + c] = __expf(g + m - mn); scl[F.tid * 64 + c] = __expf(ml - mn); m = mn; } }
    __syncthreads();
    for (int j = blockIdx.x * NT + F.tid; j < 131072; j += F.G * NT) {
        const int chain = j >> 14, el = j & 16383;
        float* p0 = S + (size_t)chain * 64 * 16384 + el; float* p1 = S + (size_t)(8 + chain) * 64 * 16384 + el;
        const float g128 = __expf(128.f * log1pf(-exp2f(-5.f - (float)(chain & 3))));
        float C = 0.f, R = 0.f;
        for (int c0 = 0; c0 < 64; c0 += 8) { float x[8], y[8];
#pragma unroll
            for (int k = 0; k < 8; ++k) { x[k] = p0[(size_t)(c0 + k) * 16384]; y[k] = p1[(size_t)(c0 + k) * 16384]; }
#pragma unroll
            for (int k = 0; k < 8; ++k) { p0[(size_t)(c0 + k) * 16384] = C; C = dec[chain * 64 + c0 + k] * C + scl[chain * 64 + c0 + k] * x[k];
                p1[(size_t)(c0 + k) * 16384] = R; R = g128 * R + y[k]; } }
    }
    for (int j = blockIdx.x * NT + F.tid; j < 1024; j += F.G * NT) { const int chain = j >> 7, d = j & 127; float* p = DN + (size_t)chain * 64 * 128 + d; float n = 0.f;
        for (int c = 0; c < 64; ++c) { const float x = p[c * 128]; p[c * 128] = n; n = dec[chain * 64 + c] * n + scl[chain * 64 + c] * x; } }
}

__device__ __forceinline__ void ph_mix_c(Frame& F) {
    LAS bf16* Kl = (LAS bf16*)F.lds;
    LAS bf16* Vl = Kl + 128 * RWS;
    LAS bf16* Cl = Vl + 128 * TRS;
    LAS float* cwl = (LAS float*)(Cl + 144 * RWS);
    LAS float* ul = cwl + 1280; LAS float* Ml = ul + 128; LAS float* bl = Ml + 128;
    const bf16* P = (const bf16*)(F.ws + WS_P); const float* G = (const float*)(F.ws + WS_G); const float* S = (const float*)(F.ws + WS_S); const float* DN = (const float*)(F.ws + WS_DN);
    const float* MSC = (const float*)((char*)F.ctl + CB_MSC); bf16* Y = (bf16*)(F.ws + WS_Y);
    const float* cw = F.in[4]; const float* cb = F.in[5];
    const int tid = F.tid, lane = F.lane, w = F.wave, fr = lane & 15, fq = lane >> 4;
    const int lt = w < 4 ? w : 11 - w, l = 16 * lt + fr;
    const unsigned vaddr = (unsigned)(size_t)Vl + (unsigned)(((4 * fq + (fr >> 2)) * TRS + 4 * (fr & 3)) * 2);
    for (int u = blockIdx.x; u < 1024; u += F.G) {
        const int type = u >> 9, b = (u >> 8) & 1, h = (u >> 6) & 3, c = u & 63, chain = type * 8 + b * 4 + h;
        const size_t m0 = (size_t)b * T + c * 128;
        const int base = type == 0 ? 0 : 2048, qcol = base + h * 128, kcol = base + 512 + h * 128, vcol = base + 1024 + h * 128, gcol = base + 1536 + h * 128;
        const float lg = log1pf(-exp2f(-5.f - (float)h));
        __syncthreads();
        if (type == 0) for (int i = tid; i < 1280; i += NT) { const int part = i / 640, r = i % 640, j = r >> 7, d = r & 127, col = part * 512 + h * 128 + d; cwl[i] = j < 4 ? cw[j * 1024 + col] : cb[col]; }
        float mc = 0.f;
        if (type == 0) {
            mc = MSC[(b * 4 + h) * 64 + c];
            if (w == 0) {
                const float i0 = G[(m0 + lane) * 8 + h], i1 = G[(m0 + lane + 64) * 8 + h];
                float b0 = G[(m0 + lane) * 8 + 4 + h], b1 = G[(m0 + lane + 64) * 8 + 4 + h];
                scan128_sum(b0, b1, lane);
                const float u0 = i0 - b0, u1 = i1 - b1; float p0 = u0, p1 = u1; scan128_max(p0, p1, lane);
                ul[lane] = u0; ul[lane + 64] = u1; Ml[lane] = fmaxf(mc, p0); Ml[lane + 64] = fmaxf(mc, p1); bl[lane] = b0; bl[lane + 64] = b1;
            }
        }
#pragma unroll
        for (int it = 0; it < 4; ++it) { const int s = (tid >> 4) + 32 * it, ch = tid & 15;
            *(LAS u32x4*)(Vl + s * TRS + ch * 8) = *(const u32x4*)(P + (m0 + s) * NP0 + vcol + ch * 8);
            const float* sp = S + ((size_t)(chain * 64 + c) * 128 + s) * 128 + ch * 8; const f32x4 x0 = *(const f32x4*)sp, x1 = *(const f32x4*)(sp + 4);
            u32x4 wv; wv.x = pg8::cvt_pk_bf16(x0.x, x0.y); wv.y = pg8::cvt_pk_bf16(x0.z, x0.w); wv.z = pg8::cvt_pk_bf16(x1.x, x1.y); wv.w = pg8::cvt_pk_bf16(x1.z, x1.w);
            *(LAS u32x4*)(Cl + s * RWS + ch * 8) = wv; }
        if (tid < 256) { const int r = tid >> 4, ch = tid & 15; u32x4 wv = (u32x4){0u, 0u, 0u, 0u};
            if (type == 0 && r == 0) { const float* np = DN + (size_t)((b * 4 + h) * 64 + c) * 128 + ch * 8; const f32x4 x0 = *(const f32x4*)np, x1 = *(const f32x4*)(np + 4);
                wv.x = pg8::cvt_pk_bf16(x0.x, x0.y); wv.y = pg8::cvt_pk_bf16(x0.z, x0.w); wv.z = pg8::cvt_pk_bf16(x1.x, x1.y); wv.w = pg8::cvt_pk_bf16(x1.z, x1.w); }
            *(LAS u32x4*)(Cl + (128 + r) * RWS + ch * 8) = wv; }
        __syncthreads();
#pragma unroll
        for (int it = 0; it < 4; ++it) { const int s = (tid >> 4) + 32 * it, ch = tid & 15; float o[8];
            if (type == 0) conv8(P + m0 * NP0 + kcol + ch * 8, s, c * 128, cwl + 640 + ch * 8, o);
            else unpack8(*(const u32x4*)(P + (m0 + s) * NP0 + kcol + ch * 8), o);
            *(LAS u32x4*)(Kl + s * RWS + ch * 8) = pack8(o, KSCALE); }
        bf16x8_t qf[4];
#pragma unroll
        for (int ks = 0; ks < 4; ++ks) { const int d0 = 32 * ks + 8 * fq;
            if (type == 0) { float o[8]; conv8(P + m0 * NP0 + qcol + d0, l, c * 128, cwl + d0, o); qf[ks] = __builtin_bit_cast(bf16x8_t, pack8(o, 1.f)); }
            else qf[ks] = *(const bf16x8_t*)(P + (m0 + l) * NP0 + qcol + d0); }
        __syncthreads();
        f32x4 st[8];
#pragma unroll
        for (int t = 0; t < 8; ++t) { st[t] = (f32x4){0.f, 0.f, 0.f, 0.f};
            if (t <= lt) {
#pragma unroll
                for (int ks = 0; ks < 4; ++ks) st[t] = __builtin_amdgcn_mfma_f32_16x16x32_bf16(*(const LAS bf16x8_t*)(Kl + (16 * t + fr) * RWS + 32 * ks + 8 * fq), qf[ks], st[t], 0, 0, 0); }
            if (t & 1) __builtin_amdgcn_sched_barrier(0); }
        int lz = l, fz = 4 * fq; asm volatile("" : "+v"(lz), "+v"(fz));
        const float Mme = (type == 0) ? Ml[lz] : 0.f;
        float den = 0.f;
#pragma unroll
        for (int t = 0; t < 8; ++t) if (t <= lt) {
#pragma unroll
            for (int rg = 0; rg < 4; ++rg) { const int s = 16 * t + fz + rg;
                float e = (type == 0) ? (ul[s] - Mme) : (lg * (float)(lz - s)); e = (s <= lz) ? e : -1e30f;
                const float p = st[t][rg] * __expf(e); st[t][rg] = p; den += p; } }
        den += __shfl_xor(den, 16); den += __shfl_xor(den, 32);
        f32x4 o1[8], o2[9];
#pragma unroll
        for (int et = 0; et < 8; ++et) o1[et] = (f32x4){0.f, 0.f, 0.f, 0.f};
#pragma unroll
        for (int et = 0; et < 9; ++et) o2[et] = (f32x4){0.f, 0.f, 0.f, 0.f};
#pragma unroll
        for (int j = 0; j < 4; ++j) if (2 * j <= lt) {
            u32x4 pw; pw.x = pg8::cvt_pk_bf16(st[2 * j][0], st[2 * j][1]); pw.y = pg8::cvt_pk_bf16(st[2 * j][2], st[2 * j][3]);
            pw.z = pg8::cvt_pk_bf16(st[2 * j + 1][0], st[2 * j + 1][1]); pw.w = pg8::cvt_pk_bf16(st[2 * j + 1][2], st[2 * j + 1][3]);
            const bf16x8_t pf = __builtin_bit_cast(bf16x8_t, pw);
            u32x2 b0, b1, b2, b3, b4, b5, b6, b7, c0, c1, c2, c3, c4, c5, c6, c7;
            tr8<0, 16 * TRS * 2>(vaddr + j * 32 * TRS * 2, b0, b1, b2, b3, b4, b5, b6, b7);
            tr8<128, 16 * TRS * 2>(vaddr + j * 32 * TRS * 2, c0, c1, c2, c3, c4, c5, c6, c7);
            __builtin_amdgcn_sched_barrier(0);
            o1[0] = __builtin_amdgcn_mfma_f32_16x16x32_bf16(pack_frag(b0, b1), pf, o1[0], 0, 0, 0);
            o1[1] = __builtin_amdgcn_mfma_f32_16x16x32_bf16(pack_frag(b2, b3), pf, o1[1], 0, 0, 0);
            o1[2] = __builtin_amdgcn_mfma_f32_16x16x32_bf16(pack_frag(b4, b5), pf, o1[2], 0, 0, 0);
            o1[3] = __builtin_amdgcn_mfma_f32_16x16x32_bf16(pack_frag(b6, b7), pf, o1[3], 0, 0, 0);
            o1[4] = __builtin_amdgcn_mfma_f32_16x16x32_bf16(pack_frag(c0, c1), pf, o1[4], 0, 0, 0);
            o1[5] = __builtin_amdgcn_mfma_f32_16x16x32_bf16(pack_frag(c2, c3), pf, o1[5], 0, 0, 0);
            o1[6] = __builtin_amdgcn_mfma_f32_16x16x32_bf16(pack_frag(c4, c5), pf, o1[6], 0, 0, 0);
            o1[7] = __builtin_amdgcn_mfma_f32_16x16x32_bf16(pack_frag(c6, c7), pf, o1[7], 0, 0, 0);
        }
        __builtin_amdgcn_sched_barrier(0);
#pragma unroll
        for (int ks = 0; ks < 4; ++ks) {
#pragma unroll
            for (int et = 0; et < 9; ++et) o2[et] = __builtin_amdgcn_mfma_f32_16x16x32_bf16(*(const LAS bf16x8_t*)(Cl + (16 * et + fr) * RWS + 32 * ks + 8 * fq), qf[ks], o2[et], 0, 0, 0);
            __builtin_amdgcn_sched_barrier(0); }
        float inter, rden = 1.f;
        if (type == 0) { inter = __expf(mc - Mme); const float qn = __shfl(o2[8][0], fr); const float dtot = den + inter * qn; rden = 1.f / fmaxf(fabsf(dtot), __expf(-(bl[l] + Mme))); }
        else inter = __expf(lg * (float)(l + 1));
        const bf16* gp = P + (m0 + l) * NP0 + gcol + 4 * fq;
        float sum = 0.f;
#pragma unroll
        for (int et = 0; et < 8; ++et) { const u32x2 gw = *(const u32x2*)(gp + 16 * et); const float g0 = bflo(gw.x), g1 = bfhi(gw.x), g2 = bflo(gw.y), g3 = bfhi(gw.y);
            f32x4 hv = (o1[et] + o2[et] * inter) * rden;
            if (type == 0) { hv[0] *= sigmoidf_(g0); hv[1] *= sigmoidf_(g1); hv[2] *= sigmoidf_(g2); hv[3] *= sigmoidf_(g3); o2[et] = (f32x4){1.f, 1.f, 1.f, 1.f}; }
            else o2[et] = (f32x4){siluf_(g0), siluf_(g1), siluf_(g2), siluf_(g3)};
            o1[et] = hv; sum += (hv[0] + hv[1]) + (hv[2] + hv[3]); if (et & 1) asm volatile("" ::: "memory"); }
        sum += __shfl_xor(sum, 16); sum += __shfl_xor(sum, 32);
        const float mean = sum * (1.f / 128.f); float sq = 0.f;
#pragma unroll
        for (int et = 0; et < 8; ++et) { o1[et] = o1[et] - mean; sq += (o1[et][0] * o1[et][0] + o1[et][1] * o1[et][1]) + (o1[et][2] * o1[et][2] + o1[et][3] * o1[et][3]); }
        sq += __shfl_xor(sq, 16); sq += __shfl_xor(sq, 32);
        const float rstd = 1.f / sqrtf(sq * (1.f / 128.f) + LN_EPS);
        const float* g6 = F.in[6]; const float* g7 = F.in[7]; asm volatile("" : "+s"(g6), "+s"(g7));
        const float* gain = (type == 0 ? g6 : g7) + h * 128 + 4 * fq;
        bf16* yp = Y + (m0 + l) * 1024 + type * 512 + h * 128 + 4 * fq;
#pragma unroll
        for (int et = 0; et < 8; ++et) { const f32x4 gn = *(const f32x4*)(gain + 16 * et); const f32x4 yv = o1[et] * rstd * gn * o2[et];
            u32x2 wv; wv.x = pg8::cvt_pk_bf16(yv[0], yv[1]); wv.y = pg8::cvt_pk_bf16(yv[2], yv[3]); *(u32x2*)(yp + 16 * et) = wv; if (et & 1) asm volatile("" ::: "memory"); }
    }
}

template <int MODE, bool ROUTE, bool WRITE_XB>
__device__ __forceinline__ void ph_ln(Frame& F, int layer) {
    LAS float* rwT = (LAS float*)F.lds;
    if (ROUTE) { const float* rw = F.in[11]; for (int i = F.tid; i < 32 * 1024; i += NT) { const int e = i >> 10, k = i & 1023; rwT[i] = rw[(size_t)k * 32 + e]; } __syncthreads(); }
    const int gwv = F.vcu * NWAVES + F.wave, NGW = F.G * NWAVES;
    const float* lg = F.in[16] + (size_t)(layer * 2 + MODE) * D; const float* lb = F.in[17] + (size_t)(layer * 2 + MODE) * D;
    bf16* XB = (bf16*)(F.ws + WS_XB); const bf16* YB = (const bf16*)(F.ws + WS_YB);
    int* EIDX = (int*)(F.ws + WS_EIDX); float* GATEV = (float*)(F.ws + WS_GATEV); int* LIST = (int*)(F.ws + WS_LIST);
    unsigned* cnt = F.ctl + CW_CNT + layer * 32 * 64;
    const float* rbias = F.in[12];
    f32x4 gv[4], bv[4];
#pragma unroll
    for (int j = 0; j < 4; ++j) { gv[j] = *((const f32x4*)lg + F.lane + 64 * j); bv[j] = *((const f32x4*)lb + F.lane + 64 * j); }
    for (int m = gwv; m < M; m += NGW) {
        f32x4* orow = (f32x4*)(F.out + (size_t)m * D) + F.lane;
        f32x4 v[4]; float s = 0.f;
#pragma unroll
        for (int j = 0; j < 4; ++j) v[j] = orow[64 * j];
        if (MODE == 1) {
            const float g0 = GATEV[2 * m], g1 = GATEV[2 * m + 1];
            const u32x2* y0 = (const u32x2*)(YB + (size_t)(2 * m) * D) + F.lane; const u32x2* y1 = (const u32x2*)(YB + (size_t)(2 * m + 1) * D) + F.lane;
#pragma unroll
            for (int j = 0; j < 4; ++j) { const u32x2 a = y0[64 * j], b = y1[64 * j];
                v[j].x = ALPHA * v[j].x + g0 * bflo(a.x) + g1 * bflo(b.x); v[j].y = ALPHA * v[j].y + g0 * bfhi(a.x) + g1 * bfhi(b.x);
                v[j].z = ALPHA * v[j].z + g0 * bflo(a.y) + g1 * bflo(b.y); v[j].w = ALPHA * v[j].w + g0 * bfhi(a.y) + g1 * bfhi(b.y); }
        }
#pragma unroll
        for (int j = 0; j < 4; ++j) s += (v[j].x + v[j].y) + (v[j].z + v[j].w);
        const float mean = wave_sum(s) * (1.f / D); float s2 = 0.f;
#pragma unroll
        for (int j = 0; j < 4; ++j) { v[j] = v[j] - mean; s2 += (v[j].x * v[j].x + v[j].y * v[j].y) + (v[j].z * v[j].z + v[j].w * v[j].w); }
        const float rstd = 1.f / sqrtf(wave_sum(s2) * (1.f / D) + LN_EPS);
#pragma unroll
        for (int j = 0; j < 4; ++j) { v[j] = v[j] * rstd * gv[j] + bv[j]; orow[64 * j] = v[j]; }
        if (WRITE_XB) { unsigned long long* o8 = (unsigned long long*)(XB + (size_t)m * D) + F.lane;
#pragma unroll
            for (int j = 0; j < 4; ++j) o8[64 * j] = (unsigned long long)pk2(v[j].x, v[j].y) | ((unsigned long long)pk2(v[j].z, v[j].w) << 32); }
        if (ROUTE) {
            float mylog = 0.f;
#pragma unroll 2
            for (int e = 0; e < 32; ++e) { float a = 0.f;
#pragma unroll
                for (int j = 0; j < 4; ++j) { const f32x4 w = *(const LAS f32x4*)(rwT + e * 1024 + 4 * F.lane + 256 * j); a += v[j].x * w.x + v[j].y * w.y + v[j].z * w.z + v[j].w * w.w; }
                a = wave_sum(a); mylog = (F.lane == e) ? a : mylog; }
            const float myaff = 1.f / (1.f + expf(-mylog)), mysel = myaff + rbias[F.lane & 31];
            float m1 = -1e30f, m2 = -1e30f; int i1 = 0, i2 = 0; float a1 = 0.f, a2 = 0.f;
            const int gbase = F.lane & 24;
#pragma unroll
            for (int j = 0; j < 8; ++j) { const float sv = __shfl(mysel, gbase + j), av = __shfl(myaff, gbase + j);
                if (sv > m1) { m2 = m1; i2 = i1; a2 = a1; m1 = sv; i1 = gbase + j; a1 = av; }
                else if (sv > m2) { m2 = sv; i2 = gbase + j; a2 = av; } }
            const float score = m1 + m2;
            float bestscore = -1e30f; int bg = 0;
#pragma unroll
            for (int g = 0; g < 4; ++g) { const float sg = __shfl(score, 8 * g); if (sg > bestscore) { bestscore = sg; bg = g; } }
            const int bi0 = __shfl(i1, 8 * bg), bi1 = __shfl(i2, 8 * bg); const float ba0 = __shfl(a1, 8 * bg), ba1 = __shfl(a2, 8 * bg);
            if (F.lane == 0) {
                const float inv = 1.f / (ba0 + ba1);
                EIDX[2 * m] = bi0; EIDX[2 * m + 1] = bi1; GATEV[2 * m] = ba0 * inv; GATEV[2 * m + 1] = ba1 * inv;
                const unsigned p0 = __hip_atomic_fetch_add(cnt + bi0 * 64, 1u, RLX_AGENT); LIST[bi0 * M + p0] = 2 * m;
                const unsigned p1 = __hip_atomic_fetch_add(cnt + bi1 * 64, 1u, RLX_AGENT); LIST[bi1 * M + p1] = 2 * m + 1;
            }
        }
    }
}

struct ExpertMap { int cnt[32]; };
__device__ __forceinline__ int moe_find(Frame& F, int layer, int unit_rows, int per_row_tiles, int t, int& e_out, int& mb_out, int& nb_out, int& hb_out, int& cnt_out) {
    const unsigned* cnt = F.ctl + CW_CNT + layer * 32 * 64;
    int base = 0, hb = 0;
    for (int e = 0; e < 32; ++e) {
        const int c = (int)cnt[e * 64]; const int nmb = (c + unit_rows - 1) / unit_rows; const int nt = nmb * per_row_tiles;
        if (t < base + nt) { const int r = t - base; e_out = e; mb_out = r / per_row_tiles; nb_out = r % per_row_tiles; hb_out = hb; cnt_out = c; return 1; }
        base += nt; hb += ((c + 255) >> 8) << 8;
    }
    return 0;
}
__device__ __forceinline__ void ph_moe1_naive(Frame& F, int layer) {
    LAS float* sA = (LAS float*)F.lds; LAS float* sB = sA + 128 * 33;
    const bf16* XB = (const bf16*)(F.ws + WS_XB); bf16* HID = (bf16*)(F.ws + WS_HID); const int* LIST = (const int*)(F.ws + WS_LIST);
    const int tx = F.tid & 15, ty = F.tid >> 4;
    for (int t = blockIdx.x;; t += F.G) {
        int e, mb, nb, hb, c; if (!moe_find(F, layer, 128, 4, t, e, mb, nb, hb, c)) break;
        const bf16* GU = (const bf16*)(F.ws + WS_EW + (size_t)e * EW_STRIDE);
        const int j0 = nb * 64, rg = (j0 >> 7) * 256 + (j0 & 127);
        auto rowA = [&](int r) -> const bf16* { const int i = mb * 128 + r; return i < c ? XB + (size_t)(LIST[e * M + i] >> 1) * D : (const bf16*)nullptr; };
        float ag[4][4], au[4][4];
        ngemm_tile(sA, sB, rowA, GU + (size_t)rg * D, D, D, ag);
        ngemm_tile(sA, sB, rowA, GU + (size_t)(rg + 128) * D, D, D, au);
#pragma unroll
        for (int i = 0; i < 4; ++i) { const int ri = mb * 128 + ty * 4 + i;
            if (ri < c) { u32x2 o; o.x = pk2(siluf_(ag[i][0]) * au[i][0], siluf_(ag[i][1]) * au[i][1]); o.y = pk2(siluf_(ag[i][2]) * au[i][2], siluf_(ag[i][3]) * au[i][3]);
                *(u32x2*)(HID + (size_t)(hb + ri) * DE + j0 + tx * 4) = o; } }
    }
}
__device__ __forceinline__ void ph_moe2_naive(Frame& F, int layer) {
    LAS float* sA = (LAS float*)F.lds; LAS float* sB = sA + 128 * 33;
    const bf16* HID = (const bf16*)(F.ws + WS_HID); bf16* YB = (bf16*)(F.ws + WS_YB); const int* LIST = (const int*)(F.ws + WS_LIST);
    const int tx = F.tid & 15, ty = F.tid >> 4;
    for (int t = blockIdx.x;; t += F.G) {
        int e, mb, nb, hb, c; if (!moe_find(F, layer, 128, 16, t, e, mb, nb, hb, c)) break;
        const bf16* DN = (const bf16*)(F.ws + WS_EW + (size_t)e * EW_STRIDE + EW_DN);
        auto rowA = [&](int r) -> const bf16* { const int i = mb * 128 + r; return i < c ? HID + (size_t)(hb + i) * DE : (const bf16*)nullptr; };
        float acc[4][4];
        ngemm_tile(sA, sB, rowA, DN + (size_t)(nb * 64) * DE, DE, DE, acc);
#pragma unroll
        for (int i = 0; i < 4; ++i) { const int ri = mb * 128 + ty * 4 + i;
            if (ri < c) { const int a = LIST[e * M + ri]; u32x2 o; o.x = pk2(acc[i][0], acc[i][1]); o.y = pk2(acc[i][2], acc[i][3]);
                *(u32x2*)(YB + (size_t)a * D + nb * 64 + tx * 4) = o; } }
    }
}

__device__ __forceinline__ void ph_attn_naive(Frame& F) {
    const bf16* P = (const bf16*)(F.ws + WS_P); bf16* OG = (bf16*)(F.ws + WS_OG); float* LSE = (float*)(F.ws + WS_LSE);
    const int total = 3 * M * 8, nth = F.G * NT;
    for (int idx = blockIdx.x * NT + F.tid; idx < total; idx += nth) {
        const int h = idx & 7, m = (idx >> 3) & (M - 1), g = idx >> 17;
        const int t = m & (T - 1), dil = (g == 0) ? 1 : (g == 1 ? 4 : 16);
        const float slope = exp2f(-(float)(h + 1));
        const bf16* qp = P + (size_t)m * IN1 + g * 1536 + h * 64;
        float q[64], o[64];
#pragma unroll
        for (int c = 0; c < 8; ++c) { const u32x4 w = *(const u32x4*)(qp + 8 * c);
            q[8 * c + 0] = bflo(w.x); q[8 * c + 1] = bfhi(w.x); q[8 * c + 2] = bflo(w.y); q[8 * c + 3] = bfhi(w.y); q[8 * c + 4] = bflo(w.z); q[8 * c + 5] = bfhi(w.z); q[8 * c + 6] = bflo(w.w); q[8 * c + 7] = bfhi(w.w); }
#pragma unroll
        for (int d = 0; d < 64; ++d) o[d] = 0.f;
        float mx = -1e30f, den = 0.f;
        for (int j = 0; j <= 128; ++j) {
            const int tk = t - j * dil; if (tk < 0) break;
            const bf16* kp = P + (size_t)(m - j * dil) * IN1 + g * 1536 + 512 + h * 64; const bf16* vp = kp + 512;
            float s = 0.f;
#pragma unroll
            for (int c = 0; c < 8; ++c) { const u32x4 w = *(const u32x4*)(kp + 8 * c);
                s += q[8 * c + 0] * bflo(w.x) + q[8 * c + 1] * bfhi(w.x) + q[8 * c + 2] * bflo(w.y) + q[8 * c + 3] * bfhi(w.y) + q[8 * c + 4] * bflo(w.z) + q[8 * c + 5] * bfhi(w.z) + q[8 * c + 6] * bflo(w.w) + q[8 * c + 7] * bfhi(w.w); }
            s = s * 0.125f - slope * (float)(j * dil);
            const float mn = fmaxf(mx, s), corr = __expf(mx - mn), p = __expf(s - mn);
            den = den * corr + p; mx = mn;
#pragma unroll
            for (int c = 0; c < 8; ++c) { const u32x4 w = *(const u32x4*)(vp + 8 * c);
                o[8 * c + 0] = o[8 * c + 0] * corr + p * bflo(w.x); o[8 * c + 1] = o[8 * c + 1] * corr + p * bfhi(w.x); o[8 * c + 2] = o[8 * c + 2] * corr + p * bflo(w.y); o[8 * c + 3] = o[8 * c + 3] * corr + p * bfhi(w.y);
                o[8 * c + 4] = o[8 * c + 4] * corr + p * bflo(w.z); o[8 * c + 5] = o[8 * c + 5] * corr + p * bfhi(w.z); o[8 * c + 6] = o[8 * c + 6] * corr + p * bflo(w.w); o[8 * c + 7] = o[8 * c + 7] * corr + p * bfhi(w.w); }
        }
        const float inv = 1.f / den;
        bf16* op = OG + ((size_t)g * M + m) * 512 + h * 64;
#pragma unroll
        for (int c = 0; c < 8; ++c) { u32x4 w; w.x = pk2(o[8 * c + 0] * inv, o[8 * c + 1] * inv); w.y = pk2(o[8 * c + 2] * inv, o[8 * c + 3] * inv); w.z = pk2(o[8 * c + 4] * inv, o[8 * c + 5] * inv); w.w = pk2(o[8 * c + 6] * inv, o[8 * c + 7] * inv);
            *(u32x4*)(op + 8 * c) = w; }
        LSE[((size_t)g * M + m) * 8 + h] = mx + __logf(den);
    }
}
__device__ __forceinline__ void ph_attn_mfma(Frame& F) {
    const bf16* P = (const bf16*)(F.ws + WS_P); bf16* OG = (bf16*)(F.ws + WS_OG); float* LSE = (float*)(F.ws + WS_LSE);
    LAS bf16* Vl = (LAS bf16*)F.lds;
    const int tid = F.tid, lane = F.lane, w = F.wave, fr = lane & 15, fq = lane >> 4;
    const int ct0 = 2 * (w >> 1);
    const unsigned vaddr0 = (unsigned)(size_t)(F.lds) + (unsigned)(((16 * ct0 + 4 * fq + (fr >> 2)) * 72 + 4 * (fr & 3)) * 2);
    for (int u = blockIdx.x; u < 3072; u += F.G) {
        const int g = u >> 10, rem = u & 1023, b = rem >> 9, h = (rem >> 6) & 7, x = rem & 63;
        const int dil = (g == 0) ? 1 : (g == 1 ? 4 : 16), nnb = 64 / dil, nb = x % nnb, r = x / nnb;
        const long rowbase = (long)b * T + (long)nb * 128 * dil + r;
        const bf16* Qp = P + g * 1536 + h * 64; const bf16* Kp = Qp + 512; const bf16* Vp = Qp + 1024;
        const float sl = exp2f(-(float)(h + 1)) * (float)dil;
        __syncthreads();
#pragma unroll
        for (int it = 0; it < 4; ++it) { const int kr = (tid >> 3) + 64 * it, ch = tid & 7; u32x4 v = (u32x4){0u, 0u, 0u, 0u};
            if (nb > 0 || kr >= 128) v = *(const u32x4*)(Vp + (size_t)(rowbase + (long)(kr - 128) * dil) * IN1 + ch * 8);
            *(LAS u32x4*)(Vl + kr * 72 + ch * 8) = v; }
        bf16x8_t qf[2];
        { const bf16* qrow = Qp + (size_t)(rowbase + (long)(16 * w + fr) * dil) * IN1 + 8 * fq; qf[0] = *(const bf16x8_t*)qrow; qf[1] = *(const bf16x8_t*)(qrow + 32); }
        f32x4 s[10];
#pragma unroll
        for (int c = 0; c < 10; ++c) { const int kr = 16 * (ct0 + c) + fr; bf16x8_t k0 = (bf16x8_t){0, 0, 0, 0, 0, 0, 0, 0}, k1 = k0;
            if (nb > 0 || kr >= 128) { const bf16* krow = Kp + (size_t)(rowbase + (long)(kr - 128) * dil) * IN1 + 8 * fq; k0 = *(const bf16x8_t*)krow; k1 = *(const bf16x8_t*)(krow + 32); }
            s[c] = __builtin_amdgcn_mfma_f32_16x16x32_bf16(k0, qf[0], (f32x4){0.f, 0.f, 0.f, 0.f}, 0, 0, 0);
            s[c] = __builtin_amdgcn_mfma_f32_16x16x32_bf16(k1, qf[1], s[c], 0, 0, 0); }
        const int l = 16 * w + fr;
        float mx = -1e30f;
#pragma unroll
        for (int c = 0; c < 10; ++c)
#pragma unroll
            for (int rg = 0; rg < 4; ++rg) { const int kr = 16 * (ct0 + c) + 4 * fq + rg, steps = l + 128 - kr;
                const bool ok = steps >= 0 && steps <= 128 && (nb > 0 || kr >= 128);
                const float v = ok ? s[c][rg] * 0.125f - sl * (float)steps : -1e30f; s[c][rg] = v; mx = fmaxf(mx, v); }
        mx = fmaxf(mx, __shfl_xor(mx, 16)); mx = fmaxf(mx, __shfl_xor(mx, 32));
        float den = 0.f;
#pragma unroll
        for (int c = 0; c < 10; ++c)
#pragma unroll
            for (int rg = 0; rg < 4; ++rg) { const float p = (s[c][rg] > -1e29f) ? __expf(s[c][rg] - mx) : 0.f; s[c][rg] = p; den += p; }
        den += __shfl_xor(den, 16); den += __shfl_xor(den, 32);
        bf16x8_t pf[5];
#pragma unroll
        for (int k = 0; k < 5; ++k) { u32x4 wv; wv.x = pg8::cvt_pk_bf16(s[2 * k][0], s[2 * k][1]); wv.y = pg8::cvt_pk_bf16(s[2 * k][2], s[2 * k][3]);
            wv.z = pg8::cvt_pk_bf16(s[2 * k + 1][0], s[2 * k + 1][1]); wv.w = pg8::cvt_pk_bf16(s[2 * k + 1][2], s[2 * k + 1][3]); pf[k] = __builtin_bit_cast(bf16x8_t, wv); }
        __syncthreads();
        f32x4 o[4];
#pragma unroll
        for (int dt = 0; dt < 4; ++dt) o[dt] = (f32x4){0.f, 0.f, 0.f, 0.f};
#pragma unroll
        for (int k = 0; k < 5; ++k) {
            u32x2 a0, a1, a2, a3, a4, a5, a6, a7; const unsigned va = vaddr0 + (unsigned)(k * 32 * 72 * 2);
            asm volatile("ds_read_b64_tr_b16 %0, %8\n\tds_read_b64_tr_b16 %1, %8 offset:2304\n\tds_read_b64_tr_b16 %2, %8 offset:32\n\tds_read_b64_tr_b16 %3, %8 offset:2336\n\t"
                         "ds_read_b64_tr_b16 %4, %8 offset:64\n\tds_read_b64_tr_b16 %5, %8 offset:2368\n\tds_read_b64_tr_b16 %6, %8 offset:96\n\tds_read_b64_tr_b16 %7, %8 offset:2400\n\ts_waitcnt lgkmcnt(0)"
                         : "=&v"(a0), "=&v"(a1), "=&v"(a2), "=&v"(a3), "=&v"(a4), "=&v"(a5), "=&v"(a6), "=&v"(a7) : "v"(va) : "memory");
            __builtin_amdgcn_sched_barrier(0);
            o[0] = __builtin_amdgcn_mfma_f32_16x16x32_bf16(__builtin_bit_cast(bf16x8_t, (u32x4){a0.x, a0.y, a1.x, a1.y}), pf[k], o[0], 0, 0, 0);
            o[1] = __builtin_amdgcn_mfma_f32_16x16x32_bf16(__builtin_bit_cast(bf16x8_t, (u32x4){a2.x, a2.y, a3.x, a3.y}), pf[k], o[1], 0, 0, 0);
            o[2] = __builtin_amdgcn_mfma_f32_16x16x32_bf16(__builtin_bit_cast(bf16x8_t, (u32x4){a4.x, a4.y, a5.x, a5.y}), pf[k], o[2], 0, 0, 0);
            o[3] = __builtin_amdgcn_mfma_f32_16x16x32_bf16(__builtin_bit_cast(bf16x8_t, (u32x4){a6.x, a6.y, a7.x, a7.y}), pf[k], o[3], 0, 0, 0);
        }
        const float inv = 1.f / den; const size_t tok = (size_t)(rowbase + (long)l * dil);
        bf16* op = OG + ((size_t)g * M + tok) * 512 + h * 64 + 4 * fq;
#pragma unroll
        for (int dt = 0; dt < 4; ++dt) { u32x2 wv; wv.x = pg8::cvt_pk_bf16(o[dt][0] * inv, o[dt][1] * inv); wv.y = pg8::cvt_pk_bf16(o[dt][2] * inv, o[dt][3] * inv); *(u32x2*)(op + 16 * dt) = wv; }
        if (fq == 0) LSE[((size_t)g * M + tok) * 8 + h] = mx + __logf(den);
    }
}

__device__ __forceinline__ void ph_merge(Frame& F) {
    const bf16* OG = (const bf16*)(F.ws + WS_OG); const float* LSE = (const float*)(F.ws + WS_LSE); bf16* Y2 = (bf16*)(F.ws + WS_Y2);
    const int total = M * 64, nth = F.G * NT;
    for (int idx = blockIdx.x * NT + F.tid; idx < total; idx += nth) {
        const int m = idx >> 6, c8 = idx & 63, h = c8 >> 3;
        const float l0 = LSE[((size_t)0 * M + m) * 8 + h], l1 = LSE[((size_t)1 * M + m) * 8 + h], l2 = LSE[((size_t)2 * M + m) * 8 + h];
        const float mx = fmaxf(l0, fmaxf(l1, l2)); float w0 = __expf(l0 - mx), w1 = __expf(l1 - mx), w2 = __expf(l2 - mx); const float inv = 1.f / (w0 + w1 + w2);
        w0 *= inv; w1 *= inv; w2 *= inv;
        const u32x4 a = *(const u32x4*)(OG + ((size_t)0 * M + m) * 512 + c8 * 8), b = *(const u32x4*)(OG + ((size_t)1 * M + m) * 512 + c8 * 8), c = *(const u32x4*)(OG + ((size_t)2 * M + m) * 512 + c8 * 8);
        u32x4 o;
        o.x = pk2(w0 * bflo(a.x) + w1 * bflo(b.x) + w2 * bflo(c.x), w0 * bfhi(a.x) + w1 * bfhi(b.x) + w2 * bfhi(c.x));
        o.y = pk2(w0 * bflo(a.y) + w1 * bflo(b.y) + w2 * bflo(c.y), w0 * bfhi(a.y) + w1 * bfhi(b.y) + w2 * bfhi(c.y));
        o.z = pk2(w0 * bflo(a.z) + w1 * bflo(b.z) + w2 * bflo(c.z), w0 * bfhi(a.z) + w1 * bfhi(b.z) + w2 * bfhi(c.z));
        o.w = pk2(w0 * bflo(a.w) + w1 * bflo(b.w) + w2 * bflo(c.w), w0 * bfhi(a.w) + w1 * bfhi(b.w) + w2 * bfhi(c.w));
        *(u32x4*)(Y2 + (size_t)m * 512 + c8 * 8) = o;
    }
}

struct Args { const float* in[18]; float* out; unsigned char* ws; int ph_lo, ph_hi, li, pad; };
__global__ void __launch_bounds__(NT, 2) mega_fwd(Args args) {
    extern __shared__ __attribute__((aligned(16))) unsigned char lds_raw[];
    Frame F;
    F.lds = (LAS unsigned char*)lds_raw;
    F.tid = threadIdx.x; F.lane = F.tid & 63; F.wave = __builtin_amdgcn_readfirstlane(F.tid >> 6);
    F.G = gridDim.x; { const int bx = blockIdx.x; F.vcu = (F.G % 8 == 0) ? (bx % 8) * (F.G / 8) + bx / 8 : bx; }
#pragma unroll
    for (int i = 0; i < 18; ++i) F.in[i] = args.in[i];
    F.out = args.out; F.ws = args.ws; F.ctl = (unsigned*)(args.ws + WS_CTL);
    volatile LAS unsigned* MISC = (volatile LAS unsigned*)(F.lds + LDS_BYTES - 128);
    if (F.tid < 32) MISC[F.tid] = 0u;
    __syncthreads();
    XcdBarrier bar; bar.bar = F.ctl + CW_BAR; bar.x = 0; bar.st = nullptr;
    if (MK_N_LAUNCHES == 1) bar = xcd_barrier_post(F.ctl + CW_BAR, MISC + 8);
    const int lo = args.ph_lo, hi = args.ph_hi;
#define IN(k) (lo <= (k) && (k) < hi)
#define SEAM(k) do { if (IN(k) && IN((k) + 1)) xcd_barrier(bar); } while (0)
    if (IN(0)) { ph0_convert(F); } SEAM(0);
    if (IN(1)) { pg8::StaticOrder S; S.init(F.ws + WS_XB, F.ws + WS_WT0, M, NP0, D, F.G, (int)blockIdx.x); pg8::EpiBf16 E{(bf16*)(F.ws + WS_P), NP0};
        pg8::gemm_phase<pg8::EpiBf16, pg8::StaticOrder, true, false>(F.lds, D, S, E); } SEAM(1);
    if (IN(2)) { ph_mix_a(F); xcd_barrier(bar); ph_mix_b(F); } SEAM(2);
    if (IN(3)) { ph_mix_c(F); } SEAM(3);
    if (IN(4)) { pg8::StaticOrder S; S.init(F.ws + WS_Y, F.ws + WS_WO0, M, D, D, F.G, (int)blockIdx.x); pg8::EpiResF32 E{F.in[0], F.out, ALPHA};
        pg8::gemm_phase<pg8::EpiResF32, pg8::StaticOrder, false, false>(F.lds, D, S, E); } SEAM(4);
    if (IN(5)) { convert_experts(F, 0); __syncthreads(); ph_ln<0, true, true>(F, 0); } SEAM(5);
    if (IN(6)) { pg8::MoeOrder S{F.ctl + CW_CNT + 0 * 32 * 64, (const int*)(F.ws + WS_LIST), (const char*)(F.ws + WS_XB), (const char*)(F.ws + WS_EW), 2, F.G, (int)blockIdx.x, D, 0};
        pg8::EpiSwiGLU E{(bf16*)(F.ws + WS_HID)}; pg8::gemm_phase<pg8::EpiSwiGLU, pg8::MoeOrder, true, true>(F.lds, D, S, E); } SEAM(6);
    if (IN(7)) { pg8::MoeOrder S{F.ctl + CW_CNT + 0 * 32 * 64, (const int*)(F.ws + WS_LIST), (const char*)(F.ws + WS_HID), (const char*)(F.ws + WS_EW + EW_DN), 4, F.G, (int)blockIdx.x, DE, 1};
        pg8::EpiMoeOut E{(bf16*)(F.ws + WS_YB), (const int*)(F.ws + WS_LIST)}; pg8::gemm_phase<pg8::EpiMoeOut, pg8::MoeOrder, true, false>(F.lds, DE, S, E); } SEAM(7);
    if (IN(8)) { ph_ln<1, false, true>(F, 0); __syncthreads(); convert_experts(F, 1); } SEAM(8);
    if (IN(9)) { pg8::StaticOrder S; S.init(F.ws + WS_XB, F.ws + WS_WT1, M, IN1, D, F.G, (int)blockIdx.x); pg8::EpiBf16 E{(bf16*)(F.ws + WS_P), IN1};
        pg8::gemm_phase<pg8::EpiBf16, pg8::StaticOrder, true, false>(F.lds, D, S, E); } SEAM(9);
    if (IN(10)) { ph_attn_mfma(F); } SEAM(10);
    if (IN(11)) { ph_merge(F); } SEAM(11);
    if (IN(12)) { pg8::StaticOrder S; S.init(F.ws + WS_Y2, F.ws + WS_WO1, M, D, 512, F.G, (int)blockIdx.x); pg8::EpiResF32 E{F.out, F.out, ALPHA};
        pg8::gemm_phase<pg8::EpiResF32, pg8::StaticOrder, false, false>(F.lds, 512, S, E); } SEAM(12);
    if (IN(13)) { ph_ln<0, true, true>(F, 1); } SEAM(13);
    if (IN(14)) { pg8::MoeOrder S{F.ctl + CW_CNT + 1 * 32 * 64, (const int*)(F.ws + WS_LIST), (const char*)(F.ws + WS_XB), (const char*)(F.ws + WS_EW), 2, F.G, (int)blockIdx.x, D, 0};
        pg8::EpiSwiGLU E{(bf16*)(F.ws + WS_HID)}; pg8::gemm_phase<pg8::EpiSwiGLU, pg8::MoeOrder, true, true>(F.lds, D, S, E); } SEAM(14);
    if (IN(15)) { pg8::MoeOrder S{F.ctl + CW_CNT + 1 * 32 * 64, (const int*)(F.ws + WS_LIST), (const char*)(F.ws + WS_HID), (const char*)(F.ws + WS_EW + EW_DN), 4, F.G, (int)blockIdx.x, DE, 1};
        pg8::EpiMoeOut E{(bf16*)(F.ws + WS_YB), (const int*)(F.ws + WS_LIST)}; pg8::gemm_phase<pg8::EpiMoeOut, pg8::MoeOrder, true, false>(F.lds, DE, S, E); } SEAM(15);
    if (IN(16)) { ph_ln<1, false, false>(F, 1); }
#undef IN
#undef SEAM
}

extern "C" void kernel_launch(void* const* d_in, const int* in_sizes, int n_in, void* d_out, int out_size, void* d_ws, size_t ws_size, hipStream_t stream) {
    static int grid = 0;
    if (grid == 0) {
        if (n_in != 18 || in_sizes[0] != M * D || out_size != M * D || ws_size < WS_END) {
            fprintf(stderr, "kernel_launch: unexpected problem (n_in %d, in0 %d, out %d, ws %zu < %zu)\n", n_in, n_in > 0 ? in_sizes[0] : -1, out_size, ws_size, (size_t)WS_END); grid = -1; return; }
        int dev = 0, cus = 0;
        if (hipGetDevice(&dev) != hipSuccess || hipDeviceGetAttribute(&cus, hipDeviceAttributeMultiprocessorCount, dev) != hipSuccess) { grid = -1; return; }
        if (hipFuncSetAttribute((const void*)mega_fwd, hipFuncAttributeMaxDynamicSharedMemorySize, LDS_BYTES) != hipSuccess) { fprintf(stderr, "kernel_launch: hipFuncSetAttribute failed\n"); grid = -1; return; }
        int per_cu = 0;
        if (hipOccupancyMaxActiveBlocksPerMultiprocessor(&per_cu, (const void*)mega_fwd, NT, LDS_BYTES) != hipSuccess || per_cu < 1) fprintf(stderr, "kernel_launch: occupancy query says %d\n", per_cu);
        (void)hipGetLastError();
        grid = cus;
    }
    if (grid < 0) return;
    (void)hipMemsetAsync((char*)d_ws + WS_CTL, 0, CTL_ZERO_BYTES, stream);
    Args a{};
    for (int i = 0; i < 18; ++i) a.in[i] = (const float*)d_in[i];
    a.out = (float*)d_out; a.ws = (unsigned char*)d_ws;
    if (MK_N_LAUNCHES == 1) {
        a.ph_lo = 0; a.ph_hi = N_PHASES; a.li = 0;
        hipLaunchKernelGGL(mega_fwd, dim3(grid), dim3(NT), LDS_BYTES, stream, a);
    } else {
        for (int p = 0; p < N_PHASES; ++p) { a.ph_lo = p; a.ph_hi = p + 1; a.li = p; hipLaunchKernelGGL(mega_fwd, dim3(grid), dim3(NT), LDS_BYTES, stream, a); }
    }
}
```

```cpp
#include <hip/hip_runtime.h>
#include <cstdio>
#include <cstdint>

#ifndef PROBE_DUP
#define PROBE_DUP 0
#endif
#ifndef MK_N_LAUNCHES
#define MK_N_LAUNCHES 1
#endif

#define LAS __attribute__((address_space(3)))
typedef unsigned short bf16;
typedef float f32x4 __attribute__((ext_vector_type(4)));
typedef unsigned u32x4 __attribute__((ext_vector_type(4)));
typedef unsigned u32x2 __attribute__((ext_vector_type(2)));
typedef short bf16x8_t __attribute__((ext_vector_type(8)));
#define RLX_AGENT __ATOMIC_RELAXED, __HIP_MEMORY_SCOPE_AGENT
#define LDS_WAIT() asm volatile("s_waitcnt lgkmcnt(0)" ::: "memory")
#define VM_WAIT() asm volatile("s_waitcnt vmcnt(0)" ::: "memory")

constexpr int NWAVES = 8, NT = NWAVES * 64;
constexpr int BATCH = 2, T = 8192, D = 1024, M = BATCH * T;
constexpr int IN0 = 4104, IN1 = 4608, NP0 = 4096;
constexpr int NE = 32, DE = 256;
constexpr float ALPHA = 1.41421356237309515f;
constexpr float LN_EPS = 1e-5f;
constexpr float KSCALE = 0.08838834764831845f;
constexpr int N_PHASES = 17;

constexpr size_t MiB = 1u << 20;
constexpr size_t WS_CTL = 0, CTL_ZERO_BYTES = 1 * MiB;
constexpr size_t WS_G = 1 * MiB;
constexpr size_t WS_EIDX = WS_G + 512 * 1024;
constexpr size_t WS_GATEV = WS_EIDX + 128 * 1024;
constexpr size_t WS_WT0 = 2 * MiB;
constexpr size_t WS_WO0 = 10 * MiB;
constexpr size_t WS_WT1 = 12 * MiB;
constexpr size_t WS_WO1 = 21 * MiB;
constexpr size_t WS_SE = 22 * MiB;
constexpr size_t WS_EW = WS_SE;
constexpr size_t EW_STRIDE = 3 * MiB / 2, EW_DN = 1 * MiB;
constexpr size_t WS_LIST = WS_SE + 48 * MiB;
constexpr size_t WS_LSE = WS_SE + 50 * MiB;
constexpr size_t WS_XB = 86 * MiB;
constexpr size_t WS_Y = 118 * MiB;
constexpr size_t WS_OG = WS_XB;
constexpr size_t WS_Y2 = WS_XB + 48 * MiB;
constexpr size_t WS_P = 150 * MiB;
constexpr size_t WS_YB = WS_P;
constexpr size_t WS_HID = WS_P + 64 * MiB;
constexpr size_t WS_END = 294 * MiB;
constexpr size_t WS_QKC = WS_SE;

constexpr int CW_BAR = 4096;
constexpr int CW_CNT = 16384;

constexpr int LDS_BYTES = 147456;

__device__ __forceinline__ unsigned f2bf(float f) { unsigned u = __builtin_bit_cast(unsigned, f); return (u + 0x7fffu + ((u >> 16) & 1u)) >> 16; }
__device__ __forceinline__ unsigned pk2(float lo, float hi) { return f2bf(lo) | (f2bf(hi) << 16); }
__device__ __forceinline__ float bf2f(unsigned b) { return __builtin_bit_cast(float, b << 16); }
__device__ __forceinline__ float bflo(unsigned w) { return __builtin_bit_cast(float, w << 16); }
__device__ __forceinline__ float bfhi(unsigned w) { return __builtin_bit_cast(float, w & 0xffff0000u); }
__device__ __forceinline__ float wave_sum(float v) {
#pragma unroll
    for (int o = 1; o < 64; o <<= 1) v += __shfl_xor(v, o);
    return v;
}
__device__ __forceinline__ float sigmoidf_(float x) { return 1.f / (1.f + __expf(-x)); }
__device__ __forceinline__ float siluf_(float x) { return x / (1.f + __expf(-x)); }

#define XB_TMO      128
#define XB_XCNT(j)  (256  + 64 * (j))
#define XB_XSUB(j)  (1280 + 64 * (j))
#define XB_XGEN(j)  (2304 + 64 * (j))
#define XB_TOP      3328
#define XB_TOPGEN   3392
#define XCD_BAR_WORDS 3456
#define XB_SPIN_CAP (1u << 22)
__device__ __forceinline__ unsigned xb_ld(unsigned* p)              { return __hip_atomic_load(p, __ATOMIC_RELAXED, __HIP_MEMORY_SCOPE_AGENT); }
__device__ __forceinline__ unsigned xb_add(unsigned* p, unsigned v) { return __hip_atomic_fetch_add(p, v, __ATOMIC_RELAXED, __HIP_MEMORY_SCOPE_AGENT); }
__device__ __forceinline__ unsigned xb_xcc_id() { return (unsigned)__builtin_amdgcn_s_getreg((3 << 11) | 20) & 0xFu; }
#define XB_SPIN(cond, bar) do { unsigned _sp = 0; while (cond) { __builtin_amdgcn_s_sleep(1); \
    if ((++_sp & 255u) == 0u) { if (xb_ld(&(bar)[XB_TMO])) break; if (_sp > XB_SPIN_CAP) { atomicAdd(&(bar)[XB_TMO], 1u); break; } } } } while (0)
struct XcdBarrier { unsigned* bar; unsigned x; volatile LAS unsigned* st; };
__device__ __forceinline__ XcdBarrier xcd_barrier_post(unsigned* bar, volatile LAS unsigned* st) {
    XcdBarrier b; b.bar = bar; b.x = xb_xcc_id(); b.st = st;
    if (threadIdx.x == 0) (void)xb_add(&bar[XB_XCNT(b.x)], 1u);
    return b;
}
__device__ __forceinline__ void xcd_barrier_complete(unsigned* bar, unsigned x, unsigned& nloc, unsigned& nx) {
    const unsigned G = gridDim.x * gridDim.y * gridDim.z;
    unsigned sum, cnt, mine, sp = 0u;
    for (;;) {
        sum = 0u; cnt = 0u; mine = 0u;
#pragma unroll
        for (unsigned j = 0; j < 16; ++j) { const unsigned c = xb_ld(&bar[XB_XCNT(j)]); sum += c; cnt += (c > 0u) ? 1u : 0u; mine = (j == x) ? c : mine; }
        if (sum == G) break;
        __builtin_amdgcn_s_sleep(1);
        if ((++sp & 255u) == 0u) { if (xb_ld(&bar[XB_TMO])) break; if (sp > XB_SPIN_CAP) { atomicAdd(&bar[XB_TMO], 1u); break; } }
    }
    nloc = mine > 0u ? mine : 1u; nx = cnt > 0u ? cnt : 1u;
}
__device__ __forceinline__ void xcd_barrier(const XcdBarrier& b) {
    asm volatile("s_waitcnt vmcnt(0)" ::: "memory");
    __syncthreads();
    if (threadIdx.x == 0) {
        unsigned* bar = b.bar;
        __builtin_amdgcn_s_waitcnt(0);
        unsigned nloc = b.st[0], nx = b.st[1];
        if (nloc == 0u) { xcd_barrier_complete(bar, b.x, nloc, nx); b.st[0] = nloc; b.st[1] = nx; }
        const unsigned old = xb_add(&bar[XB_XSUB(b.x)], 1u);
        const unsigned gen = old / nloc;
        if (old + 1u == (gen + 1u) * nloc) {
            __builtin_amdgcn_fence(__ATOMIC_RELEASE, "agent");
            asm volatile("s_waitcnt vmcnt(0)" ::: "memory");
            const unsigned og = xb_add(&bar[XB_TOP], 1u);
            const unsigned tg = og / nx;
            if (og + 1u == (tg + 1u) * nx) xb_add(&bar[XB_TOPGEN], 1u);
            else XB_SPIN(xb_ld(&bar[XB_TOPGEN]) == tg, bar);
            __builtin_amdgcn_fence(__ATOMIC_ACQUIRE, "agent");
            xb_add(&bar[XB_XGEN(b.x)], 1u);
            asm volatile("s_waitcnt vmcnt(0)" ::: "memory");
        } else {
            XB_SPIN(xb_ld(&bar[XB_XGEN(b.x)]) == gen, bar);
            __builtin_amdgcn_fence(__ATOMIC_ACQUIRE, "agent");
            asm volatile("s_waitcnt vmcnt(0)" ::: "memory");
        }
    }
    __syncthreads();
}

struct Frame {
    LAS unsigned char* lds;
    unsigned* ctl;
    int tid, lane, wave, vcu, G;
    const float* in[18];
    float* out;
    unsigned char* ws;
};

namespace pg8 {
typedef short bf16x8 __attribute__((ext_vector_type(8)));
constexpr int BM = 256, BK = 64, HALF = 128, HTB = HALF * BK * 2, STAGE_BYTES = 8 * HTB, NXCD = 8, WGM = 8;
__host__ __device__ __forceinline__ int lds_byte(int r, int c) { const int st = (r >> 4) * 2 + (c >> 5), rr = r & 15, cc = c & 31, ob = rr * 64 + cc * 2; return st * 1024 + (ob ^ (((ob >> 9) & 1) << 5)); }
__host__ __device__ __forceinline__ void stage_rc(int b, int& R, int& C) { const int st = b / 1024, sb = b % 1024, swz = sb ^ (((sb >> 9) & 1) << 5); R = (st >> 1) * 16 + swz / 64; C = (st & 1) * 32 + (swz % 64) / 2; }
__host__ __device__ __forceinline__ int perm32(int rho) { const int n = rho >> 4, i = rho & 15; return 8 * (i >> 2) + 4 * n + (i & 3); }
struct Unit { int pm, pn, e, cnt, hb; };
__device__ __forceinline__ unsigned cvt_pk_bf16(float lo, float hi) { unsigned r; asm volatile("v_cvt_pk_bf16_f32 %0, %1, %2" : "=v"(r) : "v"(lo), "v"(hi)); return r; }

struct StaticOrder {
    int nM, nN, nwg, G, c, K; const char* A; const char* Bt;
    __device__ void init(const void* A_, const void* Bt_, int M_, int N_, int K_, int G_, int c_) { A = (const char*)A_; Bt = (const char*)Bt_; nM = M_ / BM; nN = N_ / BM; nwg = nM * nN; G = G_; c = c_; K = K_; }
    __device__ bool next(int i, Unit& u) const {
        const long L = (long)i * G + c; if (L >= nwg) return false;
        int wgid = (int)L; { const int q = nwg / NXCD, r = nwg % NXCD, xcd = wgid % NXCD, off = wgid / NXCD; wgid = (xcd < r ? xcd * (q + 1) : r * (q + 1) + (xcd - r) * q) + off; }
        const int nig = WGM * nN, gid = wgid / nig, fm = gid * WGM, gsz = (nM - fm) < WGM ? (nM - fm) : WGM;
        u.pm = fm + ((wgid % nig) % gsz); u.pn = (wgid % nig) / gsz; u.e = 0; u.cnt = 0; u.hb = 0; return true;
    }
    __device__ __forceinline__ void base(const Unit& u, const char*& cA, const char*& cB) const { cA = A + (size_t)u.pm * BM * K * 2; cB = Bt + (size_t)u.pn * BM * K * 2; }
    __device__ __forceinline__ unsigned rowoff(const Unit&, int) const { return 0u; }
};

struct EpiBf16 {
    static constexpr bool PERM = true;
    bf16* O; int ldc;
    __device__ __forceinline__ void operator()(const f32x4 (&acc)[2][2][4][2], const Unit& u, int wr, int wc, int fr, int fq) const {
        const int row0 = u.pm * BM + wr * 64 + fr, col0 = u.pn * BM + wc * 32 + 8 * fq;
#pragma unroll
        for (int ai = 0; ai < 2; ++ai)
#pragma unroll
            for (int m = 0; m < 4; ++m) { bf16* rowp = O + (size_t)(row0 + ai * HALF + m * 16) * ldc + col0;
#pragma unroll
                for (int bj = 0; bj < 2; ++bj) { const f32x4 v0 = acc[ai][bj][m][0], v1 = acc[ai][bj][m][1];
                    u32x4 w; w.x = cvt_pk_bf16(v0[0], v0[1]); w.y = cvt_pk_bf16(v0[2], v0[3]); w.z = cvt_pk_bf16(v1[0], v1[1]); w.w = cvt_pk_bf16(v1[2], v1[3]);
                    *(u32x4*)(rowp + bj * HALF) = w; } }
    }
};
template <bool BASE_BF16>
struct EpiResBf16 {
    static constexpr bool PERM = true;
    const void* base; bf16* out; float alpha;
    __device__ __forceinline__ void operator()(const f32x4 (&acc)[2][2][4][2], const Unit& u, int wr, int wc, int fr, int fq) const {
        const int col0 = u.pn * BM + wc * 32 + 8 * fq;
#pragma unroll
        for (int ai = 0; ai < 2; ++ai)
#pragma unroll
            for (int m = 0; m < 4; ++m) { const size_t off = (size_t)(u.pm * BM + ai * HALF + wr * 64 + m * 16 + fr) * 1024 + col0;
#pragma unroll
                for (int bj = 0; bj < 2; ++bj) { f32x4 b0, b1;
                    if (BASE_BF16) { const u32x4 x = *(const u32x4*)((const bf16*)base + off + bj * HALF); b0 = (f32x4){bflo(x.x), bfhi(x.x), bflo(x.y), bfhi(x.y)}; b1 = (f32x4){bflo(x.z), bfhi(x.z), bflo(x.w), bfhi(x.w)}; }
                    else { b0 = *(const f32x4*)((const float*)base + off + bj * HALF); b1 = *(const f32x4*)((const float*)base + off + bj * HALF + 4); }
                    const f32x4 v0 = b0 * alpha + acc[ai][bj][m][0], v1 = b1 * alpha + acc[ai][bj][m][1];
                    u32x4 w; w.x = cvt_pk_bf16(v0[0], v0[1]); w.y = cvt_pk_bf16(v0[2], v0[3]); w.z = cvt_pk_bf16(v1[0], v1[1]); w.w = cvt_pk_bf16(v1[2], v1[3]);
                    *(u32x4*)(out + off + bj * HALF) = w; }
                if (m & 1) asm volatile("" ::: "memory"); }
    }
};

struct MoeOrder {
    const unsigned* cnt; const int* LIST; const char* A; const char* B; int NTN, G, c, K, mode;
    __device__ bool next(int i, Unit& u) const {
        const int L = i * G + c; int base = 0, hb = 0;
        for (int e = 0; e < 32; ++e) { const int cc = (int)cnt[e * 64]; const int nmb = (cc + 255) >> 8; const int ntl = nmb * NTN;
            if (L < base + ntl) { const int r = L - base; u.e = e; u.pm = r / NTN; u.pn = r % NTN; u.cnt = cc; u.hb = hb; return true; }
            base += ntl; hb += nmb << 8; }
        return false;
    }
    __device__ __forceinline__ void base(const Unit& u, const char*& cA, const char*& cB) const {
        cA = mode == 0 ? A : A + (size_t)(u.hb + u.pm * 256) * K * 2; cB = B + (size_t)u.e * EW_STRIDE + (size_t)u.pn * 256 * K * 2; }
    __device__ __forceinline__ unsigned rowoff(const Unit& u, int r) const { int i = u.pm * 256 + r; i = i < u.cnt ? i : 0; return (unsigned)(LIST[u.e * M + i] >> 1) * 2048u; }
};
struct EpiSwiGLU {
    static constexpr bool PERM = true;
    bf16* HID;
    __device__ __forceinline__ void operator()(const f32x4 (&acc)[2][2][4][2], const Unit& u, int wr, int wc, int fr, int fq) const {
#pragma unroll
        for (int ai = 0; ai < 2; ++ai)
#pragma unroll
            for (int m = 0; m < 4; ++m) { const int i = u.pm * 256 + ai * HALF + wr * 64 + m * 16 + fr;
                if (i < u.cnt) { const f32x4 g0 = acc[ai][0][m][0], g1 = acc[ai][0][m][1], u0 = acc[ai][1][m][0], u1 = acc[ai][1][m][1];
                    u32x4 w; w.x = cvt_pk_bf16(siluf_(g0[0]) * u0[0], siluf_(g0[1]) * u0[1]); w.y = cvt_pk_bf16(siluf_(g0[2]) * u0[2], siluf_(g0[3]) * u0[3]);
                    w.z = cvt_pk_bf16(siluf_(g1[0]) * u1[0], siluf_(g1[1]) * u1[1]); w.w = cvt_pk_bf16(siluf_(g1[2]) * u1[2], siluf_(g1[3]) * u1[3]);
                    *(u32x4*)(HID + (size_t)(u.hb + i) * DE + u.pn * 128 + wc * 32 + 8 * fq) = w; } }
    }
};
struct EpiMoeOut {
    static constexpr bool PERM = true;
    bf16* YB; const int* LIST;
    __device__ __forceinline__ void operator()(const f32x4 (&acc)[2][2][4][2], const Unit& u, int wr, int wc, int fr, int fq) const {
#pragma unroll
        for (int ai = 0; ai < 2; ++ai)
#pragma unroll
            for (int m = 0; m < 4; ++m) { const int i = u.pm * 256 + ai * HALF + wr * 64 + m * 16 + fr;
                if (i < u.cnt) { const int a = LIST[u.e * M + i]; bf16* rowp = YB + (size_t)a * D + u.pn * 256 + wc * 32 + 8 * fq;
#pragma unroll
                    for (int bj = 0; bj < 2; ++bj) { const f32x4 v0 = acc[ai][bj][m][0], v1 = acc[ai][bj][m][1];
                        u32x4 w; w.x = cvt_pk_bf16(v0[0], v0[1]); w.y = cvt_pk_bf16(v0[2], v0[3]); w.z = cvt_pk_bf16(v1[0], v1[1]); w.w = cvt_pk_bf16(v1[2], v1[3]);
                        *(u32x4*)(rowp + bj * HALF) = w; } }
                asm volatile("" ::: "memory"); }
    }
};

template <class Epi, class Sched, bool ALIGN_EPI, bool GATHER>
__device__ __forceinline__ void gemm_phase(LAS unsigned char* lds, const int K, const Sched& S, const Epi& E) {
    const int tid = threadIdx.x, wid = __builtin_amdgcn_readfirstlane(tid >> 6), lane = tid & 63, wr = wid >> 2, wc = wid & 3, fr = lane & 15, fq = lane >> 4;
    const int nt = K / BK;
    int Rr[2], Cc[2]; unsigned voffB[2];
#pragma unroll
    for (int i = 0; i < 2; ++i) { int R, C; stage_rc(tid * 16 + i * 8192, R, C); const int Rb = Epi::PERM ? ((R & ~31) + perm32(R & 31)) : R; Rr[i] = R; Cc[i] = C; voffB[i] = (unsigned)(Rb * K + C) * 2u; }
    const size_t kstep = (size_t)(BK * 2);
    const size_t hstep = (size_t)HALF * K * 2;
    const unsigned ldsw = (unsigned)wid * 1024u;
    const int aoff = lds_byte(wr * 64 + fr, fq * 8), boff = lds_byte(wc * 32 + fr, fq * 8);
#define PG8_SA(b, h) (((b) * 2 + (h)) * HTB)
#define PG8_SB(b, h) ((4 + (b) * 2 + (h)) * HTB)
#define PG8_STAGE(bufoff, gbase, voff) do { _Pragma("unroll") for (int _i = 0; _i < 2; ++_i) \
        __builtin_amdgcn_global_load_lds((const unsigned*)((const char*)(gbase) + (voff)[_i]), (LAS unsigned*)(lds + (bufoff) + ldsw + _i * 8192), 16, 0, 0); } while (0)
#define PG8_STAGE_A(bufoff, gbase, o0, o1) do { \
        __builtin_amdgcn_global_load_lds((const unsigned*)((const char*)(gbase) + (o0)), (LAS unsigned*)(lds + (bufoff) + ldsw), 16, 0, 0); \
        __builtin_amdgcn_global_load_lds((const unsigned*)((const char*)(gbase) + (o1)), (LAS unsigned*)(lds + (bufoff) + ldsw + 8192), 16, 0, 0); } while (0)
#define PG8_LDA(dst, b, h) do { _Pragma("unroll") for (int m = 0; m < 4; ++m) _Pragma("unroll") for (int k = 0; k < 2; ++k) dst[m][k] = *(const LAS bf16x8*)(lds + PG8_SA(b, h) + aoff + m * 2048 + k * 1024); } while (0)
#define PG8_LDB(dst, b, h) do { _Pragma("unroll") for (int n = 0; n < 2; ++n) _Pragma("unroll") for (int k = 0; k < 2; ++k) dst[n][k] = *(const LAS bf16x8*)(lds + PG8_SB(b, h) + boff + n * 2048 + k * 1024); } while (0)
#define PG8_MMA(ai, bj, At, Bt) do { __builtin_amdgcn_s_setprio(1); _Pragma("unroll") for (int m = 0; m < 4; ++m) _Pragma("unroll") for (int n = 0; n < 2; ++n) _Pragma("unroll") for (int k = 0; k < 2; ++k) \
        acc[ai][bj][m][n] = __builtin_amdgcn_mfma_f32_16x16x32_bf16(Bt[n][k], At[m][k], acc[ai][bj][m][n], 0, 0, 0); __builtin_amdgcn_s_setprio(0); } while (0)
#define PG8_WAIT_V(n) asm volatile("s_waitcnt vmcnt(" #n ")" ::: "memory")
#define PG8_WAIT_L(n) asm volatile("s_waitcnt lgkmcnt(" #n ")" ::: "memory")
#define PG8_BAR __builtin_amdgcn_s_barrier()
#define PG8_SCHED __builtin_amdgcn_sched_barrier(0)
#define PG8_CALC_VA(u, v) do { _Pragma("unroll") for (int _h = 0; _h < 2; ++_h) _Pragma("unroll") for (int _i = 0; _i < 2; ++_i) \
        v[_h][_i] = GATHER ? (S.rowoff(u, _h * HALF + Rr[_i]) + (unsigned)Cc[_i] * 2u) : (unsigned)((_h * HALF + Rr[_i]) * K + Cc[_i]) * 2u; } while (0)
    Unit cur, nxt; int ui = 0;
    if (!S.next(0, cur)) return;
    f32x4 acc[2][2][4][2];
#pragma unroll
    for (int a = 0; a < 2; ++a)
#pragma unroll
        for (int b = 0; b < 2; ++b)
#pragma unroll
            for (int m = 0; m < 4; ++m)
#pragma unroll
                for (int n = 0; n < 2; ++n) acc[a][b][m][n] = (f32x4){0.f, 0.f, 0.f, 0.f};
    bf16x8 At[4][2], B0[2][2], B1[2][2];
    const char* cA; const char* cB; S.base(cur, cA, cB);
    unsigned cvA[2][2], nvA[2][2];
    PG8_CALC_VA(cur, cvA);
    PG8_STAGE(PG8_SB(0, 0), cB, voffB); PG8_STAGE(PG8_SB(0, 1), cB + hstep, voffB); PG8_STAGE_A(PG8_SA(0, 0), cA, cvA[0][0], cvA[0][1]); PG8_STAGE_A(PG8_SA(0, 1), cA, cvA[1][0], cvA[1][1]);
    if (wr == 1) PG8_BAR;
    PG8_WAIT_V(2); PG8_BAR;
    PG8_STAGE(PG8_SB(1, 0), cB + kstep, voffB); PG8_STAGE_A(PG8_SA(1, 0), cA + kstep, cvA[0][0], cvA[0][1]); PG8_STAGE(PG8_SB(1, 1), cB + hstep + kstep, voffB);
    PG8_WAIT_V(6); PG8_BAR;
    for (;;) {
        const bool has_next = S.next(ui + 1, nxt);
        const char* nA = cA; const char* nB = cB;
        if (has_next) { S.base(nxt, nA, nB); PG8_CALC_VA(nxt, nvA); }
        else {
#pragma unroll
            for (int h = 0; h < 2; ++h)
#pragma unroll
                for (int i = 0; i < 2; ++i) nvA[h][i] = cvA[h][i]; }
        if (GATHER) { asm volatile("s_waitcnt vmcnt(0)" ::: "memory"); asm volatile("" : "+v"(nvA[0][0]), "+v"(nvA[0][1]), "+v"(nvA[1][0]), "+v"(nvA[1][1])); }
#pragma unroll 1
        for (int t = 0; t < nt; t += 2) {
            const bool last = (t == nt - 2);
            const char* a1 = cA + (size_t)(t + 1) * kstep;
            const char* a2 = last ? nA : cA + (size_t)(t + 2) * kstep; const char* b2 = last ? nB : cB + (size_t)(t + 2) * kstep;
            const char* a3 = a2 + kstep; const char* b3 = b2 + kstep;
            const unsigned x00 = last ? nvA[0][0] : cvA[0][0], x01 = last ? nvA[0][1] : cvA[0][1], x10 = last ? nvA[1][0] : cvA[1][0], x11 = last ? nvA[1][1] : cvA[1][1];
            PG8_LDB(B0, 0, 0); PG8_LDB(B1, 0, 1); PG8_SCHED; PG8_LDA(At, 0, 0); PG8_STAGE_A(PG8_SA(1, 1), a1, cvA[1][0], cvA[1][1]);
            PG8_WAIT_V(8); PG8_WAIT_L(0); PG8_BAR; PG8_MMA(0, 0, At, B0); PG8_MMA(0, 1, At, B1); PG8_BAR; PG8_SCHED;
            PG8_LDA(At, 0, 1); PG8_STAGE(PG8_SB(0, 0), b2, voffB); PG8_STAGE(PG8_SB(0, 1), b2 + hstep, voffB); PG8_STAGE_A(PG8_SA(0, 0), a2, x00, x01);
            PG8_WAIT_V(8); PG8_WAIT_L(0); PG8_BAR; PG8_MMA(1, 0, At, B0); PG8_MMA(1, 1, At, B1); PG8_BAR; PG8_SCHED;
            PG8_LDB(B0, 1, 0); PG8_LDB(B1, 1, 1); PG8_SCHED; PG8_LDA(At, 1, 0); PG8_STAGE_A(PG8_SA(0, 1), a2, x10, x11);
            PG8_WAIT_V(8); PG8_WAIT_L(0); PG8_BAR; PG8_MMA(0, 0, At, B0); PG8_MMA(0, 1, At, B1); PG8_BAR; PG8_SCHED;
            PG8_LDA(At, 1, 1); PG8_STAGE(PG8_SB(1, 0), b3, voffB); PG8_STAGE(PG8_SB(1, 1), b3 + hstep, voffB); PG8_STAGE_A(PG8_SA(1, 0), a3, x00, x01);
            PG8_WAIT_V(8); PG8_WAIT_L(0); PG8_BAR; PG8_MMA(1, 0, At, B0); PG8_MMA(1, 1, At, B1); PG8_BAR; PG8_SCHED;
        }
        if constexpr (ALIGN_EPI) { if (wr == 0) PG8_BAR; }
        E(acc, cur, wr, wc, fr, fq);
        if (!has_next) break;
#pragma unroll
        for (int a = 0; a < 2; ++a)
#pragma unroll
            for (int b = 0; b < 2; ++b)
#pragma unroll
                for (int m = 0; m < 4; ++m)
#pragma unroll
                    for (int n = 0; n < 2; ++n) acc[a][b][m][n] = (f32x4){0.f, 0.f, 0.f, 0.f};
        cur = nxt; cA = nA; cB = nB; ++ui;
#pragma unroll
        for (int h = 0; h < 2; ++h)
#pragma unroll
            for (int i = 0; i < 2; ++i) cvA[h][i] = nvA[h][i];
        if constexpr (ALIGN_EPI) { if (wr == 1) PG8_BAR; }
    }
    PG8_WAIT_V(0);
    if constexpr (!ALIGN_EPI) { if (wr == 0) PG8_BAR; }
    PG8_BAR;
#undef PG8_SA
#undef PG8_SB
#undef PG8_STAGE
#undef PG8_STAGE_A
#undef PG8_LDA
#undef PG8_LDB
#undef PG8_MMA
#undef PG8_WAIT_V
#undef PG8_WAIT_L
#undef PG8_BAR
#undef PG8_SCHED
#undef PG8_CALC_VA
}
}

template <class RowFn>
__device__ __forceinline__ void ngemm_tile(LAS float* sA, LAS float* sB, RowFn rowA, const bf16* Bt, int ldb, int K, float (&acc)[4][4]) {
    const int tid = threadIdx.x, tx = tid & 15, ty = tid >> 4;
#pragma unroll
    for (int i = 0; i < 4; ++i)
#pragma unroll
        for (int j = 0; j < 4; ++j) acc[i][j] = 0.f;
    const int ar = tid >> 2, ak = (tid & 3) * 8, br = tid >> 3, bk = (tid & 7) * 4;
    const bf16* ap = rowA(ar);
    const bf16* bp = Bt + (size_t)br * ldb;
    for (int k0 = 0; k0 < K; k0 += 32) {
        u32x4 av = (u32x4){0u, 0u, 0u, 0u};
        if (ap) av = *(const u32x4*)(ap + k0 + ak);
        const u32x2 bv = *(const u32x2*)(bp + k0 + bk);
        __syncthreads();
        LAS float* wa = sA + ar * 33 + ak;
        wa[0] = bflo(av.x); wa[1] = bfhi(av.x); wa[2] = bflo(av.y); wa[3] = bfhi(av.y); wa[4] = bflo(av.z); wa[5] = bfhi(av.z); wa[6] = bflo(av.w); wa[7] = bfhi(av.w);
        LAS float* wb = sB + br * 33 + bk;
        wb[0] = bflo(bv.x); wb[1] = bfhi(bv.x); wb[2] = bflo(bv.y); wb[3] = bfhi(bv.y);
        __syncthreads();
#pragma unroll 8
        for (int kk = 0; kk < 32; ++kk) {
            float a[4], b[4];
#pragma unroll
            for (int i = 0; i < 4; ++i) a[i] = sA[(ty * 4 + i) * 33 + kk];
#pragma unroll
            for (int j = 0; j < 4; ++j) b[j] = sB[(tx * 4 + j) * 33 + kk];
#pragma unroll
            for (int i = 0; i < 4; ++i)
#pragma unroll
                for (int j = 0; j < 4; ++j) acc[i][j] = fmaf(a[i], b[j], acc[i][j]);
        }
    }
}

__device__ __forceinline__ void tr_item(const float* W, int ldw, bf16* WT, int ldt, LAS float* scr, int kb, int nb, int lane) {
    const int k0 = 64 * kb, n0 = 32 * nb;
#pragma unroll 8
    for (int i = 0; i < 32; ++i) { const int kk = 2 * i + (lane >> 5); scr[kk * 33 + (lane & 31)] = W[(size_t)(k0 + kk) * ldw + n0 + (lane & 31)]; }
    LDS_WAIT(); asm volatile("" ::: "memory");
    const int c = lane & 7;
#pragma unroll
    for (int j = 0; j < 4; ++j) { const int n = (lane >> 3) + 8 * j; const LAS float* s = scr + (8 * c) * 33 + n;
        u32x4 o; o.x = pk2(s[0 * 33], s[1 * 33]); o.y = pk2(s[2 * 33], s[3 * 33]); o.z = pk2(s[4 * 33], s[5 * 33]); o.w = pk2(s[6 * 33], s[7 * 33]);
        *(u32x4*)(WT + (size_t)(n0 + n) * ldt + k0 + 8 * c) = o; }
    LDS_WAIT(); asm volatile("" ::: "memory");
}

__device__ __forceinline__ void ph0_convert(Frame& F) {
    LAS float* scr = (LAS float*)(F.lds + F.wave * 9216);
    LAS float* gw = (LAS float*)(F.lds + 8 * 9216);
    const float* w0 = F.in[1];
    for (int i = F.tid; i < 8 * 1024; i += NT) { const int j = i >> 10, k = i & 1023; gw[i] = w0[(size_t)k * IN0 + 2048 + j]; }
    __syncthreads();
    const int gwv = F.vcu * NWAVES + F.wave, NGW = F.G * NWAVES;
    bf16* WT0 = (bf16*)(F.ws + WS_WT0); bf16* WO0 = (bf16*)(F.ws + WS_WO0); bf16* WT1 = (bf16*)(F.ws + WS_WT1); bf16* WO1 = (bf16*)(F.ws + WS_WO1);
    constexpr int I0 = 16 * 64, I1 = 16 * 64, I2 = 16 * 32, I3 = 16 * 144, I4 = 8 * 32, NI = I0 + I1 + I2 + I3 + I4;
    for (int it = gwv; it < NI; it += NGW) {
        int r = it;
        if (r < I0) { tr_item(w0, IN0, WT0, 1024, scr, r / 64, r % 64, F.lane); continue; } r -= I0;
        if (r < I1) { tr_item(w0 + 2056, IN0, WT0 + (size_t)2048 * 1024, 1024, scr, r / 64, r % 64, F.lane); continue; } r -= I1;
        if (r < I2) { tr_item(F.in[8], 1024, WO0, 1024, scr, r / 32, r % 32, F.lane); continue; } r -= I2;
        if (r < I3) { tr_item(F.in[9], IN1, WT1, 1024, scr, r / 144, r % 144, F.lane); continue; } r -= I3;
        tr_item(F.in[10], 1024, WO1, 512, scr, r / 32, r % 32, F.lane);
    }
    const float* x = F.in[0]; bf16* XB = (bf16*)(F.ws + WS_XB); float* G = (float*)(F.ws + WS_G);
    const float* ib = F.in[2]; const float* fb = F.in[3];
    for (int m = gwv; m < M; m += NGW) {
        const f32x4* xr = (const f32x4*)(x + (size_t)m * D) + F.lane;
        f32x4 v[4];
#pragma unroll
        for (int j = 0; j < 4; ++j) v[j] = xr[64 * j];
        unsigned long long* o8 = (unsigned long long*)(XB + (size_t)m * D) + F.lane;
#pragma unroll
        for (int j = 0; j < 4; ++j) o8[64 * j] = (unsigned long long)pk2(v[j].x, v[j].y) | ((unsigned long long)pk2(v[j].z, v[j].w) << 32);
        float acc[8];
#pragma unroll
        for (int g = 0; g < 8; ++g) { float a = 0.f;
#pragma unroll
            for (int j = 0; j < 4; ++j) { const f32x4 w = *(const LAS f32x4*)(gw + g * 1024 + 4 * F.lane + 256 * j); a += v[j].x * w.x + v[j].y * w.y + v[j].z * w.z + v[j].w * w.w; }
            acc[g] = wave_sum(a); }
        if (F.lane == 0) {
#pragma unroll
            for (int g = 0; g < 4; ++g) G[(size_t)m * 8 + g] = acc[g] + ib[g];
#pragma unroll
            for (int g = 0; g < 4; ++g) { const float z = acc[4 + g] + fb[g]; G[(size_t)m * 8 + 4 + g] = fminf(z, 0.f) - log1pf(__expf(-fabsf(z))); }
        }
    }
}

__device__ __forceinline__ void convert_experts(Frame& F, int layer) {
    LAS float* scr = (LAS float*)(F.lds + F.wave * 9216);
    const int gwv = F.vcu * NWAVES + F.wave, NGW = F.G * NWAVES;
    const float* wg = F.in[13] + (size_t)layer * NE * D * DE; const float* wu = F.in[14] + (size_t)layer * NE * D * DE; const float* wd = F.in[15] + (size_t)layer * NE * DE * D;
    for (int it = gwv; it < NE * 384; it += NGW) {
        const int e = it / 384; int r = it % 384;
        bf16* GU = (bf16*)(F.ws + WS_EW + (size_t)e * EW_STRIDE); bf16* DN = (bf16*)(F.ws + WS_EW + (size_t)e * EW_STRIDE + EW_DN);
        if (r < 256) { const int job = r >> 6, q = r & 63;
            const float* src = ((job < 2) ? wg : wu) + (size_t)e * D * DE + (job & 1) * 128;
            bf16* dst = GU + (size_t)((job & 1) * 256 + (job >> 1) * 128) * 1024;
            tr_item(src, DE, dst, 1024, scr, q >> 2, q & 3, F.lane);
        } else { r -= 256;
            tr_item(wd + (size_t)e * DE * D, D, DN, DE, scr, r >> 5, r & 31, F.lane); }
    }
}

__device__ __forceinline__ void ph_inproj_naive(Frame& F, const bf16* Bt, int N) {
    LAS float* sA = (LAS float*)F.lds; LAS float* sB = sA + 128 * 33;
    const bf16* XB = (const bf16*)(F.ws + WS_XB); bf16* P = (bf16*)(F.ws + WS_P);
    const int nnb = N / 64, ntiles = (M / 128) * nnb, tx = F.tid & 15, ty = F.tid >> 4;
    for (int t = blockIdx.x; t < ntiles; t += F.G) {
        const int mb = t / nnb, nb = t % nnb; float acc[4][4];
        ngemm_tile(sA, sB, [&](int r) { return XB + (size_t)(mb * 128 + r) * D; }, Bt + (size_t)nb * 64 * D, D, D, acc);
#pragma unroll
        for (int i = 0; i < 4; ++i) { u32x2 o; o.x = pk2(acc[i][0], acc[i][1]); o.y = pk2(acc[i][2], acc[i][3]);
            *(u32x2*)(P + (size_t)(mb * 128 + ty * 4 + i) * N + nb * 64 + tx * 4) = o; }
    }
}
__device__ __forceinline__ void ph_outproj_naive(Frame& F, const bf16* A, int K, const bf16* Bt, const float* base) {
    LAS float* sA = (LAS float*)F.lds; LAS float* sB = sA + 128 * 33;
    const int nnb = D / 64, ntiles = (M / 128) * nnb, tx = F.tid & 15, ty = F.tid >> 4;
    for (int t = blockIdx.x; t < ntiles; t += F.G) {
        const int mb = t / nnb, nb = t % nnb; float acc[4][4];
        ngemm_tile(sA, sB, [&](int r) { return A + (size_t)(mb * 128 + r) * K; }, Bt + (size_t)nb * 64 * K, K, K, acc);
#pragma unroll
        for (int i = 0; i < 4; ++i) { const size_t off = (size_t)(mb * 128 + ty * 4 + i) * D + nb * 64 + tx * 4;
            const f32x4 b = *(const f32x4*)(base + off);
            *(f32x4*)(F.out + off) = (f32x4){ALPHA * b.x + acc[i][0], ALPHA * b.y + acc[i][1], ALPHA * b.z + acc[i][2], ALPHA * b.w + acc[i][3]}; }
    }
}

__device__ __forceinline__ void ph_conv_naive(Frame& F) {
    const bf16* P = (const bf16*)(F.ws + WS_P); bf16* QKC = (bf16*)(F.ws + WS_QKC);
    const float* cw = F.in[4]; const float* cb = F.in[5];
    const size_t total = (size_t)M * 1024, nth = (size_t)F.G * NT;
    for (size_t i = (size_t)blockIdx.x * NT + F.tid; i < total; i += nth) {
        const int m = (int)(i >> 10), c = (int)(i & 1023), t = m & (T - 1);
        float a = cb[c];
#pragma unroll
        for (int j = 0; j < 4; ++j) { const int tt = t - 3 + j; if (tt >= 0) a += cw[j * 1024 + c] * bf2f(P[(size_t)(m - 3 + j) * NP0 + c]); }
        QKC[i] = (bf16)f2bf(siluf_(a));
    }
}
__device__ __forceinline__ void ph_recurrent_naive(Frame& F) {
    if (blockIdx.x >= 16) return;
    const int type = blockIdx.x >> 3, b = (blockIdx.x >> 2) & 1, h = blockIdx.x & 3;
    LAS float* sin = (LAS float*)F.lds;
    LAS float* red = sin + 1024;
    LAS float* redd = red + 512;
    LAS float* sc = redd + 4;
    const bf16* P = (const bf16*)(F.ws + WS_P); const bf16* QKC = (const bf16*)(F.ws + WS_QKC); const float* G = (const float*)(F.ws + WS_G);
    bf16* Y = (bf16*)(F.ws + WS_Y);
    const float* gain = (type == 0 ? F.in[6] : F.in[7]) + h * 128;
    const int e = F.tid & 127, dg = F.tid >> 7, which = dg;
    const float gamma = 1.f - exp2f(-5.f - (float)h);
    float C[32], nn[32];
#pragma unroll
    for (int j = 0; j < 32; ++j) { C[j] = 0.f; nn[j] = 0.f; }
    const bf16* src; size_t stride;
    if (type == 0) { if (which < 2) { src = QKC + which * 512 + h * 128 + e; stride = 1024; } else { src = P + 1024 + (which - 2) * 512 + h * 128 + e; stride = NP0; } }
    else { src = P + 2048 + which * 512 + h * 128 + e; stride = NP0; }
    const float mul = (which == 1) ? KSCALE : 1.f;
    const size_t m0 = (size_t)b * T;
    float val = bf2f(src[m0 * stride]) * mul;
    float s0 = 0.f, s1 = 0.f;
    if (F.tid == 0) { if (type == 0) { s0 = __expf(G[m0 * 8 + 4 + h]); s1 = __expf(G[m0 * 8 + h]); } else { s0 = gamma; s1 = 1.f; } }
    for (int t = 0; t < T; ++t) {
        const size_t m = m0 + t; const int pb = t & 1;
        sin[pb * 512 + F.tid] = val;
        if (F.tid == 0) { sc[pb * 2] = s0; sc[pb * 2 + 1] = s1; }
        if (t + 1 < T) { val = bf2f(src[(m + 1) * stride]) * mul;
            if (F.tid == 0 && type == 0) { s0 = __expf(G[(m + 1) * 8 + 4 + h]); s1 = __expf(G[(m + 1) * 8 + h]); } }
        __syncthreads();
        const float f = sc[pb * 2], ig = sc[pb * 2 + 1];
        const LAS float* sq = sin + pb * 512; const LAS float* sk = sq + 128; const LAS float* sv = sq + 256; const LAS float* so = sq + 384;
        const float ve = sv[e] * ig;
        float pn = 0.f, pd = 0.f;
#pragma unroll
        for (int j = 0; j < 32; ++j) { const int d = dg * 32 + j; const float kd = sk[d], qd = sq[d];
            C[j] = fmaf(f, C[j], kd * ve); nn[j] = fmaf(f, nn[j], ig * kd); pn = fmaf(C[j], qd, pn); pd = fmaf(nn[j], qd, pd); }
        red[dg * 128 + e] = pn; if (e == 0) redd[dg] = pd;
        __syncthreads();
        if (F.tid < 64) {
            const int e0 = F.tid, e1 = F.tid + 64;
            float h0 = (red[e0] + red[128 + e0]) + (red[256 + e0] + red[384 + e0]);
            float h1 = (red[e1] + red[128 + e1]) + (red[256 + e1] + red[384 + e1]);
            if (type == 0) { const float den = (redd[0] + redd[1]) + (redd[2] + redd[3]); const float dn = fmaxf(fabsf(den), 1.f);
                h0 = h0 / dn * sigmoidf_(so[e0]); h1 = h1 / dn * sigmoidf_(so[e1]); }
            const float mean = wave_sum(h0 + h1) * (1.f / 128.f); const float d0 = h0 - mean, d1 = h1 - mean;
            const float rstd = 1.f / sqrtf(wave_sum(d0 * d0 + d1 * d1) * (1.f / 128.f) + LN_EPS);
            float y0 = d0 * rstd * gain[e0], y1 = d1 * rstd * gain[e1];
            if (type == 1) { y0 *= siluf_(so[e0]); y1 *= siluf_(so[e1]); }
            Y[m * 1024 + type * 512 + h * 128 + e0] = (bf16)f2bf(y0); Y[m * 1024 + type * 512 + h * 128 + e1] = (bf16)f2bf(y1);
        }
    }
}

constexpr size_t WS_S = WS_SE;
constexpr size_t WS_DN = WS_G + 768 * 1024;
constexpr int CB_GL = 512 * 1024, CB_MSC = 520 * 1024;
constexpr int TRS = 144, RWS = 136;
template <int O0, int O1>
__device__ __forceinline__ void tr2(unsigned a, u32x2& r0, u32x2& r1) {
    asm volatile("ds_read_b64_tr_b16 %0, %2 offset:%3\n\tds_read_b64_tr_b16 %1, %2 offset:%4\n\ts_waitcnt lgkmcnt(0)" : "=&v"(r0), "=&v"(r1) : "v"(a), "i"(O0), "i"(O1) : "memory");
}
template <int B, int H>
__device__ __forceinline__ void tr8(unsigned a, u32x2& r0, u32x2& r1, u32x2& r2, u32x2& r3, u32x2& r4, u32x2& r5, u32x2& r6, u32x2& r7) {
    asm volatile("ds_read_b64_tr_b16 %0, %8 offset:%9\n\tds_read_b64_tr_b16 %1, %8 offset:%10\n\tds_read_b64_tr_b16 %2, %8 offset:%11\n\tds_read_b64_tr_b16 %3, %8 offset:%12\n\t"
                 "ds_read_b64_tr_b16 %4, %8 offset:%13\n\tds_read_b64_tr_b16 %5, %8 offset:%14\n\tds_read_b64_tr_b16 %6, %8 offset:%15\n\tds_read_b64_tr_b16 %7, %8 offset:%16\n\ts_waitcnt lgkmcnt(0)"
                 : "=&v"(r0), "=&v"(r1), "=&v"(r2), "=&v"(r3), "=&v"(r4), "=&v"(r5), "=&v"(r6), "=&v"(r7)
                 : "v"(a), "i"(B), "i"(B + H), "i"(B + 32), "i"(B + 32 + H), "i"(B + 64), "i"(B + 64 + H), "i"(B + 96), "i"(B + 96 + H) : "memory");
}
__device__ __forceinline__ bf16x8_t pack_frag(u32x2 a, u32x2 b) { return __builtin_bit_cast(bf16x8_t, (u32x4){a.x, a.y, b.x, b.y}); }
__device__ __forceinline__ void scan128_sum(float& x0, float& x1, int lane) {
#pragma unroll
    for (int o = 1; o < 64; o <<= 1) { const float t0 = __shfl_up(x0, o), t1 = __shfl_up(x1, o); if (lane >= o) { x0 += t0; x1 += t1; } }
    x1 += __shfl(x0, 63);
}
__device__ __forceinline__ void scan128_max(float& x0, float& x1, int lane) {
#pragma unroll
    for (int o = 1; o < 64; o <<= 1) { const float t0 = __shfl_up(x0, o), t1 = __shfl_up(x1, o); if (lane >= o) { x0 = fmaxf(x0, t0); x1 = fmaxf(x1, t1); } }
    x1 = fmaxf(x1, __shfl(x0, 63));
}
__device__ __forceinline__ float wave_max(float v) {
#pragma unroll
    for (int o = 1; o < 64; o <<= 1) v = fmaxf(v, __shfl_xor(v, o));
    return v;
}
__device__ __forceinline__ void conv8(const bf16* Pc, int row, int tpos0, const LAS float* cwp, float (&o)[8]) {
    { const f32x4 b0 = *(const LAS f32x4*)(cwp + 512), b1 = *(const LAS f32x4*)(cwp + 516); o[0] = b0.x; o[1] = b0.y; o[2] = b0.z; o[3] = b0.w; o[4] = b1.x; o[5] = b1.y; o[6] = b1.z; o[7] = b1.w; }
#pragma unroll
    for (int j = 0; j < 4; ++j) { const int r = row - 3 + j;
        if (tpos0 + r >= 0) { const u32x4 x = *(const u32x4*)(Pc + (long)r * NP0); const f32x4 w0 = *(const LAS f32x4*)(cwp + j * 128), w1 = *(const LAS f32x4*)(cwp + j * 128 + 4);
            o[0] += w0.x * bflo(x.x); o[1] += w0.y * bfhi(x.x); o[2] += w0.z * bflo(x.y); o[3] += w0.w * bfhi(x.y); o[4] += w1.x * bflo(x.z); o[5] += w1.y * bfhi(x.z); o[6] += w1.z * bflo(x.w); o[7] += w1.w * bfhi(x.w); } }
#pragma unroll
    for (int e = 0; e < 8; ++e) o[e] = siluf_(o[e]);
}
__device__ __forceinline__ u32x4 pack8(const float (&o)[8], float sc) {
    u32x4 w; w.x = pg8::cvt_pk_bf16(o[0] * sc, o[1] * sc); w.y = pg8::cvt_pk_bf16(o[2] * sc, o[3] * sc); w.z = pg8::cvt_pk_bf16(o[4] * sc, o[5] * sc); w.w = pg8::cvt_pk_bf16(o[6] * sc, o[7] * sc); return w; }
__device__ __forceinline__ void unpack8(u32x4 x, float (&o)[8]) { o[0] = bflo(x.x); o[1] = bfhi(x.x); o[2] = bflo(x.y); o[3] = bfhi(x.y); o[4] = bflo(x.z); o[5] = bfhi(x.z); o[6] = bflo(x.w); o[7] = bfhi(x.w); }

__device__ __forceinline__ void ph_mix_a(Frame& F) {
    LAS bf16* Vl = (LAS bf16*)F.lds;
    LAS bf16* Kl = Vl + 128 * TRS;
    LAS float* cwl = (LAS float*)(Kl + 128 * TRS);
    LAS float* wl = cwl + 640;
    const bf16* P = (const bf16*)(F.ws + WS_P); const float* G = (const float*)(F.ws + WS_G); float* S = (float*)(F.ws + WS_S); float* DN = (float*)(F.ws + WS_DN);
    float* GL = (float*)((char*)F.ctl + CB_GL);
    const float* cw = F.in[4]; const float* cb = F.in[5];
    const int tid = F.tid, lane = F.lane, w = F.wave, fr = lane & 15, fq = lane >> 4;
    const unsigned vaddr = (unsigned)(size_t)Vl + (unsigned)(((4 * fq + (fr >> 2)) * TRS + 16 * w + 4 * (fr & 3)) * 2);
    const unsigned kaddr = (unsigned)(size_t)Kl + (unsigned)(((4 * fq + (fr >> 2)) * TRS + 4 * (fr & 3)) * 2);
    for (int u = blockIdx.x; u < 1024; u += F.G) {
        const int type = u >> 9, b = (u >> 8) & 1, h = (u >> 6) & 3, c = u & 63, chain = type * 8 + b * 4 + h;
        const size_t m0 = (size_t)b * T + c * 128;
        const int kcol = (type == 0 ? 512 : 2560) + h * 128, vcol = (type == 0 ? 1024 : 3072) + h * 128;
        __syncthreads();
        if (type == 0) for (int i = tid; i < 640; i += NT) { const int j = i >> 7, d = i & 127; cwl[i] = j < 4 ? cw[j * 1024 + 512 + h * 128 + d] : cb[512 + h * 128 + d]; }
        if (w == 0) {
            float w0, w1;
            if (type == 0) {
                const float i0 = G[(m0 + lane) * 8 + h], i1 = G[(m0 + lane + 64) * 8 + h];
                float b0 = G[(m0 + lane) * 8 + 4 + h], b1 = G[(m0 + lane + 64) * 8 + 4 + h];
                scan128_sum(b0, b1, lane);
                const float g = __shfl(b1, 63), lw0 = g - b0 + i0, lw1 = g - b1 + i1, ml = wave_max(fmaxf(lw0, lw1));
                w0 = __expf(lw0 - ml); w1 = __expf(lw1 - ml);
                if (lane == 0) { GL[(chain * 64 + c) * 2] = g; GL[(chain * 64 + c) * 2 + 1] = ml; }
            } else { const float lg = log1pf(-exp2f(-5.f - (float)h)); w0 = __expf(lg * (float)(127 - lane)); w1 = __expf(lg * (float)(63 - lane)); }
            wl[lane] = w0 * KSCALE; wl[lane + 64] = w1 * KSCALE;
        }
#pragma unroll
        for (int it = 0; it < 4; ++it) { const int s = (tid >> 4) + 32 * it, ch = tid & 15;
            *(LAS u32x4*)(Vl + s * TRS + ch * 8) = *(const u32x4*)(P + (m0 + s) * NP0 + vcol + ch * 8); }
        __syncthreads();
#pragma unroll
        for (int it = 0; it < 4; ++it) { const int s = (tid >> 4) + 32 * it, ch = tid & 15; float o[8];
            if (type == 0) conv8(P + m0 * NP0 + kcol + ch * 8, s, c * 128, cwl + ch * 8, o);
            else unpack8(*(const u32x4*)(P + (m0 + s) * NP0 + kcol + ch * 8), o);
            *(LAS u32x4*)(Kl + s * TRS + ch * 8) = pack8(o, wl[s]); }
        __syncthreads();
        f32x4 acc[8], accn = (f32x4){0.f, 0.f, 0.f, 0.f};
#pragma unroll
        for (int dt = 0; dt < 8; ++dt) acc[dt] = (f32x4){0.f, 0.f, 0.f, 0.f};
        const bf16x8_t ones = (bf16x8_t){0x3F80, 0x3F80, 0x3F80, 0x3F80, 0x3F80, 0x3F80, 0x3F80, 0x3F80};
#pragma unroll
        for (int ks = 0; ks < 4; ++ks) {
            u32x2 a0, a1, n0, n1, b0, b1, b2, b3, b4, b5, b6, b7, c0, c1, c2, c3, c4, c5, c6, c7;
            tr2<0, 16 * TRS * 2>(vaddr + ks * 32 * TRS * 2, a0, a1);
            tr2<0, 16 * TRS * 2>(kaddr + ks * 32 * TRS * 2 + 32 * w, n0, n1);
            tr8<0, 16 * TRS * 2>(kaddr + ks * 32 * TRS * 2, b0, b1, b2, b3, b4, b5, b6, b7);
            tr8<128, 16 * TRS * 2>(kaddr + ks * 32 * TRS * 2, c0, c1, c2, c3, c4, c5, c6, c7);
            __builtin_amdgcn_sched_barrier(0);
            const bf16x8_t A = pack_frag(a0, a1);
            acc[0] = __builtin_amdgcn_mfma_f32_16x16x32_bf16(A, pack_frag(b0, b1), acc[0], 0, 0, 0);
            acc[1] = __builtin_amdgcn_mfma_f32_16x16x32_bf16(A, pack_frag(b2, b3), acc[1], 0, 0, 0);
            acc[2] = __builtin_amdgcn_mfma_f32_16x16x32_bf16(A, pack_frag(b4, b5), acc[2], 0, 0, 0);
            acc[3] = __builtin_amdgcn_mfma_f32_16x16x32_bf16(A, pack_frag(b6, b7), acc[3], 0, 0, 0);
            acc[4] = __builtin_amdgcn_mfma_f32_16x16x32_bf16(A, pack_frag(c0, c1), acc[4], 0, 0, 0);
            acc[5] = __builtin_amdgcn_mfma_f32_16x16x32_bf16(A, pack_frag(c2, c3), acc[5], 0, 0, 0);
            acc[6] = __builtin_amdgcn_mfma_f32_16x16x32_bf16(A, pack_frag(c4, c5), acc[6], 0, 0, 0);
            acc[7] = __builtin_amdgcn_mfma_f32_16x16x32_bf16(A, pack_frag(c6, c7), acc[7], 0, 0, 0);
            accn = __builtin_amdgcn_mfma_f32_16x16x32_bf16(ones, pack_frag(n0, n1), accn, 0, 0, 0);
        }
        float* Sp = S + ((size_t)(chain * 64 + c) * 128 + 16 * w + 4 * fq) * 128 + fr;
#pragma unroll
        for (int dt = 0; dt < 8; ++dt)
#pragma unroll
            for (int rg = 0; rg < 4; ++rg) Sp[rg * 128 + 16 * dt] = acc[dt][rg];
        if (type == 0 && fq == 0) DN[(size_t)(chain * 64 + c) * 128 + 16 * w + fr] = accn[0];
    }
}

__device__ __forceinline__ void ph_mix_b(Frame& F) {
    LAS float* gl = (LAS float*)F.lds; LAS float* dec = gl + 1024; LAS float* scl = dec + 512;
    const float* GL = (const float*)((char*)F.ctl + CB_GL); float* MSC = (float*)((char*)F.ctl + CB_MSC);
    float* S = (float*)(F.ws + WS_S); float* DN = (float*)(F.ws + WS_DN);
    for (int i = F.tid; i < 1024; i += NT) gl[i] = GL[i];
    __syncthreads();
    if (F.tid < 8) { float m = 0.f;
        for (int c = 0; c < 64; ++c) { const float g = gl[(F.tid * 64 + c) * 2], ml = gl[(F.tid * 64 + c) * 2 + 1];
            if (blockIdx.x == 0) MSC[F.tid * 64 + c] = m;
            const float mn = fmaxf(g + m, ml); dec[F.tid * 64 + c] = __expf(g + m - mn); scl[F.tid * 64 + c] = __expf(ml - mn); m = mn; } }
    __syncthreads();
    for (int j = blockIdx.x * NT + F.tid; j < 131072; j += F.G * NT) {
        const int chain = j >> 14, el = j & 16383;
        float* p0 = S + (size_t)chain * 64 * 16384 + el; float* p1 = S + (size_t)(8 + chain) * 64 * 16384 + el;
        const float g128 = __expf(128.f * log1pf(-exp2f(-5.f - (float)(chain & 3))));
        float C = 0.f, R = 0.f;
        for (int c0 = 0; c0 < 64; c0 += 8) { float x[8], y[8];
#pragma unroll
            for (int k = 0; k < 8; ++k) { x[k] = p0[(size_t)(c0 + k) * 16384]; y[k] = p1[(size_t)(c0 + k) * 16384]; }
#pragma unroll
            for (int k = 0; k < 8; ++k) { p0[(size_t)(c0 + k) * 16384] = C; C = dec[chain * 64 + c0 + k] * C + scl[chain * 64 + c0 + k] * x[k];
                p1[(size_t)(c0 + k) * 16384] = R; R = g128 * R + y[k]; } }
    }
    for (int j = blockIdx.x * NT + F.tid; j < 1024; j += F.G * NT) { const int chain = j >> 7, d = j & 127; float* p = DN + (size_t)chain * 64 * 128 + d; float n = 0.f;
        for (int c = 0; c < 64; ++c) { const float x = p[c * 128]; p[c * 128] = n; n = dec[chain * 64 + c] * n + scl[chain * 64 + c] * x; } }
}

__device__ __forceinline__ void ph_mix_c(Frame& F) {
    LAS bf16* Kl = (LAS bf16*)F.lds;
    LAS bf16* Vl = Kl + 128 * RWS;
    LAS bf16* Cl = Vl + 128 * TRS;
    LAS float* cwl = (LAS float*)(Cl + 144 * RWS);
    LAS float* ul = cwl + 1280; LAS float* Ml = ul + 128; LAS float* bl = Ml + 128;
    const bf16* P = (const bf16*)(F.ws + WS_P); const float* G = (const float*)(F.ws + WS_G); const float* S = (const float*)(F.ws + WS_S); const float* DN = (const float*)(F.ws + WS_DN);
    const float* MSC = (const float*)((char*)F.ctl + CB_MSC); bf16* Y = (bf16*)(F.ws + WS_Y);
    const float* cw = F.in[4]; const float* cb = F.in[5];
    const int tid = F.tid, lane = F.lane, w = F.wave, fr = lane & 15, fq = lane >> 4;
    const int lt = w < 4 ? w : 11 - w, l = 16 * lt + fr;
    const unsigned vaddr = (unsigned)(size_t)Vl + (unsigned)(((4 * fq + (fr >> 2)) * TRS + 4 * (fr & 3)) * 2);
    for (int u = blockIdx.x; u < 1024; u += F.G) {
        const int type = u >> 9, b = (u >> 8) & 1, h = (u >> 6) & 3, c = u & 63, chain = type * 8 + b * 4 + h;
        const size_t m0 = (size_t)b * T + c * 128;
        const int base = type == 0 ? 0 : 2048, qcol = base + h * 128, kcol = base + 512 + h * 128, vcol = base + 1024 + h * 128, gcol = base + 1536 + h * 128;
        const float lg = log1pf(-exp2f(-5.f - (float)h));
        __syncthreads();
        if (type == 0) for (int i = tid; i < 1280; i += NT) { const int part = i / 640, r = i % 640, j = r >> 7, d = r & 127, col = part * 512 + h * 128 + d; cwl[i] = j < 4 ? cw[j * 1024 + col] : cb[col]; }
        float mc = 0.f;
        if (type == 0) {
            mc = MSC[(b * 4 + h) * 64 + c];
            if (w == 0) {
                const float i0 = G[(m0 + lane) * 8 + h], i1 = G[(m0 + lane + 64) * 8 + h];
                float b0 = G[(m0 + lane) * 8 + 4 + h], b1 = G[(m0 + lane + 64) * 8 + 4 + h];
                scan128_sum(b0, b1, lane);
                const float u0 = i0 - b0, u1 = i1 - b1; float p0 = u0, p1 = u1; scan128_max(p0, p1, lane);
                ul[lane] = u0; ul[lane + 64] = u1; Ml[lane] = fmaxf(mc, p0); Ml[lane + 64] = fmaxf(mc, p1); bl[lane] = b0; bl[lane + 64] = b1;
            }
        }
#pragma unroll
        for (int it = 0; it < 4; ++it) { const int s = (tid >> 4) + 32 * it, ch = tid & 15;
            *(LAS u32x4*)(Vl + s * TRS + ch * 8) = *(const u32x4*)(P + (m0 + s) * NP0 + vcol + ch * 8);
            const float* sp = S + ((size_t)(chain * 64 + c) * 128 + s) * 128 + ch * 8; const f32x4 x0 = *(const f32x4*)sp, x1 = *(const f32x4*)(sp + 4);
            u32x4 wv; wv.x = pg8::cvt_pk_bf16(x0.x, x0.y); wv.y = pg8::cvt_pk_bf16(x0.z, x0.w); wv.z = pg8::cvt_pk_bf16(x1.x, x1.y); wv.w = pg8::cvt_pk_bf16(x1.z, x1.w);
            *(LAS u32x4*)(Cl + s * RWS + ch * 8) = wv; }
        if (tid < 256) { const int r = tid >> 4, ch = tid & 15; u32x4 wv = (u32x4){0u, 0u, 0u, 0u};
            if (type == 0 && r == 0) { const float* np = DN + (size_t)((b * 4 + h) * 64 + c) * 128 + ch * 8; const f32x4 x0 = *(const f32x4*)np, x1 = *(const f32x4*)(np + 4);
                wv.x = pg8::cvt_pk_bf16(x0.x, x0.y); wv.y = pg8::cvt_pk_bf16(x0.z, x0.w); wv.z = pg8::cvt_pk_bf16(x1.x, x1.y); wv.w = pg8::cvt_pk_bf16(x1.z, x1.w); }
            *(LAS u32x4*)(Cl + (128 + r) * RWS + ch * 8) = wv; }
        __syncthreads();
#pragma unroll
        for (int it = 0; it < 4; ++it) { const int s = (tid >> 4) + 32 * it, ch = tid & 15; float o[8];
            if (type == 0) conv8(P + m0 * NP0 + kcol + ch * 8, s, c * 128, cwl + 640 + ch * 8, o);
            else unpack8(*(const u32x4*)(P + (m0 + s) * NP0 + kcol + ch * 8), o);
            *(LAS u32x4*)(Kl + s * RWS + ch * 8) = pack8(o, KSCALE); }
        bf16x8_t qf[4];
#pragma unroll
        for (int ks = 0; ks < 4; ++ks) { const int d0 = 32 * ks + 8 * fq;
            if (type == 0) { float o[8]; conv8(P + m0 * NP0 + qcol + d0, l, c * 128, cwl + d0, o); qf[ks] = __builtin_bit_cast(bf16x8_t, pack8(o, 1.f)); }
            else qf[ks] = *(const bf16x8_t*)(P + (m0 + l) * NP0 + qcol + d0); }
        __syncthreads();
        f32x4 st[8];
#pragma unroll
        for (int t = 0; t < 8; ++t) { st[t] = (f32x4){0.f, 0.f, 0.f, 0.f};
            if (t <= lt) {
#pragma unroll
                for (int ks = 0; ks < 4; ++ks) st[t] = __builtin_amdgcn_mfma_f32_16x16x32_bf16(*(const LAS bf16x8_t*)(Kl + (16 * t + fr) * RWS + 32 * ks + 8 * fq), qf[ks], st[t], 0, 0, 0); }
            if (t & 1) __builtin_amdgcn_sched_barrier(0); }
        int lz = l, fz = 4 * fq; asm volatile("" : "+v"(lz), "+v"(fz));
        const float Mme = (type == 0) ? Ml[lz] : 0.f;
        float den = 0.f;
#pragma unroll
        for (int t = 0; t < 8; ++t) if (t <= lt) {
#pragma unroll
            for (int rg = 0; rg < 4; ++rg) { const int s = 16 * t + fz + rg;
                float e = (type == 0) ? (ul[s] - Mme) : (lg * (float)(lz - s)); e = (s <= lz) ? e : -1e30f;
                const float p = st[t][rg] * __expf(e); st[t][rg] = p; den += p; } }
        den += __shfl_xor(den, 16); den += __shfl_xor(den, 32);
        f32x4 o1[8], o2[9];
#pragma unroll
        for (int et = 0; et < 8; ++et) o1[et] = (f32x4){0.f, 0.f, 0.f, 0.f};
#pragma unroll
        for (int et = 0; et < 9; ++et) o2[et] = (f32x4){0.f, 0.f, 0.f, 0.f};
#pragma unroll
        for (int j = 0; j < 4; ++j) if (2 * j <= lt) {
            u32x4 pw; pw.x = pg8::cvt_pk_bf16(st[2 * j][0], st[2 * j][1]); pw.y = pg8::cvt_pk_bf16(st[2 * j][2], st[2 * j][3]);
            pw.z = pg8::cvt_pk_bf16(st[2 * j + 1][0], st[2 * j + 1][1]); pw.w = pg8::cvt_pk_bf16(st[2 * j + 1][2], st[2 * j + 1][3]);
            const bf16x8_t pf = __builtin_bit_cast(bf16x8_t, pw);
            u32x2 b0, b1, b2, b3, b4, b5, b6, b7, c0, c1, c2, c3, c4, c5, c6, c7;
            tr8<0, 16 * TRS * 2>(vaddr + j * 32 * TRS * 2, b0, b1, b2, b3, b4, b5, b6, b7);
            tr8<128, 16 * TRS * 2>(vaddr + j * 32 * TRS * 2, c0, c1, c2, c3, c4, c5, c6, c7);
            __builtin_amdgcn_sched_barrier(0);
            o1[0] = __builtin_amdgcn_mfma_f32_16x16x32_bf16(pack_frag(b0, b1), pf, o1[0], 0, 0, 0);
            o1[1] = __builtin_amdgcn_mfma_f32_16x16x32_bf16(pack_frag(b2, b3), pf, o1[1], 0, 0, 0);
            o1[2] = __builtin_amdgcn_mfma_f32_16x16x32_bf16(pack_frag(b4, b5), pf, o1[2], 0, 0, 0);
            o1[3] = __builtin_amdgcn_mfma_f32_16x16x32_bf16(pack_frag(b6, b7), pf, o1[3], 0, 0, 0);
            o1[4] = __builtin_amdgcn_mfma_f32_16x16x32_bf16(pack_frag(c0, c1), pf, o1[4], 0, 0, 0);
            o1[5] = __builtin_amdgcn_mfma_f32_16x16x32_bf16(pack_frag(c2, c3), pf, o1[5], 0, 0, 0);
            o1[6] = __builtin_amdgcn_mfma_f32_16x16x32_bf16(pack_frag(c4, c5), pf, o1[6], 0, 0, 0);
            o1[7] = __builtin_amdgcn_mfma_f32_16x16x32_bf16(pack_frag(c6, c7), pf, o1[7], 0, 0, 0);
        }
        __builtin_amdgcn_sched_barrier(0);
#pragma unroll
        for (int ks = 0; ks < 4; ++ks) {
#pragma unroll
            for (int et = 0; et < 9; ++et) o2[et] = __builtin_amdgcn_mfma_f32_16x16x32_bf16(*(const LAS bf16x8_t*)(Cl + (16 * et + fr) * RWS + 32 * ks + 8 * fq), qf[ks], o2[et], 0, 0, 0);
            __builtin_amdgcn_sched_barrier(0); }
        float inter, rden = 1.f;
        if (type == 0) { inter = __expf(mc - Mme); const float qn = __shfl(o2[8][0], fr); const float dtot = den + inter * qn; rden = 1.f / fmaxf(fabsf(dtot), __expf(-(bl[l] + Mme))); }
        else inter = __expf(lg * (float)(l + 1));
        const bf16* gp = P + (m0 + l) * NP0 + gcol + 4 * fq;
        float sum = 0.f;
#pragma unroll
        for (int et = 0; et < 8; ++et) { const u32x2 gw = *(const u32x2*)(gp + 16 * et); const float g0 = bflo(gw.x), g1 = bfhi(gw.x), g2 = bflo(gw.y), g3 = bfhi(gw.y);
            f32x4 hv = (o1[et] + o2[et] * inter) * rden;
            if (type == 0) { hv[0] *= sigmoidf_(g0); hv[1] *= sigmoidf_(g1); hv[2] *= sigmoidf_(g2); hv[3] *= sigmoidf_(g3); o2[et] = (f32x4){1.f, 1.f, 1.f, 1.f}; }
            else o2[et] = (f32x4){siluf_(g0), siluf_(g1), siluf_(g2), siluf_(g3)};
            o1[et] = hv; sum += (hv[0] + hv[1]) + (hv[2] + hv[3]); if (et & 1) asm volatile("" ::: "memory"); }
        sum += __shfl_xor(sum, 16); sum += __shfl_xor(sum, 32);
        const float mean = sum * (1.f / 128.f); float sq = 0.f;
#pragma unroll
        for (int et = 0; et < 8; ++et) { o1[et] = o1[et] - mean; sq += (o1[et][0] * o1[et][0] + o1[et][1] * o1[et][1]) + (o1[et][2] * o1[et][2] + o1[et][3] * o1[et][3]); }
        sq += __shfl_xor(sq, 16); sq += __shfl_xor(sq, 32);
        const float rstd = 1.f / sqrtf(sq * (1.f / 128.f) + LN_EPS);
        const float* g6 = F.in[6]; const float* g7 = F.in[7]; asm volatile("" : "+s"(g6), "+s"(g7));
        const float* gain = (type == 0 ? g6 : g7) + h * 128 + 4 * fq;
        bf16* yp = Y + (m0 + l) * 1024 + type * 512 + h * 128 + 4 * fq;
#pragma unroll
        for (int et = 0; et < 8; ++et) { const f32x4 gn = *(const f32x4*)(gain + 16 * et); const f32x4 yv = o1[et] * rstd * gn * o2[et];
            u32x2 wv; wv.x = pg8::cvt_pk_bf16(yv[0], yv[1]); wv.y = pg8::cvt_pk_bf16(yv[2], yv[3]); *(u32x2*)(yp + 16 * et) = wv; if (et & 1) asm volatile("" ::: "memory"); }
    }
}

constexpr int RWT = 1028;
template <int MODE, bool ROUTE, int OUTK>
__device__ __forceinline__ void ph_ln(Frame& F, int layer) {
    LAS float* rwT = (LAS float*)F.lds;
    if (ROUTE) { const float* rw = F.in[11]; for (int i = F.tid; i < 32 * 1024; i += NT) { const int k = i >> 5, e = i & 31; rwT[e * RWT + k] = rw[i]; } __syncthreads(); }
    const int gwv = F.vcu * NWAVES + F.wave, NGW = F.G * NWAVES;
    const float* lg = F.in[16] + (size_t)(layer * 2 + MODE) * D; const float* lb = F.in[17] + (size_t)(layer * 2 + MODE) * D;
    bf16* XB = (bf16*)(F.ws + WS_XB); const bf16* YB = (const bf16*)(F.ws + WS_YB); const bf16* PRE = (const bf16*)((const char*)F.out + 32 * MiB); bf16* RES = (bf16*)F.out;
    int* EIDX = (int*)(F.ws + WS_EIDX); float* GATEV = (float*)(F.ws + WS_GATEV); int* LIST = (int*)(F.ws + WS_LIST);
    unsigned* cnt = F.ctl + CW_CNT + layer * 32 * 64;
    const float* rbias = F.in[12];
    f32x4 gv[4], bv[4];
#pragma unroll
    for (int j = 0; j < 4; ++j) { gv[j] = *((const f32x4*)lg + F.lane + 64 * j); bv[j] = *((const f32x4*)lb + F.lane + 64 * j); }
    for (int m = gwv; m < M; m += NGW) {
        f32x4 v[4]; float s = 0.f;
        if (MODE == 0) { const u32x2* pr = (const u32x2*)(PRE + (size_t)m * D) + F.lane;
#pragma unroll
            for (int j = 0; j < 4; ++j) { const u32x2 a = pr[64 * j]; v[j] = (f32x4){bflo(a.x), bfhi(a.x), bflo(a.y), bfhi(a.y)}; } }
        else {
            const float g0 = GATEV[2 * m], g1 = GATEV[2 * m + 1];
            const u32x2* xr = (const u32x2*)(XB + (size_t)m * D) + F.lane;
            const u32x2* y0 = (const u32x2*)(YB + (size_t)(2 * m) * D) + F.lane; const u32x2* y1 = (const u32x2*)(YB + (size_t)(2 * m + 1) * D) + F.lane;
#pragma unroll
            for (int j = 0; j < 4; ++j) { const u32x2 x = xr[64 * j], a = y0[64 * j], b = y1[64 * j];
                v[j].x = ALPHA * bflo(x.x) + g0 * bflo(a.x) + g1 * bflo(b.x); v[j].y = ALPHA * bfhi(x.x) + g0 * bfhi(a.x) + g1 * bfhi(b.x);
                v[j].z = ALPHA * bflo(x.y) + g0 * bflo(a.y) + g1 * bflo(b.y); v[j].w = ALPHA * bfhi(x.y) + g0 * bfhi(a.y) + g1 * bfhi(b.y); }
        }
#pragma unroll
        for (int j = 0; j < 4; ++j) s += (v[j].x + v[j].y) + (v[j].z + v[j].w);
        const float mean = wave_sum(s) * (1.f / D); float s2 = 0.f;
#pragma unroll
        for (int j = 0; j < 4; ++j) { v[j] = v[j] - mean; s2 += (v[j].x * v[j].x + v[j].y * v[j].y) + (v[j].z * v[j].z + v[j].w * v[j].w); }
        const float rstd = 1.f / sqrtf(wave_sum(s2) * (1.f / D) + LN_EPS);
#pragma unroll
        for (int j = 0; j < 4; ++j) v[j] = v[j] * rstd * gv[j] + bv[j];
        if (OUTK == 2) { f32x4* orow = (f32x4*)(F.out + (size_t)m * D) + F.lane;
#pragma unroll
            for (int j = 0; j < 4; ++j) orow[64 * j] = v[j]; }
        else { u32x2* o8 = (u32x2*)((OUTK == 0 ? XB : RES) + (size_t)m * D) + F.lane;
#pragma unroll
            for (int j = 0; j < 4; ++j) { u32x2 w; w.x = pg8::cvt_pk_bf16(v[j].x, v[j].y); w.y = pg8::cvt_pk_bf16(v[j].z, v[j].w); o8[64 * j] = w; } }
        if (ROUTE) {
            float pv[32];
#pragma unroll
            for (int e = 0; e < 32; ++e) { float a = 0.f;
#pragma unroll
                for (int j = 0; j < 4; ++j) { const f32x4 w = *(const LAS f32x4*)(rwT + e * RWT + 4 * F.lane + 256 * j); a += v[j].x * w.x + v[j].y * w.y + v[j].z * w.z + v[j].w * w.w; }
                pv[e] = a; if ((e & 7) == 7) __builtin_amdgcn_sched_barrier(0); }
#define LN_HALVE(N, MASK) { const bool up = (F.lane & (MASK)) != 0; _Pragma("unroll") for (int j = 0; j < (N); ++j) { const float keep = up ? pv[(N) + j] : pv[j], send = up ? pv[j] : pv[(N) + j]; pv[j] = keep + __shfl_xor(send, (MASK)); } }
            LN_HALVE(16, 32) LN_HALVE(8, 16) LN_HALVE(4, 8) LN_HALVE(2, 4) LN_HALVE(1, 2)
#undef LN_HALVE
            const float mylog = pv[0] + __shfl_xor(pv[0], 1);
            const int mye = F.lane >> 1;
            const float myaff = 1.f / (1.f + expf(-mylog)), mysel = myaff + rbias[mye];
            float m1 = -1e30f, m2 = -1e30f; int i1 = 0, i2 = 0; float a1 = 0.f, a2 = 0.f;
            const int lbase = F.lane & 48, ebase = (F.lane >> 4) * 8;
#pragma unroll
            for (int j = 0; j < 8; ++j) { const float sv = __shfl(mysel, lbase + 2 * j), av = __shfl(myaff, lbase + 2 * j);
                if (sv > m1) { m2 = m1; i2 = i1; a2 = a1; m1 = sv; i1 = ebase + j; a1 = av; }
                else if (sv > m2) { m2 = sv; i2 = ebase + j; a2 = av; } }
            const float score = m1 + m2;
            float bestscore = -1e30f; int bg = 0;
#pragma unroll
            for (int g = 0; g < 4; ++g) { const float sg = __shfl(score, 16 * g); if (sg > bestscore) { bestscore = sg; bg = g; } }
            const int bi0 = __shfl(i1, 16 * bg), bi1 = __shfl(i2, 16 * bg); const float ba0 = __shfl(a1, 16 * bg), ba1 = __shfl(a2, 16 * bg);
            if (F.lane == 0) {
                const float inv = 1.f / (ba0 + ba1);
                EIDX[2 * m] = bi0; EIDX[2 * m + 1] = bi1; GATEV[2 * m] = ba0 * inv; GATEV[2 * m + 1] = ba1 * inv;
                const unsigned p0 = __hip_atomic_fetch_add(cnt + bi0 * 64, 1u, RLX_AGENT); LIST[bi0 * M + p0] = 2 * m;
                const unsigned p1 = __hip_atomic_fetch_add(cnt + bi1 * 64, 1u, RLX_AGENT); LIST[bi1 * M + p1] = 2 * m + 1;
            }
        }
    }
}

struct ExpertMap { int cnt[32]; };
__device__ __forceinline__ int moe_find(Frame& F, int layer, int unit_rows, int per_row_tiles, int t, int& e_out, int& mb_out, int& nb_out, int& hb_out, int& cnt_out) {
    const unsigned* cnt = F.ctl + CW_CNT + layer * 32 * 64;
    int base = 0, hb = 0;
    for (int e = 0; e < 32; ++e) {
        const int c = (int)cnt[e * 64]; const int nmb = (c + unit_rows - 1) / unit_rows; const int nt = nmb * per_row_tiles;
        if (t < base + nt) { const int r = t - base; e_out = e; mb_out = r / per_row_tiles; nb_out = r % per_row_tiles; hb_out = hb; cnt_out = c; return 1; }
        base += nt; hb += ((c + 255) >> 8) << 8;
    }
    return 0;
}
__device__ __forceinline__ void ph_moe1_naive(Frame& F, int layer) {
    LAS float* sA = (LAS float*)F.lds; LAS float* sB = sA + 128 * 33;
    const bf16* XB = (const bf16*)(F.ws + WS_XB); bf16* HID = (bf16*)(F.ws + WS_HID); const int* LIST = (const int*)(F.ws + WS_LIST);
    const int tx = F.tid & 15, ty = F.tid >> 4;
    for (int t = blockIdx.x;; t += F.G) {
        int e, mb, nb, hb, c; if (!moe_find(F, layer, 128, 4, t, e, mb, nb, hb, c)) break;
        const bf16* GU = (const bf16*)(F.ws + WS_EW + (size_t)e * EW_STRIDE);
        const int j0 = nb * 64, rg = (j0 >> 7) * 256 + (j0 & 127);
        auto rowA = [&](int r) -> const bf16* { const int i = mb * 128 + r; return i < c ? XB + (size_t)(LIST[e * M + i] >> 1) * D : (const bf16*)nullptr; };
        float ag[4][4], au[4][4];
        ngemm_tile(sA, sB, rowA, GU + (size_t)rg * D, D, D, ag);
        ngemm_tile(sA, sB, rowA, GU + (size_t)(rg + 128) * D, D, D, au);
#pragma unroll
        for (int i = 0; i < 4; ++i) { const int ri = mb * 128 + ty * 4 + i;
            if (ri < c) { u32x2 o; o.x = pk2(siluf_(ag[i][0]) * au[i][0], siluf_(ag[i][1]) * au[i][1]); o.y = pk2(siluf_(ag[i][2]) * au[i][2], siluf_(ag[i][3]) * au[i][3]);
                *(u32x2*)(HID + (size_t)(hb + ri) * DE + j0 + tx * 4) = o; } }
    }
}
__device__ __forceinline__ void ph_moe2_naive(Frame& F, int layer) {
    LAS float* sA = (LAS float*)F.lds; LAS float* sB = sA + 128 * 33;
    const bf16* HID = (const bf16*)(F.ws + WS_HID); bf16* YB = (bf16*)(F.ws + WS_YB); const int* LIST = (const int*)(F.ws + WS_LIST);
    const int tx = F.tid & 15, ty = F.tid >> 4;
    for (int t = blockIdx.x;; t += F.G) {
        int e, mb, nb, hb, c; if (!moe_find(F, layer, 128, 16, t, e, mb, nb, hb, c)) break;
        const bf16* DN = (const bf16*)(F.ws + WS_EW + (size_t)e * EW_STRIDE + EW_DN);
        auto rowA = [&](int r) -> const bf16* { const int i = mb * 128 + r; return i < c ? HID + (size_t)(hb + i) * DE : (const bf16*)nullptr; };
        float acc[4][4];
        ngemm_tile(sA, sB, rowA, DN + (size_t)(nb * 64) * DE, DE, DE, acc);
#pragma unroll
        for (int i = 0; i < 4; ++i) { const int ri = mb * 128 + ty * 4 + i;
            if (ri < c) { const int a = LIST[e * M + ri]; u32x2 o; o.x = pk2(acc[i][0], acc[i][1]); o.y = pk2(acc[i][2], acc[i][3]);
                *(u32x2*)(YB + (size_t)a * D + nb * 64 + tx * 4) = o; } }
    }
}

__device__ __forceinline__ void ph_attn_naive(Frame& F) {
    const bf16* P = (const bf16*)(F.ws + WS_P); bf16* OG = (bf16*)(F.ws + WS_OG); float* LSE = (float*)(F.ws + WS_LSE);
    const int total = 3 * M * 8, nth = F.G * NT;
    for (int idx = blockIdx.x * NT + F.tid; idx < total; idx += nth) {
        const int h = idx & 7, m = (idx >> 3) & (M - 1), g = idx >> 17;
        const int t = m & (T - 1), dil = (g == 0) ? 1 : (g == 1 ? 4 : 16);
        const float slope = exp2f(-(float)(h + 1));
        const bf16* qp = P + (size_t)m * IN1 + g * 1536 + h * 64;
        float q[64], o[64];
#pragma unroll
        for (int c = 0; c < 8; ++c) { const u32x4 w = *(const u32x4*)(qp + 8 * c);
            q[8 * c + 0] = bflo(w.x); q[8 * c + 1] = bfhi(w.x); q[8 * c + 2] = bflo(w.y); q[8 * c + 3] = bfhi(w.y); q[8 * c + 4] = bflo(w.z); q[8 * c + 5] = bfhi(w.z); q[8 * c + 6] = bflo(w.w); q[8 * c + 7] = bfhi(w.w); }
#pragma unroll
        for (int d = 0; d < 64; ++d) o[d] = 0.f;
        float mx = -1e30f, den = 0.f;
        for (int j = 0; j <= 128; ++j) {
            const int tk = t - j * dil; if (tk < 0) break;
            const bf16* kp = P + (size_t)(m - j * dil) * IN1 + g * 1536 + 512 + h * 64; const bf16* vp = kp + 512;
            float s = 0.f;
#pragma unroll
            for (int c = 0; c < 8; ++c) { const u32x4 w = *(const u32x4*)(kp + 8 * c);
                s += q[8 * c + 0] * bflo(w.x) + q[8 * c + 1] * bfhi(w.x) + q[8 * c + 2] * bflo(w.y) + q[8 * c + 3] * bfhi(w.y) + q[8 * c + 4] * bflo(w.z) + q[8 * c + 5] * bfhi(w.z) + q[8 * c + 6] * bflo(w.w) + q[8 * c + 7] * bfhi(w.w); }
            s = s * 0.125f - slope * (float)(j * dil);
            const float mn = fmaxf(mx, s), corr = __expf(mx - mn), p = __expf(s - mn);
            den = den * corr + p; mx = mn;
#pragma unroll
            for (int c = 0; c < 8; ++c) { const u32x4 w = *(const u32x4*)(vp + 8 * c);
                o[8 * c + 0] = o[8 * c + 0] * corr + p * bflo(w.x); o[8 * c + 1] = o[8 * c + 1] * corr + p * bfhi(w.x); o[8 * c + 2] = o[8 * c + 2] * corr + p * bflo(w.y); o[8 * c + 3] = o[8 * c + 3] * corr + p * bfhi(w.y);
                o[8 * c + 4] = o[8 * c + 4] * corr + p * bflo(w.z); o[8 * c + 5] = o[8 * c + 5] * corr + p * bfhi(w.z); o[8 * c + 6] = o[8 * c + 6] * corr + p * bflo(w.w); o[8 * c + 7] = o[8 * c + 7] * corr + p * bfhi(w.w); }
        }
        const float inv = 1.f / den;
        bf16* op = OG + ((size_t)g * M + m) * 512 + h * 64;
#pragma unroll
        for (int c = 0; c < 8; ++c) { u32x4 w; w.x = pk2(o[8 * c + 0] * inv, o[8 * c + 1] * inv); w.y = pk2(o[8 * c + 2] * inv, o[8 * c + 3] * inv); w.z = pk2(o[8 * c + 4] * inv, o[8 * c + 5] * inv); w.w = pk2(o[8 * c + 6] * inv, o[8 * c + 7] * inv);
            *(u32x4*)(op + 8 * c) = w; }
        LSE[((size_t)g * M + m) * 8 + h] = mx + __logf(den);
    }
}
__device__ __forceinline__ void ph_attn_mfma(Frame& F) {
    const bf16* P = (const bf16*)(F.ws + WS_P); bf16* OG = (bf16*)(F.ws + WS_OG); float* LSE = (float*)(F.ws + WS_LSE);
    LAS bf16* Vl = (LAS bf16*)F.lds;
    const int tid = F.tid, lane = F.lane, w = F.wave, fr = lane & 15, fq = lane >> 4;
    const int ct0 = 2 * (w >> 1);
    const unsigned vaddr0 = (unsigned)(size_t)(F.lds) + (unsigned)(((16 * ct0 + 4 * fq + (fr >> 2)) * 72 + 4 * (fr & 3)) * 2);
    for (int u = blockIdx.x; u < 3072; u += F.G) {
        const int g = u >> 10, rem = u & 1023, b = rem >> 9, h = (rem >> 6) & 7, x = rem & 63;
        const int dil = (g == 0) ? 1 : (g == 1 ? 4 : 16), nnb = 64 / dil, nb = x % nnb, r = x / nnb;
        const long rowbase = (long)b * T + (long)nb * 128 * dil + r;
        const bf16* Qp = P + g * 1536 + h * 64; const bf16* Kp = Qp + 512; const bf16* Vp = Qp + 1024;
        const float sl = exp2f(-(float)(h + 1)) * (float)dil;
        __syncthreads();
#pragma unroll
        for (int it = 0; it < 4; ++it) { const int kr = (tid >> 3) + 64 * it, ch = tid & 7; u32x4 v = (u32x4){0u, 0u, 0u, 0u};
            if (nb > 0 || kr >= 128) v = *(const u32x4*)(Vp + (size_t)(rowbase + (long)(kr - 128) * dil) * IN1 + ch * 8);
            *(LAS u32x4*)(Vl + kr * 72 + ch * 8) = v; }
        bf16x8_t qf[2];
        { const bf16* qrow = Qp + (size_t)(rowbase + (long)(16 * w + fr) * dil) * IN1 + 8 * fq; qf[0] = *(const bf16x8_t*)qrow; qf[1] = *(const bf16x8_t*)(qrow + 32); }
        f32x4 s[10];
#pragma unroll
        for (int c = 0; c < 10; ++c) { const int kr = 16 * (ct0 + c) + fr; bf16x8_t k0 = (bf16x8_t){0, 0, 0, 0, 0, 0, 0, 0}, k1 = k0;
            if (nb > 0 || kr >= 128) { const bf16* krow = Kp + (size_t)(rowbase + (long)(kr - 128) * dil) * IN1 + 8 * fq; k0 = *(const bf16x8_t*)krow; k1 = *(const bf16x8_t*)(krow + 32); }
            s[c] = __builtin_amdgcn_mfma_f32_16x16x32_bf16(k0, qf[0], (f32x4){0.f, 0.f, 0.f, 0.f}, 0, 0, 0);
            s[c] = __builtin_amdgcn_mfma_f32_16x16x32_bf16(k1, qf[1], s[c], 0, 0, 0); }
        const int l = 16 * w + fr;
        float mx = -1e30f;
#pragma unroll
        for (int c = 0; c < 10; ++c)
#pragma unroll
            for (int rg = 0; rg < 4; ++rg) { const int kr = 16 * (ct0 + c) + 4 * fq + rg, steps = l + 128 - kr;
                const bool ok = steps >= 0 && steps <= 128 && (nb > 0 || kr >= 128);
                const float v = ok ? s[c][rg] * 0.125f - sl * (float)steps : -1e30f; s[c][rg] = v; mx = fmaxf(mx, v); }
        mx = fmaxf(mx, __shfl_xor(mx, 16)); mx = fmaxf(mx, __shfl_xor(mx, 32));
        float den = 0.f;
#pragma unroll
        for (int c = 0; c < 10; ++c)
#pragma unroll
            for (int rg = 0; rg < 4; ++rg) { const float p = (s[c][rg] > -1e29f) ? __expf(s[c][rg] - mx) : 0.f; s[c][rg] = p; den += p; }
        den += __shfl_xor(den, 16); den += __shfl_xor(den, 32);
        bf16x8_t pf[5];
#pragma unroll
        for (int k = 0; k < 5; ++k) { u32x4 wv; wv.x = pg8::cvt_pk_bf16(s[2 * k][0], s[2 * k][1]); wv.y = pg8::cvt_pk_bf16(s[2 * k][2], s[2 * k][3]);
            wv.z = pg8::cvt_pk_bf16(s[2 * k + 1][0], s[2 * k + 1][1]); wv.w = pg8::cvt_pk_bf16(s[2 * k + 1][2], s[2 * k + 1][3]); pf[k] = __builtin_bit_cast(bf16x8_t, wv); }
        __syncthreads();
        f32x4 o[4];
#pragma unroll
        for (int dt = 0; dt < 4; ++dt) o[dt] = (f32x4){0.f, 0.f, 0.f, 0.f};
#pragma unroll
        for (int k = 0; k < 5; ++k) {
            u32x2 a0, a1, a2, a3, a4, a5, a6, a7; const unsigned va = vaddr0 + (unsigned)(k * 32 * 72 * 2);
            asm volatile("ds_read_b64_tr_b16 %0, %8\n\tds_read_b64_tr_b16 %1, %8 offset:2304\n\tds_read_b64_tr_b16 %2, %8 offset:32\n\tds_read_b64_tr_b16 %3, %8 offset:2336\n\t"
                         "ds_read_b64_tr_b16 %4, %8 offset:64\n\tds_read_b64_tr_b16 %5, %8 offset:2368\n\tds_read_b64_tr_b16 %6, %8 offset:96\n\tds_read_b64_tr_b16 %7, %8 offset:2400\n\ts_waitcnt lgkmcnt(0)"
                         : "=&v"(a0), "=&v"(a1), "=&v"(a2), "=&v"(a3), "=&v"(a4), "=&v"(a5), "=&v"(a6), "=&v"(a7) : "v"(va) : "memory");
            __builtin_amdgcn_sched_barrier(0);
            o[0] = __builtin_amdgcn_mfma_f32_16x16x32_bf16(__builtin_bit_cast(bf16x8_t, (u32x4){a0.x, a0.y, a1.x, a1.y}), pf[k], o[0], 0, 0, 0);
            o[1] = __builtin_amdgcn_mfma_f32_16x16x32_bf16(__builtin_bit_cast(bf16x8_t, (u32x4){a2.x, a2.y, a3.x, a3.y}), pf[k], o[1], 0, 0, 0);
            o[2] = __builtin_amdgcn_mfma_f32_16x16x32_bf16(__builtin_bit_cast(bf16x8_t, (u32x4){a4.x, a4.y, a5.x, a5.y}), pf[k], o[2], 0, 0, 0);
            o[3] = __builtin_amdgcn_mfma_f32_16x16x32_bf16(__builtin_bit_cast(bf16x8_t, (u32x4){a6.x, a6.y, a7.x, a7.y}), pf[k], o[3], 0, 0, 0);
        }
        const float inv = 1.f / den; const size_t tok = (size_t)(rowbase + (long)l * dil);
        bf16* op = OG + ((size_t)g * M + tok) * 512 + h * 64 + 4 * fq;
#pragma unroll
        for (int dt = 0; dt < 4; ++dt) { u32x2 wv; wv.x = pg8::cvt_pk_bf16(o[dt][0] * inv, o[dt][1] * inv); wv.y = pg8::cvt_pk_bf16(o[dt][2] * inv, o[dt][3] * inv); *(u32x2*)(op + 16 * dt) = wv; }
        if (fq == 0) LSE[((size_t)g * M + tok) * 8 + h] = mx + __logf(den);
    }
}

__device__ __forceinline__ void ph_merge(Frame& F) {
    const bf16* OG = (const bf16*)(F.ws + WS_OG); const float* LSE = (const float*)(F.ws + WS_LSE); bf16* Y2 = (bf16*)(F.ws + WS_Y2);
    const int total = M * 64, nth = F.G * NT;
    for (int idx = blockIdx.x * NT + F.tid; idx < total; idx += nth) {
        const int m = idx >> 6, c8 = idx & 63, h = c8 >> 3;
        const float l0 = LSE[((size_t)0 * M + m) * 8 + h], l1 = LSE[((size_t)1 * M + m) * 8 + h], l2 = LSE[((size_t)2 * M + m) * 8 + h];
        const float mx = fmaxf(l0, fmaxf(l1, l2)); float w0 = __expf(l0 - mx), w1 = __expf(l1 - mx), w2 = __expf(l2 - mx); const float inv = 1.f / (w0 + w1 + w2);
        w0 *= inv; w1 *= inv; w2 *= inv;
        const u32x4 a = *(const u32x4*)(OG + ((size_t)0 * M + m) * 512 + c8 * 8), b = *(const u32x4*)(OG + ((size_t)1 * M + m) * 512 + c8 * 8), c = *(const u32x4*)(OG + ((size_t)2 * M + m) * 512 + c8 * 8);
        u32x4 o;
        o.x = pk2(w0 * bflo(a.x) + w1 * bflo(b.x) + w2 * bflo(c.x), w0 * bfhi(a.x) + w1 * bfhi(b.x) + w2 * bfhi(c.x));
        o.y = pk2(w0 * bflo(a.y) + w1 * bflo(b.y) + w2 * bflo(c.y), w0 * bfhi(a.y) + w1 * bfhi(b.y) + w2 * bfhi(c.y));
        o.z = pk2(w0 * bflo(a.z) + w1 * bflo(b.z) + w2 * bflo(c.z), w0 * bfhi(a.z) + w1 * bfhi(b.z) + w2 * bfhi(c.z));
        o.w = pk2(w0 * bflo(a.w) + w1 * bflo(b.w) + w2 * bflo(c.w), w0 * bfhi(a.w) + w1 * bfhi(b.w) + w2 * bfhi(c.w));
        *(u32x4*)(Y2 + (size_t)m * 512 + c8 * 8) = o;
    }
}

__device__ __forceinline__ void gemm_inproj(Frame& F, const void* A, size_t wt, int N) {
    pg8::StaticOrder S; S.init(A, F.ws + wt, M, N, D, F.G, (int)blockIdx.x); pg8::EpiBf16 E{(bf16*)(F.ws + WS_P), N};
    pg8::gemm_phase<pg8::EpiBf16, pg8::StaticOrder, true, false>(F.lds, D, S, E);
}
template <bool BASE_BF16>
__device__ __forceinline__ void gemm_outproj(Frame& F, size_t a, size_t wt, int K, const void* base) {
    pg8::StaticOrder S; S.init(F.ws + a, F.ws + wt, M, D, K, F.G, (int)blockIdx.x); pg8::EpiResBf16<BASE_BF16> E{base, (bf16*)((char*)F.out + 32 * MiB), ALPHA};
    pg8::gemm_phase<pg8::EpiResBf16<BASE_BF16>, pg8::StaticOrder, false, false>(F.lds, K, S, E);
}
__device__ __forceinline__ void gemm_moe1(Frame& F, int layer) {
    pg8::MoeOrder S{F.ctl + CW_CNT + layer * 32 * 64, (const int*)(F.ws + WS_LIST), (const char*)(F.ws + WS_XB), (const char*)(F.ws + WS_EW), 2, F.G, (int)blockIdx.x, D, 0};
    pg8::EpiSwiGLU E{(bf16*)(F.ws + WS_HID)}; pg8::gemm_phase<pg8::EpiSwiGLU, pg8::MoeOrder, true, true>(F.lds, D, S, E);
}
__device__ __forceinline__ void gemm_moe2(Frame& F, int layer) {
    pg8::MoeOrder S{F.ctl + CW_CNT + layer * 32 * 64, (const int*)(F.ws + WS_LIST), (const char*)(F.ws + WS_HID), (const char*)(F.ws + WS_EW + EW_DN), 4, F.G, (int)blockIdx.x, DE, 1};
    pg8::EpiMoeOut E{(bf16*)(F.ws + WS_YB), (const int*)(F.ws + WS_LIST)}; pg8::gemm_phase<pg8::EpiMoeOut, pg8::MoeOrder, true, false>(F.lds, DE, S, E);
}

struct Args { const float* in[18]; float* out; unsigned char* ws; int ph_lo, ph_hi, li, pad; };
__global__ void __launch_bounds__(NT, 2) mega_fwd(Args args) {
    extern __shared__ __attribute__((aligned(16))) unsigned char lds_raw[];
    Frame F;
    F.lds = (LAS unsigned char*)lds_raw;
    F.tid = threadIdx.x; F.lane = F.tid & 63; F.wave = __builtin_amdgcn_readfirstlane(F.tid >> 6);
    F.G = gridDim.x; { const int bx = blockIdx.x; F.vcu = (F.G % 8 == 0) ? (bx % 8) * (F.G / 8) + bx / 8 : bx; }
#pragma unroll
    for (int i = 0; i < 18; ++i) F.in[i] = args.in[i];
    F.out = args.out; F.ws = args.ws; F.ctl = (unsigned*)(args.ws + WS_CTL);
    volatile LAS unsigned* MISC = (volatile LAS unsigned*)(F.lds + LDS_BYTES - 128);
    if (F.tid < 32) MISC[F.tid] = 0u;
    __syncthreads();
    XcdBarrier bar; bar.bar = F.ctl + CW_BAR; bar.x = 0; bar.st = nullptr;
    if (MK_N_LAUNCHES == 1) bar = xcd_barrier_post(F.ctl + CW_BAR, MISC + 8);
    const int lo = args.ph_lo, hi = args.ph_hi;
#define IN(k) (lo <= (k) && (k) < hi)
#define SEAM(k) do { if (IN(k) && IN((k) + 1)) xcd_barrier(bar); } while (0)
#define DUP(k) ((PROBE_DUP >> (k)) & 1)
#define PHASE(k, ...) do { if (IN(k)) { __VA_ARGS__; if (DUP(k)) { xcd_barrier(bar); __VA_ARGS__; } } SEAM(k); } while (0)
    PHASE(0, ph0_convert(F));
    PHASE(1, gemm_inproj(F, F.ws + WS_XB, WS_WT0, NP0));
    PHASE(2, ph_mix_a(F); xcd_barrier(bar); ph_mix_b(F));
    PHASE(3, ph_mix_c(F));
    PHASE(4, gemm_outproj<false>(F, WS_Y, WS_WO0, D, F.in[0]));
    if (IN(5)) { convert_experts(F, 0); if (DUP(5)) { __syncthreads(); convert_experts(F, 0); } __syncthreads(); ph_ln<0, true, 0>(F, 0); } SEAM(5);
    PHASE(6, gemm_moe1(F, 0));
    PHASE(7, gemm_moe2(F, 0));
    if (IN(8)) { ph_ln<1, false, 1>(F, 0); __syncthreads(); convert_experts(F, 1); if (DUP(8)) { __syncthreads(); convert_experts(F, 1); } } SEAM(8);
    PHASE(9, gemm_inproj(F, F.out, WS_WT1, IN1));
    PHASE(10, ph_attn_mfma(F));
    PHASE(11, ph_merge(F));
    PHASE(12, gemm_outproj<true>(F, WS_Y2, WS_WO1, 512, F.out));
    if (IN(13)) { ph_ln<0, true, 0>(F, 1); } SEAM(13);
    PHASE(14, gemm_moe1(F, 1));
    PHASE(15, gemm_moe2(F, 1));
    if (IN(16)) { ph_ln<1, false, 2>(F, 1); }
#undef IN
#undef SEAM
#undef PHASE
#undef DUP
}

extern "C" void kernel_launch(void* const* d_in, const int* in_sizes, int n_in, void* d_out, int out_size, void* d_ws, size_t ws_size, hipStream_t stream) {
    static int grid = 0;
    if (grid == 0) {
        if (n_in != 18 || in_sizes[0] != M * D || out_size != M * D || ws_size < WS_END) {
            fprintf(stderr, "kernel_launch: unexpected problem (n_in %d, in0 %d, out %d, ws %zu < %zu)\n", n_in, n_in > 0 ? in_sizes[0] : -1, out_size, ws_size, (size_t)WS_END); grid = -1; return; }
        int dev = 0, cus = 0;
        if (hipGetDevice(&dev) != hipSuccess || hipDeviceGetAttribute(&cus, hipDeviceAttributeMultiprocessorCount, dev) != hipSuccess) { grid = -1; return; }
        if (hipFuncSetAttribute((const void*)mega_fwd, hipFuncAttributeMaxDynamicSharedMemorySize, LDS_BYTES) != hipSuccess) { fprintf(stderr, "kernel_launch: hipFuncSetAttribute failed\n"); grid = -1; return; }
        int per_cu = 0;
        if (hipOccupancyMaxActiveBlocksPerMultiprocessor(&per_cu, (const void*)mega_fwd, NT, LDS_BYTES) != hipSuccess || per_cu < 1) fprintf(stderr, "kernel_launch: occupancy query says %d\n", per_cu);
        (void)hipGetLastError();
        grid = cus;
    }
    if (grid < 0) return;
    (void)hipMemsetAsync((char*)d_ws + WS_CTL, 0, CTL_ZERO_BYTES, stream);
    Args a{};
    for (int i = 0; i < 18; ++i) a.in[i] = (const float*)d_in[i];
    a.out = (float*)d_out; a.ws = (unsigned char*)d_ws;
    if (MK_N_LAUNCHES == 1) {
        a.ph_lo = 0; a.ph_hi = N_PHASES; a.li = 0;
        hipLaunchKernelGGL(mega_fwd, dim3(grid), dim3(NT), LDS_BYTES, stream, a);
    } else {
        for (int p = 0; p < N_PHASES; ++p) { a.ph_lo = p; a.ph_hi = p + 1; a.li = p; hipLaunchKernelGGL(mega_fwd, dim3(grid), dim3(NT), LDS_BYTES, stream, a); }
    }
}
```

```cpp
#include <hip/hip_runtime.h>
#include <cstdio>
#include <cstdint>

#ifndef PROBE_DUP
#define PROBE_DUP 0
#endif
#ifndef MK_N_LAUNCHES
#define MK_N_LAUNCHES 1
#endif

#define LAS __attribute__((address_space(3)))
typedef unsigned short bf16;
typedef float f32x4 __attribute__((ext_vector_type(4)));
typedef unsigned u32x4 __attribute__((ext_vector_type(4)));
typedef unsigned u32x2 __attribute__((ext_vector_type(2)));
typedef short bf16x8_t __attribute__((ext_vector_type(8)));
#define RLX_AGENT __ATOMIC_RELAXED, __HIP_MEMORY_SCOPE_AGENT
#define LDS_WAIT() asm volatile("s_waitcnt lgkmcnt(0)" ::: "memory")
#define VM_WAIT() asm volatile("s_waitcnt vmcnt(0)" ::: "memory")

constexpr int NWAVES = 8, NT = NWAVES * 64;
constexpr int BATCH = 2, T = 8192, D = 1024, M = BATCH * T;
constexpr int IN0 = 4104, IN1 = 4608, NP0 = 4096;
constexpr int NE = 32, DE = 256;
constexpr float ALPHA = 1.41421356237309515f;
constexpr float LN_EPS = 1e-5f;
constexpr float KSCALE = 0.08838834764831845f;
constexpr int N_PHASES = 17;

constexpr size_t MiB = 1u << 20;
constexpr size_t WS_CTL = 0, CTL_ZERO_BYTES = 1 * MiB;
constexpr size_t WS_G = 1 * MiB;
constexpr size_t WS_EIDX = WS_G + 512 * 1024;
constexpr size_t WS_GATEV = WS_EIDX + 128 * 1024;
constexpr size_t WS_WT0 = 2 * MiB;
constexpr size_t WS_WO0 = 10 * MiB;
constexpr size_t WS_WT1 = 12 * MiB;
constexpr size_t WS_WO1 = 21 * MiB;
constexpr size_t WS_SE = 22 * MiB;
constexpr size_t WS_EW = WS_SE;
constexpr size_t EW_STRIDE = 3 * MiB / 2, EW_DN = 1 * MiB;
constexpr size_t WS_LIST = WS_SE + 48 * MiB;
constexpr size_t WS_LSE = WS_SE + 50 * MiB;
constexpr size_t WS_XB = 86 * MiB;
constexpr size_t WS_Y = 118 * MiB;
constexpr size_t WS_OG = WS_XB;
constexpr size_t WS_Y2 = WS_XB + 48 * MiB;
constexpr size_t WS_P = 150 * MiB;
constexpr size_t WS_YB = WS_P;
constexpr size_t WS_HID = WS_P + 64 * MiB;
constexpr size_t WS_END = 294 * MiB;
constexpr size_t WS_QKC = WS_SE;

constexpr int CW_BAR = 4096;
constexpr int CW_CNT = 16384;

constexpr int LDS_BYTES = 147456;

__device__ __forceinline__ unsigned f2bf(float f) { unsigned u = __builtin_bit_cast(unsigned, f); return (u + 0x7fffu + ((u >> 16) & 1u)) >> 16; }
__device__ __forceinline__ unsigned pk2(float lo, float hi) { return f2bf(lo) | (f2bf(hi) << 16); }
__device__ __forceinline__ float bf2f(unsigned b) { return __builtin_bit_cast(float, b << 16); }
__device__ __forceinline__ float bflo(unsigned w) { return __builtin_bit_cast(float, w << 16); }
__device__ __forceinline__ float bfhi(unsigned w) { return __builtin_bit_cast(float, w & 0xffff0000u); }
__device__ __forceinline__ float wave_sum(float v) {
#pragma unroll
    for (int o = 1; o < 64; o <<= 1) v += __shfl_xor(v, o);
    return v;
}
__device__ __forceinline__ float sigmoidf_(float x) { return 1.f / (1.f + __expf(-x)); }
__device__ __forceinline__ float siluf_(float x) { return x / (1.f + __expf(-x)); }

#define XB_TMO      128
#define XB_XCNT(j)  (256  + 64 * (j))
#define XB_XSUB(j)  (1280 + 64 * (j))
#define XB_XGEN(j)  (2304 + 64 * (j))
#define XB_TOP      3328
#define XB_TOPGEN   3392
#define XCD_BAR_WORDS 3456
#define XB_SPIN_CAP (1u << 22)
__device__ __forceinline__ unsigned xb_ld(unsigned* p)              { return __hip_atomic_load(p, __ATOMIC_RELAXED, __HIP_MEMORY_SCOPE_AGENT); }
__device__ __forceinline__ unsigned xb_add(unsigned* p, unsigned v) { return __hip_atomic_fetch_add(p, v, __ATOMIC_RELAXED, __HIP_MEMORY_SCOPE_AGENT); }
__device__ __forceinline__ unsigned xb_xcc_id() { return (unsigned)__builtin_amdgcn_s_getreg((3 << 11) | 20) & 0xFu; }
#define XB_SPIN(cond, bar) do { unsigned _sp = 0; while (cond) { __builtin_amdgcn_s_sleep(1); \
    if ((++_sp & 255u) == 0u) { if (xb_ld(&(bar)[XB_TMO])) break; if (_sp > XB_SPIN_CAP) { atomicAdd(&(bar)[XB_TMO], 1u); break; } } } } while (0)
struct XcdBarrier { unsigned* bar; unsigned x; volatile LAS unsigned* st; };
__device__ __forceinline__ XcdBarrier xcd_barrier_post(unsigned* bar, volatile LAS unsigned* st) {
    XcdBarrier b; b.bar = bar; b.x = xb_xcc_id(); b.st = st;
    if (threadIdx.x == 0) (void)xb_add(&bar[XB_XCNT(b.x)], 1u);
    return b;
}
__device__ __forceinline__ void xcd_barrier_complete(unsigned* bar, unsigned x, unsigned& nloc, unsigned& nx) {
    const unsigned G = gridDim.x * gridDim.y * gridDim.z;
    unsigned sum, cnt, mine, sp = 0u;
    for (;;) {
        sum = 0u; cnt = 0u; mine = 0u;
#pragma unroll
        for (unsigned j = 0; j < 16; ++j) { const unsigned c = xb_ld(&bar[XB_XCNT(j)]); sum += c; cnt += (c > 0u) ? 1u : 0u; mine = (j == x) ? c : mine; }
        if (sum == G) break;
        __builtin_amdgcn_s_sleep(1);
        if ((++sp & 255u) == 0u) { if (xb_ld(&bar[XB_TMO])) break; if (sp > XB_SPIN_CAP) { atomicAdd(&bar[XB_TMO], 1u); break; } }
    }
    nloc = mine > 0u ? mine : 1u; nx = cnt > 0u ? cnt : 1u;
}
__device__ __forceinline__ void xcd_barrier(const XcdBarrier& b) {
    asm volatile("s_waitcnt vmcnt(0)" ::: "memory");
    __syncthreads();
    if (threadIdx.x == 0) {
        unsigned* bar = b.bar;
        __builtin_amdgcn_s_waitcnt(0);
        unsigned nloc = b.st[0], nx = b.st[1];
        if (nloc == 0u) { xcd_barrier_complete(bar, b.x, nloc, nx); b.st[0] = nloc; b.st[1] = nx; }
        const unsigned old = xb_add(&bar[XB_XSUB(b.x)], 1u);
        const unsigned gen = old / nloc;
        if (old + 1u == (gen + 1u) * nloc) {
            __builtin_amdgcn_fence(__ATOMIC_RELEASE, "agent");
            asm volatile("s_waitcnt vmcnt(0)" ::: "memory");
            const unsigned og = xb_add(&bar[XB_TOP], 1u);
            const unsigned tg = og / nx;
            if (og + 1u == (tg + 1u) * nx) xb_add(&bar[XB_TOPGEN], 1u);
            else XB_SPIN(xb_ld(&bar[XB_TOPGEN]) == tg, bar);
            __builtin_amdgcn_fence(__ATOMIC_ACQUIRE, "agent");
            xb_add(&bar[XB_XGEN(b.x)], 1u);
            asm volatile("s_waitcnt vmcnt(0)" ::: "memory");
        } else {
            XB_SPIN(xb_ld(&bar[XB_XGEN(b.x)]) == gen, bar);
            __builtin_amdgcn_fence(__ATOMIC_ACQUIRE, "agent");
            asm volatile("s_waitcnt vmcnt(0)" ::: "memory");
        }
    }
    __syncthreads();
}

struct Frame {
    LAS unsigned char* lds;
    unsigned* ctl;
    int tid, lane, wave, vcu, G;
    const float* in[18];
    float* out;
    unsigned char* ws;
};

namespace pg8 {
typedef short bf16x8 __attribute__((ext_vector_type(8)));
constexpr int BM = 256, BK = 64, HALF = 128, HTB = HALF * BK * 2, STAGE_BYTES = 8 * HTB, NXCD = 8, WGM = 8;
__host__ __device__ __forceinline__ int lds_byte(int r, int c) { const int st = (r >> 4) * 2 + (c >> 5), rr = r & 15, cc = c & 31, ob = rr * 64 + cc * 2; return st * 1024 + (ob ^ (((ob >> 9) & 1) << 5)); }
__host__ __device__ __forceinline__ void stage_rc(int b, int& R, int& C) { const int st = b / 1024, sb = b % 1024, swz = sb ^ (((sb >> 9) & 1) << 5); R = (st >> 1) * 16 + swz / 64; C = (st & 1) * 32 + (swz % 64) / 2; }
__host__ __device__ __forceinline__ int perm32(int rho) { const int n = rho >> 4, i = rho & 15; return 8 * (i >> 2) + 4 * n + (i & 3); }
struct Unit { int pm, pn, e, cnt, hb; };
typedef __bf16 bf16n2 __attribute__((ext_vector_type(2)));
typedef float f32x2n __attribute__((ext_vector_type(2)));
__device__ __forceinline__ unsigned cvt_pk_bf16(float lo, float hi) { const bf16n2 v = __builtin_convertvector((f32x2n){lo, hi}, bf16n2); return __builtin_bit_cast(unsigned, v); }

struct StaticOrder {
    int nM, nN, nwg, G, c, K; const char* A; const char* Bt;
    __device__ void init(const void* A_, const void* Bt_, int M_, int N_, int K_, int G_, int c_) { A = (const char*)A_; Bt = (const char*)Bt_; nM = M_ / BM; nN = N_ / BM; nwg = nM * nN; G = G_; c = c_; K = K_; }
    __device__ bool next(int i, Unit& u) const {
        const long L = (long)i * G + c; if (L >= nwg) return false;
        int wgid = (int)L; { const int q = nwg / NXCD, r = nwg % NXCD, xcd = wgid % NXCD, off = wgid / NXCD; wgid = (xcd < r ? xcd * (q + 1) : r * (q + 1) + (xcd - r) * q) + off; }
        const int nig = WGM * nN, gid = wgid / nig, fm = gid * WGM, gsz = (nM - fm) < WGM ? (nM - fm) : WGM;
        u.pm = fm + ((wgid % nig) % gsz); u.pn = (wgid % nig) / gsz; u.e = 0; u.cnt = 0; u.hb = 0; return true;
    }
    __device__ __forceinline__ void base(const Unit& u, const char*& cA, const char*& cB) const { cA = A + (size_t)u.pm * BM * K * 2; cB = Bt + (size_t)u.pn * BM * K * 2; }
    __device__ __forceinline__ unsigned rowoff(const Unit&, int) const { return 0u; }
};

struct EpiBf16 {
    static constexpr bool PERM = true;
    bf16* O; int ldc;
    __device__ __forceinline__ void operator()(const f32x4 (&acc)[2][2][4][2], const Unit& u, int wr, int wc, int fr, int fq) const {
        const int row0 = u.pm * BM + wr * 64 + fr, col0 = u.pn * BM + wc * 32 + 8 * fq;
#pragma unroll
        for (int ai = 0; ai < 2; ++ai)
#pragma unroll
            for (int m = 0; m < 4; ++m) { bf16* rowp = O + (size_t)(row0 + ai * HALF + m * 16) * ldc + col0;
#pragma unroll
                for (int bj = 0; bj < 2; ++bj) { const f32x4 v0 = acc[ai][bj][m][0], v1 = acc[ai][bj][m][1];
                    u32x4 w; w.x = cvt_pk_bf16(v0[0], v0[1]); w.y = cvt_pk_bf16(v0[2], v0[3]); w.z = cvt_pk_bf16(v1[0], v1[1]); w.w = cvt_pk_bf16(v1[2], v1[3]);
                    *(u32x4*)(rowp + bj * HALF) = w; } }
    }
};
template <bool BASE_BF16>
struct EpiResBf16 {
    static constexpr bool PERM = true;
    const void* base; bf16* out; float alpha;
    __device__ __forceinline__ void operator()(const f32x4 (&acc)[2][2][4][2], const Unit& u, int wr, int wc, int fr, int fq) const {
        const int col0 = u.pn * BM + wc * 32 + 8 * fq;
#pragma unroll
        for (int ai = 0; ai < 2; ++ai)
#pragma unroll
            for (int m = 0; m < 4; ++m) { const size_t off = (size_t)(u.pm * BM + ai * HALF + wr * 64 + m * 16 + fr) * 1024 + col0;
#pragma unroll
                for (int bj = 0; bj < 2; ++bj) { f32x4 b0, b1;
                    if (BASE_BF16) { const u32x4 x = *(const u32x4*)((const bf16*)base + off + bj * HALF); b0 = (f32x4){bflo(x.x), bfhi(x.x), bflo(x.y), bfhi(x.y)}; b1 = (f32x4){bflo(x.z), bfhi(x.z), bflo(x.w), bfhi(x.w)}; }
                    else { b0 = *(const f32x4*)((const float*)base + off + bj * HALF); b1 = *(const f32x4*)((const float*)base + off + bj * HALF + 4); }
                    const f32x4 v0 = b0 * alpha + acc[ai][bj][m][0], v1 = b1 * alpha + acc[ai][bj][m][1];
                    u32x4 w; w.x = cvt_pk_bf16(v0[0], v0[1]); w.y = cvt_pk_bf16(v0[2], v0[3]); w.z = cvt_pk_bf16(v1[0], v1[1]); w.w = cvt_pk_bf16(v1[2], v1[3]);
                    *(u32x4*)(out + off + bj * HALF) = w; }
                if (m & 1) asm volatile("" ::: "memory"); }
    }
};

struct MoeOrder {
    const unsigned* cnt; const int* LIST; const char* A; const char* B; int NTN, G, c, K, mode;
    __device__ bool next(int i, Unit& u) const {
        const int L = i * G + c; int base = 0, hb = 0;
        for (int e = 0; e < 32; ++e) { const int cc = (int)cnt[e * 64]; const int nmb = (cc + 255) >> 8; const int ntl = nmb * NTN;
            if (L < base + ntl) { const int r = L - base; u.e = e; u.pm = r / NTN; u.pn = r % NTN; u.cnt = cc; u.hb = hb; return true; }
            base += ntl; hb += nmb << 8; }
        return false;
    }
    __device__ __forceinline__ void base(const Unit& u, const char*& cA, const char*& cB) const {
        cA = mode == 0 ? A : A + (size_t)(u.hb + u.pm * 256) * K * 2; cB = B + (size_t)u.e * EW_STRIDE + (size_t)u.pn * 256 * K * 2; }
    __device__ __forceinline__ unsigned rowoff(const Unit& u, int r) const { int i = u.pm * 256 + r; i = i < u.cnt ? i : 0; return (unsigned)(LIST[u.e * M + i] >> 1) * 2048u; }
};
struct EpiSwiGLU {
    static constexpr bool PERM = true;
    bf16* HID;
    __device__ __forceinline__ void operator()(const f32x4 (&acc)[2][2][4][2], const Unit& u, int wr, int wc, int fr, int fq) const {
#pragma unroll
        for (int ai = 0; ai < 2; ++ai)
#pragma unroll
            for (int m = 0; m < 4; ++m) { const int i = u.pm * 256 + ai * HALF + wr * 64 + m * 16 + fr;
                if (i < u.cnt) { const f32x4 g0 = acc[ai][0][m][0], g1 = acc[ai][0][m][1], u0 = acc[ai][1][m][0], u1 = acc[ai][1][m][1];
                    u32x4 w; w.x = cvt_pk_bf16(siluf_(g0[0]) * u0[0], siluf_(g0[1]) * u0[1]); w.y = cvt_pk_bf16(siluf_(g0[2]) * u0[2], siluf_(g0[3]) * u0[3]);
                    w.z = cvt_pk_bf16(siluf_(g1[0]) * u1[0], siluf_(g1[1]) * u1[1]); w.w = cvt_pk_bf16(siluf_(g1[2]) * u1[2], siluf_(g1[3]) * u1[3]);
                    *(u32x4*)(HID + (size_t)(u.hb + i) * DE + u.pn * 128 + wc * 32 + 8 * fq) = w; } }
    }
};
struct EpiMoeOut {
    static constexpr bool PERM = true;
    bf16* YB; const int* LIST;
    __device__ __forceinline__ void operator()(const f32x4 (&acc)[2][2][4][2], const Unit& u, int wr, int wc, int fr, int fq) const {
#pragma unroll
        for (int ai = 0; ai < 2; ++ai)
#pragma unroll
            for (int m = 0; m < 4; ++m) { const int i = u.pm * 256 + ai * HALF + wr * 64 + m * 16 + fr;
                if (i < u.cnt) { const int a = LIST[u.e * M + i]; bf16* rowp = YB + (size_t)a * D + u.pn * 256 + wc * 32 + 8 * fq;
#pragma unroll
                    for (int bj = 0; bj < 2; ++bj) { const f32x4 v0 = acc[ai][bj][m][0], v1 = acc[ai][bj][m][1];
                        u32x4 w; w.x = cvt_pk_bf16(v0[0], v0[1]); w.y = cvt_pk_bf16(v0[2], v0[3]); w.z = cvt_pk_bf16(v1[0], v1[1]); w.w = cvt_pk_bf16(v1[2], v1[3]);
                        *(u32x4*)(rowp + bj * HALF) = w; } }
                asm volatile("" ::: "memory"); }
    }
};

template <class Epi, class Sched, bool ALIGN_EPI, bool GATHER>
__device__ __forceinline__ void gemm_phase(LAS unsigned char* lds, const int K, const Sched& S, const Epi& E) {
    const int tid = threadIdx.x, wid = __builtin_amdgcn_readfirstlane(tid >> 6), lane = tid & 63, wr = wid >> 2, wc = wid & 3, fr = lane & 15, fq = lane >> 4;
    const int nt = K / BK;
    int Rr[2], Cc[2]; unsigned voffB[2];
#pragma unroll
    for (int i = 0; i < 2; ++i) { int R, C; stage_rc(tid * 16 + i * 8192, R, C); const int Rb = Epi::PERM ? ((R & ~31) + perm32(R & 31)) : R; Rr[i] = R; Cc[i] = C; voffB[i] = (unsigned)(Rb * K + C) * 2u; }
    const size_t kstep = (size_t)(BK * 2);
    const size_t hstep = (size_t)HALF * K * 2;
    const unsigned ldsw = (unsigned)wid * 1024u;
    const int aoff = lds_byte(wr * 64 + fr, fq * 8), boff = lds_byte(wc * 32 + fr, fq * 8);
#define PG8_SA(b, h) (((b) * 2 + (h)) * HTB)
#define PG8_SB(b, h) ((4 + (b) * 2 + (h)) * HTB)
#define PG8_STAGE(bufoff, gbase, voff) do { _Pragma("unroll") for (int _i = 0; _i < 2; ++_i) \
        __builtin_amdgcn_global_load_lds((const unsigned*)((const char*)(gbase) + (voff)[_i]), (LAS unsigned*)(lds + (bufoff) + ldsw + _i * 8192), 16, 0, 0); } while (0)
#define PG8_STAGE_A(bufoff, gbase, o0, o1) do { \
        __builtin_amdgcn_global_load_lds((const unsigned*)((const char*)(gbase) + (o0)), (LAS unsigned*)(lds + (bufoff) + ldsw), 16, 0, 0); \
        __builtin_amdgcn_global_load_lds((const unsigned*)((const char*)(gbase) + (o1)), (LAS unsigned*)(lds + (bufoff) + ldsw + 8192), 16, 0, 0); } while (0)
#define PG8_LDA(dst, b, h) do { _Pragma("unroll") for (int m = 0; m < 4; ++m) _Pragma("unroll") for (int k = 0; k < 2; ++k) dst[m][k] = *(const LAS bf16x8*)(lds + PG8_SA(b, h) + aoff + m * 2048 + k * 1024); } while (0)
#define PG8_LDB(dst, b, h) do { _Pragma("unroll") for (int n = 0; n < 2; ++n) _Pragma("unroll") for (int k = 0; k < 2; ++k) dst[n][k] = *(const LAS bf16x8*)(lds + PG8_SB(b, h) + boff + n * 2048 + k * 1024); } while (0)
#define PG8_MMA(ai, bj, At, Bt) do { __builtin_amdgcn_s_setprio(1); _Pragma("unroll") for (int m = 0; m < 4; ++m) _Pragma("unroll") for (int n = 0; n < 2; ++n) _Pragma("unroll") for (int k = 0; k < 2; ++k) \
        acc[ai][bj][m][n] = __builtin_amdgcn_mfma_f32_16x16x32_bf16(Bt[n][k], At[m][k], acc[ai][bj][m][n], 0, 0, 0); __builtin_amdgcn_s_setprio(0); } while (0)
#define PG8_WAIT_V(n) asm volatile("s_waitcnt vmcnt(" #n ")" ::: "memory")
#define PG8_WAIT_L(n) asm volatile("s_waitcnt lgkmcnt(" #n ")" ::: "memory")
#define PG8_BAR __builtin_amdgcn_s_barrier()
#define PG8_SCHED __builtin_amdgcn_sched_barrier(0)
#define PG8_CALC_VA(u, v) do { _Pragma("unroll") for (int _h = 0; _h < 2; ++_h) _Pragma("unroll") for (int _i = 0; _i < 2; ++_i) \
        v[_h][_i] = GATHER ? (S.rowoff(u, _h * HALF + Rr[_i]) + (unsigned)Cc[_i] * 2u) : (unsigned)((_h * HALF + Rr[_i]) * K + Cc[_i]) * 2u; } while (0)
    Unit cur, nxt; int ui = 0;
    if (!S.next(0, cur)) return;
    f32x4 acc[2][2][4][2];
#pragma unroll
    for (int a = 0; a < 2; ++a)
#pragma unroll
        for (int b = 0; b < 2; ++b)
#pragma unroll
            for (int m = 0; m < 4; ++m)
#pragma unroll
                for (int n = 0; n < 2; ++n) acc[a][b][m][n] = (f32x4){0.f, 0.f, 0.f, 0.f};
    bf16x8 At[4][2], B0[2][2], B1[2][2];
    const char* cA; const char* cB; S.base(cur, cA, cB);
    unsigned cvA[2][2], nvA[2][2];
    PG8_CALC_VA(cur, cvA);
    PG8_STAGE(PG8_SB(0, 0), cB, voffB); PG8_STAGE(PG8_SB(0, 1), cB + hstep, voffB); PG8_STAGE_A(PG8_SA(0, 0), cA, cvA[0][0], cvA[0][1]); PG8_STAGE_A(PG8_SA(0, 1), cA, cvA[1][0], cvA[1][1]);
    if (wr == 1) PG8_BAR;
    PG8_WAIT_V(2); PG8_BAR;
    PG8_STAGE(PG8_SB(1, 0), cB + kstep, voffB); PG8_STAGE_A(PG8_SA(1, 0), cA + kstep, cvA[0][0], cvA[0][1]); PG8_STAGE(PG8_SB(1, 1), cB + hstep + kstep, voffB);
    PG8_WAIT_V(6); PG8_BAR;
    for (;;) {
        const bool has_next = S.next(ui + 1, nxt);
        const char* nA = cA; const char* nB = cB;
        if (has_next) { S.base(nxt, nA, nB); PG8_CALC_VA(nxt, nvA); }
        else {
#pragma unroll
            for (int h = 0; h < 2; ++h)
#pragma unroll
                for (int i = 0; i < 2; ++i) nvA[h][i] = cvA[h][i]; }
        if (GATHER) { asm volatile("s_waitcnt vmcnt(0)" ::: "memory"); asm volatile("" : "+v"(nvA[0][0]), "+v"(nvA[0][1]), "+v"(nvA[1][0]), "+v"(nvA[1][1])); }
#pragma unroll 1
        for (int t = 0; t < nt; t += 2) {
            const bool last = (t == nt - 2);
            const char* a1 = cA + (size_t)(t + 1) * kstep;
            const char* a2 = last ? nA : cA + (size_t)(t + 2) * kstep; const char* b2 = last ? nB : cB + (size_t)(t + 2) * kstep;
            const char* a3 = a2 + kstep; const char* b3 = b2 + kstep;
            const unsigned x00 = last ? nvA[0][0] : cvA[0][0], x01 = last ? nvA[0][1] : cvA[0][1], x10 = last ? nvA[1][0] : cvA[1][0], x11 = last ? nvA[1][1] : cvA[1][1];
            PG8_LDB(B0, 0, 0); PG8_LDB(B1, 0, 1); PG8_SCHED; PG8_LDA(At, 0, 0); PG8_STAGE_A(PG8_SA(1, 1), a1, cvA[1][0], cvA[1][1]);
            PG8_WAIT_V(8); PG8_WAIT_L(0); PG8_BAR; PG8_MMA(0, 0, At, B0); PG8_MMA(0, 1, At, B1); PG8_BAR; PG8_SCHED;
            PG8_LDA(At, 0, 1); PG8_STAGE(PG8_SB(0, 0), b2, voffB); PG8_STAGE(PG8_SB(0, 1), b2 + hstep, voffB); PG8_STAGE_A(PG8_SA(0, 0), a2, x00, x01);
            PG8_WAIT_V(8); PG8_WAIT_L(0); PG8_BAR; PG8_MMA(1, 0, At, B0); PG8_MMA(1, 1, At, B1); PG8_BAR; PG8_SCHED;
            PG8_LDB(B0, 1, 0); PG8_LDB(B1, 1, 1); PG8_SCHED; PG8_LDA(At, 1, 0); PG8_STAGE_A(PG8_SA(0, 1), a2, x10, x11);
            PG8_WAIT_V(8); PG8_WAIT_L(0); PG8_BAR; PG8_MMA(0, 0, At, B0); PG8_MMA(0, 1, At, B1); PG8_BAR; PG8_SCHED;
            PG8_LDA(At, 1, 1); PG8_STAGE(PG8_SB(1, 0), b3, voffB); PG8_STAGE(PG8_SB(1, 1), b3 + hstep, voffB); PG8_STAGE_A(PG8_SA(1, 0), a3, x00, x01);
            PG8_WAIT_V(8); PG8_WAIT_L(0); PG8_BAR; PG8_MMA(1, 0, At, B0); PG8_MMA(1, 1, At, B1); PG8_BAR; PG8_SCHED;
        }
        if constexpr (ALIGN_EPI) { if (wr == 0) PG8_BAR; }
        E(acc, cur, wr, wc, fr, fq);
        if (!has_next) break;
#pragma unroll
        for (int a = 0; a < 2; ++a)
#pragma unroll
            for (int b = 0; b < 2; ++b)
#pragma unroll
                for (int m = 0; m < 4; ++m)
#pragma unroll
                    for (int n = 0; n < 2; ++n) acc[a][b][m][n] = (f32x4){0.f, 0.f, 0.f, 0.f};
        cur = nxt; cA = nA; cB = nB; ++ui;
#pragma unroll
        for (int h = 0; h < 2; ++h)
#pragma unroll
            for (int i = 0; i < 2; ++i) cvA[h][i] = nvA[h][i];
        if constexpr (ALIGN_EPI) { if (wr == 1) PG8_BAR; }
    }
    PG8_WAIT_V(0);
    if constexpr (!ALIGN_EPI) { if (wr == 0) PG8_BAR; }
    PG8_BAR;
#undef PG8_SA
#undef PG8_SB
#undef PG8_STAGE
#undef PG8_STAGE_A
#undef PG8_LDA
#undef PG8_LDB
#undef PG8_MMA
#undef PG8_WAIT_V
#undef PG8_WAIT_L
#undef PG8_BAR
#undef PG8_SCHED
#undef PG8_CALC_VA
}
}

template <class RowFn>
__device__ __forceinline__ void ngemm_tile(LAS float* sA, LAS float* sB, RowFn rowA, const bf16* Bt, int ldb, int K, float (&acc)[4][4]) {
    const int tid = threadIdx.x, tx = tid & 15, ty = tid >> 4;
#pragma unroll
    for (int i = 0; i < 4; ++i)
#pragma unroll
        for (int j = 0; j < 4; ++j) acc[i][j] = 0.f;
    const int ar = tid >> 2, ak = (tid & 3) * 8, br = tid >> 3, bk = (tid & 7) * 4;
    const bf16* ap = rowA(ar);
    const bf16* bp = Bt + (size_t)br * ldb;
    for (int k0 = 0; k0 < K; k0 += 32) {
        u32x4 av = (u32x4){0u, 0u, 0u, 0u};
        if (ap) av = *(const u32x4*)(ap + k0 + ak);
        const u32x2 bv = *(const u32x2*)(bp + k0 + bk);
        __syncthreads();
        LAS float* wa = sA + ar * 33 + ak;
        wa[0] = bflo(av.x); wa[1] = bfhi(av.x); wa[2] = bflo(av.y); wa[3] = bfhi(av.y); wa[4] = bflo(av.z); wa[5] = bfhi(av.z); wa[6] = bflo(av.w); wa[7] = bfhi(av.w);
        LAS float* wb = sB + br * 33 + bk;
        wb[0] = bflo(bv.x); wb[1] = bfhi(bv.x); wb[2] = bflo(bv.y); wb[3] = bfhi(bv.y);
        __syncthreads();
#pragma unroll 8
        for (int kk = 0; kk < 32; ++kk) {
            float a[4], b[4];
#pragma unroll
            for (int i = 0; i < 4; ++i) a[i] = sA[(ty * 4 + i) * 33 + kk];
#pragma unroll
            for (int j = 0; j < 4; ++j) b[j] = sB[(tx * 4 + j) * 33 + kk];
#pragma unroll
            for (int i = 0; i < 4; ++i)
#pragma unroll
                for (int j = 0; j < 4; ++j) acc[i][j] = fmaf(a[i], b[j], acc[i][j]);
        }
    }
}

__device__ __forceinline__ void tr_item(const float* W, int ldw, bf16* WT, int ldt, LAS float* scr, int kb, int nb, int lane) {
    const int k0 = 64 * kb, n0 = 32 * nb;
#pragma unroll 8
    for (int i = 0; i < 32; ++i) { const int kk = 2 * i + (lane >> 5); scr[kk * 33 + (lane & 31)] = W[(size_t)(k0 + kk) * ldw + n0 + (lane & 31)]; }
    LDS_WAIT(); asm volatile("" ::: "memory");
    const int c = lane & 7;
#pragma unroll
    for (int j = 0; j < 4; ++j) { const int n = (lane >> 3) + 8 * j; const LAS float* s = scr + (8 * c) * 33 + n;
        u32x4 o; o.x = pk2(s[0 * 33], s[1 * 33]); o.y = pk2(s[2 * 33], s[3 * 33]); o.z = pk2(s[4 * 33], s[5 * 33]); o.w = pk2(s[6 * 33], s[7 * 33]);
        *(u32x4*)(WT + (size_t)(n0 + n) * ldt + k0 + 8 * c) = o; }
    LDS_WAIT(); asm volatile("" ::: "memory");
}

__device__ __forceinline__ void ph0_convert(Frame& F) {
    LAS float* scr = (LAS float*)(F.lds + F.wave * 9216);
    LAS float* gw = (LAS float*)(F.lds + 8 * 9216);
    const float* w0 = F.in[1];
    for (int i = F.tid; i < 8 * 1024; i += NT) { const int j = i >> 10, k = i & 1023; gw[i] = w0[(size_t)k * IN0 + 2048 + j]; }
    __syncthreads();
    const int gwv = F.vcu * NWAVES + F.wave, NGW = F.G * NWAVES;
    bf16* WT0 = (bf16*)(F.ws + WS_WT0); bf16* WO0 = (bf16*)(F.ws + WS_WO0); bf16* WT1 = (bf16*)(F.ws + WS_WT1); bf16* WO1 = (bf16*)(F.ws + WS_WO1);
    constexpr int I0 = 16 * 64, I1 = 16 * 64, I2 = 16 * 32, I3 = 16 * 144, I4 = 8 * 32, NI = I0 + I1 + I2 + I3 + I4;
    for (int it = gwv; it < NI; it += NGW) {
        int r = it;
        if (r < I0) { tr_item(w0, IN0, WT0, 1024, scr, r / 64, r % 64, F.lane); continue; } r -= I0;
        if (r < I1) { tr_item(w0 + 2056, IN0, WT0 + (size_t)2048 * 1024, 1024, scr, r / 64, r % 64, F.lane); continue; } r -= I1;
        if (r < I2) { tr_item(F.in[8], 1024, WO0, 1024, scr, r / 32, r % 32, F.lane); continue; } r -= I2;
        if (r < I3) { tr_item(F.in[9], IN1, WT1, 1024, scr, r / 144, r % 144, F.lane); continue; } r -= I3;
        tr_item(F.in[10], 1024, WO1, 512, scr, r / 32, r % 32, F.lane);
    }
    const float* x = F.in[0]; bf16* XB = (bf16*)(F.ws + WS_XB); float* G = (float*)(F.ws + WS_G);
    const float* ib = F.in[2]; const float* fb = F.in[3];
    for (int m = gwv; m < M; m += NGW) {
        const f32x4* xr = (const f32x4*)(x + (size_t)m * D) + F.lane;
        f32x4 v[4];
#pragma unroll
        for (int j = 0; j < 4; ++j) v[j] = xr[64 * j];
        unsigned long long* o8 = (unsigned long long*)(XB + (size_t)m * D) + F.lane;
#pragma unroll
        for (int j = 0; j < 4; ++j) o8[64 * j] = (unsigned long long)pk2(v[j].x, v[j].y) | ((unsigned long long)pk2(v[j].z, v[j].w) << 32);
        float acc[8];
#pragma unroll
        for (int g = 0; g < 8; ++g) { float a = 0.f;
#pragma unroll
            for (int j = 0; j < 4; ++j) { const f32x4 w = *(const LAS f32x4*)(gw + g * 1024 + 4 * F.lane + 256 * j); a += v[j].x * w.x + v[j].y * w.y + v[j].z * w.z + v[j].w * w.w; }
            acc[g] = wave_sum(a); }
        if (F.lane == 0) {
#pragma unroll
            for (int g = 0; g < 4; ++g) G[(size_t)m * 8 + g] = acc[g] + ib[g];
#pragma unroll
            for (int g = 0; g < 4; ++g) { const float z = acc[4 + g] + fb[g]; G[(size_t)m * 8 + 4 + g] = fminf(z, 0.f) - log1pf(__expf(-fabsf(z))); }
        }
    }
}

__device__ __forceinline__ void convert_experts(Frame& F, int layer) {
    LAS float* scr = (LAS float*)(F.lds + F.wave * 9216);
    const int gwv = F.vcu * NWAVES + F.wave, NGW = F.G * NWAVES;
    const float* wg = F.in[13] + (size_t)layer * NE * D * DE; const float* wu = F.in[14] + (size_t)layer * NE * D * DE; const float* wd = F.in[15] + (size_t)layer * NE * DE * D;
    for (int it = gwv; it < NE * 384; it += NGW) {
        const int e = it / 384; int r = it % 384;
        bf16* GU = (bf16*)(F.ws + WS_EW + (size_t)e * EW_STRIDE); bf16* DN = (bf16*)(F.ws + WS_EW + (size_t)e * EW_STRIDE + EW_DN);
        if (r < 256) { const int job = r >> 6, q = r & 63;
            const float* src = ((job < 2) ? wg : wu) + (size_t)e * D * DE + (job & 1) * 128;
            bf16* dst = GU + (size_t)((job & 1) * 256 + (job >> 1) * 128) * 1024;
            tr_item(src, DE, dst, 1024, scr, q >> 2, q & 3, F.lane);
        } else { r -= 256;
            tr_item(wd + (size_t)e * DE * D, D, DN, DE, scr, r >> 5, r & 31, F.lane); }
    }
}

__device__ __forceinline__ void ph_inproj_naive(Frame& F, const bf16* Bt, int N) {
    LAS float* sA = (LAS float*)F.lds; LAS float* sB = sA + 128 * 33;
    const bf16* XB = (const bf16*)(F.ws + WS_XB); bf16* P = (bf16*)(F.ws + WS_P);
    const int nnb = N / 64, ntiles = (M / 128) * nnb, tx = F.tid & 15, ty = F.tid >> 4;
    for (int t = blockIdx.x; t < ntiles; t += F.G) {
        const int mb = t / nnb, nb = t % nnb; float acc[4][4];
        ngemm_tile(sA, sB, [&](int r) { return XB + (size_t)(mb * 128 + r) * D; }, Bt + (size_t)nb * 64 * D, D, D, acc);
#pragma unroll
        for (int i = 0; i < 4; ++i) { u32x2 o; o.x = pk2(acc[i][0], acc[i][1]); o.y = pk2(acc[i][2], acc[i][3]);
            *(u32x2*)(P + (size_t)(mb * 128 + ty * 4 + i) * N + nb * 64 + tx * 4) = o; }
    }
}
__device__ __forceinline__ void ph_outproj_naive(Frame& F, const bf16* A, int K, const bf16* Bt, const float* base) {
    LAS float* sA = (LAS float*)F.lds; LAS float* sB = sA + 128 * 33;
    const int nnb = D / 64, ntiles = (M / 128) * nnb, tx = F.tid & 15, ty = F.tid >> 4;
    for (int t = blockIdx.x; t < ntiles; t += F.G) {
        const int mb = t / nnb, nb = t % nnb; float acc[4][4];
        ngemm_tile(sA, sB, [&](int r) { return A + (size_t)(mb * 128 + r) * K; }, Bt + (size_t)nb * 64 * K, K, K, acc);
#pragma unroll
        for (int i = 0; i < 4; ++i) { const size_t off = (size_t)(mb * 128 + ty * 4 + i) * D + nb * 64 + tx * 4;
            const f32x4 b = *(const f32x4*)(base + off);
            *(f32x4*)(F.out + off) = (f32x4){ALPHA * b.x + acc[i][0], ALPHA * b.y + acc[i][1], ALPHA * b.z + acc[i][2], ALPHA * b.w + acc[i][3]}; }
    }
}

__device__ __forceinline__ void ph_conv_naive(Frame& F) {
    const bf16* P = (const bf16*)(F.ws + WS_P); bf16* QKC = (bf16*)(F.ws + WS_QKC);
    const float* cw = F.in[4]; const float* cb = F.in[5];
    const size_t total = (size_t)M * 1024, nth = (size_t)F.G * NT;
    for (size_t i = (size_t)blockIdx.x * NT + F.tid; i < total; i += nth) {
        const int m = (int)(i >> 10), c = (int)(i & 1023), t = m & (T - 1);
        float a = cb[c];
#pragma unroll
        for (int j = 0; j < 4; ++j) { const int tt = t - 3 + j; if (tt >= 0) a += cw[j * 1024 + c] * bf2f(P[(size_t)(m - 3 + j) * NP0 + c]); }
        QKC[i] = (bf16)f2bf(siluf_(a));
    }
}
__device__ __forceinline__ void ph_recurrent_naive(Frame& F) {
    if (blockIdx.x >= 16) return;
    const int type = blockIdx.x >> 3, b = (blockIdx.x >> 2) & 1, h = blockIdx.x & 3;
    LAS float* sin = (LAS float*)F.lds;
    LAS float* red = sin + 1024;
    LAS float* redd = red + 512;
    LAS float* sc = redd + 4;
    const bf16* P = (const bf16*)(F.ws + WS_P); const bf16* QKC = (const bf16*)(F.ws + WS_QKC); const float* G = (const float*)(F.ws + WS_G);
    bf16* Y = (bf16*)(F.ws + WS_Y);
    const float* gain = (type == 0 ? F.in[6] : F.in[7]) + h * 128;
    const int e = F.tid & 127, dg = F.tid >> 7, which = dg;
    const float gamma = 1.f - exp2f(-5.f - (float)h);
    float C[32], nn[32];
#pragma unroll
    for (int j = 0; j < 32; ++j) { C[j] = 0.f; nn[j] = 0.f; }
    const bf16* src; size_t stride;
    if (type == 0) { if (which < 2) { src = QKC + which * 512 + h * 128 + e; stride = 1024; } else { src = P + 1024 + (which - 2) * 512 + h * 128 + e; stride = NP0; } }
    else { src = P + 2048 + which * 512 + h * 128 + e; stride = NP0; }
    const float mul = (which == 1) ? KSCALE : 1.f;
    const size_t m0 = (size_t)b * T;
    float val = bf2f(src[m0 * stride]) * mul;
    float s0 = 0.f, s1 = 0.f;
    if (F.tid == 0) { if (type == 0) { s0 = __expf(G[m0 * 8 + 4 + h]); s1 = __expf(G[m0 * 8 + h]); } else { s0 = gamma; s1 = 1.f; } }
    for (int t = 0; t < T; ++t) {
        const size_t m = m0 + t; const int pb = t & 1;
        sin[pb * 512 + F.tid] = val;
        if (F.tid == 0) { sc[pb * 2] = s0; sc[pb * 2 + 1] = s1; }
        if (t + 1 < T) { val = bf2f(src[(m + 1) * stride]) * mul;
            if (F.tid == 0 && type == 0) { s0 = __expf(G[(m + 1) * 8 + 4 + h]); s1 = __expf(G[(m + 1) * 8 + h]); } }
        __syncthreads();
        const float f = sc[pb * 2], ig = sc[pb * 2 + 1];
        const LAS float* sq = sin + pb * 512; const LAS float* sk = sq + 128; const LAS float* sv = sq + 256; const LAS float* so = sq + 384;
        const float ve = sv[e] * ig;
        float pn = 0.f, pd = 0.f;
#pragma unroll
        for (int j = 0; j < 32; ++j) { const int d = dg * 32 + j; const float kd = sk[d], qd = sq[d];
            C[j] = fmaf(f, C[j], kd * ve); nn[j] = fmaf(f, nn[j], ig * kd); pn = fmaf(C[j], qd, pn); pd = fmaf(nn[j], qd, pd); }
        red[dg * 128 + e] = pn; if (e == 0) redd[dg] = pd;
        __syncthreads();
        if (F.tid < 64) {
            const int e0 = F.tid, e1 = F.tid + 64;
            float h0 = (red[e0] + red[128 + e0]) + (red[256 + e0] + red[384 + e0]);
            float h1 = (red[e1] + red[128 + e1]) + (red[256 + e1] + red[384 + e1]);
            if (type == 0) { const float den = (redd[0] + redd[1]) + (redd[2] + redd[3]); const float dn = fmaxf(fabsf(den), 1.f);
                h0 = h0 / dn * sigmoidf_(so[e0]); h1 = h1 / dn * sigmoidf_(so[e1]); }
            const float mean = wave_sum(h0 + h1) * (1.f / 128.f); const float d0 = h0 - mean, d1 = h1 - mean;
            const float rstd = 1.f / sqrtf(wave_sum(d0 * d0 + d1 * d1) * (1.f / 128.f) + LN_EPS);
            float y0 = d0 * rstd * gain[e0], y1 = d1 * rstd * gain[e1];
            if (type == 1) { y0 *= siluf_(so[e0]); y1 *= siluf_(so[e1]); }
            Y[m * 1024 + type * 512 + h * 128 + e0] = (bf16)f2bf(y0); Y[m * 1024 + type * 512 + h * 128 + e1] = (bf16)f2bf(y1);
        }
    }
}

constexpr size_t WS_S = WS_SE;
constexpr size_t WS_DN = WS_G + 768 * 1024;
constexpr int CB_GL = 512 * 1024, CB_MSC = 520 * 1024;
constexpr int TRS = 144, RWS = 136;
template <int O0, int O1>
__device__ __forceinline__ void tr2(unsigned a, u32x2& r0, u32x2& r1) {
    asm volatile("ds_read_b64_tr_b16 %0, %2 offset:%3\n\tds_read_b64_tr_b16 %1, %2 offset:%4\n\ts_waitcnt lgkmcnt(0)" : "=&v"(r0), "=&v"(r1) : "v"(a), "i"(O0), "i"(O1) : "memory");
}
template <int B, int H>
__device__ __forceinline__ void tr8(unsigned a, u32x2& r0, u32x2& r1, u32x2& r2, u32x2& r3, u32x2& r4, u32x2& r5, u32x2& r6, u32x2& r7) {
    asm volatile("ds_read_b64_tr_b16 %0, %8 offset:%9\n\tds_read_b64_tr_b16 %1, %8 offset:%10\n\tds_read_b64_tr_b16 %2, %8 offset:%11\n\tds_read_b64_tr_b16 %3, %8 offset:%12\n\t"
                 "ds_read_b64_tr_b16 %4, %8 offset:%13\n\tds_read_b64_tr_b16 %5, %8 offset:%14\n\tds_read_b64_tr_b16 %6, %8 offset:%15\n\tds_read_b64_tr_b16 %7, %8 offset:%16\n\ts_waitcnt lgkmcnt(0)"
                 : "=&v"(r0), "=&v"(r1), "=&v"(r2), "=&v"(r3), "=&v"(r4), "=&v"(r5), "=&v"(r6), "=&v"(r7)
                 : "v"(a), "i"(B), "i"(B + H), "i"(B + 32), "i"(B + 32 + H), "i"(B + 64), "i"(B + 64 + H), "i"(B + 96), "i"(B + 96 + H) : "memory");
}
__device__ __forceinline__ bf16x8_t pack_frag(u32x2 a, u32x2 b) { return __builtin_bit_cast(bf16x8_t, (u32x4){a.x, a.y, b.x, b.y}); }
__device__ __forceinline__ void scan128_sum(float& x0, float& x1, int lane) {
#pragma unroll
    for (int o = 1; o < 64; o <<= 1) { const float t0 = __shfl_up(x0, o), t1 = __shfl_up(x1, o); if (lane >= o) { x0 += t0; x1 += t1; } }
    x1 += __shfl(x0, 63);
}
__device__ __forceinline__ void scan128_max(float& x0, float& x1, int lane) {
#pragma unroll
    for (int o = 1; o < 64; o <<= 1) { const float t0 = __shfl_up(x0, o), t1 = __shfl_up(x1, o); if (lane >= o) { x0 = fmaxf(x0, t0); x1 = fmaxf(x1, t1); } }
    x1 = fmaxf(x1, __shfl(x0, 63));
}
__device__ __forceinline__ float wave_max(float v) {
#pragma unroll
    for (int o = 1; o < 64; o <<= 1) v = fmaxf(v, __shfl_xor(v, o));
    return v;
}
__device__ __forceinline__ void conv8(const bf16* Pc, int row, int tpos0, const LAS float* cwp, float (&o)[8]) {
    { const f32x4 b0 = *(const LAS f32x4*)(cwp + 512), b1 = *(const LAS f32x4*)(cwp + 516); o[0] = b0.x; o[1] = b0.y; o[2] = b0.z; o[3] = b0.w; o[4] = b1.x; o[5] = b1.y; o[6] = b1.z; o[7] = b1.w; }
#pragma unroll
    for (int j = 0; j < 4; ++j) { const int r = row - 3 + j;
        if (tpos0 + r >= 0) { const u32x4 x = *(const u32x4*)(Pc + (long)r * NP0); const f32x4 w0 = *(const LAS f32x4*)(cwp + j * 128), w1 = *(const LAS f32x4*)(cwp + j * 128 + 4);
            o[0] += w0.x * bflo(x.x); o[1] += w0.y * bfhi(x.x); o[2] += w0.z * bflo(x.y); o[3] += w0.w * bfhi(x.y); o[4] += w1.x * bflo(x.z); o[5] += w1.y * bfhi(x.z); o[6] += w1.z * bflo(x.w); o[7] += w1.w * bfhi(x.w); } }
#pragma unroll
    for (int e = 0; e < 8; ++e) o[e] = siluf_(o[e]);
}
__device__ __forceinline__ u32x4 pack8(const float (&o)[8], float sc) {
    u32x4 w; w.x = pg8::cvt_pk_bf16(o[0] * sc, o[1] * sc); w.y = pg8::cvt_pk_bf16(o[2] * sc, o[3] * sc); w.z = pg8::cvt_pk_bf16(o[4] * sc, o[5] * sc); w.w = pg8::cvt_pk_bf16(o[6] * sc, o[7] * sc); return w; }
__device__ __forceinline__ void unpack8(u32x4 x, float (&o)[8]) { o[0] = bflo(x.x); o[1] = bfhi(x.x); o[2] = bflo(x.y); o[3] = bfhi(x.y); o[4] = bflo(x.z); o[5] = bfhi(x.z); o[6] = bflo(x.w); o[7] = bfhi(x.w); }

__device__ __forceinline__ void ph_mix_a(Frame& F) {
    LAS bf16* Vl = (LAS bf16*)F.lds;
    LAS bf16* Kl = Vl + 128 * TRS;
    LAS float* cwl = (LAS float*)(Kl + 128 * TRS);
    LAS float* wl = cwl + 640;
    const bf16* P = (const bf16*)(F.ws + WS_P); const float* G = (const float*)(F.ws + WS_G); bf16* S = (bf16*)(F.ws + WS_S); float* DN = (float*)(F.ws + WS_DN);
    float* GL = (float*)((char*)F.ctl + CB_GL);
    const float* cw = F.in[4]; const float* cb = F.in[5];
    const int tid = F.tid, lane = F.lane, w = F.wave, fr = lane & 15, fq = lane >> 4;
    const unsigned vaddr = (unsigned)(size_t)Vl + (unsigned)(((4 * fq + (fr >> 2)) * TRS + 16 * w + 4 * (fr & 3)) * 2);
    const unsigned kaddr = (unsigned)(size_t)Kl + (unsigned)(((4 * fq + (fr >> 2)) * TRS + 4 * (fr & 3)) * 2);
    for (int u = blockIdx.x; u < 1024; u += F.G) {
        const int type = u >> 9, b = (u >> 8) & 1, h = (u >> 6) & 3, c = u & 63, chain = type * 8 + b * 4 + h;
        const size_t m0 = (size_t)b * T + c * 128;
        const int kcol = (type == 0 ? 512 : 2560) + h * 128, vcol = (type == 0 ? 1024 : 3072) + h * 128;
        __syncthreads();
        if (type == 0) for (int i = tid; i < 640; i += NT) { const int j = i >> 7, d = i & 127; cwl[i] = j < 4 ? cw[j * 1024 + 512 + h * 128 + d] : cb[512 + h * 128 + d]; }
        if (w == 0) {
            float w0, w1;
            if (type == 0) {
                const float i0 = G[(m0 + lane) * 8 + h], i1 = G[(m0 + lane + 64) * 8 + h];
                float b0 = G[(m0 + lane) * 8 + 4 + h], b1 = G[(m0 + lane + 64) * 8 + 4 + h];
                scan128_sum(b0, b1, lane);
                const float g = __shfl(b1, 63), lw0 = g - b0 + i0, lw1 = g - b1 + i1, ml = wave_max(fmaxf(lw0, lw1));
                w0 = __expf(lw0 - ml); w1 = __expf(lw1 - ml);
                if (lane == 0) { GL[(chain * 64 + c) * 2] = g; GL[(chain * 64 + c) * 2 + 1] = ml; }
            } else { const float lg = log1pf(-exp2f(-5.f - (float)h)); w0 = __expf(lg * (float)(127 - lane)); w1 = __expf(lg * (float)(63 - lane)); }
            wl[lane] = w0 * KSCALE; wl[lane + 64] = w1 * KSCALE;
        }
#pragma unroll
        for (int it = 0; it < 4; ++it) { const int s = (tid >> 4) + 32 * it, ch = tid & 15;
            *(LAS u32x4*)(Vl + s * TRS + ch * 8) = *(const u32x4*)(P + (m0 + s) * NP0 + vcol + ch * 8); }
        __syncthreads();
#pragma unroll
        for (int it = 0; it < 4; ++it) { const int s = (tid >> 4) + 32 * it, ch = tid & 15; float o[8];
            if (type == 0) conv8(P + m0 * NP0 + kcol + ch * 8, s, c * 128, cwl + ch * 8, o);
            else unpack8(*(const u32x4*)(P + (m0 + s) * NP0 + kcol + ch * 8), o);
            *(LAS u32x4*)(Kl + s * TRS + ch * 8) = pack8(o, wl[s]); }
        __syncthreads();
        f32x4 acc[8], accn = (f32x4){0.f, 0.f, 0.f, 0.f};
#pragma unroll
        for (int dt = 0; dt < 8; ++dt) acc[dt] = (f32x4){0.f, 0.f, 0.f, 0.f};
        const bf16x8_t ones = (bf16x8_t){0x3F80, 0x3F80, 0x3F80, 0x3F80, 0x3F80, 0x3F80, 0x3F80, 0x3F80};
#pragma unroll
        for (int ks = 0; ks < 4; ++ks) {
            u32x2 a0, a1, n0, n1, b0, b1, b2, b3, b4, b5, b6, b7, c0, c1, c2, c3, c4, c5, c6, c7;
            tr2<0, 16 * TRS * 2>(vaddr + ks * 32 * TRS * 2, a0, a1);
            tr2<0, 16 * TRS * 2>(kaddr + ks * 32 * TRS * 2 + 32 * w, n0, n1);
            tr8<0, 16 * TRS * 2>(kaddr + ks * 32 * TRS * 2, b0, b1, b2, b3, b4, b5, b6, b7);
            tr8<128, 16 * TRS * 2>(kaddr + ks * 32 * TRS * 2, c0, c1, c2, c3, c4, c5, c6, c7);
            __builtin_amdgcn_sched_barrier(0);
            const bf16x8_t A = pack_frag(a0, a1);
            acc[0] = __builtin_amdgcn_mfma_f32_16x16x32_bf16(pack_frag(b0, b1), A, acc[0], 0, 0, 0);
            acc[1] = __builtin_amdgcn_mfma_f32_16x16x32_bf16(pack_frag(b2, b3), A, acc[1], 0, 0, 0);
            acc[2] = __builtin_amdgcn_mfma_f32_16x16x32_bf16(pack_frag(b4, b5), A, acc[2], 0, 0, 0);
            acc[3] = __builtin_amdgcn_mfma_f32_16x16x32_bf16(pack_frag(b6, b7), A, acc[3], 0, 0, 0);
            acc[4] = __builtin_amdgcn_mfma_f32_16x16x32_bf16(pack_frag(c0, c1), A, acc[4], 0, 0, 0);
            acc[5] = __builtin_amdgcn_mfma_f32_16x16x32_bf16(pack_frag(c2, c3), A, acc[5], 0, 0, 0);
            acc[6] = __builtin_amdgcn_mfma_f32_16x16x32_bf16(pack_frag(c4, c5), A, acc[6], 0, 0, 0);
            acc[7] = __builtin_amdgcn_mfma_f32_16x16x32_bf16(pack_frag(c6, c7), A, acc[7], 0, 0, 0);
            accn = __builtin_amdgcn_mfma_f32_16x16x32_bf16(pack_frag(n0, n1), ones, accn, 0, 0, 0);
        }
        bf16* Sp = S + ((size_t)(chain * 64 + c) * 128 + 16 * w + fr) * 128 + 4 * fq;
#pragma unroll
        for (int dt = 0; dt < 8; ++dt) { u32x2 wv; wv.x = pg8::cvt_pk_bf16(acc[dt][0], acc[dt][1]); wv.y = pg8::cvt_pk_bf16(acc[dt][2], acc[dt][3]); *(u32x2*)(Sp + 16 * dt) = wv; }
        if (type == 0 && fr == 0) *(f32x4*)(DN + (size_t)(chain * 64 + c) * 128 + 16 * w + 4 * fq) = accn;
    }
}

__device__ __forceinline__ void ph_mix_b(Frame& F) {
    LAS float* gl = (LAS float*)F.lds; LAS float* dec = gl + 1024; LAS float* scl = dec + 512;
    const float* GL = (const float*)((char*)F.ctl + CB_GL); float* MSC = (float*)((char*)F.ctl + CB_MSC);
    bf16* S = (bf16*)(F.ws + WS_S); float* DN = (float*)(F.ws + WS_DN);
    for (int i = F.tid; i < 1024; i += NT) gl[i] = GL[i];
    __syncthreads();
    if (F.tid < 8) { float m = 0.f;
        for (int c = 0; c < 64; ++c) { const float g = gl[(F.tid * 64 + c) * 2], ml = gl[(F.tid * 64 + c) * 2 + 1];
            if (blockIdx.x == 0) MSC[F.tid * 64 + c] = m;
            const float mn = fmaxf(g + m, ml); dec[F.tid * 64 + c] = __expf(g + m - mn); scl[F.tid * 64 + c] = __expf(ml - mn); m = mn; } }
    __syncthreads();
    for (int j = blockIdx.x * NT + F.tid; j < 131072; j += F.G * NT) {
        const int chain = j >> 13, el = j & 8191;
        unsigned* p = (unsigned*)S + (size_t)chain * 64 * 8192 + el;
        const bool ml = chain < 8;
        const float g128 = __expf(128.f * log1pf(-exp2f(-5.f - (float)(chain & 3))));
        float C0 = 0.f, C1 = 0.f;
        for (int c0 = 0; c0 < 64; c0 += 16) { unsigned x[16];
#pragma unroll
            for (int k = 0; k < 16; ++k) x[k] = p[(size_t)(c0 + k) * 8192];
#pragma unroll
            for (int k = 0; k < 16; ++k) { p[(size_t)(c0 + k) * 8192] = pg8::cvt_pk_bf16(C0, C1);
                const float dk = ml ? dec[(chain & 7) * 64 + c0 + k] : g128, sk = ml ? scl[(chain & 7) * 64 + c0 + k] : 1.f;
                C0 = dk * C0 + sk * bflo(x[k]); C1 = dk * C1 + sk * bfhi(x[k]); } }
    }
    for (int j = blockIdx.x * NT + F.tid; j < 1024; j += F.G * NT) { const int chain = j >> 7, d = j & 127; float* p = DN + (size_t)chain * 64 * 128 + d; float n = 0.f;
        for (int c = 0; c < 64; ++c) { const float x = p[c * 128]; p[c * 128] = n; n = dec[chain * 64 + c] * n + scl[chain * 64 + c] * x; } }
}

__device__ __forceinline__ void ph_mix_c(Frame& F) {
    LAS bf16* Kl = (LAS bf16*)F.lds;
    LAS bf16* Vl = Kl + 128 * RWS;
    LAS bf16* Cl = Vl + 128 * TRS;
    LAS float* cwl = (LAS float*)(Cl + 144 * RWS);
    LAS float* ul = cwl + 1280; LAS float* Ml = ul + 128; LAS float* bl = Ml + 128;
    const bf16* P = (const bf16*)(F.ws + WS_P); const float* G = (const float*)(F.ws + WS_G); const bf16* S = (const bf16*)(F.ws + WS_S); const float* DN = (const float*)(F.ws + WS_DN);
    const float* MSC = (const float*)((char*)F.ctl + CB_MSC); bf16* Y = (bf16*)(F.ws + WS_Y);
    const float* cw = F.in[4]; const float* cb = F.in[5];
    const int tid = F.tid, lane = F.lane, w = F.wave, fr = lane & 15, fq = lane >> 4;
    const int lt = w < 4 ? w : 11 - w, l = 16 * lt + fr;
    const unsigned vaddr = (unsigned)(size_t)Vl + (unsigned)(((4 * fq + (fr >> 2)) * TRS + 4 * (fr & 3)) * 2);
    for (int u = blockIdx.x; u < 1024; u += F.G) {
        const int type = u >> 9, b = (u >> 8) & 1, h = (u >> 6) & 3, c = u & 63, chain = type * 8 + b * 4 + h;
        const size_t m0 = (size_t)b * T + c * 128;
        const int base = type == 0 ? 0 : 2048, qcol = base + h * 128, kcol = base + 512 + h * 128, vcol = base + 1024 + h * 128, gcol = base + 1536 + h * 128;
        const float lg = log1pf(-exp2f(-5.f - (float)h));
        __syncthreads();
        if (type == 0) for (int i = tid; i < 1280; i += NT) { const int part = i / 640, r = i % 640, j = r >> 7, d = r & 127, col = part * 512 + h * 128 + d; cwl[i] = j < 4 ? cw[j * 1024 + col] : cb[col]; }
        float mc = 0.f;
        if (type == 0) {
            mc = MSC[(b * 4 + h) * 64 + c];
            if (w == 0) {
                const float i0 = G[(m0 + lane) * 8 + h], i1 = G[(m0 + lane + 64) * 8 + h];
                float b0 = G[(m0 + lane) * 8 + 4 + h], b1 = G[(m0 + lane + 64) * 8 + 4 + h];
                scan128_sum(b0, b1, lane);
                const float u0 = i0 - b0, u1 = i1 - b1; float p0 = u0, p1 = u1; scan128_max(p0, p1, lane);
                ul[lane] = u0; ul[lane + 64] = u1; Ml[lane] = fmaxf(mc, p0); Ml[lane + 64] = fmaxf(mc, p1); bl[lane] = b0; bl[lane + 64] = b1;
            }
        }
#pragma unroll
        for (int it = 0; it < 4; ++it) { const int s = (tid >> 4) + 32 * it, ch = tid & 15;
            *(LAS u32x4*)(Vl + s * TRS + ch * 8) = *(const u32x4*)(P + (m0 + s) * NP0 + vcol + ch * 8);
            *(LAS u32x4*)(Cl + s * RWS + ch * 8) = *(const u32x4*)(S + ((size_t)(chain * 64 + c) * 128 + s) * 128 + ch * 8); }
        if (tid < 256) { const int r = tid >> 4, ch = tid & 15; u32x4 wv = (u32x4){0u, 0u, 0u, 0u};
            if (type == 0 && r == 0) { const float* np = DN + (size_t)((b * 4 + h) * 64 + c) * 128 + ch * 8; const f32x4 x0 = *(const f32x4*)np, x1 = *(const f32x4*)(np + 4);
                wv.x = pg8::cvt_pk_bf16(x0.x, x0.y); wv.y = pg8::cvt_pk_bf16(x0.z, x0.w); wv.z = pg8::cvt_pk_bf16(x1.x, x1.y); wv.w = pg8::cvt_pk_bf16(x1.z, x1.w); }
            *(LAS u32x4*)(Cl + (128 + r) * RWS + ch * 8) = wv; }
        __syncthreads();
#pragma unroll
        for (int it = 0; it < 4; ++it) { const int s = (tid >> 4) + 32 * it, ch = tid & 15; float o[8];
            if (type == 0) conv8(P + m0 * NP0 + kcol + ch * 8, s, c * 128, cwl + 640 + ch * 8, o);
            else unpack8(*(const u32x4*)(P + (m0 + s) * NP0 + kcol + ch * 8), o);
            *(LAS u32x4*)(Kl + s * RWS + ch * 8) = pack8(o, KSCALE); }
        bf16x8_t qf[4];
#pragma unroll
        for (int ks = 0; ks < 4; ++ks) { const int d0 = 32 * ks + 8 * fq;
            if (type == 0) { float o[8]; conv8(P + m0 * NP0 + qcol + d0, l, c * 128, cwl + d0, o); qf[ks] = __builtin_bit_cast(bf16x8_t, pack8(o, 1.f)); }
            else qf[ks] = *(const bf16x8_t*)(P + (m0 + l) * NP0 + qcol + d0); }
        __syncthreads();
        f32x4 st[8];
#pragma unroll
        for (int t = 0; t < 8; ++t) { st[t] = (f32x4){0.f, 0.f, 0.f, 0.f};
            if (t <= lt) {
#pragma unroll
                for (int ks = 0; ks < 4; ++ks) st[t] = __builtin_amdgcn_mfma_f32_16x16x32_bf16(*(const LAS bf16x8_t*)(Kl + (16 * t + fr) * RWS + 32 * ks + 8 * fq), qf[ks], st[t], 0, 0, 0); }
            if (t & 1) __builtin_amdgcn_sched_barrier(0); }
        int lz = l, fz = 4 * fq; asm volatile("" : "+v"(lz), "+v"(fz));
        const float Mme = (type == 0) ? Ml[lz] : 0.f;
        float den = 0.f;
#pragma unroll
        for (int t = 0; t < 8; ++t) if (t <= lt) {
#pragma unroll
            for (int rg = 0; rg < 4; ++rg) { const int s = 16 * t + fz + rg;
                float e = (type == 0) ? (ul[s] - Mme) : (lg * (float)(lz - s)); e = (s <= lz) ? e : -1e30f;
                const float p = st[t][rg] * __expf(e); st[t][rg] = p; den += p; } }
        den += __shfl_xor(den, 16); den += __shfl_xor(den, 32);
        f32x4 o1[8], o2[9];
#pragma unroll
        for (int et = 0; et < 8; ++et) o1[et] = (f32x4){0.f, 0.f, 0.f, 0.f};
#pragma unroll
        for (int et = 0; et < 9; ++et) o2[et] = (f32x4){0.f, 0.f, 0.f, 0.f};
#pragma unroll
        for (int j = 0; j < 4; ++j) if (2 * j <= lt) {
            u32x4 pw; pw.x = pg8::cvt_pk_bf16(st[2 * j][0], st[2 * j][1]); pw.y = pg8::cvt_pk_bf16(st[2 * j][2], st[2 * j][3]);
            pw.z = pg8::cvt_pk_bf16(st[2 * j + 1][0], st[2 * j + 1][1]); pw.w = pg8::cvt_pk_bf16(st[2 * j + 1][2], st[2 * j + 1][3]);
            const bf16x8_t pf = __builtin_bit_cast(bf16x8_t, pw);
            u32x2 b0, b1, b2, b3, b4, b5, b6, b7, c0, c1, c2, c3, c4, c5, c6, c7;
            tr8<0, 16 * TRS * 2>(vaddr + j * 32 * TRS * 2, b0, b1, b2, b3, b4, b5, b6, b7);
            tr8<128, 16 * TRS * 2>(vaddr + j * 32 * TRS * 2, c0, c1, c2, c3, c4, c5, c6, c7);
            __builtin_amdgcn_sched_barrier(0);
            o1[0] = __builtin_amdgcn_mfma_f32_16x16x32_bf16(pack_frag(b0, b1), pf, o1[0], 0, 0, 0);
            o1[1] = __builtin_amdgcn_mfma_f32_16x16x32_bf16(pack_frag(b2, b3), pf, o1[1], 0, 0, 0);
            o1[2] = __builtin_amdgcn_mfma_f32_16x16x32_bf16(pack_frag(b4, b5), pf, o1[2], 0, 0, 0);
            o1[3] = __builtin_amdgcn_mfma_f32_16x16x32_bf16(pack_frag(b6, b7), pf, o1[3], 0, 0, 0);
            o1[4] = __builtin_amdgcn_mfma_f32_16x16x32_bf16(pack_frag(c0, c1), pf, o1[4], 0, 0, 0);
            o1[5] = __builtin_amdgcn_mfma_f32_16x16x32_bf16(pack_frag(c2, c3), pf, o1[5], 0, 0, 0);
            o1[6] = __builtin_amdgcn_mfma_f32_16x16x32_bf16(pack_frag(c4, c5), pf, o1[6], 0, 0, 0);
            o1[7] = __builtin_amdgcn_mfma_f32_16x16x32_bf16(pack_frag(c6, c7), pf, o1[7], 0, 0, 0);
        }
        __builtin_amdgcn_sched_barrier(0);
#pragma unroll
        for (int ks = 0; ks < 4; ++ks) {
#pragma unroll
            for (int et = 0; et < 9; ++et) o2[et] = __builtin_amdgcn_mfma_f32_16x16x32_bf16(*(const LAS bf16x8_t*)(Cl + (16 * et + fr) * RWS + 32 * ks + 8 * fq), qf[ks], o2[et], 0, 0, 0);
            __builtin_amdgcn_sched_barrier(0); }
        float inter, rden = 1.f;
        if (type == 0) { inter = __expf(mc - Mme); const float qn = __shfl(o2[8][0], fr); const float dtot = den + inter * qn; rden = 1.f / fmaxf(fabsf(dtot), __expf(-(bl[l] + Mme))); }
        else inter = __expf(lg * (float)(l + 1));
        const bf16* gp = P + (m0 + l) * NP0 + gcol + 4 * fq;
        float sum = 0.f;
#pragma unroll
        for (int et = 0; et < 8; ++et) { const u32x2 gw = *(const u32x2*)(gp + 16 * et); const float g0 = bflo(gw.x), g1 = bfhi(gw.x), g2 = bflo(gw.y), g3 = bfhi(gw.y);
            f32x4 hv = (o1[et] + o2[et] * inter) * rden;
            if (type == 0) { hv[0] *= sigmoidf_(g0); hv[1] *= sigmoidf_(g1); hv[2] *= sigmoidf_(g2); hv[3] *= sigmoidf_(g3); o2[et] = (f32x4){1.f, 1.f, 1.f, 1.f}; }
            else o2[et] = (f32x4){siluf_(g0), siluf_(g1), siluf_(g2), siluf_(g3)};
            o1[et] = hv; sum += (hv[0] + hv[1]) + (hv[2] + hv[3]); if (et & 1) asm volatile("" ::: "memory"); }
        sum += __shfl_xor(sum, 16); sum += __shfl_xor(sum, 32);
        const float mean = sum * (1.f / 128.f); float sq = 0.f;
#pragma unroll
        for (int et = 0; et < 8; ++et) { o1[et] = o1[et] - mean; sq += (o1[et][0] * o1[et][0] + o1[et][1] * o1[et][1]) + (o1[et][2] * o1[et][2] + o1[et][3] * o1[et][3]); }
        sq += __shfl_xor(sq, 16); sq += __shfl_xor(sq, 32);
        const float rstd = 1.f / sqrtf(sq * (1.f / 128.f) + LN_EPS);
        const float* g6 = F.in[6]; const float* g7 = F.in[7]; asm volatile("" : "+s"(g6), "+s"(g7));
        const float* gain = (type == 0 ? g6 : g7) + h * 128 + 4 * fq;
        bf16* yp = Y + (m0 + l) * 1024 + type * 512 + h * 128 + 4 * fq;
#pragma unroll
        for (int et = 0; et < 8; ++et) { const f32x4 gn = *(const f32x4*)(gain + 16 * et); const f32x4 yv = o1[et] * rstd * gn * o2[et];
            u32x2 wv; wv.x = pg8::cvt_pk_bf16(yv[0], yv[1]); wv.y = pg8::cvt_pk_bf16(yv[2], yv[3]); *(u32x2*)(yp + 16 * et) = wv; if (et & 1) asm volatile("" ::: "memory"); }
    }
}

constexpr int RWT = 1028;
template <int MODE, bool ROUTE, int OUTK>
__device__ __forceinline__ void ph_ln(Frame& F, int layer) {
    LAS float* rwT = (LAS float*)F.lds;
    if (ROUTE) { const float* rw = F.in[11]; for (int i = F.tid; i < 32 * 1024; i += NT) { const int k = i >> 5, e = i & 31; rwT[e * RWT + k] = rw[i]; } __syncthreads(); }
    const int gwv = F.vcu * NWAVES + F.wave, NGW = F.G * NWAVES;
    const float* lg = F.in[16] + (size_t)(layer * 2 + MODE) * D; const float* lb = F.in[17] + (size_t)(layer * 2 + MODE) * D;
    bf16* XB = (bf16*)(F.ws + WS_XB); const bf16* YB = (const bf16*)(F.ws + WS_YB); const bf16* PRE = (const bf16*)((const char*)F.out + 32 * MiB); bf16* RES = (bf16*)F.out;
    int* EIDX = (int*)(F.ws + WS_EIDX); float* GATEV = (float*)(F.ws + WS_GATEV); int* LIST = (int*)(F.ws + WS_LIST);
    unsigned* cnt = F.ctl + CW_CNT + layer * 32 * 64;
    const float* rbias = F.in[12];
    f32x4 gv[4], bv[4];
#pragma unroll
    for (int j = 0; j < 4; ++j) { gv[j] = *((const f32x4*)lg + F.lane + 64 * j); bv[j] = *((const f32x4*)lb + F.lane + 64 * j); }
    for (int m = gwv; m < M; m += NGW) {
        f32x4 v[4]; float s = 0.f;
        if (MODE == 0) { const u32x2* pr = (const u32x2*)(PRE + (size_t)m * D) + F.lane;
#pragma unroll
            for (int j = 0; j < 4; ++j) { const u32x2 a = pr[64 * j]; v[j] = (f32x4){bflo(a.x), bfhi(a.x), bflo(a.y), bfhi(a.y)}; } }
        else {
            const float g0 = GATEV[2 * m], g1 = GATEV[2 * m + 1];
            const u32x2* xr = (const u32x2*)(XB + (size_t)m * D) + F.lane;
            const u32x2* y0 = (const u32x2*)(YB + (size_t)(2 * m) * D) + F.lane; const u32x2* y1 = (const u32x2*)(YB + (size_t)(2 * m + 1) * D) + F.lane;
#pragma unroll
            for (int j = 0; j < 4; ++j) { const u32x2 x = xr[64 * j], a = y0[64 * j], b = y1[64 * j];
                v[j].x = ALPHA * bflo(x.x) + g0 * bflo(a.x) + g1 * bflo(b.x); v[j].y = ALPHA * bfhi(x.x) + g0 * bfhi(a.x) + g1 * bfhi(b.x);
                v[j].z = ALPHA * bflo(x.y) + g0 * bflo(a.y) + g1 * bflo(b.y); v[j].w = ALPHA * bfhi(x.y) + g0 * bfhi(a.y) + g1 * bfhi(b.y); }
        }
#pragma unroll
        for (int j = 0; j < 4; ++j) s += (v[j].x + v[j].y) + (v[j].z + v[j].w);
        const float mean = wave_sum(s) * (1.f / D); float s2 = 0.f;
#pragma unroll
        for (int j = 0; j < 4; ++j) { v[j] = v[j] - mean; s2 += (v[j].x * v[j].x + v[j].y * v[j].y) + (v[j].z * v[j].z + v[j].w * v[j].w); }
        const float rstd = 1.f / sqrtf(wave_sum(s2) * (1.f / D) + LN_EPS);
#pragma unroll
        for (int j = 0; j < 4; ++j) v[j] = v[j] * rstd * gv[j] + bv[j];
        if (OUTK == 2) { f32x4* orow = (f32x4*)(F.out + (size_t)m * D) + F.lane;
#pragma unroll
            for (int j = 0; j < 4; ++j) orow[64 * j] = v[j]; }
        else { u32x2* o8 = (u32x2*)((OUTK == 0 ? XB : RES) + (size_t)m * D) + F.lane;
#pragma unroll
            for (int j = 0; j < 4; ++j) { u32x2 w; w.x = pg8::cvt_pk_bf16(v[j].x, v[j].y); w.y = pg8::cvt_pk_bf16(v[j].z, v[j].w); o8[64 * j] = w; } }
        if (ROUTE) {
            float pv[32];
#pragma unroll
            for (int e = 0; e < 32; ++e) { float a = 0.f;
#pragma unroll
                for (int j = 0; j < 4; ++j) { const f32x4 w = *(const LAS f32x4*)(rwT + e * RWT + 4 * F.lane + 256 * j); a += v[j].x * w.x + v[j].y * w.y + v[j].z * w.z + v[j].w * w.w; }
                pv[e] = a; if ((e & 7) == 7) __builtin_amdgcn_sched_barrier(0); }
#define LN_HALVE(N, MASK) { const bool up = (F.lane & (MASK)) != 0; _Pragma("unroll") for (int j = 0; j < (N); ++j) { const float keep = up ? pv[(N) + j] : pv[j], send = up ? pv[j] : pv[(N) + j]; pv[j] = keep + __shfl_xor(send, (MASK)); } }
            LN_HALVE(16, 32) LN_HALVE(8, 16) LN_HALVE(4, 8) LN_HALVE(2, 4) LN_HALVE(1, 2)
#undef LN_HALVE
            const float mylog = pv[0] + __shfl_xor(pv[0], 1);
            const int mye = F.lane >> 1;
            const float myaff = 1.f / (1.f + expf(-mylog)), mysel = myaff + rbias[mye];
            float m1 = -1e30f, m2 = -1e30f; int i1 = 0, i2 = 0; float a1 = 0.f, a2 = 0.f;
            const int lbase = F.lane & 48, ebase = (F.lane >> 4) * 8;
#pragma unroll
            for (int j = 0; j < 8; ++j) { const float sv = __shfl(mysel, lbase + 2 * j), av = __shfl(myaff, lbase + 2 * j);
                if (sv > m1) { m2 = m1; i2 = i1; a2 = a1; m1 = sv; i1 = ebase + j; a1 = av; }
                else if (sv > m2) { m2 = sv; i2 = ebase + j; a2 = av; } }
            const float score = m1 + m2;
            float bestscore = -1e30f; int bg = 0;
#pragma unroll
            for (int g = 0; g < 4; ++g) { const float sg = __shfl(score, 16 * g); if (sg > bestscore) { bestscore = sg; bg = g; } }
            const int bi0 = __shfl(i1, 16 * bg), bi1 = __shfl(i2, 16 * bg); const float ba0 = __shfl(a1, 16 * bg), ba1 = __shfl(a2, 16 * bg);
            if (F.lane == 0) {
                const float inv = 1.f / (ba0 + ba1);
                EIDX[2 * m] = bi0; EIDX[2 * m + 1] = bi1; GATEV[2 * m] = ba0 * inv; GATEV[2 * m + 1] = ba1 * inv;
                const unsigned p0 = __hip_atomic_fetch_add(cnt + bi0 * 64, 1u, RLX_AGENT); LIST[bi0 * M + p0] = 2 * m;
                const unsigned p1 = __hip_atomic_fetch_add(cnt + bi1 * 64, 1u, RLX_AGENT); LIST[bi1 * M + p1] = 2 * m + 1;
            }
        }
    }
}

struct ExpertMap { int cnt[32]; };
__device__ __forceinline__ int moe_find(Frame& F, int layer, int unit_rows, int per_row_tiles, int t, int& e_out, int& mb_out, int& nb_out, int& hb_out, int& cnt_out) {
    const unsigned* cnt = F.ctl + CW_CNT + layer * 32 * 64;
    int base = 0, hb = 0;
    for (int e = 0; e < 32; ++e) {
        const int c = (int)cnt[e * 64]; const int nmb = (c + unit_rows - 1) / unit_rows; const int nt = nmb * per_row_tiles;
        if (t < base + nt) { const int r = t - base; e_out = e; mb_out = r / per_row_tiles; nb_out = r % per_row_tiles; hb_out = hb; cnt_out = c; return 1; }
        base += nt; hb += ((c + 255) >> 8) << 8;
    }
    return 0;
}
__device__ __forceinline__ void ph_moe1_naive(Frame& F, int layer) {
    LAS float* sA = (LAS float*)F.lds; LAS float* sB = sA + 128 * 33;
    const bf16* XB = (const bf16*)(F.ws + WS_XB); bf16* HID = (bf16*)(F.ws + WS_HID); const int* LIST = (const int*)(F.ws + WS_LIST);
    const int tx = F.tid & 15, ty = F.tid >> 4;
    for (int t = blockIdx.x;; t += F.G) {
        int e, mb, nb, hb, c; if (!moe_find(F, layer, 128, 4, t, e, mb, nb, hb, c)) break;
        const bf16* GU = (const bf16*)(F.ws + WS_EW + (size_t)e * EW_STRIDE);
        const int j0 = nb * 64, rg = (j0 >> 7) * 256 + (j0 & 127);
        auto rowA = [&](int r) -> const bf16* { const int i = mb * 128 + r; return i < c ? XB + (size_t)(LIST[e * M + i] >> 1) * D : (const bf16*)nullptr; };
        float ag[4][4], au[4][4];
        ngemm_tile(sA, sB, rowA, GU + (size_t)rg * D, D, D, ag);
        ngemm_tile(sA, sB, rowA, GU + (size_t)(rg + 128) * D, D, D, au);
#pragma unroll
        for (int i = 0; i < 4; ++i) { const int ri = mb * 128 + ty * 4 + i;
            if (ri < c) { u32x2 o; o.x = pk2(siluf_(ag[i][0]) * au[i][0], siluf_(ag[i][1]) * au[i][1]); o.y = pk2(siluf_(ag[i][2]) * au[i][2], siluf_(ag[i][3]) * au[i][3]);
                *(u32x2*)(HID + (size_t)(hb + ri) * DE + j0 + tx * 4) = o; } }
    }
}
__device__ __forceinline__ void ph_moe2_naive(Frame& F, int layer) {
    LAS float* sA = (LAS float*)F.lds; LAS float* sB = sA + 128 * 33;
    const bf16* HID = (const bf16*)(F.ws + WS_HID); bf16* YB = (bf16*)(F.ws + WS_YB); const int* LIST = (const int*)(F.ws + WS_LIST);
    const int tx = F.tid & 15, ty = F.tid >> 4;
    for (int t = blockIdx.x;; t += F.G) {
        int e, mb, nb, hb, c; if (!moe_find(F, layer, 128, 16, t, e, mb, nb, hb, c)) break;
        const bf16* DN = (const bf16*)(F.ws + WS_EW + (size_t)e * EW_STRIDE + EW_DN);
        auto rowA = [&](int r) -> const bf16* { const int i = mb * 128 + r; return i < c ? HID + (size_t)(hb + i) * DE : (const bf16*)nullptr; };
        float acc[4][4];
        ngemm_tile(sA, sB, rowA, DN + (size_t)(nb * 64) * DE, DE, DE, acc);
#pragma unroll
        for (int i = 0; i < 4; ++i) { const int ri = mb * 128 + ty * 4 + i;
            if (ri < c) { const int a = LIST[e * M + ri]; u32x2 o; o.x = pk2(acc[i][0], acc[i][1]); o.y = pk2(acc[i][2], acc[i][3]);
                *(u32x2*)(YB + (size_t)a * D + nb * 64 + tx * 4) = o; } }
    }
}

__device__ __forceinline__ void ph_attn_naive(Frame& F) {
    const bf16* P = (const bf16*)(F.ws + WS_P); bf16* OG = (bf16*)(F.ws + WS_OG); float* LSE = (float*)(F.ws + WS_LSE);
    const int total = 3 * M * 8, nth = F.G * NT;
    for (int idx = blockIdx.x * NT + F.tid; idx < total; idx += nth) {
        const int h = idx & 7, m = (idx >> 3) & (M - 1), g = idx >> 17;
        const int t = m & (T - 1), dil = (g == 0) ? 1 : (g == 1 ? 4 : 16);
        const float slope = exp2f(-(float)(h + 1));
        const bf16* qp = P + (size_t)m * IN1 + g * 1536 + h * 64;
        float q[64], o[64];
#pragma unroll
        for (int c = 0; c < 8; ++c) { const u32x4 w = *(const u32x4*)(qp + 8 * c);
            q[8 * c + 0] = bflo(w.x); q[8 * c + 1] = bfhi(w.x); q[8 * c + 2] = bflo(w.y); q[8 * c + 3] = bfhi(w.y); q[8 * c + 4] = bflo(w.z); q[8 * c + 5] = bfhi(w.z); q[8 * c + 6] = bflo(w.w); q[8 * c + 7] = bfhi(w.w); }
#pragma unroll
        for (int d = 0; d < 64; ++d) o[d] = 0.f;
        float mx = -1e30f, den = 0.f;
        for (int j = 0; j <= 128; ++j) {
            const int tk = t - j * dil; if (tk < 0) break;
            const bf16* kp = P + (size_t)(m - j * dil) * IN1 + g * 1536 + 512 + h * 64; const bf16* vp = kp + 512;
            float s = 0.f;
#pragma unroll
            for (int c = 0; c < 8; ++c) { const u32x4 w = *(const u32x4*)(kp + 8 * c);
                s += q[8 * c + 0] * bflo(w.x) + q[8 * c + 1] * bfhi(w.x) + q[8 * c + 2] * bflo(w.y) + q[8 * c + 3] * bfhi(w.y) + q[8 * c + 4] * bflo(w.z) + q[8 * c + 5] * bfhi(w.z) + q[8 * c + 6] * bflo(w.w) + q[8 * c + 7] * bfhi(w.w); }
            s = s * 0.125f - slope * (float)(j * dil);
            const float mn = fmaxf(mx, s), corr = __expf(mx - mn), p = __expf(s - mn);
            den = den * corr + p; mx = mn;
#pragma unroll
            for (int c = 0; c < 8; ++c) { const u32x4 w = *(const u32x4*)(vp + 8 * c);
                o[8 * c + 0] = o[8 * c + 0] * corr + p * bflo(w.x); o[8 * c + 1] = o[8 * c + 1] * corr + p * bfhi(w.x); o[8 * c + 2] = o[8 * c + 2] * corr + p * bflo(w.y); o[8 * c + 3] = o[8 * c + 3] * corr + p * bfhi(w.y);
                o[8 * c + 4] = o[8 * c + 4] * corr + p * bflo(w.z); o[8 * c + 5] = o[8 * c + 5] * corr + p * bfhi(w.z); o[8 * c + 6] = o[8 * c + 6] * corr + p * bflo(w.w); o[8 * c + 7] = o[8 * c + 7] * corr + p * bfhi(w.w); }
        }
        const float inv = 1.f / den;
        bf16* op = OG + ((size_t)g * M + m) * 512 + h * 64;
#pragma unroll
        for (int c = 0; c < 8; ++c) { u32x4 w; w.x = pk2(o[8 * c + 0] * inv, o[8 * c + 1] * inv); w.y = pk2(o[8 * c + 2] * inv, o[8 * c + 3] * inv); w.z = pk2(o[8 * c + 4] * inv, o[8 * c + 5] * inv); w.w = pk2(o[8 * c + 6] * inv, o[8 * c + 7] * inv);
            *(u32x4*)(op + 8 * c) = w; }
        LSE[((size_t)g * M + m) * 8 + h] = mx + __logf(den);
    }
}
__device__ __forceinline__ void ph_attn_mfma(Frame& F) {
    const bf16* P = (const bf16*)(F.ws + WS_P); bf16* OG = (bf16*)(F.ws + WS_OG); float* LSE = (float*)(F.ws + WS_LSE);
    LAS bf16* Vl = (LAS bf16*)F.lds;
    const int tid = F.tid, lane = F.lane, w = F.wave, fr = lane & 15, fq = lane >> 4;
    const int ct0 = 2 * (w >> 1);
    const unsigned vaddr0 = (unsigned)(size_t)(F.lds) + (unsigned)(((16 * ct0 + 4 * fq + (fr >> 2)) * 72 + 4 * (fr & 3)) * 2);
    for (int u = blockIdx.x; u < 3072; u += F.G) {
        const int g = u >> 10, rem = u & 1023, b = rem >> 9, h = (rem >> 6) & 7, x = rem & 63;
        const int dil = (g == 0) ? 1 : (g == 1 ? 4 : 16), nnb = 64 / dil, nb = x % nnb, r = x / nnb;
        const long rowbase = (long)b * T + (long)nb * 128 * dil + r;
        const bf16* Qp = P + g * 1536 + h * 64; const bf16* Kp = Qp + 512; const bf16* Vp = Qp + 1024;
        const float sl = exp2f(-(float)(h + 1)) * (float)dil;
        __syncthreads();
#pragma unroll
        for (int it = 0; it < 4; ++it) { const int kr = (tid >> 3) + 64 * it, ch = tid & 7; u32x4 v = (u32x4){0u, 0u, 0u, 0u};
            if (nb > 0 || kr >= 128) v = *(const u32x4*)(Vp + (size_t)(rowbase + (long)(kr - 128) * dil) * IN1 + ch * 8);
            *(LAS u32x4*)(Vl + kr * 72 + ch * 8) = v; }
        bf16x8_t qf[2];
        { const bf16* qrow = Qp + (size_t)(rowbase + (long)(16 * w + fr) * dil) * IN1 + 8 * fq; qf[0] = *(const bf16x8_t*)qrow; qf[1] = *(const bf16x8_t*)(qrow + 32); }
        f32x4 s[10];
#pragma unroll
        for (int c = 0; c < 10; ++c) { const int kr = 16 * (ct0 + c) + fr; bf16x8_t k0 = (bf16x8_t){0, 0, 0, 0, 0, 0, 0, 0}, k1 = k0;
            if (nb > 0 || kr >= 128) { const bf16* krow = Kp + (size_t)(rowbase + (long)(kr - 128) * dil) * IN1 + 8 * fq; k0 = *(const bf16x8_t*)krow; k1 = *(const bf16x8_t*)(krow + 32); }
            s[c] = __builtin_amdgcn_mfma_f32_16x16x32_bf16(k0, qf[0], (f32x4){0.f, 0.f, 0.f, 0.f}, 0, 0, 0);
            s[c] = __builtin_amdgcn_mfma_f32_16x16x32_bf16(k1, qf[1], s[c], 0, 0, 0); }
        const int l = 16 * w + fr;
        float mx = -1e30f;
#pragma unroll
        for (int c = 0; c < 10; ++c)
#pragma unroll
            for (int rg = 0; rg < 4; ++rg) { const int kr = 16 * (ct0 + c) + 4 * fq + rg, steps = l + 128 - kr;
                const bool ok = steps >= 0 && steps <= 128 && (nb > 0 || kr >= 128);
                const float v = ok ? s[c][rg] * 0.125f - sl * (float)steps : -1e30f; s[c][rg] = v; mx = fmaxf(mx, v); }
        mx = fmaxf(mx, __shfl_xor(mx, 16)); mx = fmaxf(mx, __shfl_xor(mx, 32));
        float den = 0.f;
#pragma unroll
        for (int c = 0; c < 10; ++c)
#pragma unroll
            for (int rg = 0; rg < 4; ++rg) { const float p = (s[c][rg] > -1e29f) ? __expf(s[c][rg] - mx) : 0.f; s[c][rg] = p; den += p; }
        den += __shfl_xor(den, 16); den += __shfl_xor(den, 32);
        bf16x8_t pf[5];
#pragma unroll
        for (int k = 0; k < 5; ++k) { u32x4 wv; wv.x = pg8::cvt_pk_bf16(s[2 * k][0], s[2 * k][1]); wv.y = pg8::cvt_pk_bf16(s[2 * k][2], s[2 * k][3]);
            wv.z = pg8::cvt_pk_bf16(s[2 * k + 1][0], s[2 * k + 1][1]); wv.w = pg8::cvt_pk_bf16(s[2 * k + 1][2], s[2 * k + 1][3]); pf[k] = __builtin_bit_cast(bf16x8_t, wv); }
        __syncthreads();
        f32x4 o[4];
#pragma unroll
        for (int dt = 0; dt < 4; ++dt) o[dt] = (f32x4){0.f, 0.f, 0.f, 0.f};
#pragma unroll
        for (int k = 0; k < 5; ++k) {
            u32x2 a0, a1, a2, a3, a4, a5, a6, a7; const unsigned va = vaddr0 + (unsigned)(k * 32 * 72 * 2);
            asm volatile("ds_read_b64_tr_b16 %0, %8\n\tds_read_b64_tr_b16 %1, %8 offset:2304\n\tds_read_b64_tr_b16 %2, %8 offset:32\n\tds_read_b64_tr_b16 %3, %8 offset:2336\n\t"
                         "ds_read_b64_tr_b16 %4, %8 offset:64\n\tds_read_b64_tr_b16 %5, %8 offset:2368\n\tds_read_b64_tr_b16 %6, %8 offset:96\n\tds_read_b64_tr_b16 %7, %8 offset:2400\n\ts_waitcnt lgkmcnt(0)"
                         : "=&v"(a0), "=&v"(a1), "=&v"(a2), "=&v"(a3), "=&v"(a4), "=&v"(a5), "=&v"(a6), "=&v"(a7) : "v"(va) : "memory");
            __builtin_amdgcn_sched_barrier(0);
            o[0] = __builtin_amdgcn_mfma_f32_16x16x32_bf16(__builtin_bit_cast(bf16x8_t, (u32x4){a0.x, a0.y, a1.x, a1.y}), pf[k], o[0], 0, 0, 0);
            o[1] = __builtin_amdgcn_mfma_f32_16x16x32_bf16(__builtin_bit_cast(bf16x8_t, (u32x4){a2.x, a2.y, a3.x, a3.y}), pf[k], o[1], 0, 0, 0);
            o[2] = __builtin_amdgcn_mfma_f32_16x16x32_bf16(__builtin_bit_cast(bf16x8_t, (u32x4){a4.x, a4.y, a5.x, a5.y}), pf[k], o[2], 0, 0, 0);
            o[3] = __builtin_amdgcn_mfma_f32_16x16x32_bf16(__builtin_bit_cast(bf16x8_t, (u32x4){a6.x, a6.y, a7.x, a7.y}), pf[k], o[3], 0, 0, 0);
        }
        const float inv = 1.f / den; const size_t tok = (size_t)(rowbase + (long)l * dil);
        bf16* op = OG + ((size_t)g * M + tok) * 512 + h * 64 + 4 * fq;
#pragma unroll
        for (int dt = 0; dt < 4; ++dt) { u32x2 wv; wv.x = pg8::cvt_pk_bf16(o[dt][0] * inv, o[dt][1] * inv); wv.y = pg8::cvt_pk_bf16(o[dt][2] * inv, o[dt][3] * inv); *(u32x2*)(op + 16 * dt) = wv; }
        if (fq == 0) LSE[((size_t)g * M + tok) * 8 + h] = mx + __logf(den);
    }
}

__device__ __forceinline__ void ph_merge(Frame& F) {
    const bf16* OG = (const bf16*)(F.ws + WS_OG); const float* LSE = (const float*)(F.ws + WS_LSE); bf16* Y2 = (bf16*)(F.ws + WS_Y2);
    const int total = M * 64, nth = F.G * NT;
    for (int idx = blockIdx.x * NT + F.tid; idx < total; idx += nth) {
        const int m = idx >> 6, c8 = idx & 63, h = c8 >> 3;
        const float l0 = LSE[((size_t)0 * M + m) * 8 + h], l1 = LSE[((size_t)1 * M + m) * 8 + h], l2 = LSE[((size_t)2 * M + m) * 8 + h];
        const float mx = fmaxf(l0, fmaxf(l1, l2)); float w0 = __expf(l0 - mx), w1 = __expf(l1 - mx), w2 = __expf(l2 - mx); const float inv = 1.f / (w0 + w1 + w2);
        w0 *= inv; w1 *= inv; w2 *= inv;
        const u32x4 a = *(const u32x4*)(OG + ((size_t)0 * M + m) * 512 + c8 * 8), b = *(const u32x4*)(OG + ((size_t)1 * M + m) * 512 + c8 * 8), c = *(const u32x4*)(OG + ((size_t)2 * M + m) * 512 + c8 * 8);
        u32x4 o;
        o.x = pk2(w0 * bflo(a.x) + w1 * bflo(b.x) + w2 * bflo(c.x), w0 * bfhi(a.x) + w1 * bfhi(b.x) + w2 * bfhi(c.x));
        o.y = pk2(w0 * bflo(a.y) + w1 * bflo(b.y) + w2 * bflo(c.y), w0 * bfhi(a.y) + w1 * bfhi(b.y) + w2 * bfhi(c.y));
        o.z = pk2(w0 * bflo(a.z) + w1 * bflo(b.z) + w2 * bflo(c.z), w0 * bfhi(a.z) + w1 * bfhi(b.z) + w2 * bfhi(c.z));
        o.w = pk2(w0 * bflo(a.w) + w1 * bflo(b.w) + w2 * bflo(c.w), w0 * bfhi(a.w) + w1 * bfhi(b.w) + w2 * bfhi(c.w));
        *(u32x4*)(Y2 + (size_t)m * 512 + c8 * 8) = o;
    }
}

__device__ __forceinline__ void gemm_inproj(Frame& F, const void* A, size_t wt, int N) {
    pg8::StaticOrder S; S.init(A, F.ws + wt, M, N, D, F.G, (int)blockIdx.x); pg8::EpiBf16 E{(bf16*)(F.ws + WS_P), N};
    pg8::gemm_phase<pg8::EpiBf16, pg8::StaticOrder, true, false>(F.lds, D, S, E);
}
template <bool BASE_BF16>
__device__ __forceinline__ void gemm_outproj(Frame& F, size_t a, size_t wt, int K, const void* base) {
    pg8::StaticOrder S; S.init(F.ws + a, F.ws + wt, M, D, K, F.G, (int)blockIdx.x); pg8::EpiResBf16<BASE_BF16> E{base, (bf16*)((char*)F.out + 32 * MiB), ALPHA};
    pg8::gemm_phase<pg8::EpiResBf16<BASE_BF16>, pg8::StaticOrder, false, false>(F.lds, K, S, E);
}
__device__ __forceinline__ void gemm_moe1(Frame& F, int layer) {
    pg8::MoeOrder S{F.ctl + CW_CNT + layer * 32 * 64, (const int*)(F.ws + WS_LIST), (const char*)(F.ws + WS_XB), (const char*)(F.ws + WS_EW), 2, F.G, (int)blockIdx.x, D, 0};
    pg8::EpiSwiGLU E{(bf16*)(F.ws + WS_HID)}; pg8::gemm_phase<pg8::EpiSwiGLU, pg8::MoeOrder, true, true>(F.lds, D, S, E);
}
__device__ __forceinline__ void gemm_moe2(Frame& F, int layer) {
    pg8::MoeOrder S{F.ctl + CW_CNT + layer * 32 * 64, (const int*)(F.ws + WS_LIST), (const char*)(F.ws + WS_HID), (const char*)(F.ws + WS_EW + EW_DN), 4, F.G, (int)blockIdx.x, DE, 1};
    pg8::EpiMoeOut E{(bf16*)(F.ws + WS_YB), (const int*)(F.ws + WS_LIST)}; pg8::gemm_phase<pg8::EpiMoeOut, pg8::MoeOrder, true, false>(F.lds, DE, S, E);
}

struct Args { const float* in[18]; float* out; unsigned char* ws; int ph_lo, ph_hi, li, pad; };
__global__ void __launch_bounds__(NT, 2) mega_fwd(Args args) {
    extern __shared__ __attribute__((aligned(16))) unsigned char lds_raw[];
    Frame F;
    F.lds = (LAS unsigned char*)lds_raw;
    F.tid = threadIdx.x; F.lane = F.tid & 63; F.wave = __builtin_amdgcn_readfirstlane(F.tid >> 6);
    F.G = gridDim.x; { const int bx = blockIdx.x; F.vcu = (F.G % 8 == 0) ? (bx % 8) * (F.G / 8) + bx / 8 : bx; }
#pragma unroll
    for (int i = 0; i < 18; ++i) F.in[i] = args.in[i];
    F.out = args.out; F.ws = args.ws; F.ctl = (unsigned*)(args.ws + WS_CTL);
    volatile LAS unsigned* MISC = (volatile LAS unsigned*)(F.lds + LDS_BYTES - 128);
    if (F.tid < 32) MISC[F.tid] = 0u;
    __syncthreads();
    XcdBarrier bar; bar.bar = F.ctl + CW_BAR; bar.x = 0; bar.st = nullptr;
    if (MK_N_LAUNCHES == 1) bar = xcd_barrier_post(F.ctl + CW_BAR, MISC + 8);
    const int lo = args.ph_lo, hi = args.ph_hi;
#define IN(k) (lo <= (k) && (k) < hi)
#define SEAM(k) do { if (IN(k) && IN((k) + 1)) xcd_barrier(bar); } while (0)
#define DUP(k) ((PROBE_DUP >> (k)) & 1)
#define PHASE(k, ...) do { if (IN(k)) { __VA_ARGS__; if (DUP(k)) { xcd_barrier(bar); __VA_ARGS__; } } SEAM(k); } while (0)
    PHASE(0, ph0_convert(F));
    PHASE(1, gemm_inproj(F, F.ws + WS_XB, WS_WT0, NP0));
    PHASE(2, ph_mix_a(F); xcd_barrier(bar); ph_mix_b(F));
    PHASE(3, ph_mix_c(F));
    PHASE(4, gemm_outproj<false>(F, WS_Y, WS_WO0, D, F.in[0]));
    if (IN(5)) { convert_experts(F, 0); if (DUP(5)) { __syncthreads(); convert_experts(F, 0); } __syncthreads(); ph_ln<0, true, 0>(F, 0); } SEAM(5);
    PHASE(6, gemm_moe1(F, 0));
    PHASE(7, gemm_moe2(F, 0));
    if (IN(8)) { ph_ln<1, false, 1>(F, 0); __syncthreads(); convert_experts(F, 1); if (DUP(8)) { __syncthreads(); convert_experts(F, 1); } } SEAM(8);
    PHASE(9, gemm_inproj(F, F.out, WS_WT1, IN1));
    PHASE(10, ph_attn_mfma(F));
    PHASE(11, ph_merge(F));
    PHASE(12, gemm_outproj<true>(F, WS_Y2, WS_WO1, 512, F.out));
    if (IN(13)) { ph_ln<0, true, 0>(F, 1); } SEAM(13);
    PHASE(14, gemm_moe1(F, 1));
    PHASE(15, gemm_moe2(F, 1));
    if (IN(16)) { ph_ln<1, false, 2>(F, 1); }
#undef IN
#undef SEAM
#undef PHASE
#undef DUP
}

extern "C" void kernel_launch(void* const* d_in, const int* in_sizes, int n_in, void* d_out, int out_size, void* d_ws, size_t ws_size, hipStream_t stream) {
    static int grid = 0;
    if (grid == 0) {
        if (n_in != 18 || in_sizes[0] != M * D || out_size != M * D || ws_size < WS_END) {
            fprintf(stderr, "kernel_launch: unexpected problem (n_in %d, in0 %d, out %d, ws %zu < %zu)\n", n_in, n_in > 0 ? in_sizes[0] : -1, out_size, ws_size, (size_t)WS_END); grid = -1; return; }
        int dev = 0, cus = 0;
        if (hipGetDevice(&dev) != hipSuccess || hipDeviceGetAttribute(&cus, hipDeviceAttributeMultiprocessorCount, dev) != hipSuccess) { grid = -1; return; }
        if (hipFuncSetAttribute((const void*)mega_fwd, hipFuncAttributeMaxDynamicSharedMemorySize, LDS_BYTES) != hipSuccess) { fprintf(stderr, "kernel_launch: hipFuncSetAttribute failed\n"); grid = -1; return; }
        int per_cu = 0;
        if (hipOccupancyMaxActiveBlocksPerMultiprocessor(&per_cu, (const void*)mega_fwd, NT, LDS_BYTES) != hipSuccess || per_cu < 1) fprintf(stderr, "kernel_launch: occupancy query says %d\n", per_cu);
        (void)hipGetLastError();
        grid = cus;
    }
    if (grid < 0) return;
    (void)hipMemsetAsync((char*)d_ws + WS_CTL, 0, CTL_ZERO_BYTES, stream);
    Args a{};
    for (int i = 0; i < 18; ++i) a.in[i] = (const float*)d_in[i];
    a.out = (float*)d_out; a.ws = (unsigned char*)d_ws;
    if (MK_N_LAUNCHES == 1) {
        a.ph_lo = 0; a.ph_hi = N_PHASES; a.li = 0;
        hipLaunchKernelGGL(mega_fwd, dim3(grid), dim3(NT), LDS_BYTES, stream, a);
    } else {
        for (int p = 0; p < N_PHASES; ++p) { a.ph_lo = p; a.ph_hi = p + 1; a.li = p; hipLaunchKernelGGL(mega_fwd, dim3(grid), dim3(NT), LDS_BYTES, stream, a); }
    }
}
```

```cpp
#include <hip/hip_runtime.h>
#include <cstdio>
#include <cstdint>

#ifndef PROBE_DUP
#define PROBE_DUP 0
#endif
#ifndef MK_N_LAUNCHES
#define MK_N_LAUNCHES 1
#endif

#define LAS __attribute__((address_space(3)))
typedef unsigned short bf16;
typedef float f32x4 __attribute__((ext_vector_type(4)));
typedef unsigned u32x4 __attribute__((ext_vector_type(4)));
typedef unsigned u32x2 __attribute__((ext_vector_type(2)));
typedef short bf16x8_t __attribute__((ext_vector_type(8)));
#define RLX_AGENT __ATOMIC_RELAXED, __HIP_MEMORY_SCOPE_AGENT
#define LDS_WAIT() asm volatile("s_waitcnt lgkmcnt(0)" ::: "memory")
#define VM_WAIT() asm volatile("s_waitcnt vmcnt(0)" ::: "memory")

constexpr int NWAVES = 8, NT = NWAVES * 64;
constexpr int BATCH = 2, T = 8192, D = 1024, M = BATCH * T;
constexpr int IN0 = 4104, IN1 = 4608, NP0 = 4096;
constexpr int NE = 32, DE = 256;
constexpr float ALPHA = 1.41421356237309515f;
constexpr float LN_EPS = 1e-5f;
constexpr float KSCALE = 0.08838834764831845f;
constexpr int N_PHASES = 17;

constexpr size_t MiB = 1u << 20;
constexpr size_t WS_CTL = 0, CTL_ZERO_BYTES = 1 * MiB;
constexpr size_t WS_G = 1 * MiB;
constexpr size_t WS_EIDX = WS_G + 512 * 1024;
constexpr size_t WS_GATEV = WS_EIDX + 128 * 1024;
constexpr size_t WS_WT0 = 2 * MiB;
constexpr size_t WS_WO0 = 10 * MiB;
constexpr size_t WS_WT1 = 12 * MiB;
constexpr size_t WS_WO1 = 21 * MiB;
constexpr size_t WS_SE = 22 * MiB;
constexpr size_t WS_EW = WS_SE;
constexpr size_t EW_STRIDE = 3 * MiB / 2, EW_DN = 1 * MiB;
constexpr size_t WS_LIST = WS_SE + 48 * MiB;
constexpr size_t WS_LSE = WS_SE + 50 * MiB;
constexpr size_t WS_XB = 86 * MiB;
constexpr size_t WS_Y = 118 * MiB;
constexpr size_t WS_OG = WS_XB;
constexpr size_t WS_Y2 = WS_XB + 48 * MiB;
constexpr size_t WS_P = 150 * MiB;
constexpr size_t WS_YB = WS_P;
constexpr size_t WS_HID = WS_P + 64 * MiB;
constexpr size_t WS_END = 294 * MiB;
constexpr size_t WS_QKC = WS_SE;

constexpr int CW_BAR = 4096;
constexpr int CW_CNT = 16384;

constexpr int LDS_BYTES = 147456;

__device__ __forceinline__ unsigned f2bf(float f) { unsigned u = __builtin_bit_cast(unsigned, f); return (u + 0x7fffu + ((u >> 16) & 1u)) >> 16; }
__device__ __forceinline__ unsigned pk2(float lo, float hi) { return f2bf(lo) | (f2bf(hi) << 16); }
__device__ __forceinline__ float bf2f(unsigned b) { return __builtin_bit_cast(float, b << 16); }
__device__ __forceinline__ float bflo(unsigned w) { return __builtin_bit_cast(float, w << 16); }
__device__ __forceinline__ float bfhi(unsigned w) { return __builtin_bit_cast(float, w & 0xffff0000u); }
__device__ __forceinline__ float wave_sum(float v) {
#pragma unroll
    for (int o = 1; o < 64; o <<= 1) v += __shfl_xor(v, o);
    return v;
}
__device__ __forceinline__ float sigmoidf_(float x) { return 1.f / (1.f + __expf(-x)); }
__device__ __forceinline__ float siluf_(float x) { return x / (1.f + __expf(-x)); }

#define XB_TMO      128
#define XB_XCNT(j)  (256  + 64 * (j))
#define XB_XSUB(j)  (1280 + 64 * (j))
#define XB_XGEN(j)  (2304 + 64 * (j))
#define XB_TOP      3328
#define XB_TOPGEN   3392
#define XCD_BAR_WORDS 3456
#define XB_SPIN_CAP (1u << 22)
__device__ __forceinline__ unsigned xb_ld(unsigned* p)              { return __hip_atomic_load(p, __ATOMIC_RELAXED, __HIP_MEMORY_SCOPE_AGENT); }
__device__ __forceinline__ unsigned xb_add(unsigned* p, unsigned v) { return __hip_atomic_fetch_add(p, v, __ATOMIC_RELAXED, __HIP_MEMORY_SCOPE_AGENT); }
__device__ __forceinline__ unsigned xb_xcc_id() { return (unsigned)__builtin_amdgcn_s_getreg((3 << 11) | 20) & 0xFu; }
#define XB_SPIN(cond, bar) do { unsigned _sp = 0; while (cond) { __builtin_amdgcn_s_sleep(1); \
    if ((++_sp & 255u) == 0u) { if (xb_ld(&(bar)[XB_TMO])) break; if (_sp > XB_SPIN_CAP) { atomicAdd(&(bar)[XB_TMO], 1u); break; } } } } while (0)
struct XcdBarrier { unsigned* bar; unsigned x; volatile LAS unsigned* st; };
__device__ __forceinline__ XcdBarrier xcd_barrier_post(unsigned* bar, volatile LAS unsigned* st) {
    XcdBarrier b; b.bar = bar; b.x = xb_xcc_id(); b.st = st;
    if (threadIdx.x == 0) (void)xb_add(&bar[XB_XCNT(b.x)], 1u);
    return b;
}
__device__ __forceinline__ void xcd_barrier_complete(unsigned* bar, unsigned x, unsigned& nloc, unsigned& nx) {
    const unsigned G = gridDim.x * gridDim.y * gridDim.z;
    unsigned sum, cnt, mine, sp = 0u;
    for (;;) {
        sum = 0u; cnt = 0u; mine = 0u;
#pragma unroll
        for (unsigned j = 0; j < 16; ++j) { const unsigned c = xb_ld(&bar[XB_XCNT(j)]); sum += c; cnt += (c > 0u) ? 1u : 0u; mine = (j == x) ? c : mine; }
        if (sum == G) break;
        __builtin_amdgcn_s_sleep(1);
        if ((++sp & 255u) == 0u) { if (xb_ld(&bar[XB_TMO])) break; if (sp > XB_SPIN_CAP) { atomicAdd(&bar[XB_TMO], 1u); break; } }
    }
    nloc = mine > 0u ? mine : 1u; nx = cnt > 0u ? cnt : 1u;
}
__device__ __forceinline__ void xcd_barrier(const XcdBarrier& b) {
    asm volatile("s_waitcnt vmcnt(0)" ::: "memory");
    __syncthreads();
    if (threadIdx.x == 0) {
        unsigned* bar = b.bar;
        __builtin_amdgcn_s_waitcnt(0);
        unsigned nloc = b.st[0], nx = b.st[1];
        if (nloc == 0u) { xcd_barrier_complete(bar, b.x, nloc, nx); b.st[0] = nloc; b.st[1] = nx; }
        const unsigned old = xb_add(&bar[XB_XSUB(b.x)], 1u);
        const unsigned gen = old / nloc;
        if (old + 1u == (gen + 1u) * nloc) {
            __builtin_amdgcn_fence(__ATOMIC_RELEASE, "agent");
            asm volatile("s_waitcnt vmcnt(0)" ::: "memory");
            const unsigned og = xb_add(&bar[XB_TOP], 1u);
            const unsigned tg = og / nx;
            if (og + 1u == (tg + 1u) * nx) xb_add(&bar[XB_TOPGEN], 1u);
            else XB_SPIN(xb_ld(&bar[XB_TOPGEN]) == tg, bar);
            __builtin_amdgcn_fence(__ATOMIC_ACQUIRE, "agent");
            xb_add(&bar[XB_XGEN(b.x)], 1u);
            asm volatile("s_waitcnt vmcnt(0)" ::: "memory");
        } else {
            XB_SPIN(xb_ld(&bar[XB_XGEN(b.x)]) == gen, bar);
            __builtin_amdgcn_fence(__ATOMIC_ACQUIRE, "agent");
            asm volatile("s_waitcnt vmcnt(0)" ::: "memory");
        }
    }
    __syncthreads();
}

struct Frame {
    LAS unsigned char* lds;
    unsigned* ctl;
    int tid, lane, wave, vcu, G;
    const float* in[18];
    float* out;
    unsigned char* ws;
};

namespace pg8 {
typedef short bf16x8 __attribute__((ext_vector_type(8)));
constexpr int BM = 256, BK = 64, HALF = 128, HTB = HALF * BK * 2, STAGE_BYTES = 8 * HTB, NXCD = 8, WGM = 8;
__host__ __device__ __forceinline__ int lds_byte(int r, int c) { const int st = (r >> 4) * 2 + (c >> 5), rr = r & 15, cc = c & 31, ob = rr * 64 + cc * 2; return st * 1024 + (ob ^ (((ob >> 9) & 1) << 5)); }
__host__ __device__ __forceinline__ void stage_rc(int b, int& R, int& C) { const int st = b / 1024, sb = b % 1024, swz = sb ^ (((sb >> 9) & 1) << 5); R = (st >> 1) * 16 + swz / 64; C = (st & 1) * 32 + (swz % 64) / 2; }
__host__ __device__ __forceinline__ int perm32(int rho) { const int n = rho >> 4, i = rho & 15; return 8 * (i >> 2) + 4 * n + (i & 3); }
struct Unit { int pm, pn, e, cnt, hb; };
typedef __bf16 bf16n2 __attribute__((ext_vector_type(2)));
typedef float f32x2n __attribute__((ext_vector_type(2)));
__device__ __forceinline__ unsigned cvt_pk_bf16(float lo, float hi) { const bf16n2 v = __builtin_convertvector((f32x2n){lo, hi}, bf16n2); return __builtin_bit_cast(unsigned, v); }

struct StaticOrder {
    int nM, nN, nwg, G, c, K; const char* A; const char* Bt;
    __device__ void init(const void* A_, const void* Bt_, int M_, int N_, int K_, int G_, int c_) { A = (const char*)A_; Bt = (const char*)Bt_; nM = M_ / BM; nN = N_ / BM; nwg = nM * nN; G = G_; c = c_; K = K_; }
    __device__ bool next(int i, Unit& u) const {
        const long L = (long)i * G + c; if (L >= nwg) return false;
        int wgid = (int)L; { const int q = nwg / NXCD, r = nwg % NXCD, xcd = wgid % NXCD, off = wgid / NXCD; wgid = (xcd < r ? xcd * (q + 1) : r * (q + 1) + (xcd - r) * q) + off; }
        const int nig = WGM * nN, gid = wgid / nig, fm = gid * WGM, gsz = (nM - fm) < WGM ? (nM - fm) : WGM;
        u.pm = fm + ((wgid % nig) % gsz); u.pn = (wgid % nig) / gsz; u.e = 0; u.cnt = 0; u.hb = 0; return true;
    }
    __device__ __forceinline__ void base(const Unit& u, const char*& cA, const char*& cB) const { cA = A + (size_t)u.pm * BM * K * 2; cB = Bt + (size_t)u.pn * BM * K * 2; }
    __device__ __forceinline__ unsigned rowoff(const Unit&, int) const { return 0u; }
};

struct EpiBf16 {
    static constexpr bool PERM = true;
    bf16* O; int ldc;
    __device__ __forceinline__ void operator()(const f32x4 (&acc)[2][2][4][2], const Unit& u, int wr, int wc, int fr, int fq) const {
        const int row0 = u.pm * BM + wr * 64 + fr, col0 = u.pn * BM + wc * 32 + 8 * fq;
#pragma unroll
        for (int ai = 0; ai < 2; ++ai)
#pragma unroll
            for (int m = 0; m < 4; ++m) { bf16* rowp = O + (size_t)(row0 + ai * HALF + m * 16) * ldc + col0;
#pragma unroll
                for (int bj = 0; bj < 2; ++bj) { const f32x4 v0 = acc[ai][bj][m][0], v1 = acc[ai][bj][m][1];
                    u32x4 w; w.x = cvt_pk_bf16(v0[0], v0[1]); w.y = cvt_pk_bf16(v0[2], v0[3]); w.z = cvt_pk_bf16(v1[0], v1[1]); w.w = cvt_pk_bf16(v1[2], v1[3]);
                    *(u32x4*)(rowp + bj * HALF) = w; } }
    }
};
template <bool BASE_BF16>
struct EpiResBf16 {
    static constexpr bool PERM = true;
    const void* base; bf16* out; float alpha;
    __device__ __forceinline__ void operator()(const f32x4 (&acc)[2][2][4][2], const Unit& u, int wr, int wc, int fr, int fq) const {
        const int col0 = u.pn * BM + wc * 32 + 8 * fq;
#pragma unroll
        for (int ai = 0; ai < 2; ++ai)
#pragma unroll
            for (int m = 0; m < 4; ++m) { const size_t off = (size_t)(u.pm * BM + ai * HALF + wr * 64 + m * 16 + fr) * 1024 + col0;
#pragma unroll
                for (int bj = 0; bj < 2; ++bj) { f32x4 b0, b1;
                    if (BASE_BF16) { const u32x4 x = *(const u32x4*)((const bf16*)base + off + bj * HALF); b0 = (f32x4){bflo(x.x), bfhi(x.x), bflo(x.y), bfhi(x.y)}; b1 = (f32x4){bflo(x.z), bfhi(x.z), bflo(x.w), bfhi(x.w)}; }
                    else { b0 = *(const f32x4*)((const float*)base + off + bj * HALF); b1 = *(const f32x4*)((const float*)base + off + bj * HALF + 4); }
                    const f32x4 v0 = b0 * alpha + acc[ai][bj][m][0], v1 = b1 * alpha + acc[ai][bj][m][1];
                    u32x4 w; w.x = cvt_pk_bf16(v0[0], v0[1]); w.y = cvt_pk_bf16(v0[2], v0[3]); w.z = cvt_pk_bf16(v1[0], v1[1]); w.w = cvt_pk_bf16(v1[2], v1[3]);
                    *(u32x4*)(out + off + bj * HALF) = w; }
                if (m & 1) asm volatile("" ::: "memory"); }
    }
};

struct MoeOrder {
    const unsigned* cnt; const int* LIST; const char* A; const char* B; int NTN, G, c, K, mode;
    __device__ bool next(int i, Unit& u) const {
        const int L = i * G + c; int base = 0, hb = 0;
        for (int e = 0; e < 32; ++e) { const int cc = (int)cnt[e * 64]; const int nmb = (cc + 255) >> 8; const int ntl = nmb * NTN;
            if (L < base + ntl) { const int r = L - base; u.e = e; u.pm = r / NTN; u.pn = r % NTN; u.cnt = cc; u.hb = hb; return true; }
            base += ntl; hb += nmb << 8; }
        return false;
    }
    __device__ __forceinline__ void base(const Unit& u, const char*& cA, const char*& cB) const {
        cA = mode == 0 ? A : A + (size_t)(u.hb + u.pm * 256) * K * 2; cB = B + (size_t)u.e * EW_STRIDE + (size_t)u.pn * 256 * K * 2; }
    __device__ __forceinline__ unsigned rowoff(const Unit& u, int r) const { int i = u.pm * 256 + r; i = i < u.cnt ? i : 0; return (unsigned)(LIST[u.e * M + i] >> 1) * 2048u; }
};
struct EpiSwiGLU {
    static constexpr bool PERM = true;
    bf16* HID;
    __device__ __forceinline__ void operator()(const f32x4 (&acc)[2][2][4][2], const Unit& u, int wr, int wc, int fr, int fq) const {
#pragma unroll
        for (int ai = 0; ai < 2; ++ai)
#pragma unroll
            for (int m = 0; m < 4; ++m) { const int i = u.pm * 256 + ai * HALF + wr * 64 + m * 16 + fr;
                if (i < u.cnt) { const f32x4 g0 = acc[ai][0][m][0], g1 = acc[ai][0][m][1], u0 = acc[ai][1][m][0], u1 = acc[ai][1][m][1];
                    u32x4 w; w.x = cvt_pk_bf16(siluf_(g0[0]) * u0[0], siluf_(g0[1]) * u0[1]); w.y = cvt_pk_bf16(siluf_(g0[2]) * u0[2], siluf_(g0[3]) * u0[3]);
                    w.z = cvt_pk_bf16(siluf_(g1[0]) * u1[0], siluf_(g1[1]) * u1[1]); w.w = cvt_pk_bf16(siluf_(g1[2]) * u1[2], siluf_(g1[3]) * u1[3]);
                    *(u32x4*)(HID + (size_t)(u.hb + i) * DE + u.pn * 128 + wc * 32 + 8 * fq) = w; } }
    }
};
struct EpiMoeOut {
    static constexpr bool PERM = true;
    bf16* YB; const int* LIST;
    __device__ __forceinline__ void operator()(const f32x4 (&acc)[2][2][4][2], const Unit& u, int wr, int wc, int fr, int fq) const {
#pragma unroll
        for (int ai = 0; ai < 2; ++ai)
#pragma unroll
            for (int m = 0; m < 4; ++m) { const int i = u.pm * 256 + ai * HALF + wr * 64 + m * 16 + fr;
                if (i < u.cnt) { const int a = LIST[u.e * M + i]; bf16* rowp = YB + (size_t)a * D + u.pn * 256 + wc * 32 + 8 * fq;
#pragma unroll
                    for (int bj = 0; bj < 2; ++bj) { const f32x4 v0 = acc[ai][bj][m][0], v1 = acc[ai][bj][m][1];
                        u32x4 w; w.x = cvt_pk_bf16(v0[0], v0[1]); w.y = cvt_pk_bf16(v0[2], v0[3]); w.z = cvt_pk_bf16(v1[0], v1[1]); w.w = cvt_pk_bf16(v1[2], v1[3]);
                        *(u32x4*)(rowp + bj * HALF) = w; } }
                asm volatile("" ::: "memory"); }
    }
};

template <class Epi, class Sched, bool ALIGN_EPI, bool GATHER>
__device__ __forceinline__ void gemm_phase(LAS unsigned char* lds, const int K, const Sched& S, const Epi& E) {
    const int tid = threadIdx.x, wid = __builtin_amdgcn_readfirstlane(tid >> 6), lane = tid & 63, wr = wid >> 2, wc = wid & 3, fr = lane & 15, fq = lane >> 4;
    const int nt = K / BK;
    int Rr[2], Cc[2]; unsigned voffB[2];
#pragma unroll
    for (int i = 0; i < 2; ++i) { int R, C; stage_rc(tid * 16 + i * 8192, R, C); const int Rb = Epi::PERM ? ((R & ~31) + perm32(R & 31)) : R; Rr[i] = R; Cc[i] = C; voffB[i] = (unsigned)(Rb * K + C) * 2u; }
    const size_t kstep = (size_t)(BK * 2);
    const size_t hstep = (size_t)HALF * K * 2;
    const unsigned ldsw = (unsigned)wid * 1024u;
    const int aoff = lds_byte(wr * 64 + fr, fq * 8), boff = lds_byte(wc * 32 + fr, fq * 8);
#define PG8_SA(b, h) (((b) * 2 + (h)) * HTB)
#define PG8_SB(b, h) ((4 + (b) * 2 + (h)) * HTB)
#define PG8_STAGE(bufoff, gbase, voff) do { _Pragma("unroll") for (int _i = 0; _i < 2; ++_i) \
        __builtin_amdgcn_global_load_lds((const unsigned*)((const char*)(gbase) + (voff)[_i]), (LAS unsigned*)(lds + (bufoff) + ldsw + _i * 8192), 16, 0, 0); } while (0)
#define PG8_STAGE_A(bufoff, gbase, o0, o1) do { \
        __builtin_amdgcn_global_load_lds((const unsigned*)((const char*)(gbase) + (o0)), (LAS unsigned*)(lds + (bufoff) + ldsw), 16, 0, 0); \
        __builtin_amdgcn_global_load_lds((const unsigned*)((const char*)(gbase) + (o1)), (LAS unsigned*)(lds + (bufoff) + ldsw + 8192), 16, 0, 0); } while (0)
#define PG8_LDA(dst, b, h) do { _Pragma("unroll") for (int m = 0; m < 4; ++m) _Pragma("unroll") for (int k = 0; k < 2; ++k) dst[m][k] = *(const LAS bf16x8*)(lds + PG8_SA(b, h) + aoff + m * 2048 + k * 1024); } while (0)
#define PG8_LDB(dst, b, h) do { _Pragma("unroll") for (int n = 0; n < 2; ++n) _Pragma("unroll") for (int k = 0; k < 2; ++k) dst[n][k] = *(const LAS bf16x8*)(lds + PG8_SB(b, h) + boff + n * 2048 + k * 1024); } while (0)
#define PG8_MMA(ai, bj, At, Bt) do { __builtin_amdgcn_s_setprio(1); _Pragma("unroll") for (int m = 0; m < 4; ++m) _Pragma("unroll") for (int n = 0; n < 2; ++n) _Pragma("unroll") for (int k = 0; k < 2; ++k) \
        acc[ai][bj][m][n] = __builtin_amdgcn_mfma_f32_16x16x32_bf16(Bt[n][k], At[m][k], acc[ai][bj][m][n], 0, 0, 0); __builtin_amdgcn_s_setprio(0); } while (0)
#define PG8_WAIT_V(n) asm volatile("s_waitcnt vmcnt(" #n ")" ::: "memory")
#define PG8_WAIT_L(n) asm volatile("s_waitcnt lgkmcnt(" #n ")" ::: "memory")
#define PG8_BAR __builtin_amdgcn_s_barrier()
#define PG8_SCHED __builtin_amdgcn_sched_barrier(0)
#define PG8_CALC_VA(u, v) do { _Pragma("unroll") for (int _h = 0; _h < 2; ++_h) _Pragma("unroll") for (int _i = 0; _i < 2; ++_i) \
        v[_h][_i] = GATHER ? (S.rowoff(u, _h * HALF + Rr[_i]) + (unsigned)Cc[_i] * 2u) : (unsigned)((_h * HALF + Rr[_i]) * K + Cc[_i]) * 2u; } while (0)
    Unit cur, nxt; int ui = 0;
    if (!S.next(0, cur)) return;
    f32x4 acc[2][2][4][2];
#pragma unroll
    for (int a = 0; a < 2; ++a)
#pragma unroll
        for (int b = 0; b < 2; ++b)
#pragma unroll
            for (int m = 0; m < 4; ++m)
#pragma unroll
                for (int n = 0; n < 2; ++n) acc[a][b][m][n] = (f32x4){0.f, 0.f, 0.f, 0.f};
    bf16x8 At[4][2], B0[2][2], B1[2][2];
    const char* cA; const char* cB; S.base(cur, cA, cB);
    unsigned cvA[2][2], nvA[2][2];
    PG8_CALC_VA(cur, cvA);
    PG8_STAGE(PG8_SB(0, 0), cB, voffB); PG8_STAGE(PG8_SB(0, 1), cB + hstep, voffB); PG8_STAGE_A(PG8_SA(0, 0), cA, cvA[0][0], cvA[0][1]); PG8_STAGE_A(PG8_SA(0, 1), cA, cvA[1][0], cvA[1][1]);
    if (wr == 1) PG8_BAR;
    PG8_WAIT_V(2); PG8_BAR;
    PG8_STAGE(PG8_SB(1, 0), cB + kstep, voffB); PG8_STAGE_A(PG8_SA(1, 0), cA + kstep, cvA[0][0], cvA[0][1]); PG8_STAGE(PG8_SB(1, 1), cB + hstep + kstep, voffB);
    PG8_WAIT_V(6); PG8_BAR;
    for (;;) {
        const bool has_next = S.next(ui + 1, nxt);
        const char* nA = cA; const char* nB = cB;
        if (has_next) { S.base(nxt, nA, nB); PG8_CALC_VA(nxt, nvA); }
        else {
#pragma unroll
            for (int h = 0; h < 2; ++h)
#pragma unroll
                for (int i = 0; i < 2; ++i) nvA[h][i] = cvA[h][i]; }
        if (GATHER) { asm volatile("s_waitcnt vmcnt(0)" ::: "memory"); asm volatile("" : "+v"(nvA[0][0]), "+v"(nvA[0][1]), "+v"(nvA[1][0]), "+v"(nvA[1][1])); }
#pragma unroll 1
        for (int t = 0; t < nt; t += 2) {
            const bool last = (t == nt - 2);
            const char* a1 = cA + (size_t)(t + 1) * kstep;
            const char* a2 = last ? nA : cA + (size_t)(t + 2) * kstep; const char* b2 = last ? nB : cB + (size_t)(t + 2) * kstep;
            const char* a3 = a2 + kstep; const char* b3 = b2 + kstep;
            const unsigned x00 = last ? nvA[0][0] : cvA[0][0], x01 = last ? nvA[0][1] : cvA[0][1], x10 = last ? nvA[1][0] : cvA[1][0], x11 = last ? nvA[1][1] : cvA[1][1];
            PG8_LDB(B0, 0, 0); PG8_LDB(B1, 0, 1); PG8_SCHED; PG8_LDA(At, 0, 0); PG8_STAGE_A(PG8_SA(1, 1), a1, cvA[1][0], cvA[1][1]);
            PG8_WAIT_V(8); PG8_WAIT_L(0); PG8_BAR; PG8_MMA(0, 0, At, B0); PG8_MMA(0, 1, At, B1); PG8_BAR; PG8_SCHED;
            PG8_LDA(At, 0, 1); PG8_STAGE(PG8_SB(0, 0), b2, voffB); PG8_STAGE(PG8_SB(0, 1), b2 + hstep, voffB); PG8_STAGE_A(PG8_SA(0, 0), a2, x00, x01);
            PG8_WAIT_V(8); PG8_WAIT_L(0); PG8_BAR; PG8_MMA(1, 0, At, B0); PG8_MMA(1, 1, At, B1); PG8_BAR; PG8_SCHED;
            PG8_LDB(B0, 1, 0); PG8_LDB(B1, 1, 1); PG8_SCHED; PG8_LDA(At, 1, 0); PG8_STAGE_A(PG8_SA(0, 1), a2, x10, x11);
            PG8_WAIT_V(8); PG8_WAIT_L(0); PG8_BAR; PG8_MMA(0, 0, At, B0); PG8_MMA(0, 1, At, B1); PG8_BAR; PG8_SCHED;
            PG8_LDA(At, 1, 1); PG8_STAGE(PG8_SB(1, 0), b3, voffB); PG8_STAGE(PG8_SB(1, 1), b3 + hstep, voffB); PG8_STAGE_A(PG8_SA(1, 0), a3, x00, x01);
            PG8_WAIT_V(8); PG8_WAIT_L(0); PG8_BAR; PG8_MMA(1, 0, At, B0); PG8_MMA(1, 1, At, B1); PG8_BAR; PG8_SCHED;
        }
        if constexpr (ALIGN_EPI) { if (wr == 0) PG8_BAR; }
        E(acc, cur, wr, wc, fr, fq);
        if (!has_next) break;
#pragma unroll
        for (int a = 0; a < 2; ++a)
#pragma unroll
            for (int b = 0; b < 2; ++b)
#pragma unroll
                for (int m = 0; m < 4; ++m)
#pragma unroll
                    for (int n = 0; n < 2; ++n) acc[a][b][m][n] = (f32x4){0.f, 0.f, 0.f, 0.f};
        cur = nxt; cA = nA; cB = nB; ++ui;
#pragma unroll
        for (int h = 0; h < 2; ++h)
#pragma unroll
            for (int i = 0; i < 2; ++i) cvA[h][i] = nvA[h][i];
        if constexpr (ALIGN_EPI) { if (wr == 1) PG8_BAR; }
    }
    PG8_WAIT_V(0);
    if constexpr (!ALIGN_EPI) { if (wr == 0) PG8_BAR; }
    PG8_BAR;
#undef PG8_SA
#undef PG8_SB
#undef PG8_STAGE
#undef PG8_STAGE_A
#undef PG8_LDA
#undef PG8_LDB
#undef PG8_MMA
#undef PG8_WAIT_V
#undef PG8_WAIT_L
#undef PG8_BAR
#undef PG8_SCHED
#undef PG8_CALC_VA
}
}

template <class RowFn>
__device__ __forceinline__ void ngemm_tile(LAS float* sA, LAS float* sB, RowFn rowA, const bf16* Bt, int ldb, int K, float (&acc)[4][4]) {
    const int tid = threadIdx.x, tx = tid & 15, ty = tid >> 4;
#pragma unroll
    for (int i = 0; i < 4; ++i)
#pragma unroll
        for (int j = 0; j < 4; ++j) acc[i][j] = 0.f;
    const int ar = tid >> 2, ak = (tid & 3) * 8, br = tid >> 3, bk = (tid & 7) * 4;
    const bf16* ap = rowA(ar);
    const bf16* bp = Bt + (size_t)br * ldb;
    for (int k0 = 0; k0 < K; k0 += 32) {
        u32x4 av = (u32x4){0u, 0u, 0u, 0u};
        if (ap) av = *(const u32x4*)(ap + k0 + ak);
        const u32x2 bv = *(const u32x2*)(bp + k0 + bk);
        __syncthreads();
        LAS float* wa = sA + ar * 33 + ak;
        wa[0] = bflo(av.x); wa[1] = bfhi(av.x); wa[2] = bflo(av.y); wa[3] = bfhi(av.y); wa[4] = bflo(av.z); wa[5] = bfhi(av.z); wa[6] = bflo(av.w); wa[7] = bfhi(av.w);
        LAS float* wb = sB + br * 33 + bk;
        wb[0] = bflo(bv.x); wb[1] = bfhi(bv.x); wb[2] = bflo(bv.y); wb[3] = bfhi(bv.y);
        __syncthreads();
#pragma unroll 8
        for (int kk = 0; kk < 32; ++kk) {
            float a[4], b[4];
#pragma unroll
            for (int i = 0; i < 4; ++i) a[i] = sA[(ty * 4 + i) * 33 + kk];
#pragma unroll
            for (int j = 0; j < 4; ++j) b[j] = sB[(tx * 4 + j) * 33 + kk];
#pragma unroll
            for (int i = 0; i < 4; ++i)
#pragma unroll
                for (int j = 0; j < 4; ++j) acc[i][j] = fmaf(a[i], b[j], acc[i][j]);
        }
    }
}

__device__ __forceinline__ void tr_item(const float* W, int ldw, bf16* WT, int ldt, LAS float* scr, int kb, int nb, int lane) {
    const int k0 = 64 * kb, n0 = 32 * nb;
#pragma unroll 8
    for (int i = 0; i < 32; ++i) { const int kk = 2 * i + (lane >> 5); scr[kk * 33 + (lane & 31)] = W[(size_t)(k0 + kk) * ldw + n0 + (lane & 31)]; }
    LDS_WAIT(); asm volatile("" ::: "memory");
    const int c = lane & 7;
#pragma unroll
    for (int j = 0; j < 4; ++j) { const int n = (lane >> 3) + 8 * j; const LAS float* s = scr + (8 * c) * 33 + n;
        u32x4 o; o.x = pk2(s[0 * 33], s[1 * 33]); o.y = pk2(s[2 * 33], s[3 * 33]); o.z = pk2(s[4 * 33], s[5 * 33]); o.w = pk2(s[6 * 33], s[7 * 33]);
        *(u32x4*)(WT + (size_t)(n0 + n) * ldt + k0 + 8 * c) = o; }
    LDS_WAIT(); asm volatile("" ::: "memory");
}

__device__ __forceinline__ void ph0_convert(Frame& F) {
    LAS float* scr = (LAS float*)(F.lds + F.wave * 9216);
    LAS float* gw = (LAS float*)(F.lds + 8 * 9216);
    const float* w0 = F.in[1];
    for (int i = F.tid; i < 8 * 1024; i += NT) { const int j = i >> 10, k = i & 1023; gw[i] = w0[(size_t)k * IN0 + 2048 + j]; }
    __syncthreads();
    const int gwv = F.vcu * NWAVES + F.wave, NGW = F.G * NWAVES;
    bf16* WT0 = (bf16*)(F.ws + WS_WT0); bf16* WO0 = (bf16*)(F.ws + WS_WO0); bf16* WT1 = (bf16*)(F.ws + WS_WT1); bf16* WO1 = (bf16*)(F.ws + WS_WO1);
    constexpr int I0 = 16 * 64, I1 = 16 * 64, I2 = 16 * 32, I3 = 16 * 144, I4 = 8 * 32, NI = I0 + I1 + I2 + I3 + I4;
    for (int it = gwv; it < NI; it += NGW) {
        int r = it;
        if (r < I0) { tr_item(w0, IN0, WT0, 1024, scr, r / 64, r % 64, F.lane); continue; } r -= I0;
        if (r < I1) { tr_item(w0 + 2056, IN0, WT0 + (size_t)2048 * 1024, 1024, scr, r / 64, r % 64, F.lane); continue; } r -= I1;
        if (r < I2) { tr_item(F.in[8], 1024, WO0, 1024, scr, r / 32, r % 32, F.lane); continue; } r -= I2;
        if (r < I3) { tr_item(F.in[9], IN1, WT1, 1024, scr, r / 144, r % 144, F.lane); continue; } r -= I3;
        tr_item(F.in[10], 1024, WO1, 512, scr, r / 32, r % 32, F.lane);
    }
    const float* x = F.in[0]; bf16* XB = (bf16*)(F.ws + WS_XB); float* G = (float*)(F.ws + WS_G);
    const float* ib = F.in[2]; const float* fb = F.in[3];
    for (int m = gwv; m < M; m += NGW) {
        const f32x4* xr = (const f32x4*)(x + (size_t)m * D) + F.lane;
        f32x4 v[4];
#pragma unroll
        for (int j = 0; j < 4; ++j) v[j] = xr[64 * j];
        unsigned long long* o8 = (unsigned long long*)(XB + (size_t)m * D) + F.lane;
#pragma unroll
        for (int j = 0; j < 4; ++j) o8[64 * j] = (unsigned long long)pk2(v[j].x, v[j].y) | ((unsigned long long)pk2(v[j].z, v[j].w) << 32);
        float acc[8];
#pragma unroll
        for (int g = 0; g < 8; ++g) { float a = 0.f;
#pragma unroll
            for (int j = 0; j < 4; ++j) { const f32x4 w = *(const LAS f32x4*)(gw + g * 1024 + 4 * F.lane + 256 * j); a += v[j].x * w.x + v[j].y * w.y + v[j].z * w.z + v[j].w * w.w; }
            acc[g] = wave_sum(a); }
        if (F.lane == 0) {
#pragma unroll
            for (int g = 0; g < 4; ++g) G[(size_t)m * 8 + g] = acc[g] + ib[g];
#pragma unroll
            for (int g = 0; g < 4; ++g) { const float z = acc[4 + g] + fb[g]; G[(size_t)m * 8 + 4 + g] = fminf(z, 0.f) - log1pf(__expf(-fabsf(z))); }
        }
    }
}

__device__ __forceinline__ void convert_experts(Frame& F, int layer) {
    LAS float* scr = (LAS float*)(F.lds + F.wave * 9216);
    const int gwv = F.vcu * NWAVES + F.wave, NGW = F.G * NWAVES;
    const float* wg = F.in[13] + (size_t)layer * NE * D * DE; const float* wu = F.in[14] + (size_t)layer * NE * D * DE; const float* wd = F.in[15] + (size_t)layer * NE * DE * D;
    for (int it = gwv; it < NE * 384; it += NGW) {
        const int e = it / 384; int r = it % 384;
        bf16* GU = (bf16*)(F.ws + WS_EW + (size_t)e * EW_STRIDE); bf16* DN = (bf16*)(F.ws + WS_EW + (size_t)e * EW_STRIDE + EW_DN);
        if (r < 256) { const int job = r >> 6, q = r & 63;
            const float* src = ((job < 2) ? wg : wu) + (size_t)e * D * DE + (job & 1) * 128;
            bf16* dst = GU + (size_t)((job & 1) * 256 + (job >> 1) * 128) * 1024;
            tr_item(src, DE, dst, 1024, scr, q >> 2, q & 3, F.lane);
        } else { r -= 256;
            tr_item(wd + (size_t)e * DE * D, D, DN, DE, scr, r >> 5, r & 31, F.lane); }
    }
}

__device__ __forceinline__ void ph_inproj_naive(Frame& F, const bf16* Bt, int N) {
    LAS float* sA = (LAS float*)F.lds; LAS float* sB = sA + 128 * 33;
    const bf16* XB = (const bf16*)(F.ws + WS_XB); bf16* P = (bf16*)(F.ws + WS_P);
    const int nnb = N / 64, ntiles = (M / 128) * nnb, tx = F.tid & 15, ty = F.tid >> 4;
    for (int t = blockIdx.x; t < ntiles; t += F.G) {
        const int mb = t / nnb, nb = t % nnb; float acc[4][4];
        ngemm_tile(sA, sB, [&](int r) { return XB + (size_t)(mb * 128 + r) * D; }, Bt + (size_t)nb * 64 * D, D, D, acc);
#pragma unroll
        for (int i = 0; i < 4; ++i) { u32x2 o; o.x = pk2(acc[i][0], acc[i][1]); o.y = pk2(acc[i][2], acc[i][3]);
            *(u32x2*)(P + (size_t)(mb * 128 + ty * 4 + i) * N + nb * 64 + tx * 4) = o; }
    }
}
__device__ __forceinline__ void ph_outproj_naive(Frame& F, const bf16* A, int K, const bf16* Bt, const float* base) {
    LAS float* sA = (LAS float*)F.lds; LAS float* sB = sA + 128 * 33;
    const int nnb = D / 64, ntiles = (M / 128) * nnb, tx = F.tid & 15, ty = F.tid >> 4;
    for (int t = blockIdx.x; t < ntiles; t += F.G) {
        const int mb = t / nnb, nb = t % nnb; float acc[4][4];
        ngemm_tile(sA, sB, [&](int r) { return A + (size_t)(mb * 128 + r) * K; }, Bt + (size_t)nb * 64 * K, K, K, acc);
#pragma unroll
        for (int i = 0; i < 4; ++i) { const size_t off = (size_t)(mb * 128 + ty * 4 + i) * D + nb * 64 + tx * 4;
            const f32x4 b = *(const f32x4*)(base + off);
            *(f32x4*)(F.out + off) = (f32x4){ALPHA * b.x + acc[i][0], ALPHA * b.y + acc[i][1], ALPHA * b.z + acc[i][2], ALPHA * b.w + acc[i][3]}; }
    }
}

__device__ __forceinline__ void ph_conv_naive(Frame& F) {
    const bf16* P = (const bf16*)(F.ws + WS_P); bf16* QKC = (bf16*)(F.ws + WS_QKC);
    const float* cw = F.in[4]; const float* cb = F.in[5];
    const size_t total = (size_t)M * 1024, nth = (size_t)F.G * NT;
    for (size_t i = (size_t)blockIdx.x * NT + F.tid; i < total; i += nth) {
        const int m = (int)(i >> 10), c = (int)(i & 1023), t = m & (T - 1);
        float a = cb[c];
#pragma unroll
        for (int j = 0; j < 4; ++j) { const int tt = t - 3 + j; if (tt >= 0) a += cw[j * 1024 + c] * bf2f(P[(size_t)(m - 3 + j) * NP0 + c]); }
        QKC[i] = (bf16)f2bf(siluf_(a));
    }
}
__device__ __forceinline__ void ph_recurrent_naive(Frame& F) {
    if (blockIdx.x >= 16) return;
    const int type = blockIdx.x >> 3, b = (blockIdx.x >> 2) & 1, h = blockIdx.x & 3;
    LAS float* sin = (LAS float*)F.lds;
    LAS float* red = sin + 1024;
    LAS float* redd = red + 512;
    LAS float* sc = redd + 4;
    const bf16* P = (const bf16*)(F.ws + WS_P); const bf16* QKC = (const bf16*)(F.ws + WS_QKC); const float* G = (const float*)(F.ws + WS_G);
    bf16* Y = (bf16*)(F.ws + WS_Y);
    const float* gain = (type == 0 ? F.in[6] : F.in[7]) + h * 128;
    const int e = F.tid & 127, dg = F.tid >> 7, which = dg;
    const float gamma = 1.f - exp2f(-5.f - (float)h);
    float C[32], nn[32];
#pragma unroll
    for (int j = 0; j < 32; ++j) { C[j] = 0.f; nn[j] = 0.f; }
    const bf16* src; size_t stride;
    if (type == 0) { if (which < 2) { src = QKC + which * 512 + h * 128 + e; stride = 1024; } else { src = P + 1024 + (which - 2) * 512 + h * 128 + e; stride = NP0; } }
    else { src = P + 2048 + which * 512 + h * 128 + e; stride = NP0; }
    const float mul = (which == 1) ? KSCALE : 1.f;
    const size_t m0 = (size_t)b * T;
    float val = bf2f(src[m0 * stride]) * mul;
    float s0 = 0.f, s1 = 0.f;
    if (F.tid == 0) { if (type == 0) { s0 = __expf(G[m0 * 8 + 4 + h]); s1 = __expf(G[m0 * 8 + h]); } else { s0 = gamma; s1 = 1.f; } }
    for (int t = 0; t < T; ++t) {
        const size_t m = m0 + t; const int pb = t & 1;
        sin[pb * 512 + F.tid] = val;
        if (F.tid == 0) { sc[pb * 2] = s0; sc[pb * 2 + 1] = s1; }
        if (t + 1 < T) { val = bf2f(src[(m + 1) * stride]) * mul;
            if (F.tid == 0 && type == 0) { s0 = __expf(G[(m + 1) * 8 + 4 + h]); s1 = __expf(G[(m + 1) * 8 + h]); } }
        __syncthreads();
        const float f = sc[pb * 2], ig = sc[pb * 2 + 1];
        const LAS float* sq = sin + pb * 512; const LAS float* sk = sq + 128; const LAS float* sv = sq + 256; const LAS float* so = sq + 384;
        const float ve = sv[e] * ig;
        float pn = 0.f, pd = 0.f;
#pragma unroll
        for (int j = 0; j < 32; ++j) { const int d = dg * 32 + j; const float kd = sk[d], qd = sq[d];
            C[j] = fmaf(f, C[j], kd * ve); nn[j] = fmaf(f, nn[j], ig * kd); pn = fmaf(C[j], qd, pn); pd = fmaf(nn[j], qd, pd); }
        red[dg * 128 + e] = pn; if (e == 0) redd[dg] = pd;
        __syncthreads();
        if (F.tid < 64) {
            const int e0 = F.tid, e1 = F.tid + 64;
            float h0 = (red[e0] + red[128 + e0]) + (red[256 + e0] + red[384 + e0]);
            float h1 = (red[e1] + red[128 + e1]) + (red[256 + e1] + red[384 + e1]);
            if (type == 0) { const float den = (redd[0] + redd[1]) + (redd[2] + redd[3]); const float dn = fmaxf(fabsf(den), 1.f);
                h0 = h0 / dn * sigmoidf_(so[e0]); h1 = h1 / dn * sigmoidf_(so[e1]); }
            const float mean = wave_sum(h0 + h1) * (1.f / 128.f); const float d0 = h0 - mean, d1 = h1 - mean;
            const float rstd = 1.f / sqrtf(wave_sum(d0 * d0 + d1 * d1) * (1.f / 128.f) + LN_EPS);
            float y0 = d0 * rstd * gain[e0], y1 = d1 * rstd * gain[e1];
            if (type == 1) { y0 *= siluf_(so[e0]); y1 *= siluf_(so[e1]); }
            Y[m * 1024 + type * 512 + h * 128 + e0] = (bf16)f2bf(y0); Y[m * 1024 + type * 512 + h * 128 + e1] = (bf16)f2bf(y1);
        }
    }
}

constexpr size_t WS_S = WS_SE;
constexpr size_t WS_DN = WS_G + 768 * 1024;
constexpr int CB_GL = 512 * 1024, CB_MSC = 520 * 1024;
constexpr int TRS = 144, RWS = 136;
template <int O0, int O1>
__device__ __forceinline__ void tr2(unsigned a, u32x2& r0, u32x2& r1) {
    asm volatile("ds_read_b64_tr_b16 %0, %2 offset:%3\n\tds_read_b64_tr_b16 %1, %2 offset:%4\n\ts_waitcnt lgkmcnt(0)" : "=&v"(r0), "=&v"(r1) : "v"(a), "i"(O0), "i"(O1) : "memory");
}
template <int B, int H>
__device__ __forceinline__ void tr8(unsigned a, u32x2& r0, u32x2& r1, u32x2& r2, u32x2& r3, u32x2& r4, u32x2& r5, u32x2& r6, u32x2& r7) {
    asm volatile("ds_read_b64_tr_b16 %0, %8 offset:%9\n\tds_read_b64_tr_b16 %1, %8 offset:%10\n\tds_read_b64_tr_b16 %2, %8 offset:%11\n\tds_read_b64_tr_b16 %3, %8 offset:%12\n\t"
                 "ds_read_b64_tr_b16 %4, %8 offset:%13\n\tds_read_b64_tr_b16 %5, %8 offset:%14\n\tds_read_b64_tr_b16 %6, %8 offset:%15\n\tds_read_b64_tr_b16 %7, %8 offset:%16\n\ts_waitcnt lgkmcnt(0)"
                 : "=&v"(r0), "=&v"(r1), "=&v"(r2), "=&v"(r3), "=&v"(r4), "=&v"(r5), "=&v"(r6), "=&v"(r7)
                 : "v"(a), "i"(B), "i"(B + H), "i"(B + 32), "i"(B + 32 + H), "i"(B + 64), "i"(B + 64 + H), "i"(B + 96), "i"(B + 96 + H) : "memory");
}
__device__ __forceinline__ bf16x8_t pack_frag(u32x2 a, u32x2 b) { return __builtin_bit_cast(bf16x8_t, (u32x4){a.x, a.y, b.x, b.y}); }
__device__ __forceinline__ void scan128_sum(float& x0, float& x1, int lane) {
#pragma unroll
    for (int o = 1; o < 64; o <<= 1) { const float t0 = __shfl_up(x0, o), t1 = __shfl_up(x1, o); if (lane >= o) { x0 += t0; x1 += t1; } }
    x1 += __shfl(x0, 63);
}
__device__ __forceinline__ void scan128_max(float& x0, float& x1, int lane) {
#pragma unroll
    for (int o = 1; o < 64; o <<= 1) { const float t0 = __shfl_up(x0, o), t1 = __shfl_up(x1, o); if (lane >= o) { x0 = fmaxf(x0, t0); x1 = fmaxf(x1, t1); } }
    x1 = fmaxf(x1, __shfl(x0, 63));
}
__device__ __forceinline__ float wave_max(float v) {
#pragma unroll
    for (int o = 1; o < 64; o <<= 1) v = fmaxf(v, __shfl_xor(v, o));
    return v;
}
__device__ __forceinline__ void conv8(const bf16* Pc, int row, int tpos0, const LAS float* cwp, float (&o)[8]) {
    { const f32x4 b0 = *(const LAS f32x4*)(cwp + 512), b1 = *(const LAS f32x4*)(cwp + 516); o[0] = b0.x; o[1] = b0.y; o[2] = b0.z; o[3] = b0.w; o[4] = b1.x; o[5] = b1.y; o[6] = b1.z; o[7] = b1.w; }
#pragma unroll
    for (int j = 0; j < 4; ++j) { const int r = row - 3 + j;
        if (tpos0 + r >= 0) { const u32x4 x = *(const u32x4*)(Pc + (long)r * NP0); const f32x4 w0 = *(const LAS f32x4*)(cwp + j * 128), w1 = *(const LAS f32x4*)(cwp + j * 128 + 4);
            o[0] += w0.x * bflo(x.x); o[1] += w0.y * bfhi(x.x); o[2] += w0.z * bflo(x.y); o[3] += w0.w * bfhi(x.y); o[4] += w1.x * bflo(x.z); o[5] += w1.y * bfhi(x.z); o[6] += w1.z * bflo(x.w); o[7] += w1.w * bfhi(x.w); } }
#pragma unroll
    for (int e = 0; e < 8; ++e) o[e] = siluf_(o[e]);
}
__device__ __forceinline__ u32x4 pack8(const float (&o)[8], float sc) {
    u32x4 w; w.x = pg8::cvt_pk_bf16(o[0] * sc, o[1] * sc); w.y = pg8::cvt_pk_bf16(o[2] * sc, o[3] * sc); w.z = pg8::cvt_pk_bf16(o[4] * sc, o[5] * sc); w.w = pg8::cvt_pk_bf16(o[6] * sc, o[7] * sc); return w; }
__device__ __forceinline__ void unpack8(u32x4 x, float (&o)[8]) { o[0] = bflo(x.x); o[1] = bfhi(x.x); o[2] = bflo(x.y); o[3] = bfhi(x.y); o[4] = bflo(x.z); o[5] = bfhi(x.z); o[6] = bflo(x.w); o[7] = bfhi(x.w); }

__device__ __forceinline__ void ph_mix_a(Frame& F) {
    LAS bf16* Vl = (LAS bf16*)F.lds;
    LAS bf16* Kl = Vl + 128 * TRS;
    LAS float* cwl = (LAS float*)(Kl + 128 * TRS);
    LAS float* wl = cwl + 640;
    const bf16* P = (const bf16*)(F.ws + WS_P); const float* G = (const float*)(F.ws + WS_G); bf16* S = (bf16*)(F.ws + WS_S); float* DN = (float*)(F.ws + WS_DN);
    float* GL = (float*)((char*)F.ctl + CB_GL);
    const float* cw = F.in[4]; const float* cb = F.in[5];
    const int tid = F.tid, lane = F.lane, w = F.wave, fr = lane & 15, fq = lane >> 4;
    const unsigned vaddr = (unsigned)(size_t)Vl + (unsigned)(((4 * fq + (fr >> 2)) * TRS + 16 * w + 4 * (fr & 3)) * 2);
    const unsigned kaddr = (unsigned)(size_t)Kl + (unsigned)(((4 * fq + (fr >> 2)) * TRS + 4 * (fr & 3)) * 2);
    for (int u = blockIdx.x; u < 1024; u += F.G) {
        const int type = u >> 9, b = (u >> 8) & 1, h = (u >> 6) & 3, c = u & 63, chain = type * 8 + b * 4 + h;
        const size_t m0 = (size_t)b * T + c * 128;
        const int kcol = (type == 0 ? 512 : 2560) + h * 128, vcol = (type == 0 ? 1024 : 3072) + h * 128;
        __syncthreads();
        if (type == 0) for (int i = tid; i < 640; i += NT) { const int j = i >> 7, d = i & 127; cwl[i] = j < 4 ? cw[j * 1024 + 512 + h * 128 + d] : cb[512 + h * 128 + d]; }
        if (w == 0) {
            float w0, w1;
            if (type == 0) {
                const float i0 = G[(m0 + lane) * 8 + h], i1 = G[(m0 + lane + 64) * 8 + h];
                float b0 = G[(m0 + lane) * 8 + 4 + h], b1 = G[(m0 + lane + 64) * 8 + 4 + h];
                scan128_sum(b0, b1, lane);
                const float g = __shfl(b1, 63), lw0 = g - b0 + i0, lw1 = g - b1 + i1, ml = wave_max(fmaxf(lw0, lw1));
                w0 = __expf(lw0 - ml); w1 = __expf(lw1 - ml);
                if (lane == 0) { GL[(chain * 64 + c) * 2] = g; GL[(chain * 64 + c) * 2 + 1] = ml; }
            } else { const float lg = log1pf(-exp2f(-5.f - (float)h)); w0 = __expf(lg * (float)(127 - lane)); w1 = __expf(lg * (float)(63 - lane)); }
            wl[lane] = w0 * KSCALE; wl[lane + 64] = w1 * KSCALE;
        }
#pragma unroll
        for (int it = 0; it < 4; ++it) { const int s = (tid >> 4) + 32 * it, ch = tid & 15;
            *(LAS u32x4*)(Vl + s * TRS + ch * 8) = *(const u32x4*)(P + (m0 + s) * NP0 + vcol + ch * 8); }
        __syncthreads();
#pragma unroll
        for (int it = 0; it < 4; ++it) { const int s = (tid >> 4) + 32 * it, ch = tid & 15; float o[8];
            if (type == 0) conv8(P + m0 * NP0 + kcol + ch * 8, s, c * 128, cwl + ch * 8, o);
            else unpack8(*(const u32x4*)(P + (m0 + s) * NP0 + kcol + ch * 8), o);
            *(LAS u32x4*)(Kl + s * TRS + ch * 8) = pack8(o, wl[s]); }
        __syncthreads();
        f32x4 acc[8], accn = (f32x4){0.f, 0.f, 0.f, 0.f};
#pragma unroll
        for (int dt = 0; dt < 8; ++dt) acc[dt] = (f32x4){0.f, 0.f, 0.f, 0.f};
        const bf16x8_t ones = (bf16x8_t){0x3F80, 0x3F80, 0x3F80, 0x3F80, 0x3F80, 0x3F80, 0x3F80, 0x3F80};
#pragma unroll
        for (int ks = 0; ks < 4; ++ks) {
            u32x2 a0, a1, n0, n1, b0, b1, b2, b3, b4, b5, b6, b7, c0, c1, c2, c3, c4, c5, c6, c7;
            tr2<0, 16 * TRS * 2>(vaddr + ks * 32 * TRS * 2, a0, a1);
            tr2<0, 16 * TRS * 2>(kaddr + ks * 32 * TRS * 2 + 32 * w, n0, n1);
            tr8<0, 16 * TRS * 2>(kaddr + ks * 32 * TRS * 2, b0, b1, b2, b3, b4, b5, b6, b7);
            tr8<128, 16 * TRS * 2>(kaddr + ks * 32 * TRS * 2, c0, c1, c2, c3, c4, c5, c6, c7);
            __builtin_amdgcn_sched_barrier(0);
            const bf16x8_t A = pack_frag(a0, a1);
            acc[0] = __builtin_amdgcn_mfma_f32_16x16x32_bf16(pack_frag(b0, b1), A, acc[0], 0, 0, 0);
            acc[1] = __builtin_amdgcn_mfma_f32_16x16x32_bf16(pack_frag(b2, b3), A, acc[1], 0, 0, 0);
            acc[2] = __builtin_amdgcn_mfma_f32_16x16x32_bf16(pack_frag(b4, b5), A, acc[2], 0, 0, 0);
            acc[3] = __builtin_amdgcn_mfma_f32_16x16x32_bf16(pack_frag(b6, b7), A, acc[3], 0, 0, 0);
            acc[4] = __builtin_amdgcn_mfma_f32_16x16x32_bf16(pack_frag(c0, c1), A, acc[4], 0, 0, 0);
            acc[5] = __builtin_amdgcn_mfma_f32_16x16x32_bf16(pack_frag(c2, c3), A, acc[5], 0, 0, 0);
            acc[6] = __builtin_amdgcn_mfma_f32_16x16x32_bf16(pack_frag(c4, c5), A, acc[6], 0, 0, 0);
            acc[7] = __builtin_amdgcn_mfma_f32_16x16x32_bf16(pack_frag(c6, c7), A, acc[7], 0, 0, 0);
            accn = __builtin_amdgcn_mfma_f32_16x16x32_bf16(pack_frag(n0, n1), ones, accn, 0, 0, 0);
        }
        bf16* Sp = S + ((size_t)(chain * 64 + c) * 128 + 16 * w + fr) * 128 + 4 * fq;
#pragma unroll
        for (int dt = 0; dt < 8; ++dt) { u32x2 wv; wv.x = pg8::cvt_pk_bf16(acc[dt][0], acc[dt][1]); wv.y = pg8::cvt_pk_bf16(acc[dt][2], acc[dt][3]); *(u32x2*)(Sp + 16 * dt) = wv; }
        if (type == 0 && fr == 0) *(f32x4*)(DN + (size_t)(chain * 64 + c) * 128 + 16 * w + 4 * fq) = accn;
    }
}

__device__ __forceinline__ void ph_mix_b(Frame& F) {
    LAS float* gl = (LAS float*)F.lds; LAS float* dec = gl + 1024; LAS float* scl = dec + 512;
    const float* GL = (const float*)((char*)F.ctl + CB_GL); float* MSC = (float*)((char*)F.ctl + CB_MSC);
    bf16* S = (bf16*)(F.ws + WS_S); float* DN = (float*)(F.ws + WS_DN);
    for (int i = F.tid; i < 1024; i += NT) gl[i] = GL[i];
    __syncthreads();
    if (F.tid < 8) { float m = 0.f;
        for (int c = 0; c < 64; ++c) { const float g = gl[(F.tid * 64 + c) * 2], ml = gl[(F.tid * 64 + c) * 2 + 1];
            if (blockIdx.x == 0) MSC[F.tid * 64 + c] = m;
            const float mn = fmaxf(g + m, ml); dec[F.tid * 64 + c] = __expf(g + m - mn); scl[F.tid * 64 + c] = __expf(ml - mn); m = mn; } }
    __syncthreads();
    for (int j = blockIdx.x * NT + F.tid; j < 131072; j += F.G * NT) {
        const int chain = j >> 13, el = j & 8191;
        unsigned* p = (unsigned*)S + (size_t)chain * 64 * 8192 + el;
        const bool ml = chain < 8;
        const float g128 = __expf(128.f * log1pf(-exp2f(-5.f - (float)(chain & 3))));
        float C0 = 0.f, C1 = 0.f;
        for (int c0 = 0; c0 < 64; c0 += 16) { unsigned x[16];
#pragma unroll
            for (int k = 0; k < 16; ++k) x[k] = p[(size_t)(c0 + k) * 8192];
#pragma unroll
            for (int k = 0; k < 16; ++k) { p[(size_t)(c0 + k) * 8192] = pg8::cvt_pk_bf16(C0, C1);
                const float dk = ml ? dec[(chain & 7) * 64 + c0 + k] : g128, sk = ml ? scl[(chain & 7) * 64 + c0 + k] : 1.f;
                C0 = dk * C0 + sk * bflo(x[k]); C1 = dk * C1 + sk * bfhi(x[k]); } }
    }
    for (int j = blockIdx.x * NT + F.tid; j < 1024; j += F.G * NT) { const int chain = j >> 7, d = j & 127; float* p = DN + (size_t)chain * 64 * 128 + d; float n = 0.f;
        for (int c = 0; c < 64; ++c) { const float x = p[c * 128]; p[c * 128] = n; n = dec[chain * 64 + c] * n + scl[chain * 64 + c] * x; } }
}

__device__ __forceinline__ void ph_mix_c(Frame& F) {
    LAS bf16* Kl = (LAS bf16*)F.lds;
    LAS bf16* Vl = Kl + 128 * RWS;
    LAS bf16* Cl = Vl + 128 * TRS;
    LAS float* cwl = (LAS float*)(Cl + 144 * RWS);
    LAS float* ul = cwl + 1280; LAS float* Ml = ul + 128; LAS float* bl = Ml + 128;
    const bf16* P = (const bf16*)(F.ws + WS_P); const float* G = (const float*)(F.ws + WS_G); const bf16* S = (const bf16*)(F.ws + WS_S); const float* DN = (const float*)(F.ws + WS_DN);
    const float* MSC = (const float*)((char*)F.ctl + CB_MSC); bf16* Y = (bf16*)(F.ws + WS_Y);
    const float* cw = F.in[4]; const float* cb = F.in[5];
    const int tid = F.tid, lane = F.lane, w = F.wave, fr = lane & 15, fq = lane >> 4;
    const int lt = w < 4 ? w : 11 - w, l = 16 * lt + fr;
    const unsigned vaddr = (unsigned)(size_t)Vl + (unsigned)(((4 * fq + (fr >> 2)) * TRS + 4 * (fr & 3)) * 2);
    for (int u = blockIdx.x; u < 1024; u += F.G) {
        const int type = u >> 9, b = (u >> 8) & 1, h = (u >> 6) & 3, c = u & 63, chain = type * 8 + b * 4 + h;
        const size_t m0 = (size_t)b * T + c * 128;
        const int base = type == 0 ? 0 : 2048, qcol = base + h * 128, kcol = base + 512 + h * 128, vcol = base + 1024 + h * 128, gcol = base + 1536 + h * 128;
        const float lg = log1pf(-exp2f(-5.f - (float)h));
        __syncthreads();
        if (type == 0) for (int i = tid; i < 1280; i += NT) { const int part = i / 640, r = i % 640, j = r >> 7, d = r & 127, col = part * 512 + h * 128 + d; cwl[i] = j < 4 ? cw[j * 1024 + col] : cb[col]; }
        float mc = 0.f;
        if (type == 0) {
            mc = MSC[(b * 4 + h) * 64 + c];
            if (w == 0) {
                const float i0 = G[(m0 + lane) * 8 + h], i1 = G[(m0 + lane + 64) * 8 + h];
                float b0 = G[(m0 + lane) * 8 + 4 + h], b1 = G[(m0 + lane + 64) * 8 + 4 + h];
                scan128_sum(b0, b1, lane);
                const float u0 = i0 - b0, u1 = i1 - b1; float p0 = u0, p1 = u1; scan128_max(p0, p1, lane);
                ul[lane] = u0; ul[lane + 64] = u1; Ml[lane] = fmaxf(mc, p0); Ml[lane + 64] = fmaxf(mc, p1); bl[lane] = b0; bl[lane + 64] = b1;
            }
        }
#pragma unroll
        for (int it = 0; it < 4; ++it) { const int s = (tid >> 4) + 32 * it, ch = tid & 15;
            *(LAS u32x4*)(Vl + s * TRS + ch * 8) = *(const u32x4*)(P + (m0 + s) * NP0 + vcol + ch * 8);
            *(LAS u32x4*)(Cl + s * RWS + ch * 8) = *(const u32x4*)(S + ((size_t)(chain * 64 + c) * 128 + s) * 128 + ch * 8); }
        if (tid < 256) { const int r = tid >> 4, ch = tid & 15; u32x4 wv = (u32x4){0u, 0u, 0u, 0u};
            if (type == 0 && r == 0) { const float* np = DN + (size_t)((b * 4 + h) * 64 + c) * 128 + ch * 8; const f32x4 x0 = *(const f32x4*)np, x1 = *(const f32x4*)(np + 4);
                wv.x = pg8::cvt_pk_bf16(x0.x, x0.y); wv.y = pg8::cvt_pk_bf16(x0.z, x0.w); wv.z = pg8::cvt_pk_bf16(x1.x, x1.y); wv.w = pg8::cvt_pk_bf16(x1.z, x1.w); }
            *(LAS u32x4*)(Cl + (128 + r) * RWS + ch * 8) = wv; }
        __syncthreads();
#pragma unroll
        for (int it = 0; it < 4; ++it) { const int s = (tid >> 4) + 32 * it, ch = tid & 15; float o[8];
            if (type == 0) conv8(P + m0 * NP0 + kcol + ch * 8, s, c * 128, cwl + 640 + ch * 8, o);
            else unpack8(*(const u32x4*)(P + (m0 + s) * NP0 + kcol + ch * 8), o);
            *(LAS u32x4*)(Kl + s * RWS + ch * 8) = pack8(o, KSCALE); }
        bf16x8_t qf[4];
#pragma unroll
        for (int ks = 0; ks < 4; ++ks) { const int d0 = 32 * ks + 8 * fq;
            if (type == 0) { float o[8]; conv8(P + m0 * NP0 + qcol + d0, l, c * 128, cwl + d0, o); qf[ks] = __builtin_bit_cast(bf16x8_t, pack8(o, 1.f)); }
            else qf[ks] = *(const bf16x8_t*)(P + (m0 + l) * NP0 + qcol + d0); }
        __syncthreads();
        f32x4 st[8];
#pragma unroll
        for (int t = 0; t < 8; ++t) { st[t] = (f32x4){0.f, 0.f, 0.f, 0.f};
            if (t <= lt) {
#pragma unroll
                for (int ks = 0; ks < 4; ++ks) st[t] = __builtin_amdgcn_mfma_f32_16x16x32_bf16(*(const LAS bf16x8_t*)(Kl + (16 * t + fr) * RWS + 32 * ks + 8 * fq), qf[ks], st[t], 0, 0, 0); }
            if (t & 1) __builtin_amdgcn_sched_barrier(0); }
        int lz = l, fz = 4 * fq; asm volatile("" : "+v"(lz), "+v"(fz));
        const float Mme = (type == 0) ? Ml[lz] : 0.f;
        float den = 0.f;
#pragma unroll
        for (int t = 0; t < 8; ++t) if (t <= lt) {
#pragma unroll
            for (int rg = 0; rg < 4; ++rg) { const int s = 16 * t + fz + rg;
                float e = (type == 0) ? (ul[s] - Mme) : (lg * (float)(lz - s)); e = (s <= lz) ? e : -1e30f;
                const float p = st[t][rg] * __expf(e); st[t][rg] = p; den += p; } }
        den += __shfl_xor(den, 16); den += __shfl_xor(den, 32);
        f32x4 o1[8], o2[9];
#pragma unroll
        for (int et = 0; et < 8; ++et) o1[et] = (f32x4){0.f, 0.f, 0.f, 0.f};
#pragma unroll
        for (int et = 0; et < 9; ++et) o2[et] = (f32x4){0.f, 0.f, 0.f, 0.f};
#pragma unroll
        for (int j = 0; j < 4; ++j) if (2 * j <= lt) {
            u32x4 pw; pw.x = pg8::cvt_pk_bf16(st[2 * j][0], st[2 * j][1]); pw.y = pg8::cvt_pk_bf16(st[2 * j][2], st[2 * j][3]);
            pw.z = pg8::cvt_pk_bf16(st[2 * j + 1][0], st[2 * j + 1][1]); pw.w = pg8::cvt_pk_bf16(st[2 * j + 1][2], st[2 * j + 1][3]);
            const bf16x8_t pf = __builtin_bit_cast(bf16x8_t, pw);
            u32x2 b0, b1, b2, b3, b4, b5, b6, b7, c0, c1, c2, c3, c4, c5, c6, c7;
            tr8<0, 16 * TRS * 2>(vaddr + j * 32 * TRS * 2, b0, b1, b2, b3, b4, b5, b6, b7);
            tr8<128, 16 * TRS * 2>(vaddr + j * 32 * TRS * 2, c0, c1, c2, c3, c4, c5, c6, c7);
            __builtin_amdgcn_sched_barrier(0);
            o1[0] = __builtin_amdgcn_mfma_f32_16x16x32_bf16(pack_frag(b0, b1), pf, o1[0], 0, 0, 0);
            o1[1] = __builtin_amdgcn_mfma_f32_16x16x32_bf16(pack_frag(b2, b3), pf, o1[1], 0, 0, 0);
            o1[2] = __builtin_amdgcn_mfma_f32_16x16x32_bf16(pack_frag(b4, b5), pf, o1[2], 0, 0, 0);
            o1[3] = __builtin_amdgcn_mfma_f32_16x16x32_bf16(pack_frag(b6, b7), pf, o1[3], 0, 0, 0);
            o1[4] = __builtin_amdgcn_mfma_f32_16x16x32_bf16(pack_frag(c0, c1), pf, o1[4], 0, 0, 0);
            o1[5] = __builtin_amdgcn_mfma_f32_16x16x32_bf16(pack_frag(c2, c3), pf, o1[5], 0, 0, 0);
            o1[6] = __builtin_amdgcn_mfma_f32_16x16x32_bf16(pack_frag(c4, c5), pf, o1[6], 0, 0, 0);
            o1[7] = __builtin_amdgcn_mfma_f32_16x16x32_bf16(pack_frag(c6, c7), pf, o1[7], 0, 0, 0);
        }
        __builtin_amdgcn_sched_barrier(0);
#pragma unroll
        for (int ks = 0; ks < 4; ++ks) {
#pragma unroll
            for (int et = 0; et < 9; ++et) o2[et] = __builtin_amdgcn_mfma_f32_16x16x32_bf16(*(const LAS bf16x8_t*)(Cl + (16 * et + fr) * RWS + 32 * ks + 8 * fq), qf[ks], o2[et], 0, 0, 0);
            __builtin_amdgcn_sched_barrier(0); }
        float inter, rden = 1.f;
        if (type == 0) { inter = __expf(mc - Mme); const float qn = __shfl(o2[8][0], fr); const float dtot = den + inter * qn; rden = 1.f / fmaxf(fabsf(dtot), __expf(-(bl[l] + Mme))); }
        else inter = __expf(lg * (float)(l + 1));
        const bf16* gp = P + (m0 + l) * NP0 + gcol + 4 * fq;
        float sum = 0.f;
#pragma unroll
        for (int et = 0; et < 8; ++et) { const u32x2 gw = *(const u32x2*)(gp + 16 * et); const float g0 = bflo(gw.x), g1 = bfhi(gw.x), g2 = bflo(gw.y), g3 = bfhi(gw.y);
            f32x4 hv = (o1[et] + o2[et] * inter) * rden;
            if (type == 0) { hv[0] *= sigmoidf_(g0); hv[1] *= sigmoidf_(g1); hv[2] *= sigmoidf_(g2); hv[3] *= sigmoidf_(g3); o2[et] = (f32x4){1.f, 1.f, 1.f, 1.f}; }
            else o2[et] = (f32x4){siluf_(g0), siluf_(g1), siluf_(g2), siluf_(g3)};
            o1[et] = hv; sum += (hv[0] + hv[1]) + (hv[2] + hv[3]); if (et & 1) asm volatile("" ::: "memory"); }
        sum += __shfl_xor(sum, 16); sum += __shfl_xor(sum, 32);
        const float mean = sum * (1.f / 128.f); float sq = 0.f;
#pragma unroll
        for (int et = 0; et < 8; ++et) { o1[et] = o1[et] - mean; sq += (o1[et][0] * o1[et][0] + o1[et][1] * o1[et][1]) + (o1[et][2] * o1[et][2] + o1[et][3] * o1[et][3]); }
        sq += __shfl_xor(sq, 16); sq += __shfl_xor(sq, 32);
        const float rstd = 1.f / sqrtf(sq * (1.f / 128.f) + LN_EPS);
        const float* g6 = F.in[6]; const float* g7 = F.in[7]; asm volatile("" : "+s"(g6), "+s"(g7));
        const float* gain = (type == 0 ? g6 : g7) + h * 128 + 4 * fq;
        bf16* yp = Y + (m0 + l) * 1024 + type * 512 + h * 128 + 4 * fq;
#pragma unroll
        for (int et = 0; et < 8; ++et) { const f32x4 gn = *(const f32x4*)(gain + 16 * et); const f32x4 yv = o1[et] * rstd * gn * o2[et];
            u32x2 wv; wv.x = pg8::cvt_pk_bf16(yv[0], yv[1]); wv.y = pg8::cvt_pk_bf16(yv[2], yv[3]); *(u32x2*)(yp + 16 * et) = wv; if (et & 1) asm volatile("" ::: "memory"); }
    }
}

constexpr int RWT = 1028;
template <int MODE, bool ROUTE, int OUTK>
__device__ __forceinline__ void ph_ln(Frame& F, int layer) {
    LAS float* rwT = (LAS float*)F.lds;
    if (ROUTE) { const float* rw = F.in[11]; for (int i = F.tid; i < 32 * 1024; i += NT) { const int k = i >> 5, e = i & 31; rwT[e * RWT + k] = rw[i]; } __syncthreads(); }
    const int gwv = F.vcu * NWAVES + F.wave, NGW = F.G * NWAVES;
    const float* lg = F.in[16] + (size_t)(layer * 2 + MODE) * D; const float* lb = F.in[17] + (size_t)(layer * 2 + MODE) * D;
    bf16* XB = (bf16*)(F.ws + WS_XB); const bf16* YB = (const bf16*)(F.ws + WS_YB); const bf16* PRE = (const bf16*)((const char*)F.out + 32 * MiB); bf16* RES = (bf16*)F.out;
    int* EIDX = (int*)(F.ws + WS_EIDX); float* GATEV = (float*)(F.ws + WS_GATEV); int* LIST = (int*)(F.ws + WS_LIST);
    unsigned* cnt = F.ctl + CW_CNT + layer * 32 * 64;
    const float* rbias = F.in[12];
    f32x4 gv[4], bv[4];
#pragma unroll
    for (int j = 0; j < 4; ++j) { gv[j] = *((const f32x4*)lg + F.lane + 64 * j); bv[j] = *((const f32x4*)lb + F.lane + 64 * j); }
    for (int m = gwv; m < M; m += NGW) {
        f32x4 v[4]; float s = 0.f;
        if (MODE == 0) { const u32x2* pr = (const u32x2*)(PRE + (size_t)m * D) + F.lane;
#pragma unroll
            for (int j = 0; j < 4; ++j) { const u32x2 a = pr[64 * j]; v[j] = (f32x4){bflo(a.x), bfhi(a.x), bflo(a.y), bfhi(a.y)}; } }
        else {
            const float g0 = GATEV[2 * m], g1 = GATEV[2 * m + 1];
            const u32x2* xr = (const u32x2*)(XB + (size_t)m * D) + F.lane;
            const u32x2* y0 = (const u32x2*)(YB + (size_t)(2 * m) * D) + F.lane; const u32x2* y1 = (const u32x2*)(YB + (size_t)(2 * m + 1) * D) + F.lane;
#pragma unroll
            for (int j = 0; j < 4; ++j) { const u32x2 x = xr[64 * j], a = y0[64 * j], b = y1[64 * j];
                v[j].x = ALPHA * bflo(x.x) + g0 * bflo(a.x) + g1 * bflo(b.x); v[j].y = ALPHA * bfhi(x.x) + g0 * bfhi(a.x) + g1 * bfhi(b.x);
                v[j].z = ALPHA * bflo(x.y) + g0 * bflo(a.y) + g1 * bflo(b.y); v[j].w = ALPHA * bfhi(x.y) + g0 * bfhi(a.y) + g1 * bfhi(b.y); }
        }
#pragma unroll
        for (int j = 0; j < 4; ++j) s += (v[j].x + v[j].y) + (v[j].z + v[j].w);
        const float mean = wave_sum(s) * (1.f / D); float s2 = 0.f;
#pragma unroll
        for (int j = 0; j < 4; ++j) { v[j] = v[j] - mean; s2 += (v[j].x * v[j].x + v[j].y * v[j].y) + (v[j].z * v[j].z + v[j].w * v[j].w); }
        const float rstd = 1.f / sqrtf(wave_sum(s2) * (1.f / D) + LN_EPS);
#pragma unroll
        for (int j = 0; j < 4; ++j) v[j] = v[j] * rstd * gv[j] + bv[j];
        if (OUTK == 2) { f32x4* orow = (f32x4*)(F.out + (size_t)m * D) + F.lane;
#pragma unroll
            for (int j = 0; j < 4; ++j) orow[64 * j] = v[j]; }
        else { u32x2* o8 = (u32x2*)((OUTK == 0 ? XB : RES) + (size_t)m * D) + F.lane;
#pragma unroll
            for (int j = 0; j < 4; ++j) { u32x2 w; w.x = pg8::cvt_pk_bf16(v[j].x, v[j].y); w.y = pg8::cvt_pk_bf16(v[j].z, v[j].w); o8[64 * j] = w; } }
        if (ROUTE) {
            float pv[32];
#pragma unroll
            for (int e = 0; e < 32; ++e) { float a = 0.f;
#pragma unroll
                for (int j = 0; j < 4; ++j) { const f32x4 w = *(const LAS f32x4*)(rwT + e * RWT + 4 * F.lane + 256 * j); a += v[j].x * w.x + v[j].y * w.y + v[j].z * w.z + v[j].w * w.w; }
                pv[e] = a; if ((e & 7) == 7) __builtin_amdgcn_sched_barrier(0); }
#define LN_HALVE(N, MASK) { const bool up = (F.lane & (MASK)) != 0; _Pragma("unroll") for (int j = 0; j < (N); ++j) { const float keep = up ? pv[(N) + j] : pv[j], send = up ? pv[j] : pv[(N) + j]; pv[j] = keep + __shfl_xor(send, (MASK)); } }
            LN_HALVE(16, 32) LN_HALVE(8, 16) LN_HALVE(4, 8) LN_HALVE(2, 4) LN_HALVE(1, 2)
#undef LN_HALVE
            const float mylog = pv[0] + __shfl_xor(pv[0], 1);
            const int mye = F.lane >> 1;
            const float myaff = 1.f / (1.f + expf(-mylog)), mysel = myaff + rbias[mye];
            float m1 = -1e30f, m2 = -1e30f; int i1 = 0, i2 = 0; float a1 = 0.f, a2 = 0.f;
            const int lbase = F.lane & 48, ebase = (F.lane >> 4) * 8;
#pragma unroll
            for (int j = 0; j < 8; ++j) { const float sv = __shfl(mysel, lbase + 2 * j), av = __shfl(myaff, lbase + 2 * j);
                if (sv > m1) { m2 = m1; i2 = i1; a2 = a1; m1 = sv; i1 = ebase + j; a1 = av; }
                else if (sv > m2) { m2 = sv; i2 = ebase + j; a2 = av; } }
            const float score = m1 + m2;
            float bestscore = -1e30f; int bg = 0;
#pragma unroll
            for (int g = 0; g < 4; ++g) { const float sg = __shfl(score, 16 * g); if (sg > bestscore) { bestscore = sg; bg = g; } }
            const int bi0 = __shfl(i1, 16 * bg), bi1 = __shfl(i2, 16 * bg); const float ba0 = __shfl(a1, 16 * bg), ba1 = __shfl(a2, 16 * bg);
            if (F.lane == 0) {
                const float inv = 1.f / (ba0 + ba1);
                EIDX[2 * m] = bi0; EIDX[2 * m + 1] = bi1; GATEV[2 * m] = ba0 * inv; GATEV[2 * m + 1] = ba1 * inv;
                const unsigned p0 = __hip_atomic_fetch_add(cnt + bi0 * 64, 1u, RLX_AGENT); LIST[bi0 * M + p0] = 2 * m;
                const unsigned p1 = __hip_atomic_fetch_add(cnt + bi1 * 64, 1u, RLX_AGENT); LIST[bi1 * M + p1] = 2 * m + 1;
            }
        }
    }
}

struct ExpertMap { int cnt[32]; };
__device__ __forceinline__ int moe_find(Frame& F, int layer, int unit_rows, int per_row_tiles, int t, int& e_out, int& mb_out, int& nb_out, int& hb_out, int& cnt_out) {
    const unsigned* cnt = F.ctl + CW_CNT + layer * 32 * 64;
    int base = 0, hb = 0;
    for (int e = 0; e < 32; ++e) {
        const int c = (int)cnt[e * 64]; const int nmb = (c + unit_rows - 1) / unit_rows; const int nt = nmb * per_row_tiles;
        if (t < base + nt) { const int r = t - base; e_out = e; mb_out = r / per_row_tiles; nb_out = r % per_row_tiles; hb_out = hb; cnt_out = c; return 1; }
        base += nt; hb += ((c + 255) >> 8) << 8;
    }
    return 0;
}
__device__ __forceinline__ void ph_moe1_naive(Frame& F, int layer) {
    LAS float* sA = (LAS float*)F.lds; LAS float* sB = sA + 128 * 33;
    const bf16* XB = (const bf16*)(F.ws + WS_XB); bf16* HID = (bf16*)(F.ws + WS_HID); const int* LIST = (const int*)(F.ws + WS_LIST);
    const int tx = F.tid & 15, ty = F.tid >> 4;
    for (int t = blockIdx.x;; t += F.G) {
        int e, mb, nb, hb, c; if (!moe_find(F, layer, 128, 4, t, e, mb, nb, hb, c)) break;
        const bf16* GU = (const bf16*)(F.ws + WS_EW + (size_t)e * EW_STRIDE);
        const int j0 = nb * 64, rg = (j0 >> 7) * 256 + (j0 & 127);
        auto rowA = [&](int r) -> const bf16* { const int i = mb * 128 + r; return i < c ? XB + (size_t)(LIST[e * M + i] >> 1) * D : (const bf16*)nullptr; };
        float ag[4][4], au[4][4];
        ngemm_tile(sA, sB, rowA, GU + (size_t)rg * D, D, D, ag);
        ngemm_tile(sA, sB, rowA, GU + (size_t)(rg + 128) * D, D, D, au);
#pragma unroll
        for (int i = 0; i < 4; ++i) { const int ri = mb * 128 + ty * 4 + i;
            if (ri < c) { u32x2 o; o.x = pk2(siluf_(ag[i][0]) * au[i][0], siluf_(ag[i][1]) * au[i][1]); o.y = pk2(siluf_(ag[i][2]) * au[i][2], siluf_(ag[i][3]) * au[i][3]);
                *(u32x2*)(HID + (size_t)(hb + ri) * DE + j0 + tx * 4) = o; } }
    }
}
__device__ __forceinline__ void ph_moe2_naive(Frame& F, int layer) {
    LAS float* sA = (LAS float*)F.lds; LAS float* sB = sA + 128 * 33;
    const bf16* HID = (const bf16*)(F.ws + WS_HID); bf16* YB = (bf16*)(F.ws + WS_YB); const int* LIST = (const int*)(F.ws + WS_LIST);
    const int tx = F.tid & 15, ty = F.tid >> 4;
    for (int t = blockIdx.x;; t += F.G) {
        int e, mb, nb, hb, c; if (!moe_find(F, layer, 128, 16, t, e, mb, nb, hb, c)) break;
        const bf16* DN = (const bf16*)(F.ws + WS_EW + (size_t)e * EW_STRIDE + EW_DN);
        auto rowA = [&](int r) -> const bf16* { const int i = mb * 128 + r; return i < c ? HID + (size_t)(hb + i) * DE : (const bf16*)nullptr; };
        float acc[4][4];
        ngemm_tile(sA, sB, rowA, DN + (size_t)(nb * 64) * DE, DE, DE, acc);
#pragma unroll
        for (int i = 0; i < 4; ++i) { const int ri = mb * 128 + ty * 4 + i;
            if (ri < c) { const int a = LIST[e * M + ri]; u32x2 o; o.x = pk2(acc[i][0], acc[i][1]); o.y = pk2(acc[i][2], acc[i][3]);
                *(u32x2*)(YB + (size_t)a * D + nb * 64 + tx * 4) = o; } }
    }
}

__device__ __forceinline__ void ph_attn_naive(Frame& F) {
    const bf16* P = (const bf16*)(F.ws + WS_P); bf16* OG = (bf16*)(F.ws + WS_OG); float* LSE = (float*)(F.ws + WS_LSE);
    const int total = 3 * M * 8, nth = F.G * NT;
    for (int idx = blockIdx.x * NT + F.tid; idx < total; idx += nth) {
        const int h = idx & 7, m = (idx >> 3) & (M - 1), g = idx >> 17;
        const int t = m & (T - 1), dil = (g == 0) ? 1 : (g == 1 ? 4 : 16);
        const float slope = exp2f(-(float)(h + 1));
        const bf16* qp = P + (size_t)m * IN1 + g * 1536 + h * 64;
        float q[64], o[64];
#pragma unroll
        for (int c = 0; c < 8; ++c) { const u32x4 w = *(const u32x4*)(qp + 8 * c);
            q[8 * c + 0] = bflo(w.x); q[8 * c + 1] = bfhi(w.x); q[8 * c + 2] = bflo(w.y); q[8 * c + 3] = bfhi(w.y); q[8 * c + 4] = bflo(w.z); q[8 * c + 5] = bfhi(w.z); q[8 * c + 6] = bflo(w.w); q[8 * c + 7] = bfhi(w.w); }
#pragma unroll
        for (int d = 0; d < 64; ++d) o[d] = 0.f;
        float mx = -1e30f, den = 0.f;
        for (int j = 0; j <= 128; ++j) {
            const int tk = t - j * dil; if (tk < 0) break;
            const bf16* kp = P + (size_t)(m - j * dil) * IN1 + g * 1536 + 512 + h * 64; const bf16* vp = kp + 512;
            float s = 0.f;
#pragma unroll
            for (int c = 0; c < 8; ++c) { const u32x4 w = *(const u32x4*)(kp + 8 * c);
                s += q[8 * c + 0] * bflo(w.x) + q[8 * c + 1] * bfhi(w.x) + q[8 * c + 2] * bflo(w.y) + q[8 * c + 3] * bfhi(w.y) + q[8 * c + 4] * bflo(w.z) + q[8 * c + 5] * bfhi(w.z) + q[8 * c + 6] * bflo(w.w) + q[8 * c + 7] * bfhi(w.w); }
            s = s * 0.125f - slope * (float)(j * dil);
            const float mn = fmaxf(mx, s), corr = __expf(mx - mn), p = __expf(s - mn);
            den = den * corr + p; mx = mn;
#pragma unroll
            for (int c = 0; c < 8; ++c) { const u32x4 w = *(const u32x4*)(vp + 8 * c);
                o[8 * c + 0] = o[8 * c + 0] * corr + p * bflo(w.x); o[8 * c + 1] = o[8 * c + 1] * corr + p * bfhi(w.x); o[8 * c + 2] = o[8 * c + 2] * corr + p * bflo(w.y); o[8 * c + 3] = o[8 * c + 3] * corr + p * bfhi(w.y);
                o[8 * c + 4] = o[8 * c + 4] * corr + p * bflo(w.z); o[8 * c + 5] = o[8 * c + 5] * corr + p * bfhi(w.z); o[8 * c + 6] = o[8 * c + 6] * corr + p * bflo(w.w); o[8 * c + 7] = o[8 * c + 7] * corr + p * bfhi(w.w); }
        }
        const float inv = 1.f / den;
        bf16* op = OG + ((size_t)g * M + m) * 512 + h * 64;
#pragma unroll
        for (int c = 0; c < 8; ++c) { u32x4 w; w.x = pk2(o[8 * c + 0] * inv, o[8 * c + 1] * inv); w.y = pk2(o[8 * c + 2] * inv, o[8 * c + 3] * inv); w.z = pk2(o[8 * c + 4] * inv, o[8 * c + 5] * inv); w.w = pk2(o[8 * c + 6] * inv, o[8 * c + 7] * inv);
            *(u32x4*)(op + 8 * c) = w; }
        LSE[((size_t)g * M + m) * 8 + h] = mx + __logf(den);
    }
}
__device__ __forceinline__ void ph_attn_mfma(Frame& F) {
    const bf16* P = (const bf16*)(F.ws + WS_P); bf16* OG = (bf16*)(F.ws + WS_OG); float* LSE = (float*)(F.ws + WS_LSE);
    LAS bf16* Vl = (LAS bf16*)F.lds;
    const int tid = F.tid, lane = F.lane, w = F.wave, fr = lane & 15, fq = lane >> 4;
    const int ct0 = 2 * (w >> 1);
    const unsigned vaddr0 = (unsigned)(size_t)(F.lds) + (unsigned)(((16 * ct0 + 4 * fq + (fr >> 2)) * 72 + 4 * (fr & 3)) * 2);
    for (int u = blockIdx.x; u < 3072; u += F.G) {
        const int g = u >> 10, rem = u & 1023, b = rem >> 9, h = (rem >> 6) & 7, x = rem & 63;
        const int dil = (g == 0) ? 1 : (g == 1 ? 4 : 16), nnb = 64 / dil, nb = x % nnb, r = x / nnb;
        const long rowbase = (long)b * T + (long)nb * 128 * dil + r;
        const bf16* Qp = P + g * 1536 + h * 64; const bf16* Kp = Qp + 512; const bf16* Vp = Qp + 1024;
        const float sl = exp2f(-(float)(h + 1)) * (float)dil;
        __syncthreads();
#pragma unroll
        for (int it = 0; it < 4; ++it) { const int kr = (tid >> 3) + 64 * it, ch = tid & 7; u32x4 v = (u32x4){0u, 0u, 0u, 0u};
            if (nb > 0 || kr >= 128) v = *(const u32x4*)(Vp + (size_t)(rowbase + (long)(kr - 128) * dil) * IN1 + ch * 8);
            *(LAS u32x4*)(Vl + kr * 72 + ch * 8) = v; }
        bf16x8_t qf[2];
        { const bf16* qrow = Qp + (size_t)(rowbase + (long)(16 * w + fr) * dil) * IN1 + 8 * fq; qf[0] = *(const bf16x8_t*)qrow; qf[1] = *(const bf16x8_t*)(qrow + 32); }
        f32x4 s[10];
#pragma unroll
        for (int c = 0; c < 10; ++c) { const int kr = 16 * (ct0 + c) + fr; bf16x8_t k0 = (bf16x8_t){0, 0, 0, 0, 0, 0, 0, 0}, k1 = k0;
            if (nb > 0 || kr >= 128) { const bf16* krow = Kp + (size_t)(rowbase + (long)(kr - 128) * dil) * IN1 + 8 * fq; k0 = *(const bf16x8_t*)krow; k1 = *(const bf16x8_t*)(krow + 32); }
            s[c] = __builtin_amdgcn_mfma_f32_16x16x32_bf16(k0, qf[0], (f32x4){0.f, 0.f, 0.f, 0.f}, 0, 0, 0);
            s[c] = __builtin_amdgcn_mfma_f32_16x16x32_bf16(k1, qf[1], s[c], 0, 0, 0); }
        const int l = 16 * w + fr;
        float mx = -1e30f;
#pragma unroll
        for (int c = 0; c < 10; ++c)
#pragma unroll
            for (int rg = 0; rg < 4; ++rg) { const int kr = 16 * (ct0 + c) + 4 * fq + rg, steps = l + 128 - kr;
                const bool ok = steps >= 0 && steps <= 128 && (nb > 0 || kr >= 128);
                const float v = ok ? s[c][rg] * 0.125f - sl * (float)steps : -1e30f; s[c][rg] = v; mx = fmaxf(mx, v); }
        mx = fmaxf(mx, __shfl_xor(mx, 16)); mx = fmaxf(mx, __shfl_xor(mx, 32));
        float den = 0.f;
#pragma unroll
        for (int c = 0; c < 10; ++c)
#pragma unroll
            for (int rg = 0; rg < 4; ++rg) { const float p = (s[c][rg] > -1e29f) ? __expf(s[c][rg] - mx) : 0.f; s[c][rg] = p; den += p; }
        den += __shfl_xor(den, 16); den += __shfl_xor(den, 32);
        bf16x8_t pf[5];
#pragma unroll
        for (int k = 0; k < 5; ++k) { u32x4 wv; wv.x = pg8::cvt_pk_bf16(s[2 * k][0], s[2 * k][1]); wv.y = pg8::cvt_pk_bf16(s[2 * k][2], s[2 * k][3]);
            wv.z = pg8::cvt_pk_bf16(s[2 * k + 1][0], s[2 * k + 1][1]); wv.w = pg8::cvt_pk_bf16(s[2 * k + 1][2], s[2 * k + 1][3]); pf[k] = __builtin_bit_cast(bf16x8_t, wv); }
        __syncthreads();
        f32x4 o[4];
#pragma unroll
        for (int dt = 0; dt < 4; ++dt) o[dt] = (f32x4){0.f, 0.f, 0.f, 0.f};
#pragma unroll
        for (int k = 0; k < 5; ++k) {
            u32x2 a0, a1, a2, a3, a4, a5, a6, a7; const unsigned va = vaddr0 + (unsigned)(k * 32 * 72 * 2);
            asm volatile("ds_read_b64_tr_b16 %0, %8\n\tds_read_b64_tr_b16 %1, %8 offset:2304\n\tds_read_b64_tr_b16 %2, %8 offset:32\n\tds_read_b64_tr_b16 %3, %8 offset:2336\n\t"
                         "ds_read_b64_tr_b16 %4, %8 offset:64\n\tds_read_b64_tr_b16 %5, %8 offset:2368\n\tds_read_b64_tr_b16 %6, %8 offset:96\n\tds_read_b64_tr_b16 %7, %8 offset:2400\n\ts_waitcnt lgkmcnt(0)"
                         : "=&v"(a0), "=&v"(a1), "=&v"(a2), "=&v"(a3), "=&v"(a4), "=&v"(a5), "=&v"(a6), "=&v"(a7) : "v"(va) : "memory");
            __builtin_amdgcn_sched_barrier(0);
            o[0] = __builtin_amdgcn_mfma_f32_16x16x32_bf16(__builtin_bit_cast(bf16x8_t, (u32x4){a0.x, a0.y, a1.x, a1.y}), pf[k], o[0], 0, 0, 0);
            o[1] = __builtin_amdgcn_mfma_f32_16x16x32_bf16(__builtin_bit_cast(bf16x8_t, (u32x4){a2.x, a2.y, a3.x, a3.y}), pf[k], o[1], 0, 0, 0);
            o[2] = __builtin_amdgcn_mfma_f32_16x16x32_bf16(__builtin_bit_cast(bf16x8_t, (u32x4){a4.x, a4.y, a5.x, a5.y}), pf[k], o[2], 0, 0, 0);
            o[3] = __builtin_amdgcn_mfma_f32_16x16x32_bf16(__builtin_bit_cast(bf16x8_t, (u32x4){a6.x, a6.y, a7.x, a7.y}), pf[k], o[3], 0, 0, 0);
        }
        const float inv = 1.f / den; const size_t tok = (size_t)(rowbase + (long)l * dil);
        bf16* op = OG + ((size_t)g * M + tok) * 512 + h * 64 + 4 * fq;
#pragma unroll
        for (int dt = 0; dt < 4; ++dt) { u32x2 wv; wv.x = pg8::cvt_pk_bf16(o[dt][0] * inv, o[dt][1] * inv); wv.y = pg8::cvt_pk_bf16(o[dt][2] * inv, o[dt][3] * inv); *(u32x2*)(op + 16 * dt) = wv; }
        if (fq == 0) LSE[((size_t)g * M + tok) * 8 + h] = mx + __logf(den);
    }
}

__device__ __forceinline__ void ph_attn_v2(Frame& F) {
    const bf16* P = (const bf16*)(F.ws + WS_P); bf16* OG = (bf16*)(F.ws + WS_OG); float* LSE = (float*)(F.ws + WS_LSE);
    LAS bf16* Kl = (LAS bf16*)F.lds;
    LAS bf16* Vl = Kl + 2 * 128 * 72;
    constexpr int SLOT = 128 * 72;
    const int tid = F.tid, lane = F.lane, w = F.wave, fr = lane & 15, fq = lane >> 4;
    const int ct0 = 2 * (w >> 1), l = 16 * w + fr;
    const int srow = tid >> 3, sch = tid & 7;
    for (int p = blockIdx.x; p < 512; p += F.G) {
        int g, b, h, r, nb0, nun;
        if (p < 128) { g = 0; const int seq = p >> 3; b = seq >> 3; h = seq & 7; r = 0; nb0 = (p & 7) * 8; nun = 8; }
        else if (p < 256) { g = 1; const int q = p - 128, seq = q >> 1; b = seq >> 5; h = (seq >> 2) & 7; r = seq & 3; nb0 = (q & 1) * 8; nun = 8; }
        else { g = 2; const int q = p - 256; b = q >> 7; h = (q >> 4) & 7; r = q & 15; nb0 = 0; nun = 4; }
        const int dil = (g == 0) ? 1 : (g == 1 ? 4 : 16);
        const size_t rstride = (size_t)dil * IN1;
        const bf16* Qp = P + g * 1536 + h * 64 + ((size_t)b * T + r) * IN1; const bf16* Kp = Qp + 512; const bf16* Vp = Qp + 1024;
        const float sl = exp2f(-(float)(h + 1)) * (float)dil;
        __syncthreads();
#pragma unroll
        for (int it = 0; it < 2; ++it) { const int row = srow + 64 * it;
            u32x4 k0 = (u32x4){0u, 0u, 0u, 0u}, v0 = k0;
            if (nb0 > 0) { const size_t off = (size_t)((nb0 - 1) * 128 + row) * rstride + sch * 8; k0 = *(const u32x4*)(Kp + off); v0 = *(const u32x4*)(Vp + off); }
            const size_t off1 = (size_t)(nb0 * 128 + row) * rstride + sch * 8; const u32x4 k1 = *(const u32x4*)(Kp + off1), v1 = *(const u32x4*)(Vp + off1);
            const int ps = (nb0 + 1) & 1, cs = nb0 & 1;
            *(LAS u32x4*)(Kl + ps * SLOT + row * 72 + sch * 8) = k0; *(LAS u32x4*)(Vl + ps * SLOT + row * 72 + sch * 8) = v0;
            *(LAS u32x4*)(Kl + cs * SLOT + row * 72 + sch * 8) = k1; *(LAS u32x4*)(Vl + cs * SLOT + row * 72 + sch * 8) = v1; }
        bf16x8_t qn0, qn1;
        { const bf16* qrow = Qp + (size_t)(nb0 * 128 + l) * rstride + 8 * fq; qn0 = *(const bf16x8_t*)qrow; qn1 = *(const bf16x8_t*)(qrow + 32); }
        __syncthreads();
        for (int i = 0; i < nun; ++i) {
            const int nb = nb0 + i; const bool more = (i + 1 < nun);
            const bf16x8_t qf0 = qn0, qf1 = qn1;
            u32x4 pk0 = (u32x4){0u, 0u, 0u, 0u}, pk1 = pk0, pv0 = pk0, pv1 = pk0;
            if (more) { const size_t off = (size_t)((nb + 1) * 128 + srow) * rstride + sch * 8;
                pk0 = *(const u32x4*)(Kp + off); pv0 = *(const u32x4*)(Vp + off); pk1 = *(const u32x4*)(Kp + off + 64 * rstride); pv1 = *(const u32x4*)(Vp + off + 64 * rstride);
                const bf16* qrow = Qp + (size_t)((nb + 1) * 128 + l) * rstride + 8 * fq; qn0 = *(const bf16x8_t*)qrow; qn1 = *(const bf16x8_t*)(qrow + 32); }
            const int ps = (nb + 1) & 1, cs = nb & 1;
            f32x4 s[10];
#pragma unroll
            for (int c = 0; c < 10; ++c) { const int ct = ct0 + c; const LAS bf16* kb = Kl + (ct < 8 ? ps : cs) * SLOT + ((ct & 7) * 16 + fr) * 72 + 8 * fq;
                s[c] = __builtin_amdgcn_mfma_f32_16x16x32_bf16(*(const LAS bf16x8_t*)kb, qf0, (f32x4){0.f, 0.f, 0.f, 0.f}, 0, 0, 0);
                s[c] = __builtin_amdgcn_mfma_f32_16x16x32_bf16(*(const LAS bf16x8_t*)(kb + 32), qf1, s[c], 0, 0, 0); }
            int lz = l, fz = 4 * fq; asm volatile("" : "+v"(lz), "+v"(fz));
            float mx = -1e30f;
#pragma unroll
            for (int c = 0; c < 10; ++c)
#pragma unroll
                for (int rg = 0; rg < 4; ++rg) { const int kr = 16 * (ct0 + c) + fz + rg, steps = lz + 128 - kr;
                    const bool ok = steps >= 0 && steps <= 128 && (nb > 0 || kr >= 128);
                    const float v = ok ? s[c][rg] * 0.125f - sl * (float)steps : -1e30f; s[c][rg] = v; mx = fmaxf(mx, v); }
            mx = fmaxf(mx, __shfl_xor(mx, 16)); mx = fmaxf(mx, __shfl_xor(mx, 32));
            float den = 0.f;
#pragma unroll
            for (int c = 0; c < 10; ++c)
#pragma unroll
                for (int rg = 0; rg < 4; ++rg) { const float pe = __expf(s[c][rg] - mx); s[c][rg] = pe; den += pe; }
            den += __shfl_xor(den, 16); den += __shfl_xor(den, 32);
            f32x4 o[4];
#pragma unroll
            for (int dt = 0; dt < 4; ++dt) o[dt] = (f32x4){0.f, 0.f, 0.f, 0.f};
#pragma unroll
            for (int k = 0; k < 5; ++k) { const int ct = ct0 + 2 * k;
                u32x4 wv; wv.x = pg8::cvt_pk_bf16(s[2 * k][0], s[2 * k][1]); wv.y = pg8::cvt_pk_bf16(s[2 * k][2], s[2 * k][3]);
                wv.z = pg8::cvt_pk_bf16(s[2 * k + 1][0], s[2 * k + 1][1]); wv.w = pg8::cvt_pk_bf16(s[2 * k + 1][2], s[2 * k + 1][3]);
                const bf16x8_t pf = __builtin_bit_cast(bf16x8_t, wv);
                const unsigned va = (unsigned)(size_t)(Vl + (ct < 8 ? ps : cs) * SLOT) + (unsigned)((((ct & 7) * 16 + 4 * fq + (fr >> 2)) * 72 + 4 * (fr & 3)) * 2);
                u32x2 a0, a1, a2, a3, a4, a5, a6, a7;
                tr8<0, 16 * 72 * 2>(va, a0, a1, a2, a3, a4, a5, a6, a7);
                __builtin_amdgcn_sched_barrier(0);
                o[0] = __builtin_amdgcn_mfma_f32_16x16x32_bf16(pack_frag(a0, a1), pf, o[0], 0, 0, 0);
                o[1] = __builtin_amdgcn_mfma_f32_16x16x32_bf16(pack_frag(a2, a3), pf, o[1], 0, 0, 0);
                o[2] = __builtin_amdgcn_mfma_f32_16x16x32_bf16(pack_frag(a4, a5), pf, o[2], 0, 0, 0);
                o[3] = __builtin_amdgcn_mfma_f32_16x16x32_bf16(pack_frag(a6, a7), pf, o[3], 0, 0, 0); }
            const float inv = 1.f / den; const size_t tok = (size_t)b * T + (size_t)(nb * 128 + l) * dil + r;
            bf16* op = OG + ((size_t)g * M + tok) * 512 + h * 64 + 4 * fq;
#pragma unroll
            for (int dt = 0; dt < 4; ++dt) { u32x2 wv; wv.x = pg8::cvt_pk_bf16(o[dt][0] * inv, o[dt][1] * inv); wv.y = pg8::cvt_pk_bf16(o[dt][2] * inv, o[dt][3] * inv); *(u32x2*)(op + 16 * dt) = wv; }
            if (fq == 0) LSE[((size_t)g * M + tok) * 8 + h] = mx + __logf(den);
            __syncthreads();
            if (more) { *(LAS u32x4*)(Kl + ps * SLOT + srow * 72 + sch * 8) = pk0; *(LAS u32x4*)(Vl + ps * SLOT + srow * 72 + sch * 8) = pv0;
                *(LAS u32x4*)(Kl + ps * SLOT + (srow + 64) * 72 + sch * 8) = pk1; *(LAS u32x4*)(Vl + ps * SLOT + (srow + 64) * 72 + sch * 8) = pv1; }
            __syncthreads();
        }
    }
}

__device__ __forceinline__ void ph_merge(Frame& F) {
    const bf16* OG = (const bf16*)(F.ws + WS_OG); const float* LSE = (const float*)(F.ws + WS_LSE); bf16* Y2 = (bf16*)(F.ws + WS_Y2);
    const int total = M * 64, nth = F.G * NT;
    for (int idx = blockIdx.x * NT + F.tid; idx < total; idx += nth) {
        const int m = idx >> 6, c8 = idx & 63, h = c8 >> 3;
        const float l0 = LSE[((size_t)0 * M + m) * 8 + h], l1 = LSE[((size_t)1 * M + m) * 8 + h], l2 = LSE[((size_t)2 * M + m) * 8 + h];
        const float mx = fmaxf(l0, fmaxf(l1, l2)); float w0 = __expf(l0 - mx), w1 = __expf(l1 - mx), w2 = __expf(l2 - mx); const float inv = 1.f / (w0 + w1 + w2);
        w0 *= inv; w1 *= inv; w2 *= inv;
        const u32x4 a = *(const u32x4*)(OG + ((size_t)0 * M + m) * 512 + c8 * 8), b = *(const u32x4*)(OG + ((size_t)1 * M + m) * 512 + c8 * 8), c = *(const u32x4*)(OG + ((size_t)2 * M + m) * 512 + c8 * 8);
        u32x4 o;
        o.x = pk2(w0 * bflo(a.x) + w1 * bflo(b.x) + w2 * bflo(c.x), w0 * bfhi(a.x) + w1 * bfhi(b.x) + w2 * bfhi(c.x));
        o.y = pk2(w0 * bflo(a.y) + w1 * bflo(b.y) + w2 * bflo(c.y), w0 * bfhi(a.y) + w1 * bfhi(b.y) + w2 * bfhi(c.y));
        o.z = pk2(w0 * bflo(a.z) + w1 * bflo(b.z) + w2 * bflo(c.z), w0 * bfhi(a.z) + w1 * bfhi(b.z) + w2 * bfhi(c.z));
        o.w = pk2(w0 * bflo(a.w) + w1 * bflo(b.w) + w2 * bflo(c.w), w0 * bfhi(a.w) + w1 * bfhi(b.w) + w2 * bfhi(c.w));
        *(u32x4*)(Y2 + (size_t)m * 512 + c8 * 8) = o;
    }
}

__device__ __forceinline__ void gemm_inproj(Frame& F, const void* A, size_t wt, int N) {
    pg8::StaticOrder S; S.init(A, F.ws + wt, M, N, D, F.G, (int)blockIdx.x); pg8::EpiBf16 E{(bf16*)(F.ws + WS_P), N};
    pg8::gemm_phase<pg8::EpiBf16, pg8::StaticOrder, true, false>(F.lds, D, S, E);
}
template <bool BASE_BF16>
__device__ __forceinline__ void gemm_outproj(Frame& F, size_t a, size_t wt, int K, const void* base) {
    pg8::StaticOrder S; S.init(F.ws + a, F.ws + wt, M, D, K, F.G, (int)blockIdx.x); pg8::EpiResBf16<BASE_BF16> E{base, (bf16*)((char*)F.out + 32 * MiB), ALPHA};
    pg8::gemm_phase<pg8::EpiResBf16<BASE_BF16>, pg8::StaticOrder, false, false>(F.lds, K, S, E);
}
__device__ __forceinline__ void gemm_moe1(Frame& F, int layer) {
    pg8::MoeOrder S{F.ctl + CW_CNT + layer * 32 * 64, (const int*)(F.ws + WS_LIST), (const char*)(F.ws + WS_XB), (const char*)(F.ws + WS_EW), 2, F.G, (int)blockIdx.x, D, 0};
    pg8::EpiSwiGLU E{(bf16*)(F.ws + WS_HID)}; pg8::gemm_phase<pg8::EpiSwiGLU, pg8::MoeOrder, true, true>(F.lds, D, S, E);
}
__device__ __forceinline__ void gemm_moe2(Frame& F, int layer) {
    pg8::MoeOrder S{F.ctl + CW_CNT + layer * 32 * 64, (const int*)(F.ws + WS_LIST), (const char*)(F.ws + WS_HID), (const char*)(F.ws + WS_EW + EW_DN), 4, F.G, (int)blockIdx.x, DE, 1};
    pg8::EpiMoeOut E{(bf16*)(F.ws + WS_YB), (const int*)(F.ws + WS_LIST)}; pg8::gemm_phase<pg8::EpiMoeOut, pg8::MoeOrder, true, false>(F.lds, DE, S, E);
}

struct Args { const float* in[18]; float* out; unsigned char* ws; int ph_lo, ph_hi, li, pad; };
__global__ void __launch_bounds__(NT, 2) mega_fwd(Args args) {
    extern __shared__ __attribute__((aligned(16))) unsigned char lds_raw[];
    Frame F;
    F.lds = (LAS unsigned char*)lds_raw;
    F.tid = threadIdx.x; F.lane = F.tid & 63; F.wave = __builtin_amdgcn_readfirstlane(F.tid >> 6);
    F.G = gridDim.x; { const int bx = blockIdx.x; F.vcu = (F.G % 8 == 0) ? (bx % 8) * (F.G / 8) + bx / 8 : bx; }
#pragma unroll
    for (int i = 0; i < 18; ++i) F.in[i] = args.in[i];
    F.out = args.out; F.ws = args.ws; F.ctl = (unsigned*)(args.ws + WS_CTL);
    volatile LAS unsigned* MISC = (volatile LAS unsigned*)(F.lds + LDS_BYTES - 128);
    if (F.tid < 32) MISC[F.tid] = 0u;
    __syncthreads();
    XcdBarrier bar; bar.bar = F.ctl + CW_BAR; bar.x = 0; bar.st = nullptr;
    if (MK_N_LAUNCHES == 1) bar = xcd_barrier_post(F.ctl + CW_BAR, MISC + 8);
    const int lo = args.ph_lo, hi = args.ph_hi;
#define IN(k) (lo <= (k) && (k) < hi)
#define SEAM(k) do { if (IN(k) && IN((k) + 1)) xcd_barrier(bar); } while (0)
#define DUP(k) ((PROBE_DUP >> (k)) & 1)
#define PHASE(k, ...) do { if (IN(k)) { __VA_ARGS__; if (DUP(k)) { xcd_barrier(bar); __VA_ARGS__; } } SEAM(k); } while (0)
    PHASE(0, ph0_convert(F));
    PHASE(1, gemm_inproj(F, F.ws + WS_XB, WS_WT0, NP0));
    PHASE(2, ph_mix_a(F); xcd_barrier(bar); ph_mix_b(F));
    PHASE(3, ph_mix_c(F));
    PHASE(4, gemm_outproj<false>(F, WS_Y, WS_WO0, D, F.in[0]));
    if (IN(5)) { convert_experts(F, 0); if (DUP(5)) { __syncthreads(); convert_experts(F, 0); } __syncthreads(); ph_ln<0, true, 0>(F, 0); } SEAM(5);
    PHASE(6, gemm_moe1(F, 0));
    PHASE(7, gemm_moe2(F, 0));
    if (IN(8)) { ph_ln<1, false, 1>(F, 0); __syncthreads(); convert_experts(F, 1); if (DUP(8)) { __syncthreads(); convert_experts(F, 1); } } SEAM(8);
    PHASE(9, gemm_inproj(F, F.out, WS_WT1, IN1));
    PHASE(10, ph_attn_v2(F));
    PHASE(11, ph_merge(F));
    PHASE(12, gemm_outproj<true>(F, WS_Y2, WS_WO1, 512, F.out));
    if (IN(13)) { ph_ln<0, true, 0>(F, 1); } SEAM(13);
    PHASE(14, gemm_moe1(F, 1));
    PHASE(15, gemm_moe2(F, 1));
    if (IN(16)) { ph_ln<1, false, 2>(F, 1); }
#undef IN
#undef SEAM
#undef PHASE
#undef DUP
}

extern "C" void kernel_launch(void* const* d_in, const int* in_sizes, int n_in, void* d_out, int out_size, void* d_ws, size_t ws_size, hipStream_t stream) {
    static int grid = 0;
    if (grid == 0) {
        if (n_in != 18 || in_sizes[0] != M * D || out_size != M * D || ws_size < WS_END) {
            fprintf(stderr, "kernel_launch: unexpected problem (n_in %d, in0 %d, out %d, ws %zu < %zu)\n", n_in, n_in > 0 ? in_sizes[0] : -1, out_size, ws_size, (size_t)WS_END); grid = -1; return; }
        int dev = 0, cus = 0;
        if (hipGetDevice(&dev) != hipSuccess || hipDeviceGetAttribute(&cus, hipDeviceAttributeMultiprocessorCount, dev) != hipSuccess) { grid = -1; return; }
        if (hipFuncSetAttribute((const void*)mega_fwd, hipFuncAttributeMaxDynamicSharedMemorySize, LDS_BYTES) != hipSuccess) { fprintf(stderr, "kernel_launch: hipFuncSetAttribute failed\n"); grid = -1; return; }
        int per_cu = 0;
        if (hipOccupancyMaxActiveBlocksPerMultiprocessor(&per_cu, (const void*)mega_fwd, NT, LDS_BYTES) != hipSuccess || per_cu < 1) fprintf(stderr, "kernel_launch: occupancy query says %d\n", per_cu);
        (void)hipGetLastError();
        grid = cus;
    }
    if (grid < 0) return;
    (void)hipMemsetAsync((char*)d_ws + WS_CTL, 0, CTL_ZERO_BYTES, stream);
    Args a{};
    for (int i = 0; i < 18; ++i) a.in[i] = (const float*)d_in[i];
    a.out = (float*)d_out; a.ws = (unsigned char*)d_ws;
    if (MK_N_LAUNCHES == 1) {
        a.ph_lo = 0; a.ph_hi = N_PHASES; a.li = 0;
        hipLaunchKernelGGL(mega_fwd, dim3(grid), dim3(NT), LDS_BYTES, stream, a);
    } else {
        for (int p = 0; p < N_PHASES; ++p) { a.ph_lo = p; a.ph_hi = p + 1; a.li = p; hipLaunchKernelGGL(mega_fwd, dim3(grid), dim3(NT), LDS_BYTES, stream, a); }
    }
}
```

```cpp
#include <hip/hip_runtime.h>
#include <cstdio>
#include <cstdint>

#ifndef PROBE_DUP
#define PROBE_DUP 0
#endif
#ifndef MK_N_LAUNCHES
#define MK_N_LAUNCHES 1
#endif

#define LAS __attribute__((address_space(3)))
typedef unsigned short bf16;
typedef float f32x4 __attribute__((ext_vector_type(4)));
typedef unsigned u32x4 __attribute__((ext_vector_type(4)));
typedef unsigned u32x2 __attribute__((ext_vector_type(2)));
typedef short bf16x8_t __attribute__((ext_vector_type(8)));
#define RLX_AGENT __ATOMIC_RELAXED, __HIP_MEMORY_SCOPE_AGENT
#define LDS_WAIT() asm volatile("s_waitcnt lgkmcnt(0)" ::: "memory")
#define VM_WAIT() asm volatile("s_waitcnt vmcnt(0)" ::: "memory")

constexpr int NWAVES = 8, NT = NWAVES * 64;
constexpr int BATCH = 2, T = 8192, D = 1024, M = BATCH * T;
constexpr int IN0 = 4104, IN1 = 4608, NP0 = 4096;
constexpr int NE = 32, DE = 256;
constexpr float ALPHA = 1.41421356237309515f;
constexpr float LN_EPS = 1e-5f;
constexpr float KSCALE = 0.08838834764831845f;
constexpr int N_PHASES = 17;

constexpr size_t MiB = 1u << 20;
constexpr size_t WS_CTL = 0, CTL_ZERO_BYTES = 1 * MiB;
constexpr size_t WS_G = 1 * MiB;
constexpr size_t WS_EIDX = WS_G + 512 * 1024;
constexpr size_t WS_GATEV = WS_EIDX + 128 * 1024;
constexpr size_t WS_WT0 = 2 * MiB;
constexpr size_t WS_WO0 = 10 * MiB;
constexpr size_t WS_WT1 = 12 * MiB;
constexpr size_t WS_WO1 = 21 * MiB;
constexpr size_t WS_SE = 22 * MiB;
constexpr size_t WS_EW = WS_SE;
constexpr size_t EW_STRIDE = 3 * MiB / 2, EW_DN = 1 * MiB;
constexpr size_t WS_LIST = WS_SE + 48 * MiB;
constexpr size_t WS_LSE = WS_SE + 50 * MiB;
constexpr size_t WS_XB = 86 * MiB;
constexpr size_t WS_Y = 118 * MiB;
constexpr size_t WS_OG = WS_XB;
constexpr size_t WS_Y2 = WS_XB + 48 * MiB;
constexpr size_t WS_P = 150 * MiB;
constexpr size_t WS_YB = WS_P;
constexpr size_t WS_HID = WS_P + 64 * MiB;
constexpr size_t WS_END = 294 * MiB;
constexpr size_t WS_QKC = WS_SE;

constexpr int CW_BAR = 4096;
constexpr int CW_CNT = 16384;

constexpr int LDS_BYTES = 147456;

__device__ __forceinline__ unsigned f2bf(float f) { unsigned u = __builtin_bit_cast(unsigned, f); return (u + 0x7fffu + ((u >> 16) & 1u)) >> 16; }
__device__ __forceinline__ unsigned pk2(float lo, float hi) { return f2bf(lo) | (f2bf(hi) << 16); }
__device__ __forceinline__ float bf2f(unsigned b) { return __builtin_bit_cast(float, b << 16); }
__device__ __forceinline__ float bflo(unsigned w) { return __builtin_bit_cast(float, w << 16); }
__device__ __forceinline__ float bfhi(unsigned w) { return __builtin_bit_cast(float, w & 0xffff0000u); }
__device__ __forceinline__ float wave_sum(float v) {
#pragma unroll
    for (int o = 1; o < 64; o <<= 1) v += __shfl_xor(v, o);
    return v;
}
__device__ __forceinline__ float sigmoidf_(float x) { return 1.f / (1.f + __expf(-x)); }
__device__ __forceinline__ float siluf_(float x) { return x / (1.f + __expf(-x)); }

#define XB_TMO      128
#define XB_XCNT(j)  (256  + 64 * (j))
#define XB_XSUB(j)  (1280 + 64 * (j))
#define XB_XGEN(j)  (2304 + 64 * (j))
#define XB_TOP      3328
#define XB_TOPGEN   3392
#define XCD_BAR_WORDS 3456
#define XB_SPIN_CAP (1u << 22)
__device__ __forceinline__ unsigned xb_ld(unsigned* p)              { return __hip_atomic_load(p, __ATOMIC_RELAXED, __HIP_MEMORY_SCOPE_AGENT); }
__device__ __forceinline__ unsigned xb_add(unsigned* p, unsigned v) { return __hip_atomic_fetch_add(p, v, __ATOMIC_RELAXED, __HIP_MEMORY_SCOPE_AGENT); }
__device__ __forceinline__ unsigned xb_xcc_id() { return (unsigned)__builtin_amdgcn_s_getreg((3 << 11) | 20) & 0xFu; }
#define XB_SPIN(cond, bar) do { unsigned _sp = 0; while (cond) { __builtin_amdgcn_s_sleep(1); \
    if ((++_sp & 255u) == 0u) { if (xb_ld(&(bar)[XB_TMO])) break; if (_sp > XB_SPIN_CAP) { atomicAdd(&(bar)[XB_TMO], 1u); break; } } } } while (0)
struct XcdBarrier { unsigned* bar; unsigned x; volatile LAS unsigned* st; };
__device__ __forceinline__ XcdBarrier xcd_barrier_post(unsigned* bar, volatile LAS unsigned* st) {
    XcdBarrier b; b.bar = bar; b.x = xb_xcc_id(); b.st = st;
    if (threadIdx.x == 0) (void)xb_add(&bar[XB_XCNT(b.x)], 1u);
    return b;
}
__device__ __forceinline__ void xcd_barrier_complete(unsigned* bar, unsigned x, unsigned& nloc, unsigned& nx) {
    const unsigned G = gridDim.x * gridDim.y * gridDim.z;
    unsigned sum, cnt, mine, sp = 0u;
    for (;;) {
        sum = 0u; cnt = 0u; mine = 0u;
#pragma unroll
        for (unsigned j = 0; j < 16; ++j) { const unsigned c = xb_ld(&bar[XB_XCNT(j)]); sum += c; cnt += (c > 0u) ? 1u : 0u; mine = (j == x) ? c : mine; }
        if (sum == G) break;
        __builtin_amdgcn_s_sleep(1);
        if ((++sp & 255u) == 0u) { if (xb_ld(&bar[XB_TMO])) break; if (sp > XB_SPIN_CAP) { atomicAdd(&bar[XB_TMO], 1u); break; } }
    }
    nloc = mine > 0u ? mine : 1u; nx = cnt > 0u ? cnt : 1u;
}
__device__ __forceinline__ void xcd_barrier(const XcdBarrier& b) {
    asm volatile("s_waitcnt vmcnt(0)" ::: "memory");
    __syncthreads();
    if (threadIdx.x == 0) {
        unsigned* bar = b.bar;
        __builtin_amdgcn_s_waitcnt(0);
        unsigned nloc = b.st[0], nx = b.st[1];
        if (nloc == 0u) { xcd_barrier_complete(bar, b.x, nloc, nx); b.st[0] = nloc; b.st[1] = nx; }
        const unsigned old = xb_add(&bar[XB_XSUB(b.x)], 1u);
        const unsigned gen = old / nloc;
        if (old + 1u == (gen + 1u) * nloc) {
            __builtin_amdgcn_fence(__ATOMIC_RELEASE, "agent");
            asm volatile("s_waitcnt vmcnt(0)" ::: "memory");
            const unsigned og = xb_add(&bar[XB_TOP], 1u);
            const unsigned tg = og / nx;
            if (og + 1u == (tg + 1u) * nx) xb_add(&bar[XB_TOPGEN], 1u);
            else XB_SPIN(xb_ld(&bar[XB_TOPGEN]) == tg, bar);
            __builtin_amdgcn_fence(__ATOMIC_ACQUIRE, "agent");
            xb_add(&bar[XB_XGEN(b.x)], 1u);
            asm volatile("s_waitcnt vmcnt(0)" ::: "memory");
        } else {
            XB_SPIN(xb_ld(&bar[XB_XGEN(b.x)]) == gen, bar);
            __builtin_amdgcn_fence(__ATOMIC_ACQUIRE, "agent");
            asm volatile("s_waitcnt vmcnt(0)" ::: "memory");
        }
    }
    __syncthreads();
}

struct Frame {
    LAS unsigned char* lds;
    unsigned* ctl;
    int tid, lane, wave, vcu, G;
    const float* in[18];
    float* out;
    unsigned char* ws;
};

namespace pg8 {
typedef short bf16x8 __attribute__((ext_vector_type(8)));
constexpr int BM = 256, BK = 64, HALF = 128, HTB = HALF * BK * 2, STAGE_BYTES = 8 * HTB, NXCD = 8, WGM = 8;
__host__ __device__ __forceinline__ int lds_byte(int r, int c) { const int st = (r >> 4) * 2 + (c >> 5), rr = r & 15, cc = c & 31, ob = rr * 64 + cc * 2; return st * 1024 + (ob ^ (((ob >> 9) & 1) << 5)); }
__host__ __device__ __forceinline__ void stage_rc(int b, int& R, int& C) { const int st = b / 1024, sb = b % 1024, swz = sb ^ (((sb >> 9) & 1) << 5); R = (st >> 1) * 16 + swz / 64; C = (st & 1) * 32 + (swz % 64) / 2; }
__host__ __device__ __forceinline__ int perm32(int rho) { const int n = rho >> 4, i = rho & 15; return 8 * (i >> 2) + 4 * n + (i & 3); }
struct Unit { int pm, pn, e, cnt, hb; };
typedef __bf16 bf16n2 __attribute__((ext_vector_type(2)));
typedef float f32x2n __attribute__((ext_vector_type(2)));
__device__ __forceinline__ unsigned cvt_pk_bf16(float lo, float hi) { const bf16n2 v = __builtin_convertvector((f32x2n){lo, hi}, bf16n2); return __builtin_bit_cast(unsigned, v); }

struct StaticOrder {
    int nM, nN, nwg, G, c, K; const char* A; const char* Bt;
    __device__ void init(const void* A_, const void* Bt_, int M_, int N_, int K_, int G_, int c_) { A = (const char*)A_; Bt = (const char*)Bt_; nM = M_ / BM; nN = N_ / BM; nwg = nM * nN; G = G_; c = c_; K = K_; }
    __device__ bool next(int i, Unit& u) const {
        const long L = (long)i * G + c; if (L >= nwg) return false;
        int wgid = (int)L; { const int q = nwg / NXCD, r = nwg % NXCD, xcd = wgid % NXCD, off = wgid / NXCD; wgid = (xcd < r ? xcd * (q + 1) : r * (q + 1) + (xcd - r) * q) + off; }
        const int nig = WGM * nN, gid = wgid / nig, fm = gid * WGM, gsz = (nM - fm) < WGM ? (nM - fm) : WGM;
        u.pm = fm + ((wgid % nig) % gsz); u.pn = (wgid % nig) / gsz; u.e = 0; u.cnt = 0; u.hb = 0; return true;
    }
    __device__ __forceinline__ void base(const Unit& u, const char*& cA, const char*& cB) const { cA = A + (size_t)u.pm * BM * K * 2; cB = Bt + (size_t)u.pn * BM * K * 2; }
    __device__ __forceinline__ unsigned rowoff(const Unit&, int) const { return 0u; }
};

struct EpiBf16 {
    static constexpr bool PERM = true;
    bf16* O; int ldc;
    __device__ __forceinline__ void operator()(const f32x4 (&acc)[2][2][4][2], const Unit& u, int wr, int wc, int fr, int fq) const {
        const int row0 = u.pm * BM + wr * 64 + fr, col0 = u.pn * BM + wc * 32 + 8 * fq;
#pragma unroll
        for (int ai = 0; ai < 2; ++ai)
#pragma unroll
            for (int m = 0; m < 4; ++m) { bf16* rowp = O + (size_t)(row0 + ai * HALF + m * 16) * ldc + col0;
#pragma unroll
                for (int bj = 0; bj < 2; ++bj) { const f32x4 v0 = acc[ai][bj][m][0], v1 = acc[ai][bj][m][1];
                    u32x4 w; w.x = cvt_pk_bf16(v0[0], v0[1]); w.y = cvt_pk_bf16(v0[2], v0[3]); w.z = cvt_pk_bf16(v1[0], v1[1]); w.w = cvt_pk_bf16(v1[2], v1[3]);
                    *(u32x4*)(rowp + bj * HALF) = w; } }
    }
};
template <bool BASE_BF16>
struct EpiResBf16 {
    static constexpr bool PERM = true;
    const void* base; bf16* out; float alpha;
    __device__ __forceinline__ void operator()(const f32x4 (&acc)[2][2][4][2], const Unit& u, int wr, int wc, int fr, int fq) const {
        const int col0 = u.pn * BM + wc * 32 + 8 * fq;
#pragma unroll
        for (int ai = 0; ai < 2; ++ai)
#pragma unroll
            for (int m = 0; m < 4; ++m) { const size_t off = (size_t)(u.pm * BM + ai * HALF + wr * 64 + m * 16 + fr) * 1024 + col0;
#pragma unroll
                for (int bj = 0; bj < 2; ++bj) { f32x4 b0, b1;
                    if (BASE_BF16) { const u32x4 x = *(const u32x4*)((const bf16*)base + off + bj * HALF); b0 = (f32x4){bflo(x.x), bfhi(x.x), bflo(x.y), bfhi(x.y)}; b1 = (f32x4){bflo(x.z), bfhi(x.z), bflo(x.w), bfhi(x.w)}; }
                    else { b0 = *(const f32x4*)((const float*)base + off + bj * HALF); b1 = *(const f32x4*)((const float*)base + off + bj * HALF + 4); }
                    const f32x4 v0 = b0 * alpha + acc[ai][bj][m][0], v1 = b1 * alpha + acc[ai][bj][m][1];
                    u32x4 w; w.x = cvt_pk_bf16(v0[0], v0[1]); w.y = cvt_pk_bf16(v0[2], v0[3]); w.z = cvt_pk_bf16(v1[0], v1[1]); w.w = cvt_pk_bf16(v1[2], v1[3]);
                    *(u32x4*)(out + off + bj * HALF) = w; }
                if (m & 1) asm volatile("" ::: "memory"); }
    }
};

struct MoeOrder {
    const unsigned* cnt; const int* LIST; const char* A; const char* B; int NTN, G, c, K, mode, Lbase, Lend;
    __device__ bool next(int i, Unit& u) const {
        if (c < 0) return false;
        const int L = Lbase + i * G + c; if (L >= Lend) return false;
        int base = 0, hb = 0;
        for (int e = 0; e < 32; ++e) { const int cc = (int)cnt[e * 64]; const int nmb = (cc + 255) >> 8; const int ntl = nmb * NTN;
            if (L < base + ntl) { const int r = L - base; u.e = e; u.pm = r / NTN; u.pn = r % NTN; u.cnt = cc; u.hb = hb; return true; }
            base += ntl; hb += nmb << 8; }
        return false;
    }
    __device__ __forceinline__ void base(const Unit& u, const char*& cA, const char*& cB) const {
        cA = mode == 0 ? A : A + (size_t)(u.hb + u.pm * 256) * K * 2; cB = B + (size_t)u.e * EW_STRIDE + (size_t)u.pn * 256 * K * 2; }
    __device__ __forceinline__ unsigned rowoff(const Unit& u, int r) const { int i = u.pm * 256 + r; i = i < u.cnt ? i : 0; return (unsigned)(LIST[u.e * M + i] >> 1) * 2048u; }
};
struct EpiSwiGLU {
    static constexpr bool PERM = true;
    bf16* HID;
    __device__ __forceinline__ void operator()(const f32x4 (&acc)[2][2][4][2], const Unit& u, int wr, int wc, int fr, int fq) const {
#pragma unroll
        for (int ai = 0; ai < 2; ++ai)
#pragma unroll
            for (int m = 0; m < 4; ++m) { const int i = u.pm * 256 + ai * HALF + wr * 64 + m * 16 + fr;
                if (i < u.cnt) { const f32x4 g0 = acc[ai][0][m][0], g1 = acc[ai][0][m][1], u0 = acc[ai][1][m][0], u1 = acc[ai][1][m][1];
                    u32x4 w; w.x = cvt_pk_bf16(siluf_(g0[0]) * u0[0], siluf_(g0[1]) * u0[1]); w.y = cvt_pk_bf16(siluf_(g0[2]) * u0[2], siluf_(g0[3]) * u0[3]);
                    w.z = cvt_pk_bf16(siluf_(g1[0]) * u1[0], siluf_(g1[1]) * u1[1]); w.w = cvt_pk_bf16(siluf_(g1[2]) * u1[2], siluf_(g1[3]) * u1[3]);
                    *(u32x4*)(HID + (size_t)(u.hb + i) * DE + u.pn * 128 + wc * 32 + 8 * fq) = w; } }
    }
};
struct EpiMoeOut {
    static constexpr bool PERM = true;
    bf16* YB; const int* LIST;
    __device__ __forceinline__ void operator()(const f32x4 (&acc)[2][2][4][2], const Unit& u, int wr, int wc, int fr, int fq) const {
#pragma unroll
        for (int ai = 0; ai < 2; ++ai)
#pragma unroll
            for (int m = 0; m < 4; ++m) { const int i = u.pm * 256 + ai * HALF + wr * 64 + m * 16 + fr;
                if (i < u.cnt) { const int a = LIST[u.e * M + i]; bf16* rowp = YB + (size_t)a * D + u.pn * 256 + wc * 32 + 8 * fq;
#pragma unroll
                    for (int bj = 0; bj < 2; ++bj) { const f32x4 v0 = acc[ai][bj][m][0], v1 = acc[ai][bj][m][1];
                        u32x4 w; w.x = cvt_pk_bf16(v0[0], v0[1]); w.y = cvt_pk_bf16(v0[2], v0[3]); w.z = cvt_pk_bf16(v1[0], v1[1]); w.w = cvt_pk_bf16(v1[2], v1[3]);
                        *(u32x4*)(rowp + bj * HALF) = w; } }
                asm volatile("" ::: "memory"); }
    }
};

template <class Epi, class Sched, bool ALIGN_EPI, bool GATHER>
__device__ __forceinline__ void gemm_phase(LAS unsigned char* lds, const int K, const Sched& S, const Epi& E) {
    const int tid = threadIdx.x, wid = __builtin_amdgcn_readfirstlane(tid >> 6), lane = tid & 63, wr = wid >> 2, wc = wid & 3, fr = lane & 15, fq = lane >> 4;
    const int nt = K / BK;
    int Rr[2], Cc[2]; unsigned voffB[2];
#pragma unroll
    for (int i = 0; i < 2; ++i) { int R, C; stage_rc(tid * 16 + i * 8192, R, C); const int Rb = Epi::PERM ? ((R & ~31) + perm32(R & 31)) : R; Rr[i] = R; Cc[i] = C; voffB[i] = (unsigned)(Rb * K + C) * 2u; }
    const size_t kstep = (size_t)(BK * 2);
    const size_t hstep = (size_t)HALF * K * 2;
    const unsigned ldsw = (unsigned)wid * 1024u;
    const int aoff = lds_byte(wr * 64 + fr, fq * 8), boff = lds_byte(wc * 32 + fr, fq * 8);
#define PG8_SA(b, h) (((b) * 2 + (h)) * HTB)
#define PG8_SB(b, h) ((4 + (b) * 2 + (h)) * HTB)
#define PG8_STAGE(bufoff, gbase, voff) do { _Pragma("unroll") for (int _i = 0; _i < 2; ++_i) \
        __builtin_amdgcn_global_load_lds((const unsigned*)((const char*)(gbase) + (voff)[_i]), (LAS unsigned*)(lds + (bufoff) + ldsw + _i * 8192), 16, 0, 0); } while (0)
#define PG8_STAGE_A(bufoff, gbase, o0, o1) do { \
        __builtin_amdgcn_global_load_lds((const unsigned*)((const char*)(gbase) + (o0)), (LAS unsigned*)(lds + (bufoff) + ldsw), 16, 0, 0); \
        __builtin_amdgcn_global_load_lds((const unsigned*)((const char*)(gbase) + (o1)), (LAS unsigned*)(lds + (bufoff) + ldsw + 8192), 16, 0, 0); } while (0)
#define PG8_LDA(dst, b, h) do { _Pragma("unroll") for (int m = 0; m < 4; ++m) _Pragma("unroll") for (int k = 0; k < 2; ++k) dst[m][k] = *(const LAS bf16x8*)(lds + PG8_SA(b, h) + aoff + m * 2048 + k * 1024); } while (0)
#define PG8_LDB(dst, b, h) do { _Pragma("unroll") for (int n = 0; n < 2; ++n) _Pragma("unroll") for (int k = 0; k < 2; ++k) dst[n][k] = *(const LAS bf16x8*)(lds + PG8_SB(b, h) + boff + n * 2048 + k * 1024); } while (0)
#define PG8_MMA(ai, bj, At, Bt) do { __builtin_amdgcn_s_setprio(1); _Pragma("unroll") for (int m = 0; m < 4; ++m) _Pragma("unroll") for (int n = 0; n < 2; ++n) _Pragma("unroll") for (int k = 0; k < 2; ++k) \
        acc[ai][bj][m][n] = __builtin_amdgcn_mfma_f32_16x16x32_bf16(Bt[n][k], At[m][k], acc[ai][bj][m][n], 0, 0, 0); __builtin_amdgcn_s_setprio(0); } while (0)
#define PG8_WAIT_V(n) asm volatile("s_waitcnt vmcnt(" #n ")" ::: "memory")
#define PG8_WAIT_L(n) asm volatile("s_waitcnt lgkmcnt(" #n ")" ::: "memory")
#define PG8_BAR __builtin_amdgcn_s_barrier()
#define PG8_SCHED __builtin_amdgcn_sched_barrier(0)
#define PG8_CALC_VA(u, v) do { _Pragma("unroll") for (int _h = 0; _h < 2; ++_h) _Pragma("unroll") for (int _i = 0; _i < 2; ++_i) \
        v[_h][_i] = GATHER ? (S.rowoff(u, _h * HALF + Rr[_i]) + (unsigned)Cc[_i] * 2u) : (unsigned)((_h * HALF + Rr[_i]) * K + Cc[_i]) * 2u; } while (0)
    Unit cur, nxt; int ui = 0;
    if (!S.next(0, cur)) return;
    f32x4 acc[2][2][4][2];
#pragma unroll
    for (int a = 0; a < 2; ++a)
#pragma unroll
        for (int b = 0; b < 2; ++b)
#pragma unroll
            for (int m = 0; m < 4; ++m)
#pragma unroll
                for (int n = 0; n < 2; ++n) acc[a][b][m][n] = (f32x4){0.f, 0.f, 0.f, 0.f};
    bf16x8 At[4][2], B0[2][2], B1[2][2];
    const char* cA; const char* cB; S.base(cur, cA, cB);
    unsigned cvA[2][2], nvA[2][2];
    PG8_CALC_VA(cur, cvA);
    PG8_STAGE(PG8_SB(0, 0), cB, voffB); PG8_STAGE(PG8_SB(0, 1), cB + hstep, voffB); PG8_STAGE_A(PG8_SA(0, 0), cA, cvA[0][0], cvA[0][1]); PG8_STAGE_A(PG8_SA(0, 1), cA, cvA[1][0], cvA[1][1]);
    if (wr == 1) PG8_BAR;
    PG8_WAIT_V(2); PG8_BAR;
    PG8_STAGE(PG8_SB(1, 0), cB + kstep, voffB); PG8_STAGE_A(PG8_SA(1, 0), cA + kstep, cvA[0][0], cvA[0][1]); PG8_STAGE(PG8_SB(1, 1), cB + hstep + kstep, voffB);
    PG8_WAIT_V(6); PG8_BAR;
    for (;;) {
        const bool has_next = S.next(ui + 1, nxt);
        const char* nA = cA; const char* nB = cB;
        if (has_next) { S.base(nxt, nA, nB); PG8_CALC_VA(nxt, nvA); }
        else {
#pragma unroll
            for (int h = 0; h < 2; ++h)
#pragma unroll
                for (int i = 0; i < 2; ++i) nvA[h][i] = cvA[h][i]; }
        if (GATHER) { asm volatile("s_waitcnt vmcnt(0)" ::: "memory"); asm volatile("" : "+v"(nvA[0][0]), "+v"(nvA[0][1]), "+v"(nvA[1][0]), "+v"(nvA[1][1])); }
#pragma unroll 1
        for (int t = 0; t < nt; t += 2) {
            const bool last = (t == nt - 2);
            const char* a1 = cA + (size_t)(t + 1) * kstep;
            const char* a2 = last ? nA : cA + (size_t)(t + 2) * kstep; const char* b2 = last ? nB : cB + (size_t)(t + 2) * kstep;
            const char* a3 = a2 + kstep; const char* b3 = b2 + kstep;
            const unsigned x00 = last ? nvA[0][0] : cvA[0][0], x01 = last ? nvA[0][1] : cvA[0][1], x10 = last ? nvA[1][0] : cvA[1][0], x11 = last ? nvA[1][1] : cvA[1][1];
            PG8_LDB(B0, 0, 0); PG8_LDB(B1, 0, 1); PG8_SCHED; PG8_LDA(At, 0, 0); PG8_STAGE_A(PG8_SA(1, 1), a1, cvA[1][0], cvA[1][1]);
            PG8_WAIT_V(8); PG8_WAIT_L(0); PG8_BAR; PG8_MMA(0, 0, At, B0); PG8_MMA(0, 1, At, B1); PG8_BAR; PG8_SCHED;
            PG8_LDA(At, 0, 1); PG8_STAGE(PG8_SB(0, 0), b2, voffB); PG8_STAGE(PG8_SB(0, 1), b2 + hstep, voffB); PG8_STAGE_A(PG8_SA(0, 0), a2, x00, x01);
            PG8_WAIT_V(8); PG8_WAIT_L(0); PG8_BAR; PG8_MMA(1, 0, At, B0); PG8_MMA(1, 1, At, B1); PG8_BAR; PG8_SCHED;
            PG8_LDB(B0, 1, 0); PG8_LDB(B1, 1, 1); PG8_SCHED; PG8_LDA(At, 1, 0); PG8_STAGE_A(PG8_SA(0, 1), a2, x10, x11);
            PG8_WAIT_V(8); PG8_WAIT_L(0); PG8_BAR; PG8_MMA(0, 0, At, B0); PG8_MMA(0, 1, At, B1); PG8_BAR; PG8_SCHED;
            PG8_LDA(At, 1, 1); PG8_STAGE(PG8_SB(1, 0), b3, voffB); PG8_STAGE(PG8_SB(1, 1), b3 + hstep, voffB); PG8_STAGE_A(PG8_SA(1, 0), a3, x00, x01);
            PG8_WAIT_V(8); PG8_WAIT_L(0); PG8_BAR; PG8_MMA(1, 0, At, B0); PG8_MMA(1, 1, At, B1); PG8_BAR; PG8_SCHED;
        }
        if constexpr (ALIGN_EPI) { if (wr == 0) PG8_BAR; }
        E(acc, cur, wr, wc, fr, fq);
        if (!has_next) break;
#pragma unroll
        for (int a = 0; a < 2; ++a)
#pragma unroll
            for (int b = 0; b < 2; ++b)
#pragma unroll
                for (int m = 0; m < 4; ++m)
#pragma unroll
                    for (int n = 0; n < 2; ++n) acc[a][b][m][n] = (f32x4){0.f, 0.f, 0.f, 0.f};
        cur = nxt; cA = nA; cB = nB; ++ui;
#pragma unroll
        for (int h = 0; h < 2; ++h)
#pragma unroll
            for (int i = 0; i < 2; ++i) cvA[h][i] = nvA[h][i];
        if constexpr (ALIGN_EPI) { if (wr == 1) PG8_BAR; }
    }
    PG8_WAIT_V(0);
    if constexpr (!ALIGN_EPI) { if (wr == 0) PG8_BAR; }
    PG8_BAR;
#undef PG8_SA
#undef PG8_SB
#undef PG8_STAGE
#undef PG8_STAGE_A
#undef PG8_LDA
#undef PG8_LDB
#undef PG8_MMA
#undef PG8_WAIT_V
#undef PG8_WAIT_L
#undef PG8_BAR
#undef PG8_SCHED
#undef PG8_CALC_VA
}
}

template <class RowFn>
__device__ __forceinline__ void ngemm_tile(LAS float* sA, LAS float* sB, RowFn rowA, const bf16* Bt, int ldb, int K, float (&acc)[4][4]) {
    const int tid = threadIdx.x, tx = tid & 15, ty = tid >> 4;
#pragma unroll
    for (int i = 0; i < 4; ++i)
#pragma unroll
        for (int j = 0; j < 4; ++j) acc[i][j] = 0.f;
    const int ar = tid >> 2, ak = (tid & 3) * 8, br = tid >> 3, bk = (tid & 7) * 4;
    const bf16* ap = rowA(ar);
    const bf16* bp = Bt + (size_t)br * ldb;
    for (int k0 = 0; k0 < K; k0 += 32) {
        u32x4 av = (u32x4){0u, 0u, 0u, 0u};
        if (ap) av = *(const u32x4*)(ap + k0 + ak);
        const u32x2 bv = *(const u32x2*)(bp + k0 + bk);
        __syncthreads();
        LAS float* wa = sA + ar * 33 + ak;
        wa[0] = bflo(av.x); wa[1] = bfhi(av.x); wa[2] = bflo(av.y); wa[3] = bfhi(av.y); wa[4] = bflo(av.z); wa[5] = bfhi(av.z); wa[6] = bflo(av.w); wa[7] = bfhi(av.w);
        LAS float* wb = sB + br * 33 + bk;
        wb[0] = bflo(bv.x); wb[1] = bfhi(bv.x); wb[2] = bflo(bv.y); wb[3] = bfhi(bv.y);
        __syncthreads();
#pragma unroll 8
        for (int kk = 0; kk < 32; ++kk) {
            float a[4], b[4];
#pragma unroll
            for (int i = 0; i < 4; ++i) a[i] = sA[(ty * 4 + i) * 33 + kk];
#pragma unroll
            for (int j = 0; j < 4; ++j) b[j] = sB[(tx * 4 + j) * 33 + kk];
#pragma unroll
            for (int i = 0; i < 4; ++i)
#pragma unroll
                for (int j = 0; j < 4; ++j) acc[i][j] = fmaf(a[i], b[j], acc[i][j]);
        }
    }
}

__device__ __forceinline__ void tr_item(const float* W, int ldw, bf16* WT, int ldt, LAS float* scr, int kb, int nb, int lane) {
    const int k0 = 64 * kb, n0 = 32 * nb;
#pragma unroll 8
    for (int i = 0; i < 32; ++i) { const int kk = 2 * i + (lane >> 5); scr[kk * 33 + (lane & 31)] = W[(size_t)(k0 + kk) * ldw + n0 + (lane & 31)]; }
    LDS_WAIT(); asm volatile("" ::: "memory");
    const int c = lane & 7;
#pragma unroll
    for (int j = 0; j < 4; ++j) { const int n = (lane >> 3) + 8 * j; const LAS float* s = scr + (8 * c) * 33 + n;
        u32x4 o; o.x = pk2(s[0 * 33], s[1 * 33]); o.y = pk2(s[2 * 33], s[3 * 33]); o.z = pk2(s[4 * 33], s[5 * 33]); o.w = pk2(s[6 * 33], s[7 * 33]);
        *(u32x4*)(WT + (size_t)(n0 + n) * ldt + k0 + 8 * c) = o; }
    LDS_WAIT(); asm volatile("" ::: "memory");
}

__device__ __forceinline__ void ph0_convert(Frame& F) {
    LAS float* scr = (LAS float*)(F.lds + F.wave * 9216);
    LAS float* gw = (LAS float*)(F.lds + 8 * 9216);
    const float* w0 = F.in[1];
    for (int i = F.tid; i < 8 * 1024; i += NT) { const int j = i >> 10, k = i & 1023; gw[i] = w0[(size_t)k * IN0 + 2048 + j]; }
    __syncthreads();
    const int gwv = F.vcu * NWAVES + F.wave, NGW = F.G * NWAVES;
    bf16* WT0 = (bf16*)(F.ws + WS_WT0); bf16* WO0 = (bf16*)(F.ws + WS_WO0); bf16* WT1 = (bf16*)(F.ws + WS_WT1); bf16* WO1 = (bf16*)(F.ws + WS_WO1);
    constexpr int I0 = 16 * 64, I1 = 16 * 64, I2 = 16 * 32, I3 = 16 * 144, I4 = 8 * 32, NI = I0 + I1 + I2 + I3 + I4;
    for (int it = gwv; it < NI; it += NGW) {
        int r = it;
        if (r < I0) { tr_item(w0, IN0, WT0, 1024, scr, r / 64, r % 64, F.lane); continue; } r -= I0;
        if (r < I1) { tr_item(w0 + 2056, IN0, WT0 + (size_t)2048 * 1024, 1024, scr, r / 64, r % 64, F.lane); continue; } r -= I1;
        if (r < I2) { tr_item(F.in[8], 1024, WO0, 1024, scr, r / 32, r % 32, F.lane); continue; } r -= I2;
        if (r < I3) { tr_item(F.in[9], IN1, WT1, 1024, scr, r / 144, r % 144, F.lane); continue; } r -= I3;
        tr_item(F.in[10], 1024, WO1, 512, scr, r / 32, r % 32, F.lane);
    }
    const float* x = F.in[0]; bf16* XB = (bf16*)(F.ws + WS_XB); float* G = (float*)(F.ws + WS_G);
    const float* ib = F.in[2]; const float* fb = F.in[3];
    f32x4 nx[4];
    if (gwv < M) { const f32x4* xr = (const f32x4*)(x + (size_t)gwv * D) + F.lane;
#pragma unroll
        for (int j = 0; j < 4; ++j) nx[j] = xr[64 * j]; }
    for (int m = gwv; m < M; m += NGW) {
        f32x4 v[4];
#pragma unroll
        for (int j = 0; j < 4; ++j) v[j] = nx[j];
        if (m + NGW < M) { const f32x4* xr = (const f32x4*)(x + (size_t)(m + NGW) * D) + F.lane;
#pragma unroll
            for (int j = 0; j < 4; ++j) nx[j] = xr[64 * j]; }
        unsigned long long* o8 = (unsigned long long*)(XB + (size_t)m * D) + F.lane;
#pragma unroll
        for (int j = 0; j < 4; ++j) o8[64 * j] = (unsigned long long)pk2(v[j].x, v[j].y) | ((unsigned long long)pk2(v[j].z, v[j].w) << 32);
        float acc[8];
#pragma unroll
        for (int g = 0; g < 8; ++g) { float a = 0.f;
#pragma unroll
            for (int j = 0; j < 4; ++j) { const f32x4 w = *(const LAS f32x4*)(gw + g * 1024 + 4 * F.lane + 256 * j); a += v[j].x * w.x + v[j].y * w.y + v[j].z * w.z + v[j].w * w.w; }
            acc[g] = wave_sum(a); }
        if (F.lane == 0) {
#pragma unroll
            for (int g = 0; g < 4; ++g) G[(size_t)m * 8 + g] = acc[g] + ib[g];
#pragma unroll
            for (int g = 0; g < 4; ++g) { const float z = acc[4 + g] + fb[g]; G[(size_t)m * 8 + 4 + g] = fminf(z, 0.f) - log1pf(__expf(-fabsf(z))); }
        }
    }
}

__device__ __forceinline__ void convert_experts(Frame& F, int layer) {
    LAS float* scr = (LAS float*)(F.lds + F.wave * 9216);
    const int gwv = F.vcu * NWAVES + F.wave, NGW = F.G * NWAVES;
    const float* wg = F.in[13] + (size_t)layer * NE * D * DE; const float* wu = F.in[14] + (size_t)layer * NE * D * DE; const float* wd = F.in[15] + (size_t)layer * NE * DE * D;
    for (int it = gwv; it < NE * 384; it += NGW) {
        const int e = it / 384; int r = it % 384;
        bf16* GU = (bf16*)(F.ws + WS_EW + (size_t)e * EW_STRIDE); bf16* DN = (bf16*)(F.ws + WS_EW + (size_t)e * EW_STRIDE + EW_DN);
        if (r < 256) { const int job = r >> 6, q = r & 63;
            const float* src = ((job < 2) ? wg : wu) + (size_t)e * D * DE + (job & 1) * 128;
            bf16* dst = GU + (size_t)((job & 1) * 256 + (job >> 1) * 128) * 1024;
            tr_item(src, DE, dst, 1024, scr, q >> 2, q & 3, F.lane);
        } else { r -= 256;
            tr_item(wd + (size_t)e * DE * D, D, DN, DE, scr, r >> 5, r & 31, F.lane); }
    }
}

__device__ __forceinline__ void ph_inproj_naive(Frame& F, const bf16* Bt, int N) {
    LAS float* sA = (LAS float*)F.lds; LAS float* sB = sA + 128 * 33;
    const bf16* XB = (const bf16*)(F.ws + WS_XB); bf16* P = (bf16*)(F.ws + WS_P);
    const int nnb = N / 64, ntiles = (M / 128) * nnb, tx = F.tid & 15, ty = F.tid >> 4;
    for (int t = blockIdx.x; t < ntiles; t += F.G) {
        const int mb = t / nnb, nb = t % nnb; float acc[4][4];
        ngemm_tile(sA, sB, [&](int r) { return XB + (size_t)(mb * 128 + r) * D; }, Bt + (size_t)nb * 64 * D, D, D, acc);
#pragma unroll
        for (int i = 0; i < 4; ++i) { u32x2 o; o.x = pk2(acc[i][0], acc[i][1]); o.y = pk2(acc[i][2], acc[i][3]);
            *(u32x2*)(P + (size_t)(mb * 128 + ty * 4 + i) * N + nb * 64 + tx * 4) = o; }
    }
}
__device__ __forceinline__ void ph_outproj_naive(Frame& F, const bf16* A, int K, const bf16* Bt, const float* base) {
    LAS float* sA = (LAS float*)F.lds; LAS float* sB = sA + 128 * 33;
    const int nnb = D / 64, ntiles = (M / 128) * nnb, tx = F.tid & 15, ty = F.tid >> 4;
    for (int t = blockIdx.x; t < ntiles; t += F.G) {
        const int mb = t / nnb, nb = t % nnb; float acc[4][4];
        ngemm_tile(sA, sB, [&](int r) { return A + (size_t)(mb * 128 + r) * K; }, Bt + (size_t)nb * 64 * K, K, K, acc);
#pragma unroll
        for (int i = 0; i < 4; ++i) { const size_t off = (size_t)(mb * 128 + ty * 4 + i) * D + nb * 64 + tx * 4;
            const f32x4 b = *(const f32x4*)(base + off);
            *(f32x4*)(F.out + off) = (f32x4){ALPHA * b.x + acc[i][0], ALPHA * b.y + acc[i][1], ALPHA * b.z + acc[i][2], ALPHA * b.w + acc[i][3]}; }
    }
}

__device__ __forceinline__ void ph_conv_naive(Frame& F) {
    const bf16* P = (const bf16*)(F.ws + WS_P); bf16* QKC = (bf16*)(F.ws + WS_QKC);
    const float* cw = F.in[4]; const float* cb = F.in[5];
    const size_t total = (size_t)M * 1024, nth = (size_t)F.G * NT;
    for (size_t i = (size_t)blockIdx.x * NT + F.tid; i < total; i += nth) {
        const int m = (int)(i >> 10), c = (int)(i & 1023), t = m & (T - 1);
        float a = cb[c];
#pragma unroll
        for (int j = 0; j < 4; ++j) { const int tt = t - 3 + j; if (tt >= 0) a += cw[j * 1024 + c] * bf2f(P[(size_t)(m - 3 + j) * NP0 + c]); }
        QKC[i] = (bf16)f2bf(siluf_(a));
    }
}
__device__ __forceinline__ void ph_recurrent_naive(Frame& F) {
    if (blockIdx.x >= 16) return;
    const int type = blockIdx.x >> 3, b = (blockIdx.x >> 2) & 1, h = blockIdx.x & 3;
    LAS float* sin = (LAS float*)F.lds;
    LAS float* red = sin + 1024;
    LAS float* redd = red + 512;
    LAS float* sc = redd + 4;
    const bf16* P = (const bf16*)(F.ws + WS_P); const bf16* QKC = (const bf16*)(F.ws + WS_QKC); const float* G = (const float*)(F.ws + WS_G);
    bf16* Y = (bf16*)(F.ws + WS_Y);
    const float* gain = (type == 0 ? F.in[6] : F.in[7]) + h * 128;
    const int e = F.tid & 127, dg = F.tid >> 7, which = dg;
    const float gamma = 1.f - exp2f(-5.f - (float)h);
    float C[32], nn[32];
#pragma unroll
    for (int j = 0; j < 32; ++j) { C[j] = 0.f; nn[j] = 0.f; }
    const bf16* src; size_t stride;
    if (type == 0) { if (which < 2) { src = QKC + which * 512 + h * 128 + e; stride = 1024; } else { src = P + 1024 + (which - 2) * 512 + h * 128 + e; stride = NP0; } }
    else { src = P + 2048 + which * 512 + h * 128 + e; stride = NP0; }
    const float mul = (which == 1) ? KSCALE : 1.f;
    const size_t m0 = (size_t)b * T;
    float val = bf2f(src[m0 * stride]) * mul;
    float s0 = 0.f, s1 = 0.f;
    if (F.tid == 0) { if (type == 0) { s0 = __expf(G[m0 * 8 + 4 + h]); s1 = __expf(G[m0 * 8 + h]); } else { s0 = gamma; s1 = 1.f; } }
    for (int t = 0; t < T; ++t) {
        const size_t m = m0 + t; const int pb = t & 1;
        sin[pb * 512 + F.tid] = val;
        if (F.tid == 0) { sc[pb * 2] = s0; sc[pb * 2 + 1] = s1; }
        if (t + 1 < T) { val = bf2f(src[(m + 1) * stride]) * mul;
            if (F.tid == 0 && type == 0) { s0 = __expf(G[(m + 1) * 8 + 4 + h]); s1 = __expf(G[(m + 1) * 8 + h]); } }
        __syncthreads();
        const float f = sc[pb * 2], ig = sc[pb * 2 + 1];
        const LAS float* sq = sin + pb * 512; const LAS float* sk = sq + 128; const LAS float* sv = sq + 256; const LAS float* so = sq + 384;
        const float ve = sv[e] * ig;
        float pn = 0.f, pd = 0.f;
#pragma unroll
        for (int j = 0; j < 32; ++j) { const int d = dg * 32 + j; const float kd = sk[d], qd = sq[d];
            C[j] = fmaf(f, C[j], kd * ve); nn[j] = fmaf(f, nn[j], ig * kd); pn = fmaf(C[j], qd, pn); pd = fmaf(nn[j], qd, pd); }
        red[dg * 128 + e] = pn; if (e == 0) redd[dg] = pd;
        __syncthreads();
        if (F.tid < 64) {
            const int e0 = F.tid, e1 = F.tid + 64;
            float h0 = (red[e0] + red[128 + e0]) + (red[256 + e0] + red[384 + e0]);
            float h1 = (red[e1] + red[128 + e1]) + (red[256 + e1] + red[384 + e1]);
            if (type == 0) { const float den = (redd[0] + redd[1]) + (redd[2] + redd[3]); const float dn = fmaxf(fabsf(den), 1.f);
                h0 = h0 / dn * sigmoidf_(so[e0]); h1 = h1 / dn * sigmoidf_(so[e1]); }
            const float mean = wave_sum(h0 + h1) * (1.f / 128.f); const float d0 = h0 - mean, d1 = h1 - mean;
            const float rstd = 1.f / sqrtf(wave_sum(d0 * d0 + d1 * d1) * (1.f / 128.f) + LN_EPS);
            float y0 = d0 * rstd * gain[e0], y1 = d1 * rstd * gain[e1];
            if (type == 1) { y0 *= siluf_(so[e0]); y1 *= siluf_(so[e1]); }
            Y[m * 1024 + type * 512 + h * 128 + e0] = (bf16)f2bf(y0); Y[m * 1024 + type * 512 + h * 128 + e1] = (bf16)f2bf(y1);
        }
    }
}

constexpr size_t WS_S = WS_SE;
constexpr size_t WS_DN = WS_G + 768 * 1024;
constexpr int CB_GL = 512 * 1024, CB_MSC = 520 * 1024;
constexpr int TRS = 144, RWS = 136;
template <int O0, int O1>
__device__ __forceinline__ void tr2(unsigned a, u32x2& r0, u32x2& r1) {
    asm volatile("ds_read_b64_tr_b16 %0, %2 offset:%3\n\tds_read_b64_tr_b16 %1, %2 offset:%4\n\ts_waitcnt lgkmcnt(0)" : "=&v"(r0), "=&v"(r1) : "v"(a), "i"(O0), "i"(O1) : "memory");
}
template <int B, int H>
__device__ __forceinline__ void tr8(unsigned a, u32x2& r0, u32x2& r1, u32x2& r2, u32x2& r3, u32x2& r4, u32x2& r5, u32x2& r6, u32x2& r7) {
    asm volatile("ds_read_b64_tr_b16 %0, %8 offset:%9\n\tds_read_b64_tr_b16 %1, %8 offset:%10\n\tds_read_b64_tr_b16 %2, %8 offset:%11\n\tds_read_b64_tr_b16 %3, %8 offset:%12\n\t"
                 "ds_read_b64_tr_b16 %4, %8 offset:%13\n\tds_read_b64_tr_b16 %5, %8 offset:%14\n\tds_read_b64_tr_b16 %6, %8 offset:%15\n\tds_read_b64_tr_b16 %7, %8 offset:%16\n\ts_waitcnt lgkmcnt(0)"
                 : "=&v"(r0), "=&v"(r1), "=&v"(r2), "=&v"(r3), "=&v"(r4), "=&v"(r5), "=&v"(r6), "=&v"(r7)
                 : "v"(a), "i"(B), "i"(B + H), "i"(B + 32), "i"(B + 32 + H), "i"(B + 64), "i"(B + 64 + H), "i"(B + 96), "i"(B + 96 + H) : "memory");
}
__device__ __forceinline__ bf16x8_t pack_frag(u32x2 a, u32x2 b) { return __builtin_bit_cast(bf16x8_t, (u32x4){a.x, a.y, b.x, b.y}); }
__device__ __forceinline__ void scan128_sum(float& x0, float& x1, int lane) {
#pragma unroll
    for (int o = 1; o < 64; o <<= 1) { const float t0 = __shfl_up(x0, o), t1 = __shfl_up(x1, o); if (lane >= o) { x0 += t0; x1 += t1; } }
    x1 += __shfl(x0, 63);
}
__device__ __forceinline__ void scan128_max(float& x0, float& x1, int lane) {
#pragma unroll
    for (int o = 1; o < 64; o <<= 1) { const float t0 = __shfl_up(x0, o), t1 = __shfl_up(x1, o); if (lane >= o) { x0 = fmaxf(x0, t0); x1 = fmaxf(x1, t1); } }
    x1 = fmaxf(x1, __shfl(x0, 63));
}
__device__ __forceinline__ float wave_max(float v) {
#pragma unroll
    for (int o = 1; o < 64; o <<= 1) v = fmaxf(v, __shfl_xor(v, o));
    return v;
}
__device__ __forceinline__ void conv8(const bf16* Pc, int row, int tpos0, const LAS float* cwp, float (&o)[8]) {
    { const f32x4 b0 = *(const LAS f32x4*)(cwp + 512), b1 = *(const LAS f32x4*)(cwp + 516); o[0] = b0.x; o[1] = b0.y; o[2] = b0.z; o[3] = b0.w; o[4] = b1.x; o[5] = b1.y; o[6] = b1.z; o[7] = b1.w; }
#pragma unroll
    for (int j = 0; j < 4; ++j) { const int r = row - 3 + j;
        if (tpos0 + r >= 0) { const u32x4 x = *(const u32x4*)(Pc + (long)r * NP0); const f32x4 w0 = *(const LAS f32x4*)(cwp + j * 128), w1 = *(const LAS f32x4*)(cwp + j * 128 + 4);
            o[0] += w0.x * bflo(x.x); o[1] += w0.y * bfhi(x.x); o[2] += w0.z * bflo(x.y); o[3] += w0.w * bfhi(x.y); o[4] += w1.x * bflo(x.z); o[5] += w1.y * bfhi(x.z); o[6] += w1.z * bflo(x.w); o[7] += w1.w * bfhi(x.w); } }
#pragma unroll
    for (int e = 0; e < 8; ++e) o[e] = siluf_(o[e]);
}
__device__ __forceinline__ u32x4 pack8(const float (&o)[8], float sc) {
    u32x4 w; w.x = pg8::cvt_pk_bf16(o[0] * sc, o[1] * sc); w.y = pg8::cvt_pk_bf16(o[2] * sc, o[3] * sc); w.z = pg8::cvt_pk_bf16(o[4] * sc, o[5] * sc); w.w = pg8::cvt_pk_bf16(o[6] * sc, o[7] * sc); return w; }
__device__ __forceinline__ void unpack8(u32x4 x, float (&o)[8]) { o[0] = bflo(x.x); o[1] = bfhi(x.x); o[2] = bflo(x.y); o[3] = bfhi(x.y); o[4] = bflo(x.z); o[5] = bfhi(x.z); o[6] = bflo(x.w); o[7] = bfhi(x.w); }

__device__ __forceinline__ void ph_mix_a(Frame& F) {
    LAS bf16* Vl = (LAS bf16*)F.lds;
    LAS bf16* Kl = Vl + 128 * TRS;
    LAS float* cwl = (LAS float*)(Kl + 128 * TRS);
    LAS float* wl = cwl + 640;
    const bf16* P = (const bf16*)(F.ws + WS_P); const float* G = (const float*)(F.ws + WS_G); bf16* S = (bf16*)(F.ws + WS_S); float* DN = (float*)(F.ws + WS_DN);
    float* GL = (float*)((char*)F.ctl + CB_GL);
    const float* cw = F.in[4]; const float* cb = F.in[5];
    const int tid = F.tid, lane = F.lane, w = F.wave, fr = lane & 15, fq = lane >> 4;
    const unsigned vaddr = (unsigned)(size_t)Vl + (unsigned)(((4 * fq + (fr >> 2)) * TRS + 16 * w + 4 * (fr & 3)) * 2);
    const unsigned kaddr = (unsigned)(size_t)Kl + (unsigned)(((4 * fq + (fr >> 2)) * TRS + 4 * (fr & 3)) * 2);
    for (int u = blockIdx.x; u < 1024; u += F.G) {
        const int type = u >> 9, b = (u >> 8) & 1, h = (u >> 6) & 3, c = u & 63, chain = type * 8 + b * 4 + h;
        const size_t m0 = (size_t)b * T + c * 128;
        const int kcol = (type == 0 ? 512 : 2560) + h * 128, vcol = (type == 0 ? 1024 : 3072) + h * 128;
        __syncthreads();
        if (type == 0) for (int i = tid; i < 640; i += NT) { const int j = i >> 7, d = i & 127; cwl[i] = j < 4 ? cw[j * 1024 + 512 + h * 128 + d] : cb[512 + h * 128 + d]; }
        if (w == 0) {
            float w0, w1;
            if (type == 0) {
                const float i0 = G[(m0 + lane) * 8 + h], i1 = G[(m0 + lane + 64) * 8 + h];
                float b0 = G[(m0 + lane) * 8 + 4 + h], b1 = G[(m0 + lane + 64) * 8 + 4 + h];
                scan128_sum(b0, b1, lane);
                const float g = __shfl(b1, 63), lw0 = g - b0 + i0, lw1 = g - b1 + i1, ml = wave_max(fmaxf(lw0, lw1));
                w0 = __expf(lw0 - ml); w1 = __expf(lw1 - ml);
                if (lane == 0) { GL[(chain * 64 + c) * 2] = g; GL[(chain * 64 + c) * 2 + 1] = ml; }
            } else { const float lg = log1pf(-exp2f(-5.f - (float)h)); w0 = __expf(lg * (float)(127 - lane)); w1 = __expf(lg * (float)(63 - lane)); }
            wl[lane] = w0 * KSCALE; wl[lane + 64] = w1 * KSCALE;
        }
#pragma unroll
        for (int it = 0; it < 4; ++it) { const int s = (tid >> 4) + 32 * it, ch = tid & 15;
            *(LAS u32x4*)(Vl + s * TRS + ch * 8) = *(const u32x4*)(P + (m0 + s) * NP0 + vcol + ch * 8); }
        __syncthreads();
#pragma unroll
        for (int it = 0; it < 4; ++it) { const int s = (tid >> 4) + 32 * it, ch = tid & 15; float o[8];
            if (type == 0) conv8(P + m0 * NP0 + kcol + ch * 8, s, c * 128, cwl + ch * 8, o);
            else unpack8(*(const u32x4*)(P + (m0 + s) * NP0 + kcol + ch * 8), o);
            *(LAS u32x4*)(Kl + s * TRS + ch * 8) = pack8(o, wl[s]); }
        __syncthreads();
        f32x4 acc[8], accn = (f32x4){0.f, 0.f, 0.f, 0.f};
#pragma unroll
        for (int dt = 0; dt < 8; ++dt) acc[dt] = (f32x4){0.f, 0.f, 0.f, 0.f};
        const bf16x8_t ones = (bf16x8_t){0x3F80, 0x3F80, 0x3F80, 0x3F80, 0x3F80, 0x3F80, 0x3F80, 0x3F80};
#pragma unroll
        for (int ks = 0; ks < 4; ++ks) {
            u32x2 a0, a1, n0, n1, b0, b1, b2, b3, b4, b5, b6, b7, c0, c1, c2, c3, c4, c5, c6, c7;
            tr2<0, 16 * TRS * 2>(vaddr + ks * 32 * TRS * 2, a0, a1);
            tr2<0, 16 * TRS * 2>(kaddr + ks * 32 * TRS * 2 + 32 * w, n0, n1);
            tr8<0, 16 * TRS * 2>(kaddr + ks * 32 * TRS * 2, b0, b1, b2, b3, b4, b5, b6, b7);
            tr8<128, 16 * TRS * 2>(kaddr + ks * 32 * TRS * 2, c0, c1, c2, c3, c4, c5, c6, c7);
            __builtin_amdgcn_sched_barrier(0);
            const bf16x8_t A = pack_frag(a0, a1);
            acc[0] = __builtin_amdgcn_mfma_f32_16x16x32_bf16(pack_frag(b0, b1), A, acc[0], 0, 0, 0);
            acc[1] = __builtin_amdgcn_mfma_f32_16x16x32_bf16(pack_frag(b2, b3), A, acc[1], 0, 0, 0);
            acc[2] = __builtin_amdgcn_mfma_f32_16x16x32_bf16(pack_frag(b4, b5), A, acc[2], 0, 0, 0);
            acc[3] = __builtin_amdgcn_mfma_f32_16x16x32_bf16(pack_frag(b6, b7), A, acc[3], 0, 0, 0);
            acc[4] = __builtin_amdgcn_mfma_f32_16x16x32_bf16(pack_frag(c0, c1), A, acc[4], 0, 0, 0);
            acc[5] = __builtin_amdgcn_mfma_f32_16x16x32_bf16(pack_frag(c2, c3), A, acc[5], 0, 0, 0);
            acc[6] = __builtin_amdgcn_mfma_f32_16x16x32_bf16(pack_frag(c4, c5), A, acc[6], 0, 0, 0);
            acc[7] = __builtin_amdgcn_mfma_f32_16x16x32_bf16(pack_frag(c6, c7), A, acc[7], 0, 0, 0);
            accn = __builtin_amdgcn_mfma_f32_16x16x32_bf16(pack_frag(n0, n1), ones, accn, 0, 0, 0);
        }
        bf16* Sp = S + ((size_t)(chain * 64 + c) * 128 + 16 * w + fr) * 128 + 4 * fq;
#pragma unroll
        for (int dt = 0; dt < 8; ++dt) { u32x2 wv; wv.x = pg8::cvt_pk_bf16(acc[dt][0], acc[dt][1]); wv.y = pg8::cvt_pk_bf16(acc[dt][2], acc[dt][3]); *(u32x2*)(Sp + 16 * dt) = wv; }
        if (type == 0 && fr == 0) *(f32x4*)(DN + (size_t)(chain * 64 + c) * 128 + 16 * w + 4 * fq) = accn;
    }
}

__device__ __forceinline__ void ph_mix_b(Frame& F) {
    LAS float* gl = (LAS float*)F.lds; LAS float* dec = gl + 1024; LAS float* scl = dec + 512;
    const float* GL = (const float*)((char*)F.ctl + CB_GL); float* MSC = (float*)((char*)F.ctl + CB_MSC);
    bf16* S = (bf16*)(F.ws + WS_S); float* DN = (float*)(F.ws + WS_DN);
    for (int i = F.tid; i < 1024; i += NT) gl[i] = GL[i];
    __syncthreads();
    if (F.tid < 8) { float m = 0.f;
        for (int c = 0; c < 64; ++c) { const float g = gl[(F.tid * 64 + c) * 2], ml = gl[(F.tid * 64 + c) * 2 + 1];
            if (blockIdx.x == 0) MSC[F.tid * 64 + c] = m;
            const float mn = fmaxf(g + m, ml); dec[F.tid * 64 + c] = __expf(g + m - mn); scl[F.tid * 64 + c] = __expf(ml - mn); m = mn; } }
    __syncthreads();
    for (int j = blockIdx.x * NT + F.tid; j < 131072; j += F.G * NT) {
        const int chain = j >> 13, el = j & 8191;
        unsigned* p = (unsigned*)S + (size_t)chain * 64 * 8192 + el;
        const bool ml = chain < 8;
        const float g128 = __expf(128.f * log1pf(-exp2f(-5.f - (float)(chain & 3))));
        float C0 = 0.f, C1 = 0.f;
        for (int c0 = 0; c0 < 64; c0 += 16) { unsigned x[16];
#pragma unroll
            for (int k = 0; k < 16; ++k) x[k] = p[(size_t)(c0 + k) * 8192];
#pragma unroll
            for (int k = 0; k < 16; ++k) { p[(size_t)(c0 + k) * 8192] = pg8::cvt_pk_bf16(C0, C1);
                const float dk = ml ? dec[(chain & 7) * 64 + c0 + k] : g128, sk = ml ? scl[(chain & 7) * 64 + c0 + k] : 1.f;
                C0 = dk * C0 + sk * bflo(x[k]); C1 = dk * C1 + sk * bfhi(x[k]); } }
    }
    for (int j = blockIdx.x * NT + F.tid; j < 1024; j += F.G * NT) { const int chain = j >> 7, d = j & 127; float* p = DN + (size_t)chain * 64 * 128 + d; float n = 0.f;
        for (int c = 0; c < 64; ++c) { const float x = p[c * 128]; p[c * 128] = n; n = dec[chain * 64 + c] * n + scl[chain * 64 + c] * x; } }
}

__device__ __forceinline__ void ph_mix_c(Frame& F) {
    LAS bf16* Kl = (LAS bf16*)F.lds;
    LAS bf16* Vl = Kl + 128 * RWS;
    LAS bf16* Cl = Vl + 128 * TRS;
    LAS float* cwl = (LAS float*)(Cl + 144 * RWS);
    LAS float* ul = cwl + 1280; LAS float* Ml = ul + 128; LAS float* bl = Ml + 128;
    const bf16* P = (const bf16*)(F.ws + WS_P); const float* G = (const float*)(F.ws + WS_G); const bf16* S = (const bf16*)(F.ws + WS_S); const float* DN = (const float*)(F.ws + WS_DN);
    const float* MSC = (const float*)((char*)F.ctl + CB_MSC); bf16* Y = (bf16*)(F.ws + WS_Y);
    const float* cw = F.in[4]; const float* cb = F.in[5];
    const int tid = F.tid, lane = F.lane, w = F.wave, fr = lane & 15, fq = lane >> 4;
    const int lt = w < 4 ? w : 11 - w, l = 16 * lt + fr;
    const unsigned vaddr = (unsigned)(size_t)Vl + (unsigned)(((4 * fq + (fr >> 2)) * TRS + 4 * (fr & 3)) * 2);
    for (int u = blockIdx.x; u < 1024; u += F.G) {
        const int type = u >> 9, b = (u >> 8) & 1, h = (u >> 6) & 3, c = u & 63, chain = type * 8 + b * 4 + h;
        const size_t m0 = (size_t)b * T + c * 128;
        const int base = type == 0 ? 0 : 2048, qcol = base + h * 128, kcol = base + 512 + h * 128, vcol = base + 1024 + h * 128, gcol = base + 1536 + h * 128;
        const float lg = log1pf(-exp2f(-5.f - (float)h));
        __syncthreads();
        if (type == 0) for (int i = tid; i < 1280; i += NT) { const int part = i / 640, r = i % 640, j = r >> 7, d = r & 127, col = part * 512 + h * 128 + d; cwl[i] = j < 4 ? cw[j * 1024 + col] : cb[col]; }
        float mc = 0.f;
        if (type == 0) {
            mc = MSC[(b * 4 + h) * 64 + c];
            if (w == 0) {
                const float i0 = G[(m0 + lane) * 8 + h], i1 = G[(m0 + lane + 64) * 8 + h];
                float b0 = G[(m0 + lane) * 8 + 4 + h], b1 = G[(m0 + lane + 64) * 8 + 4 + h];
                scan128_sum(b0, b1, lane);
                const float u0 = i0 - b0, u1 = i1 - b1; float p0 = u0, p1 = u1; scan128_max(p0, p1, lane);
                ul[lane] = u0; ul[lane + 64] = u1; Ml[lane] = fmaxf(mc, p0); Ml[lane + 64] = fmaxf(mc, p1); bl[lane] = b0; bl[lane + 64] = b1;
            }
        }
#pragma unroll
        for (int it = 0; it < 4; ++it) { const int s = (tid >> 4) + 32 * it, ch = tid & 15;
            *(LAS u32x4*)(Vl + s * TRS + ch * 8) = *(const u32x4*)(P + (m0 + s) * NP0 + vcol + ch * 8);
            *(LAS u32x4*)(Cl + s * RWS + ch * 8) = *(const u32x4*)(S + ((size_t)(chain * 64 + c) * 128 + s) * 128 + ch * 8); }
        if (tid < 256) { const int r = tid >> 4, ch = tid & 15; u32x4 wv = (u32x4){0u, 0u, 0u, 0u};
            if (type == 0 && r == 0) { const float* np = DN + (size_t)((b * 4 + h) * 64 + c) * 128 + ch * 8; const f32x4 x0 = *(const f32x4*)np, x1 = *(const f32x4*)(np + 4);
                wv.x = pg8::cvt_pk_bf16(x0.x, x0.y); wv.y = pg8::cvt_pk_bf16(x0.z, x0.w); wv.z = pg8::cvt_pk_bf16(x1.x, x1.y); wv.w = pg8::cvt_pk_bf16(x1.z, x1.w); }
            *(LAS u32x4*)(Cl + (128 + r) * RWS + ch * 8) = wv; }
        __syncthreads();
#pragma unroll
        for (int it = 0; it < 4; ++it) { const int s = (tid >> 4) + 32 * it, ch = tid & 15; float o[8];
            if (type == 0) conv8(P + m0 * NP0 + kcol + ch * 8, s, c * 128, cwl + 640 + ch * 8, o);
            else unpack8(*(const u32x4*)(P + (m0 + s) * NP0 + kcol + ch * 8), o);
            *(LAS u32x4*)(Kl + s * RWS + ch * 8) = pack8(o, KSCALE); }
        bf16x8_t qf[4];
#pragma unroll
        for (int ks = 0; ks < 4; ++ks) { const int d0 = 32 * ks + 8 * fq;
            if (type == 0) { float o[8]; conv8(P + m0 * NP0 + qcol + d0, l, c * 128, cwl + d0, o); qf[ks] = __builtin_bit_cast(bf16x8_t, pack8(o, 1.f)); }
            else qf[ks] = *(const bf16x8_t*)(P + (m0 + l) * NP0 + qcol + d0); }
        __syncthreads();
        f32x4 st[8];
#pragma unroll
        for (int t = 0; t < 8; ++t) { st[t] = (f32x4){0.f, 0.f, 0.f, 0.f};
            if (t <= lt) {
#pragma unroll
                for (int ks = 0; ks < 4; ++ks) st[t] = __builtin_amdgcn_mfma_f32_16x16x32_bf16(*(const LAS bf16x8_t*)(Kl + (16 * t + fr) * RWS + 32 * ks + 8 * fq), qf[ks], st[t], 0, 0, 0); }
            if (t & 1) __builtin_amdgcn_sched_barrier(0); }
        int lz = l, fz = 4 * fq; asm volatile("" : "+v"(lz), "+v"(fz));
        const float Mme = (type == 0) ? Ml[lz] : 0.f;
        float den = 0.f;
#pragma unroll
        for (int t = 0; t < 8; ++t) if (t <= lt) {
#pragma unroll
            for (int rg = 0; rg < 4; ++rg) { const int s = 16 * t + fz + rg;
                float e = (type == 0) ? (ul[s] - Mme) : (lg * (float)(lz - s)); e = (s <= lz) ? e : -1e30f;
                const float p = st[t][rg] * __expf(e); st[t][rg] = p; den += p; } }
        den += __shfl_xor(den, 16); den += __shfl_xor(den, 32);
        f32x4 o1[8], o2[9];
#pragma unroll
        for (int et = 0; et < 8; ++et) o1[et] = (f32x4){0.f, 0.f, 0.f, 0.f};
#pragma unroll
        for (int et = 0; et < 9; ++et) o2[et] = (f32x4){0.f, 0.f, 0.f, 0.f};
#pragma unroll
        for (int j = 0; j < 4; ++j) if (2 * j <= lt) {
            u32x4 pw; pw.x = pg8::cvt_pk_bf16(st[2 * j][0], st[2 * j][1]); pw.y = pg8::cvt_pk_bf16(st[2 * j][2], st[2 * j][3]);
            pw.z = pg8::cvt_pk_bf16(st[2 * j + 1][0], st[2 * j + 1][1]); pw.w = pg8::cvt_pk_bf16(st[2 * j + 1][2], st[2 * j + 1][3]);
            const bf16x8_t pf = __builtin_bit_cast(bf16x8_t, pw);
            u32x2 b0, b1, b2, b3, b4, b5, b6, b7, c0, c1, c2, c3, c4, c5, c6, c7;
            tr8<0, 16 * TRS * 2>(vaddr + j * 32 * TRS * 2, b0, b1, b2, b3, b4, b5, b6, b7);
            tr8<128, 16 * TRS * 2>(vaddr + j * 32 * TRS * 2, c0, c1, c2, c3, c4, c5, c6, c7);
            __builtin_amdgcn_sched_barrier(0);
            o1[0] = __builtin_amdgcn_mfma_f32_16x16x32_bf16(pack_frag(b0, b1), pf, o1[0], 0, 0, 0);
            o1[1] = __builtin_amdgcn_mfma_f32_16x16x32_bf16(pack_frag(b2, b3), pf, o1[1], 0, 0, 0);
            o1[2] = __builtin_amdgcn_mfma_f32_16x16x32_bf16(pack_frag(b4, b5), pf, o1[2], 0, 0, 0);
            o1[3] = __builtin_amdgcn_mfma_f32_16x16x32_bf16(pack_frag(b6, b7), pf, o1[3], 0, 0, 0);
            o1[4] = __builtin_amdgcn_mfma_f32_16x16x32_bf16(pack_frag(c0, c1), pf, o1[4], 0, 0, 0);
            o1[5] = __builtin_amdgcn_mfma_f32_16x16x32_bf16(pack_frag(c2, c3), pf, o1[5], 0, 0, 0);
            o1[6] = __builtin_amdgcn_mfma_f32_16x16x32_bf16(pack_frag(c4, c5), pf, o1[6], 0, 0, 0);
            o1[7] = __builtin_amdgcn_mfma_f32_16x16x32_bf16(pack_frag(c6, c7), pf, o1[7], 0, 0, 0);
        }
        __builtin_amdgcn_sched_barrier(0);
#pragma unroll
        for (int ks = 0; ks < 4; ++ks) {
#pragma unroll
            for (int et = 0; et < 9; ++et) o2[et] = __builtin_amdgcn_mfma_f32_16x16x32_bf16(*(const LAS bf16x8_t*)(Cl + (16 * et + fr) * RWS + 32 * ks + 8 * fq), qf[ks], o2[et], 0, 0, 0);
            __builtin_amdgcn_sched_barrier(0); }
        float inter, rden = 1.f;
        if (type == 0) { inter = __expf(mc - Mme); const float qn = __shfl(o2[8][0], fr); const float dtot = den + inter * qn; rden = 1.f / fmaxf(fabsf(dtot), __expf(-(bl[l] + Mme))); }
        else inter = __expf(lg * (float)(l + 1));
        const bf16* gp = P + (m0 + l) * NP0 + gcol + 4 * fq;
        float sum = 0.f;
#pragma unroll
        for (int et = 0; et < 8; ++et) { const u32x2 gw = *(const u32x2*)(gp + 16 * et); const float g0 = bflo(gw.x), g1 = bfhi(gw.x), g2 = bflo(gw.y), g3 = bfhi(gw.y);
            f32x4 hv = (o1[et] + o2[et] * inter) * rden;
            if (type == 0) { hv[0] *= sigmoidf_(g0); hv[1] *= sigmoidf_(g1); hv[2] *= sigmoidf_(g2); hv[3] *= sigmoidf_(g3); o2[et] = (f32x4){1.f, 1.f, 1.f, 1.f}; }
            else o2[et] = (f32x4){siluf_(g0), siluf_(g1), siluf_(g2), siluf_(g3)};
            o1[et] = hv; sum += (hv[0] + hv[1]) + (hv[2] + hv[3]); if (et & 1) asm volatile("" ::: "memory"); }
        sum += __shfl_xor(sum, 16); sum += __shfl_xor(sum, 32);
        const float mean = sum * (1.f / 128.f); float sq = 0.f;
#pragma unroll
        for (int et = 0; et < 8; ++et) { o1[et] = o1[et] - mean; sq += (o1[et][0] * o1[et][0] + o1[et][1] * o1[et][1]) + (o1[et][2] * o1[et][2] + o1[et][3] * o1[et][3]); }
        sq += __shfl_xor(sq, 16); sq += __shfl_xor(sq, 32);
        const float rstd = 1.f / sqrtf(sq * (1.f / 128.f) + LN_EPS);
        const float* g6 = F.in[6]; const float* g7 = F.in[7]; asm volatile("" : "+s"(g6), "+s"(g7));
        const float* gain = (type == 0 ? g6 : g7) + h * 128 + 4 * fq;
        bf16* yp = Y + (m0 + l) * 1024 + type * 512 + h * 128 + 4 * fq;
#pragma unroll
        for (int et = 0; et < 8; ++et) { const f32x4 gn = *(const f32x4*)(gain + 16 * et); const f32x4 yv = o1[et] * rstd * gn * o2[et];
            u32x2 wv; wv.x = pg8::cvt_pk_bf16(yv[0], yv[1]); wv.y = pg8::cvt_pk_bf16(yv[2], yv[3]); *(u32x2*)(yp + 16 * et) = wv; if (et & 1) asm volatile("" ::: "memory"); }
    }
}

constexpr int RWT = 1028;
template <int MODE, bool ROUTE, int OUTK>
__device__ __forceinline__ void ph_ln(Frame& F, int layer, bool dry = false) {
    LAS float* rwT = (LAS float*)F.lds;
    LAS int* rsel = (LAS int*)(rwT + 32 * RWT);
    int nrow = 0;
    if (ROUTE) { const float* rw = F.in[11]; for (int i = F.tid; i < 32 * 1024; i += NT) { const int k = i >> 5, e = i & 31; rwT[e * RWT + k] = rw[i]; } __syncthreads(); }
    const int gwv = F.vcu * NWAVES + F.wave, NGW = F.G * NWAVES;
    const float* lg = F.in[16] + (size_t)(layer * 2 + MODE) * D; const float* lb = F.in[17] + (size_t)(layer * 2 + MODE) * D;
    bf16* XB = (bf16*)(F.ws + WS_XB); const bf16* YB = (const bf16*)(F.ws + WS_YB); const bf16* PRE = (const bf16*)((const char*)F.out + 32 * MiB); bf16* RES = (bf16*)F.out;
    int* EIDX = (int*)(F.ws + WS_EIDX); float* GATEV = (float*)(F.ws + WS_GATEV); int* LIST = (int*)(F.ws + WS_LIST);
    unsigned* cnt = F.ctl + CW_CNT + layer * 32 * 64;
    const float* rbias = F.in[12];
    f32x4 gv[4], bv[4];
#pragma unroll
    for (int j = 0; j < 4; ++j) { gv[j] = *((const f32x4*)lg + F.lane + 64 * j); bv[j] = *((const f32x4*)lb + F.lane + 64 * j); }
    u32x2 rx[4], ry0[4], ry1[4]; float rg0 = 0.f, rg1 = 0.f;
#define LN_LOAD(mm) do { if (MODE == 0) { const u32x2* pr = (const u32x2*)(PRE + (size_t)(mm) * D) + F.lane; _Pragma("unroll") for (int j = 0; j < 4; ++j) rx[j] = pr[64 * j]; } \
        else { rg0 = GATEV[2 * (mm)]; rg1 = GATEV[2 * (mm) + 1]; const u32x2* xr = (const u32x2*)(XB + (size_t)(mm) * D) + F.lane; \
            const u32x2* y0 = (const u32x2*)(YB + (size_t)(2 * (mm)) * D) + F.lane; const u32x2* y1 = (const u32x2*)(YB + (size_t)(2 * (mm) + 1) * D) + F.lane; \
            _Pragma("unroll") for (int j = 0; j < 4; ++j) { rx[j] = xr[64 * j]; ry0[j] = y0[64 * j]; ry1[j] = y1[64 * j]; } } } while (0)
    if (gwv < M) LN_LOAD(gwv);
    for (int m = gwv; m < M; m += NGW) {
        f32x4 v[4]; float s = 0.f;
        if (MODE == 0) {
#pragma unroll
            for (int j = 0; j < 4; ++j) { const u32x2 a = rx[j]; v[j] = (f32x4){bflo(a.x), bfhi(a.x), bflo(a.y), bfhi(a.y)}; } }
        else {
            const float g0 = rg0, g1 = rg1;
#pragma unroll
            for (int j = 0; j < 4; ++j) { const u32x2 x = rx[j], a = ry0[j], b = ry1[j];
                v[j].x = ALPHA * bflo(x.x) + g0 * bflo(a.x) + g1 * bflo(b.x); v[j].y = ALPHA * bfhi(x.x) + g0 * bfhi(a.x) + g1 * bfhi(b.x);
                v[j].z = ALPHA * bflo(x.y) + g0 * bflo(a.y) + g1 * bflo(b.y); v[j].w = ALPHA * bfhi(x.y) + g0 * bfhi(a.y) + g1 * bfhi(b.y); }
        }
        if (m + NGW < M) LN_LOAD(m + NGW);
#pragma unroll
        for (int j = 0; j < 4; ++j) s += (v[j].x + v[j].y) + (v[j].z + v[j].w);
        const float mean = wave_sum(s) * (1.f / D); float s2 = 0.f;
#pragma unroll
        for (int j = 0; j < 4; ++j) { v[j] = v[j] - mean; s2 += (v[j].x * v[j].x + v[j].y * v[j].y) + (v[j].z * v[j].z + v[j].w * v[j].w); }
        const float rstd = 1.f / sqrtf(wave_sum(s2) * (1.f / D) + LN_EPS);
#pragma unroll
        for (int j = 0; j < 4; ++j) v[j] = v[j] * rstd * gv[j] + bv[j];
        if (OUTK == 2) { f32x4* orow = (f32x4*)(F.out + (size_t)m * D) + F.lane;
#pragma unroll
            for (int j = 0; j < 4; ++j) orow[64 * j] = v[j]; }
        else { u32x2* o8 = (u32x2*)((OUTK == 0 ? XB : RES) + (size_t)m * D) + F.lane;
#pragma unroll
            for (int j = 0; j < 4; ++j) { u32x2 w; w.x = pg8::cvt_pk_bf16(v[j].x, v[j].y); w.y = pg8::cvt_pk_bf16(v[j].z, v[j].w); o8[64 * j] = w; } }
        if (ROUTE) {
            float pv[32];
#pragma unroll
            for (int e = 0; e < 32; ++e) { float a = 0.f;
#pragma unroll
                for (int j = 0; j < 4; ++j) { const f32x4 w = *(const LAS f32x4*)(rwT + e * RWT + 4 * F.lane + 256 * j); a += v[j].x * w.x + v[j].y * w.y + v[j].z * w.z + v[j].w * w.w; }
                pv[e] = a; if ((e & 7) == 7) __builtin_amdgcn_sched_barrier(0); }
#define LN_HALVE(N, MASK) { const bool up = (F.lane & (MASK)) != 0; _Pragma("unroll") for (int j = 0; j < (N); ++j) { const float keep = up ? pv[(N) + j] : pv[j], send = up ? pv[j] : pv[(N) + j]; pv[j] = keep + __shfl_xor(send, (MASK)); } }
            LN_HALVE(16, 32) LN_HALVE(8, 16) LN_HALVE(4, 8) LN_HALVE(2, 4) LN_HALVE(1, 2)
#undef LN_HALVE
            const float mylog = pv[0] + __shfl_xor(pv[0], 1);
            const int mye = F.lane >> 1;
            const float myaff = 1.f / (1.f + expf(-mylog)), mysel = myaff + rbias[mye];
            float m1 = -1e30f, m2 = -1e30f; int i1 = 0, i2 = 0; float a1 = 0.f, a2 = 0.f;
            const int lbase = F.lane & 48, ebase = (F.lane >> 4) * 8;
#pragma unroll
            for (int j = 0; j < 8; ++j) { const float sv = __shfl(mysel, lbase + 2 * j), av = __shfl(myaff, lbase + 2 * j);
                if (sv > m1) { m2 = m1; i2 = i1; a2 = a1; m1 = sv; i1 = ebase + j; a1 = av; }
                else if (sv > m2) { m2 = sv; i2 = ebase + j; a2 = av; } }
            const float score = m1 + m2;
            float bestscore = -1e30f; int bg = 0;
#pragma unroll
            for (int g = 0; g < 4; ++g) { const float sg = __shfl(score, 16 * g); if (sg > bestscore) { bestscore = sg; bg = g; } }
            const int bi0 = __shfl(i1, 16 * bg), bi1 = __shfl(i2, 16 * bg); const float ba0 = __shfl(a1, 16 * bg), ba1 = __shfl(a2, 16 * bg);
            if (F.lane == 0) {
                const float inv = 1.f / (ba0 + ba1);
                EIDX[2 * m] = bi0; EIDX[2 * m + 1] = bi1; GATEV[2 * m] = ba0 * inv; GATEV[2 * m + 1] = ba1 * inv;
                if (dry) {} else if (nrow < 16) { rsel[(F.wave * 16 + nrow) * 2] = (bi0 << 24) | (2 * m); rsel[(F.wave * 16 + nrow) * 2 + 1] = (bi1 << 24) | (2 * m + 1); }
                else {
                    const unsigned p0 = __hip_atomic_fetch_add(cnt + bi0 * 64, 1u, RLX_AGENT); LIST[bi0 * M + p0] = 2 * m;
                    const unsigned p1 = __hip_atomic_fetch_add(cnt + bi1 * 64, 1u, RLX_AGENT); LIST[bi1 * M + p1] = 2 * m + 1; }
            }
            ++nrow;
        }
    }
    if (ROUTE && !dry) {
        if (F.lane == 0) rsel[256 + 32 + F.wave] = nrow < 16 ? nrow : 16;
        if (F.tid < 32) rsel[256 + F.tid] = 0;
        __syncthreads();
        const int wv = F.tid >> 5, k = (F.tid >> 1) & 15;
        const bool have = F.tid < 256 && k < rsel[256 + 32 + (wv & 7)];
        int ent = 0, lp = 0;
        if (have) { ent = rsel[(wv * 16 + k) * 2 + (F.tid & 1)]; lp = __hip_atomic_fetch_add(&rsel[256 + (ent >> 24)], 1, __ATOMIC_RELAXED, __HIP_MEMORY_SCOPE_WORKGROUP); }
        __syncthreads();
        if (F.tid < 32) { const int c = rsel[256 + F.tid]; rsel[256 + F.tid] = c > 0 ? (int)__hip_atomic_fetch_add(cnt + F.tid * 64, (unsigned)c, RLX_AGENT) : 0; }
        __syncthreads();
        if (have) { const int e = ent >> 24; LIST[e * M + rsel[256 + e] + lp] = ent & 0xffffff; }
    }
}

#undef LN_LOAD
struct ExpertMap { int cnt[32]; };
__device__ __forceinline__ int moe_find(Frame& F, int layer, int unit_rows, int per_row_tiles, int t, int& e_out, int& mb_out, int& nb_out, int& hb_out, int& cnt_out) {
    const unsigned* cnt = F.ctl + CW_CNT + layer * 32 * 64;
    int base = 0, hb = 0;
    for (int e = 0; e < 32; ++e) {
        const int c = (int)cnt[e * 64]; const int nmb = (c + unit_rows - 1) / unit_rows; const int nt = nmb * per_row_tiles;
        if (t < base + nt) { const int r = t - base; e_out = e; mb_out = r / per_row_tiles; nb_out = r % per_row_tiles; hb_out = hb; cnt_out = c; return 1; }
        base += nt; hb += ((c + 255) >> 8) << 8;
    }
    return 0;
}
__device__ __forceinline__ void ph_moe1_naive(Frame& F, int layer) {
    LAS float* sA = (LAS float*)F.lds; LAS float* sB = sA + 128 * 33;
    const bf16* XB = (const bf16*)(F.ws + WS_XB); bf16* HID = (bf16*)(F.ws + WS_HID); const int* LIST = (const int*)(F.ws + WS_LIST);
    const int tx = F.tid & 15, ty = F.tid >> 4;
    for (int t = blockIdx.x;; t += F.G) {
        int e, mb, nb, hb, c; if (!moe_find(F, layer, 128, 4, t, e, mb, nb, hb, c)) break;
        const bf16* GU = (const bf16*)(F.ws + WS_EW + (size_t)e * EW_STRIDE);
        const int j0 = nb * 64, rg = (j0 >> 7) * 256 + (j0 & 127);
        auto rowA = [&](int r) -> const bf16* { const int i = mb * 128 + r; return i < c ? XB + (size_t)(LIST[e * M + i] >> 1) * D : (const bf16*)nullptr; };
        float ag[4][4], au[4][4];
        ngemm_tile(sA, sB, rowA, GU + (size_t)rg * D, D, D, ag);
        ngemm_tile(sA, sB, rowA, GU + (size_t)(rg + 128) * D, D, D, au);
#pragma unroll
        for (int i = 0; i < 4; ++i) { const int ri = mb * 128 + ty * 4 + i;
            if (ri < c) { u32x2 o; o.x = pk2(siluf_(ag[i][0]) * au[i][0], siluf_(ag[i][1]) * au[i][1]); o.y = pk2(siluf_(ag[i][2]) * au[i][2], siluf_(ag[i][3]) * au[i][3]);
                *(u32x2*)(HID + (size_t)(hb + ri) * DE + j0 + tx * 4) = o; } }
    }
}
__device__ __forceinline__ void ph_moe2_naive(Frame& F, int layer) {
    LAS float* sA = (LAS float*)F.lds; LAS float* sB = sA + 128 * 33;
    const bf16* HID = (const bf16*)(F.ws + WS_HID); bf16* YB = (bf16*)(F.ws + WS_YB); const int* LIST = (const int*)(F.ws + WS_LIST);
    const int tx = F.tid & 15, ty = F.tid >> 4;
    for (int t = blockIdx.x;; t += F.G) {
        int e, mb, nb, hb, c; if (!moe_find(F, layer, 128, 16, t, e, mb, nb, hb, c)) break;
        const bf16* DN = (const bf16*)(F.ws + WS_EW + (size_t)e * EW_STRIDE + EW_DN);
        auto rowA = [&](int r) -> const bf16* { const int i = mb * 128 + r; return i < c ? HID + (size_t)(hb + i) * DE : (const bf16*)nullptr; };
        float acc[4][4];
        ngemm_tile(sA, sB, rowA, DN + (size_t)(nb * 64) * DE, DE, DE, acc);
#pragma unroll
        for (int i = 0; i < 4; ++i) { const int ri = mb * 128 + ty * 4 + i;
            if (ri < c) { const int a = LIST[e * M + ri]; u32x2 o; o.x = pk2(acc[i][0], acc[i][1]); o.y = pk2(acc[i][2], acc[i][3]);
                *(u32x2*)(YB + (size_t)a * D + nb * 64 + tx * 4) = o; } }
    }
}

__device__ __forceinline__ void ph_attn_naive(Frame& F) {
    const bf16* P = (const bf16*)(F.ws + WS_P); bf16* OG = (bf16*)(F.ws + WS_OG); float* LSE = (float*)(F.ws + WS_LSE);
    const int total = 3 * M * 8, nth = F.G * NT;
    for (int idx = blockIdx.x * NT + F.tid; idx < total; idx += nth) {
        const int h = idx & 7, m = (idx >> 3) & (M - 1), g = idx >> 17;
        const int t = m & (T - 1), dil = (g == 0) ? 1 : (g == 1 ? 4 : 16);
        const float slope = exp2f(-(float)(h + 1));
        const bf16* qp = P + (size_t)m * IN1 + g * 1536 + h * 64;
        float q[64], o[64];
#pragma unroll
        for (int c = 0; c < 8; ++c) { const u32x4 w = *(const u32x4*)(qp + 8 * c);
            q[8 * c + 0] = bflo(w.x); q[8 * c + 1] = bfhi(w.x); q[8 * c + 2] = bflo(w.y); q[8 * c + 3] = bfhi(w.y); q[8 * c + 4] = bflo(w.z); q[8 * c + 5] = bfhi(w.z); q[8 * c + 6] = bflo(w.w); q[8 * c + 7] = bfhi(w.w); }
#pragma unroll
        for (int d = 0; d < 64; ++d) o[d] = 0.f;
        float mx = -1e30f, den = 0.f;
        for (int j = 0; j <= 128; ++j) {
            const int tk = t - j * dil; if (tk < 0) break;
            const bf16* kp = P + (size_t)(m - j * dil) * IN1 + g * 1536 + 512 + h * 64; const bf16* vp = kp + 512;
            float s = 0.f;
#pragma unroll
            for (int c = 0; c < 8; ++c) { const u32x4 w = *(const u32x4*)(kp + 8 * c);
                s += q[8 * c + 0] * bflo(w.x) + q[8 * c + 1] * bfhi(w.x) + q[8 * c + 2] * bflo(w.y) + q[8 * c + 3] * bfhi(w.y) + q[8 * c + 4] * bflo(w.z) + q[8 * c + 5] * bfhi(w.z) + q[8 * c + 6] * bflo(w.w) + q[8 * c + 7] * bfhi(w.w); }
            s = s * 0.125f - slope * (float)(j * dil);
            const float mn = fmaxf(mx, s), corr = __expf(mx - mn), p = __expf(s - mn);
            den = den * corr + p; mx = mn;
#pragma unroll
            for (int c = 0; c < 8; ++c) { const u32x4 w = *(const u32x4*)(vp + 8 * c);
                o[8 * c + 0] = o[8 * c + 0] * corr + p * bflo(w.x); o[8 * c + 1] = o[8 * c + 1] * corr + p * bfhi(w.x); o[8 * c + 2] = o[8 * c + 2] * corr + p * bflo(w.y); o[8 * c + 3] = o[8 * c + 3] * corr + p * bfhi(w.y);
                o[8 * c + 4] = o[8 * c + 4] * corr + p * bflo(w.z); o[8 * c + 5] = o[8 * c + 5] * corr + p * bfhi(w.z); o[8 * c + 6] = o[8 * c + 6] * corr + p * bflo(w.w); o[8 * c + 7] = o[8 * c + 7] * corr + p * bfhi(w.w); }
        }
        const float inv = 1.f / den;
        bf16* op = OG + ((size_t)g * M + m) * 512 + h * 64;
#pragma unroll
        for (int c = 0; c < 8; ++c) { u32x4 w; w.x = pk2(o[8 * c + 0] * inv, o[8 * c + 1] * inv); w.y = pk2(o[8 * c + 2] * inv, o[8 * c + 3] * inv); w.z = pk2(o[8 * c + 4] * inv, o[8 * c + 5] * inv); w.w = pk2(o[8 * c + 6] * inv, o[8 * c + 7] * inv);
            *(u32x4*)(op + 8 * c) = w; }
        LSE[((size_t)g * M + m) * 8 + h] = mx + __logf(den);
    }
}
__device__ __forceinline__ void ph_attn_mfma(Frame& F) {
    const bf16* P = (const bf16*)(F.ws + WS_P); bf16* OG = (bf16*)(F.ws + WS_OG); float* LSE = (float*)(F.ws + WS_LSE);
    LAS bf16* Vl = (LAS bf16*)F.lds;
    const int tid = F.tid, lane = F.lane, w = F.wave, fr = lane & 15, fq = lane >> 4;
    const int ct0 = 2 * (w >> 1);
    const unsigned vaddr0 = (unsigned)(size_t)(F.lds) + (unsigned)(((16 * ct0 + 4 * fq + (fr >> 2)) * 72 + 4 * (fr & 3)) * 2);
    for (int u = blockIdx.x; u < 3072; u += F.G) {
        const int g = u >> 10, rem = u & 1023, b = rem >> 9, h = (rem >> 6) & 7, x = rem & 63;
        const int dil = (g == 0) ? 1 : (g == 1 ? 4 : 16), nnb = 64 / dil, nb = x % nnb, r = x / nnb;
        const long rowbase = (long)b * T + (long)nb * 128 * dil + r;
        const bf16* Qp = P + g * 1536 + h * 64; const bf16* Kp = Qp + 512; const bf16* Vp = Qp + 1024;
        const float sl = exp2f(-(float)(h + 1)) * (float)dil;
        __syncthreads();
#pragma unroll
        for (int it = 0; it < 4; ++it) { const int kr = (tid >> 3) + 64 * it, ch = tid & 7; u32x4 v = (u32x4){0u, 0u, 0u, 0u};
            if (nb > 0 || kr >= 128) v = *(const u32x4*)(Vp + (size_t)(rowbase + (long)(kr - 128) * dil) * IN1 + ch * 8);
            *(LAS u32x4*)(Vl + kr * 72 + ch * 8) = v; }
        bf16x8_t qf[2];
        { const bf16* qrow = Qp + (size_t)(rowbase + (long)(16 * w + fr) * dil) * IN1 + 8 * fq; qf[0] = *(const bf16x8_t*)qrow; qf[1] = *(const bf16x8_t*)(qrow + 32); }
        f32x4 s[10];
#pragma unroll
        for (int c = 0; c < 10; ++c) { const int kr = 16 * (ct0 + c) + fr; bf16x8_t k0 = (bf16x8_t){0, 0, 0, 0, 0, 0, 0, 0}, k1 = k0;
            if (nb > 0 || kr >= 128) { const bf16* krow = Kp + (size_t)(rowbase + (long)(kr - 128) * dil) * IN1 + 8 * fq; k0 = *(const bf16x8_t*)krow; k1 = *(const bf16x8_t*)(krow + 32); }
            s[c] = __builtin_amdgcn_mfma_f32_16x16x32_bf16(k0, qf[0], (f32x4){0.f, 0.f, 0.f, 0.f}, 0, 0, 0);
            s[c] = __builtin_amdgcn_mfma_f32_16x16x32_bf16(k1, qf[1], s[c], 0, 0, 0); }
        const int l = 16 * w + fr;
        float mx = -1e30f;
#pragma unroll
        for (int c = 0; c < 10; ++c)
#pragma unroll
            for (int rg = 0; rg < 4; ++rg) { const int kr = 16 * (ct0 + c) + 4 * fq + rg, steps = l + 128 - kr;
                const bool ok = steps >= 0 && steps <= 128 && (nb > 0 || kr >= 128);
                const float v = ok ? s[c][rg] * 0.125f - sl * (float)steps : -1e30f; s[c][rg] = v; mx = fmaxf(mx, v); }
        mx = fmaxf(mx, __shfl_xor(mx, 16)); mx = fmaxf(mx, __shfl_xor(mx, 32));
        float den = 0.f;
#pragma unroll
        for (int c = 0; c < 10; ++c)
#pragma unroll
            for (int rg = 0; rg < 4; ++rg) { const float p = (s[c][rg] > -1e29f) ? __expf(s[c][rg] - mx) : 0.f; s[c][rg] = p; den += p; }
        den += __shfl_xor(den, 16); den += __shfl_xor(den, 32);
        bf16x8_t pf[5];
#pragma unroll
        for (int k = 0; k < 5; ++k) { u32x4 wv; wv.x = pg8::cvt_pk_bf16(s[2 * k][0], s[2 * k][1]); wv.y = pg8::cvt_pk_bf16(s[2 * k][2], s[2 * k][3]);
            wv.z = pg8::cvt_pk_bf16(s[2 * k + 1][0], s[2 * k + 1][1]); wv.w = pg8::cvt_pk_bf16(s[2 * k + 1][2], s[2 * k + 1][3]); pf[k] = __builtin_bit_cast(bf16x8_t, wv); }
        __syncthreads();
        f32x4 o[4];
#pragma unroll
        for (int dt = 0; dt < 4; ++dt) o[dt] = (f32x4){0.f, 0.f, 0.f, 0.f};
#pragma unroll
        for (int k = 0; k < 5; ++k) {
            u32x2 a0, a1, a2, a3, a4, a5, a6, a7; const unsigned va = vaddr0 + (unsigned)(k * 32 * 72 * 2);
            asm volatile("ds_read_b64_tr_b16 %0, %8\n\tds_read_b64_tr_b16 %1, %8 offset:2304\n\tds_read_b64_tr_b16 %2, %8 offset:32\n\tds_read_b64_tr_b16 %3, %8 offset:2336\n\t"
                         "ds_read_b64_tr_b16 %4, %8 offset:64\n\tds_read_b64_tr_b16 %5, %8 offset:2368\n\tds_read_b64_tr_b16 %6, %8 offset:96\n\tds_read_b64_tr_b16 %7, %8 offset:2400\n\ts_waitcnt lgkmcnt(0)"
                         : "=&v"(a0), "=&v"(a1), "=&v"(a2), "=&v"(a3), "=&v"(a4), "=&v"(a5), "=&v"(a6), "=&v"(a7) : "v"(va) : "memory");
            __builtin_amdgcn_sched_barrier(0);
            o[0] = __builtin_amdgcn_mfma_f32_16x16x32_bf16(__builtin_bit_cast(bf16x8_t, (u32x4){a0.x, a0.y, a1.x, a1.y}), pf[k], o[0], 0, 0, 0);
            o[1] = __builtin_amdgcn_mfma_f32_16x16x32_bf16(__builtin_bit_cast(bf16x8_t, (u32x4){a2.x, a2.y, a3.x, a3.y}), pf[k], o[1], 0, 0, 0);
            o[2] = __builtin_amdgcn_mfma_f32_16x16x32_bf16(__builtin_bit_cast(bf16x8_t, (u32x4){a4.x, a4.y, a5.x, a5.y}), pf[k], o[2], 0, 0, 0);
            o[3] = __builtin_amdgcn_mfma_f32_16x16x32_bf16(__builtin_bit_cast(bf16x8_t, (u32x4){a6.x, a6.y, a7.x, a7.y}), pf[k], o[3], 0, 0, 0);
        }
        const float inv = 1.f / den; const size_t tok = (size_t)(rowbase + (long)l * dil);
        bf16* op = OG + ((size_t)g * M + tok) * 512 + h * 64 + 4 * fq;
#pragma unroll
        for (int dt = 0; dt < 4; ++dt) { u32x2 wv; wv.x = pg8::cvt_pk_bf16(o[dt][0] * inv, o[dt][1] * inv); wv.y = pg8::cvt_pk_bf16(o[dt][2] * inv, o[dt][3] * inv); *(u32x2*)(op + 16 * dt) = wv; }
        if (fq == 0) LSE[((size_t)g * M + tok) * 8 + h] = mx + __logf(den);
    }
}

__device__ __forceinline__ void ph_attn_v2(Frame& F) {
    const bf16* P = (const bf16*)(F.ws + WS_P); bf16* OG = (bf16*)(F.ws + WS_OG); float* LSE = (float*)(F.ws + WS_LSE);
    LAS bf16* Kl = (LAS bf16*)F.lds;
    LAS bf16* Vl = Kl + 2 * 128 * 72;
    constexpr int SLOT = 128 * 72;
    const int tid = F.tid, lane = F.lane, w = F.wave, fr = lane & 15, fq = lane >> 4;
    const int ct0 = 2 * (w >> 1), l = 16 * w + fr;
    const int srow = tid >> 3, sch = tid & 7;
    for (int p = blockIdx.x; p < 512; p += F.G) {
        int g, b, h, r, nb0, nun;
        if (p < 128) { g = 0; const int seq = p >> 3; b = seq >> 3; h = seq & 7; r = 0; nb0 = (p & 7) * 8; nun = 8; }
        else if (p < 256) { g = 1; const int q = p - 128, seq = q >> 1; b = seq >> 5; h = (seq >> 2) & 7; r = seq & 3; nb0 = (q & 1) * 8; nun = 8; }
        else { g = 2; const int q = p - 256; b = q >> 7; h = (q >> 4) & 7; r = q & 15; nb0 = 0; nun = 4; }
        const int dil = (g == 0) ? 1 : (g == 1 ? 4 : 16);
        const size_t rstride = (size_t)dil * IN1;
        const bf16* Qp = P + g * 1536 + h * 64 + ((size_t)b * T + r) * IN1; const bf16* Kp = Qp + 512; const bf16* Vp = Qp + 1024;
        const float sl = exp2f(-(float)(h + 1)) * (float)dil;
        __syncthreads();
#pragma unroll
        for (int it = 0; it < 2; ++it) { const int row = srow + 64 * it;
            u32x4 k0 = (u32x4){0u, 0u, 0u, 0u}, v0 = k0;
            if (nb0 > 0) { const size_t off = (size_t)((nb0 - 1) * 128 + row) * rstride + sch * 8; k0 = *(const u32x4*)(Kp + off); v0 = *(const u32x4*)(Vp + off); }
            const size_t off1 = (size_t)(nb0 * 128 + row) * rstride + sch * 8; const u32x4 k1 = *(const u32x4*)(Kp + off1), v1 = *(const u32x4*)(Vp + off1);
            const int ps = (nb0 + 1) & 1, cs = nb0 & 1;
            *(LAS u32x4*)(Kl + ps * SLOT + row * 72 + sch * 8) = k0; *(LAS u32x4*)(Vl + ps * SLOT + row * 72 + sch * 8) = v0;
            *(LAS u32x4*)(Kl + cs * SLOT + row * 72 + sch * 8) = k1; *(LAS u32x4*)(Vl + cs * SLOT + row * 72 + sch * 8) = v1; }
        bf16x8_t qn0, qn1;
        { const bf16* qrow = Qp + (size_t)(nb0 * 128 + l) * rstride + 8 * fq; qn0 = *(const bf16x8_t*)qrow; qn1 = *(const bf16x8_t*)(qrow + 32); }
        __syncthreads();
        for (int i = 0; i < nun; ++i) {
            const int nb = nb0 + i; const bool more = (i + 1 < nun);
            const bf16x8_t qf0 = qn0, qf1 = qn1;
            u32x4 pk0 = (u32x4){0u, 0u, 0u, 0u}, pk1 = pk0, pv0 = pk0, pv1 = pk0;
            if (more) { const size_t off = (size_t)((nb + 1) * 128 + srow) * rstride + sch * 8;
                pk0 = *(const u32x4*)(Kp + off); pv0 = *(const u32x4*)(Vp + off); pk1 = *(const u32x4*)(Kp + off + 64 * rstride); pv1 = *(const u32x4*)(Vp + off + 64 * rstride);
                const bf16* qrow = Qp + (size_t)((nb + 1) * 128 + l) * rstride + 8 * fq; qn0 = *(const bf16x8_t*)qrow; qn1 = *(const bf16x8_t*)(qrow + 32); }
            const int ps = (nb + 1) & 1, cs = nb & 1;
            f32x4 s[10];
#pragma unroll
            for (int c = 0; c < 10; ++c) { const int ct = ct0 + c; const LAS bf16* kb = Kl + (ct < 8 ? ps : cs) * SLOT + ((ct & 7) * 16 + fr) * 72 + 8 * fq;
                s[c] = __builtin_amdgcn_mfma_f32_16x16x32_bf16(*(const LAS bf16x8_t*)kb, qf0, (f32x4){0.f, 0.f, 0.f, 0.f}, 0, 0, 0);
                s[c] = __builtin_amdgcn_mfma_f32_16x16x32_bf16(*(const LAS bf16x8_t*)(kb + 32), qf1, s[c], 0, 0, 0); }
            int lz = l, fz = 4 * fq; asm volatile("" : "+v"(lz), "+v"(fz));
            float mx = -1e30f;
#pragma unroll
            for (int c = 0; c < 10; ++c)
#pragma unroll
                for (int rg = 0; rg < 4; ++rg) { const int kr = 16 * (ct0 + c) + fz + rg, steps = lz + 128 - kr;
                    const bool ok = steps >= 0 && steps <= 128 && (nb > 0 || kr >= 128);
                    const float v = ok ? s[c][rg] * 0.125f - sl * (float)steps : -1e30f; s[c][rg] = v; mx = fmaxf(mx, v); }
            mx = fmaxf(mx, __shfl_xor(mx, 16)); mx = fmaxf(mx, __shfl_xor(mx, 32));
            float den = 0.f;
#pragma unroll
            for (int c = 0; c < 10; ++c)
#pragma unroll
                for (int rg = 0; rg < 4; ++rg) { const float pe = __expf(s[c][rg] - mx); s[c][rg] = pe; den += pe; }
            den += __shfl_xor(den, 16); den += __shfl_xor(den, 32);
            f32x4 o[4];
#pragma unroll
            for (int dt = 0; dt < 4; ++dt) o[dt] = (f32x4){0.f, 0.f, 0.f, 0.f};
#pragma unroll
            for (int k = 0; k < 5; ++k) { const int ct = ct0 + 2 * k;
                u32x4 wv; wv.x = pg8::cvt_pk_bf16(s[2 * k][0], s[2 * k][1]); wv.y = pg8::cvt_pk_bf16(s[2 * k][2], s[2 * k][3]);
                wv.z = pg8::cvt_pk_bf16(s[2 * k + 1][0], s[2 * k + 1][1]); wv.w = pg8::cvt_pk_bf16(s[2 * k + 1][2], s[2 * k + 1][3]);
                const bf16x8_t pf = __builtin_bit_cast(bf16x8_t, wv);
                const unsigned va = (unsigned)(size_t)(Vl + (ct < 8 ? ps : cs) * SLOT) + (unsigned)((((ct & 7) * 16 + 4 * fq + (fr >> 2)) * 72 + 4 * (fr & 3)) * 2);
                u32x2 a0, a1, a2, a3, a4, a5, a6, a7;
                tr8<0, 16 * 72 * 2>(va, a0, a1, a2, a3, a4, a5, a6, a7);
                __builtin_amdgcn_sched_barrier(0);
                o[0] = __builtin_amdgcn_mfma_f32_16x16x32_bf16(pack_frag(a0, a1), pf, o[0], 0, 0, 0);
                o[1] = __builtin_amdgcn_mfma_f32_16x16x32_bf16(pack_frag(a2, a3), pf, o[1], 0, 0, 0);
                o[2] = __builtin_amdgcn_mfma_f32_16x16x32_bf16(pack_frag(a4, a5), pf, o[2], 0, 0, 0);
                o[3] = __builtin_amdgcn_mfma_f32_16x16x32_bf16(pack_frag(a6, a7), pf, o[3], 0, 0, 0); }
            const float inv = 1.f / den; const size_t tok = (size_t)b * T + (size_t)(nb * 128 + l) * dil + r;
            bf16* op = OG + ((size_t)g * M + tok) * 512 + h * 64 + 4 * fq;
#pragma unroll
            for (int dt = 0; dt < 4; ++dt) { u32x2 wv; wv.x = pg8::cvt_pk_bf16(o[dt][0] * inv, o[dt][1] * inv); wv.y = pg8::cvt_pk_bf16(o[dt][2] * inv, o[dt][3] * inv); *(u32x2*)(op + 16 * dt) = wv; }
            if (fq == 0) LSE[((size_t)g * M + tok) * 8 + h] = mx + __logf(den);
            __syncthreads();
            if (more) { *(LAS u32x4*)(Kl + ps * SLOT + srow * 72 + sch * 8) = pk0; *(LAS u32x4*)(Vl + ps * SLOT + srow * 72 + sch * 8) = pv0;
                *(LAS u32x4*)(Kl + ps * SLOT + (srow + 64) * 72 + sch * 8) = pk1; *(LAS u32x4*)(Vl + ps * SLOT + (srow + 64) * 72 + sch * 8) = pv1; }
            __syncthreads();
        }
    }
}

__device__ __forceinline__ void ph_merge(Frame& F) {
    const bf16* OG = (const bf16*)(F.ws + WS_OG); const float* LSE = (const float*)(F.ws + WS_LSE); bf16* Y2 = (bf16*)(F.ws + WS_Y2);
    const int total = M * 64, nth = F.G * NT;
    for (int idx = blockIdx.x * NT + F.tid; idx < total; idx += nth) {
        const int m = idx >> 6, c8 = idx & 63, h = c8 >> 3;
        const float l0 = LSE[((size_t)0 * M + m) * 8 + h], l1 = LSE[((size_t)1 * M + m) * 8 + h], l2 = LSE[((size_t)2 * M + m) * 8 + h];
        const float mx = fmaxf(l0, fmaxf(l1, l2)); float w0 = __expf(l0 - mx), w1 = __expf(l1 - mx), w2 = __expf(l2 - mx); const float inv = 1.f / (w0 + w1 + w2);
        w0 *= inv; w1 *= inv; w2 *= inv;
        const u32x4 a = *(const u32x4*)(OG + ((size_t)0 * M + m) * 512 + c8 * 8), b = *(const u32x4*)(OG + ((size_t)1 * M + m) * 512 + c8 * 8), c = *(const u32x4*)(OG + ((size_t)2 * M + m) * 512 + c8 * 8);
        u32x4 o;
        o.x = pk2(w0 * bflo(a.x) + w1 * bflo(b.x) + w2 * bflo(c.x), w0 * bfhi(a.x) + w1 * bfhi(b.x) + w2 * bfhi(c.x));
        o.y = pk2(w0 * bflo(a.y) + w1 * bflo(b.y) + w2 * bflo(c.y), w0 * bfhi(a.y) + w1 * bfhi(b.y) + w2 * bfhi(c.y));
        o.z = pk2(w0 * bflo(a.z) + w1 * bflo(b.z) + w2 * bflo(c.z), w0 * bfhi(a.z) + w1 * bfhi(b.z) + w2 * bfhi(c.z));
        o.w = pk2(w0 * bflo(a.w) + w1 * bflo(b.w) + w2 * bflo(c.w), w0 * bfhi(a.w) + w1 * bfhi(b.w) + w2 * bfhi(c.w));
        *(u32x4*)(Y2 + (size_t)m * 512 + c8 * 8) = o;
    }
}

__device__ __forceinline__ void gemm_inproj(Frame& F, const void* A, size_t wt, int N) {
    pg8::StaticOrder S; S.init(A, F.ws + wt, M, N, D, F.G, (int)blockIdx.x); pg8::EpiBf16 E{(bf16*)(F.ws + WS_P), N};
    pg8::gemm_phase<pg8::EpiBf16, pg8::StaticOrder, true, false>(F.lds, D, S, E);
}
template <bool BASE_BF16>
__device__ __forceinline__ void gemm_outproj(Frame& F, size_t a, size_t wt, int K, const void* base) {
    pg8::StaticOrder S; S.init(F.ws + a, F.ws + wt, M, D, K, F.G, (int)blockIdx.x); pg8::EpiResBf16<BASE_BF16> E{base, (bf16*)((char*)F.out + 32 * MiB), ALPHA};
    pg8::gemm_phase<pg8::EpiResBf16<BASE_BF16>, pg8::StaticOrder, false, false>(F.lds, K, S, E);
}
__device__ __forceinline__ int moe_row_tiles(Frame& F, int layer) { const unsigned* cnt = F.ctl + CW_CNT + layer * 32 * 64; int n = 0; for (int e = 0; e < 32; ++e) n += ((int)cnt[e * 64] + 255) >> 8; return n; }
__device__ __forceinline__ void gemm_moe1(Frame& F, int layer, int Lbase, int Lend, int G, int c) {
    pg8::MoeOrder S{F.ctl + CW_CNT + layer * 32 * 64, (const int*)(F.ws + WS_LIST), (const char*)(F.ws + WS_XB), (const char*)(F.ws + WS_EW), 2, G, c, D, 0, Lbase, Lend};
    pg8::EpiSwiGLU E{(bf16*)(F.ws + WS_HID)}; pg8::gemm_phase<pg8::EpiSwiGLU, pg8::MoeOrder, true, true>(F.lds, D, S, E);
}
__device__ __forceinline__ void gemm_moe2(Frame& F, int layer, int Lbase, int Lend, int G, int c) {
    pg8::MoeOrder S{F.ctl + CW_CNT + layer * 32 * 64, (const int*)(F.ws + WS_LIST), (const char*)(F.ws + WS_HID), (const char*)(F.ws + WS_EW + EW_DN), 4, G, c, DE, 1, Lbase, Lend};
    pg8::EpiMoeOut E{(bf16*)(F.ws + WS_YB), (const int*)(F.ws + WS_LIST)}; pg8::gemm_phase<pg8::EpiMoeOut, pg8::MoeOrder, true, false>(F.lds, DE, S, E);
}
__device__ __forceinline__ void moe_alpha(Frame& F, int layer) { const int n1 = 2 * moe_row_tiles(F, layer); gemm_moe1(F, layer, 0, n1 < F.G ? n1 : F.G, F.G, (int)blockIdx.x); }
__device__ __forceinline__ void moe_beta(Frame& F, int layer) {
    const int nrt = moe_row_tiles(F, layer), n1 = 2 * nrt, c = (int)blockIdx.x;
    int nb1 = n1 - F.G; nb1 = nb1 < 0 ? 0 : (nb1 > F.G / 2 ? F.G / 2 : nb1);
    const int rt_a = nrt < F.G / 2 ? nrt : F.G / 2;
    if (c < nb1) gemm_moe1(F, layer, F.G, n1, nb1, c);
    else gemm_moe2(F, layer, 0, 4 * rt_a, F.G - nb1, c - nb1);
}
__device__ __forceinline__ void moe_gamma(Frame& F, int layer) {
    const int nrt = moe_row_tiles(F, layer), rt_a = nrt < F.G / 2 ? nrt : F.G / 2;
    gemm_moe2(F, layer, 4 * rt_a, 4 * nrt, F.G, (int)blockIdx.x);
}

struct Args { const float* in[18]; float* out; unsigned char* ws; int ph_lo, ph_hi, li, pad; };
__global__ void __launch_bounds__(NT, 2) mega_fwd(Args args) {
    extern __shared__ __attribute__((aligned(16))) unsigned char lds_raw[];
    Frame F;
    F.lds = (LAS unsigned char*)lds_raw;
    F.tid = threadIdx.x; F.lane = F.tid & 63; F.wave = __builtin_amdgcn_readfirstlane(F.tid >> 6);
    F.G = gridDim.x; { const int bx = blockIdx.x; F.vcu = (F.G % 8 == 0) ? (bx % 8) * (F.G / 8) + bx / 8 : bx; }
#pragma unroll
    for (int i = 0; i < 18; ++i) F.in[i] = args.in[i];
    F.out = args.out; F.ws = args.ws; F.ctl = (unsigned*)(args.ws + WS_CTL);
    volatile LAS unsigned* MISC = (volatile LAS unsigned*)(F.lds + LDS_BYTES - 128);
    if (F.tid < 32) MISC[F.tid] = 0u;
    __syncthreads();
    XcdBarrier bar; bar.bar = F.ctl + CW_BAR; bar.x = 0; bar.st = nullptr;
    if (MK_N_LAUNCHES == 1) bar = xcd_barrier_post(F.ctl + CW_BAR, MISC + 8);
    const int lo = args.ph_lo, hi = args.ph_hi;
#define IN(k) (lo <= (k) && (k) < hi)
#define SEAM(k) do { if (IN(k) && IN((k) + 1)) xcd_barrier(bar); } while (0)
#define DUP(k) ((PROBE_DUP >> (k)) & 1)
#define PHASE(k, ...) do { if (IN(k)) { __VA_ARGS__; if (DUP(k)) { xcd_barrier(bar); __VA_ARGS__; } } SEAM(k); } while (0)
    PHASE(0, ph0_convert(F));
    PHASE(1, gemm_inproj(F, F.ws + WS_XB, WS_WT0, NP0));
    PHASE(2, ph_mix_a(F); xcd_barrier(bar); ph_mix_b(F));
    PHASE(3, ph_mix_c(F));
    PHASE(4, gemm_outproj<false>(F, WS_Y, WS_WO0, D, F.in[0]));
    if (IN(5)) { convert_experts(F, 0); if (DUP(5)) { __syncthreads(); convert_experts(F, 0); } __syncthreads(); ph_ln<0, true, 0>(F, 0); } SEAM(5);
    PHASE(6, moe_alpha(F, 0));
    PHASE(7, moe_beta(F, 0); xcd_barrier(bar); moe_gamma(F, 0));
    if (IN(8)) { ph_ln<1, false, 1>(F, 0); __syncthreads(); convert_experts(F, 1); if (DUP(8)) { __syncthreads(); convert_experts(F, 1); } } SEAM(8);
    PHASE(9, gemm_inproj(F, F.out, WS_WT1, IN1));
    PHASE(10, ph_attn_v2(F));
    PHASE(11, ph_merge(F));
    PHASE(12, gemm_outproj<true>(F, WS_Y2, WS_WO1, 512, F.out));
    if (IN(13)) { ph_ln<0, true, 0>(F, 1); if (DUP(13)) { xcd_barrier(bar); ph_ln<0, true, 0>(F, 1, true); } } SEAM(13);
    PHASE(14, moe_alpha(F, 1));
    PHASE(15, moe_beta(F, 1); xcd_barrier(bar); moe_gamma(F, 1));
    if (IN(16)) { ph_ln<1, false, 2>(F, 1); if (DUP(16)) { xcd_barrier(bar); ph_ln<1, false, 2>(F, 1); } }
#undef IN
#undef SEAM
#undef PHASE
#undef DUP
}

extern "C" void kernel_launch(void* const* d_in, const int* in_sizes, int n_in, void* d_out, int out_size, void* d_ws, size_t ws_size, hipStream_t stream) {
    static int grid = 0;
    if (grid == 0) {
        if (n_in != 18 || in_sizes[0] != M * D || out_size != M * D || ws_size < WS_END) {
            fprintf(stderr, "kernel_launch: unexpected problem (n_in %d, in0 %d, out %d, ws %zu < %zu)\n", n_in, n_in > 0 ? in_sizes[0] : -1, out_size, ws_size, (size_t)WS_END); grid = -1; return; }
        int dev = 0, cus = 0;
        if (hipGetDevice(&dev) != hipSuccess || hipDeviceGetAttribute(&cus, hipDeviceAttributeMultiprocessorCount, dev) != hipSuccess) { grid = -1; return; }
        if (hipFuncSetAttribute((const void*)mega_fwd, hipFuncAttributeMaxDynamicSharedMemorySize, LDS_BYTES) != hipSuccess) { fprintf(stderr, "kernel_launch: hipFuncSetAttribute failed\n"); grid = -1; return; }
        int per_cu = 0;
        if (hipOccupancyMaxActiveBlocksPerMultiprocessor(&per_cu, (const void*)mega_fwd, NT, LDS_BYTES) != hipSuccess || per_cu < 1) fprintf(stderr, "kernel_launch: occupancy query says %d\n", per_cu);
        (void)hipGetLastError();
        grid = cus;
    }
    if (grid < 0) return;
    (void)hipMemsetAsync((char*)d_ws + WS_CTL, 0, CTL_ZERO_BYTES, stream);
    Args a{};
    for (int i = 0; i < 18; ++i) a.in[i] = (const float*)d_in[i];
    a.out = (float*)d_out; a.ws = (unsigned char*)d_ws;
    if (MK_N_LAUNCHES == 1) {
        a.ph_lo = 0; a.ph_hi = N_PHASES; a.li = 0;
        hipLaunchKernelGGL(mega_fwd, dim3(grid), dim3(NT), LDS_BYTES, stream, a);
    } else {
        for (int p = 0; p < N_PHASES; ++p) { a.ph_lo = p; a.ph_hi = p + 1; a.li = p; hipLaunchKernelGGL(mega_fwd, dim3(grid), dim3(NT), LDS_BYTES, stream, a); }
    }
}
```

```cpp
#include <hip/hip_runtime.h>
#include <cstdio>
#include <cstdint>

#ifndef PROBE_DUP
#define PROBE_DUP 0
#endif
#ifndef PROBE_CVAR
#define PROBE_CVAR 0
#endif
#ifndef MK_N_LAUNCHES
#define MK_N_LAUNCHES 1
#endif

#define LAS __attribute__((address_space(3)))
typedef unsigned short bf16;
typedef float f32x4 __attribute__((ext_vector_type(4)));
typedef unsigned u32x4 __attribute__((ext_vector_type(4)));
typedef unsigned u32x2 __attribute__((ext_vector_type(2)));
typedef short bf16x8_t __attribute__((ext_vector_type(8)));
#define RLX_AGENT __ATOMIC_RELAXED, __HIP_MEMORY_SCOPE_AGENT
#define LDS_WAIT() asm volatile("s_waitcnt lgkmcnt(0)" ::: "memory")
#define VM_WAIT() asm volatile("s_waitcnt vmcnt(0)" ::: "memory")

constexpr int NWAVES = 8, NT = NWAVES * 64;
constexpr int BATCH = 2, T = 8192, D = 1024, M = BATCH * T;
constexpr int IN0 = 4104, IN1 = 4608, NP0 = 4096;
constexpr int NE = 32, DE = 256;
constexpr float ALPHA = 1.41421356237309515f;
constexpr float LN_EPS = 1e-5f;
constexpr float KSCALE = 0.08838834764831845f;
constexpr int N_PHASES = 17;

constexpr size_t MiB = 1u << 20;
constexpr size_t WS_CTL = 0, CTL_ZERO_BYTES = 1 * MiB;
constexpr size_t WS_G = 1 * MiB;
constexpr size_t WS_EIDX = WS_G + 512 * 1024;
constexpr size_t WS_GATEV = WS_EIDX + 128 * 1024;
constexpr size_t WS_WT0 = 2 * MiB;
constexpr size_t WS_WO0 = 10 * MiB;
constexpr size_t WS_WT1 = 12 * MiB;
constexpr size_t WS_WO1 = 21 * MiB;
constexpr size_t WS_SE = 22 * MiB;
constexpr size_t WS_EW = WS_SE;
constexpr size_t EW_STRIDE = 3 * MiB / 2, EW_DN = 1 * MiB;
constexpr size_t WS_LIST = WS_SE + 48 * MiB;
constexpr size_t WS_LSE = WS_SE + 50 * MiB;
constexpr size_t WS_XB = 86 * MiB;
constexpr size_t WS_Y = 118 * MiB;
constexpr size_t WS_OG = WS_XB;
constexpr size_t WS_Y2 = WS_XB + 48 * MiB;
constexpr size_t WS_P = 150 * MiB;
constexpr size_t WS_YB = WS_P;
constexpr size_t WS_HID = WS_P + 64 * MiB;
constexpr size_t WS_END = 294 * MiB;
constexpr size_t WS_QKC = WS_SE;

constexpr int GWS = 1032;
constexpr int CB_GWT = 640 * 1024;
constexpr int CB_C12 = 960 * 1024;
constexpr int CW_BAR = 4096;
constexpr int CW_CNT = 16384;

constexpr int LDS_BYTES = 147456;

__device__ __forceinline__ unsigned f2bf(float f) { unsigned u = __builtin_bit_cast(unsigned, f); return (u + 0x7fffu + ((u >> 16) & 1u)) >> 16; }
__device__ __forceinline__ unsigned pk2(float lo, float hi) { return f2bf(lo) | (f2bf(hi) << 16); }
__device__ __forceinline__ float bf2f(unsigned b) { return __builtin_bit_cast(float, b << 16); }
__device__ __forceinline__ float bflo(unsigned w) { return __builtin_bit_cast(float, w << 16); }
__device__ __forceinline__ float bfhi(unsigned w) { return __builtin_bit_cast(float, w & 0xffff0000u); }
__device__ __forceinline__ float wave_sum(float v) {
#pragma unroll
    for (int o = 1; o < 64; o <<= 1) v += __shfl_xor(v, o);
    return v;
}
__device__ __forceinline__ float sigmoidf_(float x) { return 1.f / (1.f + __expf(-x)); }
__device__ __forceinline__ float siluf_(float x) { return x / (1.f + __expf(-x)); }

#define XB_TMO      128
#define XB_XCNT(j)  (256  + 64 * (j))
#define XB_XSUB(j)  (1280 + 64 * (j))
#define XB_XGEN(j)  (2304 + 64 * (j))
#define XB_TOP      3328
#define XB_TOPGEN   3392
#define XCD_BAR_WORDS 3456
#define XB_SPIN_CAP (1u << 22)
__device__ __forceinline__ unsigned xb_ld(unsigned* p)              { return __hip_atomic_load(p, __ATOMIC_RELAXED, __HIP_MEMORY_SCOPE_AGENT); }
__device__ __forceinline__ unsigned xb_add(unsigned* p, unsigned v) { return __hip_atomic_fetch_add(p, v, __ATOMIC_RELAXED, __HIP_MEMORY_SCOPE_AGENT); }
__device__ __forceinline__ unsigned xb_xcc_id() { return (unsigned)__builtin_amdgcn_s_getreg((3 << 11) | 20) & 0xFu; }
#define XB_SPIN(cond, bar) do { unsigned _sp = 0; while (cond) { __builtin_amdgcn_s_sleep(1); \
    if ((++_sp & 255u) == 0u) { if (xb_ld(&(bar)[XB_TMO])) break; if (_sp > XB_SPIN_CAP) { atomicAdd(&(bar)[XB_TMO], 1u); break; } } } } while (0)
struct XcdBarrier { unsigned* bar; unsigned x; volatile LAS unsigned* st; };
__device__ __forceinline__ XcdBarrier xcd_barrier_post(unsigned* bar, volatile LAS unsigned* st) {
    XcdBarrier b; b.bar = bar; b.x = xb_xcc_id(); b.st = st;
    if (threadIdx.x == 0) (void)xb_add(&bar[XB_XCNT(b.x)], 1u);
    return b;
}
__device__ __forceinline__ void xcd_barrier_complete(unsigned* bar, unsigned x, unsigned& nloc, unsigned& nx) {
    const unsigned G = gridDim.x * gridDim.y * gridDim.z;
    unsigned sum, cnt, mine, sp = 0u;
    for (;;) {
        sum = 0u; cnt = 0u; mine = 0u;
#pragma unroll
        for (unsigned j = 0; j < 16; ++j) { const unsigned c = xb_ld(&bar[XB_XCNT(j)]); sum += c; cnt += (c > 0u) ? 1u : 0u; mine = (j == x) ? c : mine; }
        if (sum == G) break;
        __builtin_amdgcn_s_sleep(1);
        if ((++sp & 255u) == 0u) { if (xb_ld(&bar[XB_TMO])) break; if (sp > XB_SPIN_CAP) { atomicAdd(&bar[XB_TMO], 1u); break; } }
    }
    nloc = mine > 0u ? mine : 1u; nx = cnt > 0u ? cnt : 1u;
}
__device__ __forceinline__ void xcd_barrier(const XcdBarrier& b) {
    asm volatile("s_waitcnt vmcnt(0)" ::: "memory");
    __syncthreads();
    if (threadIdx.x == 0) {
        unsigned* bar = b.bar;
        __builtin_amdgcn_s_waitcnt(0);
        unsigned nloc = b.st[0], nx = b.st[1];
        if (nloc == 0u) { xcd_barrier_complete(bar, b.x, nloc, nx); b.st[0] = nloc; b.st[1] = nx; }
        const unsigned old = xb_add(&bar[XB_XSUB(b.x)], 1u);
        const unsigned gen = old / nloc;
        if (old + 1u == (gen + 1u) * nloc) {
            __builtin_amdgcn_fence(__ATOMIC_RELEASE, "agent");
            asm volatile("s_waitcnt vmcnt(0)" ::: "memory");
            const unsigned og = xb_add(&bar[XB_TOP], 1u);
            const unsigned tg = og / nx;
            if (og + 1u == (tg + 1u) * nx) xb_add(&bar[XB_TOPGEN], 1u);
            else XB_SPIN(xb_ld(&bar[XB_TOPGEN]) == tg, bar);
            __builtin_amdgcn_fence(__ATOMIC_ACQUIRE, "agent");
            xb_add(&bar[XB_XGEN(b.x)], 1u);
            asm volatile("s_waitcnt vmcnt(0)" ::: "memory");
        } else {
            XB_SPIN(xb_ld(&bar[XB_XGEN(b.x)]) == gen, bar);
            __builtin_amdgcn_fence(__ATOMIC_ACQUIRE, "agent");
            asm volatile("s_waitcnt vmcnt(0)" ::: "memory");
        }
    }
    __syncthreads();
}

struct Frame {
    LAS unsigned char* lds;
    unsigned* ctl;
    int tid, lane, wave, vcu, G;
    const float* in[18];
    float* out;
    unsigned char* ws;
};

namespace pg8 {
typedef short bf16x8 __attribute__((ext_vector_type(8)));
constexpr int BM = 256, BK = 64, HALF = 128, HTB = HALF * BK * 2, STAGE_BYTES = 8 * HTB, NXCD = 8, WGM = 8;
__host__ __device__ __forceinline__ int lds_byte(int r, int c) { const int st = (r >> 4) * 2 + (c >> 5), rr = r & 15, cc = c & 31, ob = rr * 64 + cc * 2; return st * 1024 + (ob ^ (((ob >> 9) & 1) << 5)); }
__host__ __device__ __forceinline__ void stage_rc(int b, int& R, int& C) { const int st = b / 1024, sb = b % 1024, swz = sb ^ (((sb >> 9) & 1) << 5); R = (st >> 1) * 16 + swz / 64; C = (st & 1) * 32 + (swz % 64) / 2; }
__host__ __device__ __forceinline__ int perm32(int rho) { const int n = rho >> 4, i = rho & 15; return 8 * (i >> 2) + 4 * n + (i & 3); }
struct Unit { int pm, pn, e, cnt, hb; };
typedef __bf16 bf16n2 __attribute__((ext_vector_type(2)));
typedef float f32x2n __attribute__((ext_vector_type(2)));
__device__ __forceinline__ unsigned cvt_pk_bf16(float lo, float hi) { const bf16n2 v = __builtin_convertvector((f32x2n){lo, hi}, bf16n2); return __builtin_bit_cast(unsigned, v); }

struct StaticOrder {
    int nM, nN, nwg, G, c, K; const char* A; const char* Bt;
    __device__ void init(const void* A_, const void* Bt_, int M_, int N_, int K_, int G_, int c_) { A = (const char*)A_; Bt = (const char*)Bt_; nM = M_ / BM; nN = N_ / BM; nwg = nM * nN; G = G_; c = c_; K = K_; }
    __device__ bool next(int i, Unit& u) const {
        const long L = (long)i * G + c; if (L >= nwg) return false;
        int wgid = (int)L; { const int q = nwg / NXCD, r = nwg % NXCD, xcd = wgid % NXCD, off = wgid / NXCD; wgid = (xcd < r ? xcd * (q + 1) : r * (q + 1) + (xcd - r) * q) + off; }
        const int nig = WGM * nN, gid = wgid / nig, fm = gid * WGM, gsz = (nM - fm) < WGM ? (nM - fm) : WGM;
        u.pm = fm + ((wgid % nig) % gsz); u.pn = (wgid % nig) / gsz; u.e = 0; u.cnt = 0; u.hb = 0; return true;
    }
    __device__ __forceinline__ void base(const Unit& u, const char*& cA, const char*& cB) const { cA = A + (size_t)u.pm * BM * K * 2; cB = Bt + (size_t)u.pn * BM * K * 2; }
    __device__ __forceinline__ unsigned rowoff(const Unit&, int) const { return 0u; }
};

struct EpiBf16 {
    static constexpr bool PERM = true;
    bf16* O; int ldc;
    __device__ __forceinline__ void operator()(const f32x4 (&acc)[2][2][4][2], const Unit& u, int wr, int wc, int fr, int fq) const {
        const int row0 = u.pm * BM + wr * 64 + fr, col0 = u.pn * BM + wc * 32 + 8 * fq;
#pragma unroll
        for (int ai = 0; ai < 2; ++ai)
#pragma unroll
            for (int m = 0; m < 4; ++m) { bf16* rowp = O + (size_t)(row0 + ai * HALF + m * 16) * ldc + col0;
#pragma unroll
                for (int bj = 0; bj < 2; ++bj) { const f32x4 v0 = acc[ai][bj][m][0], v1 = acc[ai][bj][m][1];
                    u32x4 w; w.x = cvt_pk_bf16(v0[0], v0[1]); w.y = cvt_pk_bf16(v0[2], v0[3]); w.z = cvt_pk_bf16(v1[0], v1[1]); w.w = cvt_pk_bf16(v1[2], v1[3]);
                    *(u32x4*)(rowp + bj * HALF) = w; } }
    }
};
template <bool BASE_BF16>
struct EpiResBf16 {
    static constexpr bool PERM = true;
    const void* base; bf16* out; float alpha;
    __device__ __forceinline__ void operator()(const f32x4 (&acc)[2][2][4][2], const Unit& u, int wr, int wc, int fr, int fq) const {
        const int col0 = u.pn * BM + wc * 32 + 8 * fq;
#pragma unroll
        for (int ai = 0; ai < 2; ++ai)
#pragma unroll
            for (int m = 0; m < 4; ++m) { const size_t off = (size_t)(u.pm * BM + ai * HALF + wr * 64 + m * 16 + fr) * 1024 + col0;
#pragma unroll
                for (int bj = 0; bj < 2; ++bj) { f32x4 b0, b1;
                    if (BASE_BF16) { const u32x4 x = *(const u32x4*)((const bf16*)base + off + bj * HALF); b0 = (f32x4){bflo(x.x), bfhi(x.x), bflo(x.y), bfhi(x.y)}; b1 = (f32x4){bflo(x.z), bfhi(x.z), bflo(x.w), bfhi(x.w)}; }
                    else { b0 = *(const f32x4*)((const float*)base + off + bj * HALF); b1 = *(const f32x4*)((const float*)base + off + bj * HALF + 4); }
                    const f32x4 v0 = b0 * alpha + acc[ai][bj][m][0], v1 = b1 * alpha + acc[ai][bj][m][1];
                    u32x4 w; w.x = cvt_pk_bf16(v0[0], v0[1]); w.y = cvt_pk_bf16(v0[2], v0[3]); w.z = cvt_pk_bf16(v1[0], v1[1]); w.w = cvt_pk_bf16(v1[2], v1[3]);
                    *(u32x4*)(out + off + bj * HALF) = w; }
                if (m & 1) asm volatile("" ::: "memory"); }
    }
};

struct MoeOrder {
    const unsigned* cnt; const int* LIST; const char* A; const char* B; int NTN, G, c, K, mode, Lbase, Lend;
    __device__ bool next(int i, Unit& u) const {
        if (c < 0) return false;
        const int L = Lbase + i * G + c; if (L >= Lend) return false;
        int base = 0, hb = 0;
        for (int e = 0; e < 32; ++e) { const int cc = (int)cnt[e * 64]; const int nmb = (cc + 255) >> 8; const int ntl = nmb * NTN;
            if (L < base + ntl) { const int r = L - base; u.e = e; u.pm = r / NTN; u.pn = r % NTN; u.cnt = cc; u.hb = hb; return true; }
            base += ntl; hb += nmb << 8; }
        return false;
    }
    __device__ __forceinline__ void base(const Unit& u, const char*& cA, const char*& cB) const {
        cA = mode == 0 ? A : A + (size_t)(u.hb + u.pm * 256) * K * 2; cB = B + (size_t)u.e * EW_STRIDE + (size_t)u.pn * 256 * K * 2; }
    __device__ __forceinline__ unsigned rowoff(const Unit& u, int r) const { int i = u.pm * 256 + r; i = i < u.cnt ? i : 0; return (unsigned)(LIST[u.e * M + i] >> 1) * 2048u; }
};
struct EpiSwiGLU {
    static constexpr bool PERM = true;
    bf16* HID;
    __device__ __forceinline__ void operator()(const f32x4 (&acc)[2][2][4][2], const Unit& u, int wr, int wc, int fr, int fq) const {
#pragma unroll
        for (int ai = 0; ai < 2; ++ai)
#pragma unroll
            for (int m = 0; m < 4; ++m) { const int i = u.pm * 256 + ai * HALF + wr * 64 + m * 16 + fr;
                if (i < u.cnt) { const f32x4 g0 = acc[ai][0][m][0], g1 = acc[ai][0][m][1], u0 = acc[ai][1][m][0], u1 = acc[ai][1][m][1];
                    u32x4 w; w.x = cvt_pk_bf16(siluf_(g0[0]) * u0[0], siluf_(g0[1]) * u0[1]); w.y = cvt_pk_bf16(siluf_(g0[2]) * u0[2], siluf_(g0[3]) * u0[3]);
                    w.z = cvt_pk_bf16(siluf_(g1[0]) * u1[0], siluf_(g1[1]) * u1[1]); w.w = cvt_pk_bf16(siluf_(g1[2]) * u1[2], siluf_(g1[3]) * u1[3]);
                    *(u32x4*)(HID + (size_t)(u.hb + i) * DE + u.pn * 128 + wc * 32 + 8 * fq) = w; } }
    }
};
struct EpiMoeOut {
    static constexpr bool PERM = true;
    bf16* YB; const int* LIST;
    __device__ __forceinline__ void operator()(const f32x4 (&acc)[2][2][4][2], const Unit& u, int wr, int wc, int fr, int fq) const {
#pragma unroll
        for (int ai = 0; ai < 2; ++ai)
#pragma unroll
            for (int m = 0; m < 4; ++m) { const int i = u.pm * 256 + ai * HALF + wr * 64 + m * 16 + fr;
                if (i < u.cnt) { const int a = LIST[u.e * M + i]; bf16* rowp = YB + (size_t)a * D + u.pn * 256 + wc * 32 + 8 * fq;
#pragma unroll
                    for (int bj = 0; bj < 2; ++bj) { const f32x4 v0 = acc[ai][bj][m][0], v1 = acc[ai][bj][m][1];
                        u32x4 w; w.x = cvt_pk_bf16(v0[0], v0[1]); w.y = cvt_pk_bf16(v0[2], v0[3]); w.z = cvt_pk_bf16(v1[0], v1[1]); w.w = cvt_pk_bf16(v1[2], v1[3]);
                        *(u32x4*)(rowp + bj * HALF) = w; } }
                asm volatile("" ::: "memory"); }
    }
};

template <class Epi, class Sched, bool ALIGN_EPI, bool GATHER>
__device__ __forceinline__ void gemm_phase(LAS unsigned char* lds, const int K, const Sched& S, const Epi& E) {
    const int tid = threadIdx.x, wid = __builtin_amdgcn_readfirstlane(tid >> 6), lane = tid & 63, wr = wid >> 2, wc = wid & 3, fr = lane & 15, fq = lane >> 4;
    const int nt = K / BK;
    int Rr[2], Cc[2]; unsigned voffB[2];
#pragma unroll
    for (int i = 0; i < 2; ++i) { int R, C; stage_rc(tid * 16 + i * 8192, R, C); const int Rb = Epi::PERM ? ((R & ~31) + perm32(R & 31)) : R; Rr[i] = R; Cc[i] = C; voffB[i] = (unsigned)(Rb * K + C) * 2u; }
    const size_t kstep = (size_t)(BK * 2);
    const size_t hstep = (size_t)HALF * K * 2;
    const unsigned ldsw = (unsigned)wid * 1024u;
    const int aoff = lds_byte(wr * 64 + fr, fq * 8), boff = lds_byte(wc * 32 + fr, fq * 8);
#define PG8_SA(b, h) (((b) * 2 + (h)) * HTB)
#define PG8_SB(b, h) ((4 + (b) * 2 + (h)) * HTB)
#define PG8_STAGE(bufoff, gbase, voff) do { _Pragma("unroll") for (int _i = 0; _i < 2; ++_i) \
        __builtin_amdgcn_global_load_lds((const unsigned*)((const char*)(gbase) + (voff)[_i]), (LAS unsigned*)(lds + (bufoff) + ldsw + _i * 8192), 16, 0, 0); } while (0)
#define PG8_STAGE_A(bufoff, gbase, o0, o1) do { \
        __builtin_amdgcn_global_load_lds((const unsigned*)((const char*)(gbase) + (o0)), (LAS unsigned*)(lds + (bufoff) + ldsw), 16, 0, 0); \
        __builtin_amdgcn_global_load_lds((const unsigned*)((const char*)(gbase) + (o1)), (LAS unsigned*)(lds + (bufoff) + ldsw + 8192), 16, 0, 0); } while (0)
#define PG8_LDA(dst, b, h) do { _Pragma("unroll") for (int m = 0; m < 4; ++m) _Pragma("unroll") for (int k = 0; k < 2; ++k) dst[m][k] = *(const LAS bf16x8*)(lds + PG8_SA(b, h) + aoff + m * 2048 + k * 1024); } while (0)
#define PG8_LDB(dst, b, h) do { _Pragma("unroll") for (int n = 0; n < 2; ++n) _Pragma("unroll") for (int k = 0; k < 2; ++k) dst[n][k] = *(const LAS bf16x8*)(lds + PG8_SB(b, h) + boff + n * 2048 + k * 1024); } while (0)
#define PG8_MMA(ai, bj, At, Bt) do { __builtin_amdgcn_s_setprio(1); _Pragma("unroll") for (int m = 0; m < 4; ++m) _Pragma("unroll") for (int n = 0; n < 2; ++n) _Pragma("unroll") for (int k = 0; k < 2; ++k) \
        acc[ai][bj][m][n] = __builtin_amdgcn_mfma_f32_16x16x32_bf16(Bt[n][k], At[m][k], acc[ai][bj][m][n], 0, 0, 0); __builtin_amdgcn_s_setprio(0); } while (0)
#define PG8_WAIT_V(n) asm volatile("s_waitcnt vmcnt(" #n ")" ::: "memory")
#define PG8_WAIT_L(n) asm volatile("s_waitcnt lgkmcnt(" #n ")" ::: "memory")
#define PG8_BAR __builtin_amdgcn_s_barrier()
#define PG8_SCHED __builtin_amdgcn_sched_barrier(0)
#define PG8_CALC_VA(u, v) do { _Pragma("unroll") for (int _h = 0; _h < 2; ++_h) _Pragma("unroll") for (int _i = 0; _i < 2; ++_i) \
        v[_h][_i] = GATHER ? (S.rowoff(u, _h * HALF + Rr[_i]) + (unsigned)Cc[_i] * 2u) : (unsigned)((_h * HALF + Rr[_i]) * K + Cc[_i]) * 2u; } while (0)
    Unit cur, nxt; int ui = 0;
    if (!S.next(0, cur)) return;
    f32x4 acc[2][2][4][2];
#pragma unroll
    for (int a = 0; a < 2; ++a)
#pragma unroll
        for (int b = 0; b < 2; ++b)
#pragma unroll
            for (int m = 0; m < 4; ++m)
#pragma unroll
                for (int n = 0; n < 2; ++n) acc[a][b][m][n] = (f32x4){0.f, 0.f, 0.f, 0.f};
    bf16x8 At[4][2], B0[2][2], B1[2][2];
    const char* cA; const char* cB; S.base(cur, cA, cB);
    unsigned cvA[2][2], nvA[2][2];
    PG8_CALC_VA(cur, cvA);
    PG8_STAGE(PG8_SB(0, 0), cB, voffB); PG8_STAGE(PG8_SB(0, 1), cB + hstep, voffB); PG8_STAGE_A(PG8_SA(0, 0), cA, cvA[0][0], cvA[0][1]); PG8_STAGE_A(PG8_SA(0, 1), cA, cvA[1][0], cvA[1][1]);
    if (wr == 1) PG8_BAR;
    PG8_WAIT_V(2); PG8_BAR;
    PG8_STAGE(PG8_SB(1, 0), cB + kstep, voffB); PG8_STAGE_A(PG8_SA(1, 0), cA + kstep, cvA[0][0], cvA[0][1]); PG8_STAGE(PG8_SB(1, 1), cB + hstep + kstep, voffB);
    PG8_WAIT_V(6); PG8_BAR;
    for (;;) {
        const bool has_next = S.next(ui + 1, nxt);
        const char* nA = cA; const char* nB = cB;
        if (has_next) { S.base(nxt, nA, nB); PG8_CALC_VA(nxt, nvA); }
        else {
#pragma unroll
            for (int h = 0; h < 2; ++h)
#pragma unroll
                for (int i = 0; i < 2; ++i) nvA[h][i] = cvA[h][i]; }
        if (GATHER) { asm volatile("s_waitcnt vmcnt(0)" ::: "memory"); asm volatile("" : "+v"(nvA[0][0]), "+v"(nvA[0][1]), "+v"(nvA[1][0]), "+v"(nvA[1][1])); }
#pragma unroll 1
        for (int t = 0; t < nt; t += 2) {
            const bool last = (t == nt - 2);
            const char* a1 = cA + (size_t)(t + 1) * kstep;
            const char* a2 = last ? nA : cA + (size_t)(t + 2) * kstep; const char* b2 = last ? nB : cB + (size_t)(t + 2) * kstep;
            const char* a3 = a2 + kstep; const char* b3 = b2 + kstep;
            const unsigned x00 = last ? nvA[0][0] : cvA[0][0], x01 = last ? nvA[0][1] : cvA[0][1], x10 = last ? nvA[1][0] : cvA[1][0], x11 = last ? nvA[1][1] : cvA[1][1];
            PG8_LDB(B0, 0, 0); PG8_LDB(B1, 0, 1); PG8_SCHED; PG8_LDA(At, 0, 0); PG8_STAGE_A(PG8_SA(1, 1), a1, cvA[1][0], cvA[1][1]);
            PG8_WAIT_V(8); PG8_WAIT_L(0); PG8_BAR; PG8_MMA(0, 0, At, B0); PG8_MMA(0, 1, At, B1); PG8_BAR; PG8_SCHED;
            PG8_LDA(At, 0, 1); PG8_STAGE(PG8_SB(0, 0), b2, voffB); PG8_STAGE(PG8_SB(0, 1), b2 + hstep, voffB); PG8_STAGE_A(PG8_SA(0, 0), a2, x00, x01);
            PG8_WAIT_V(8); PG8_WAIT_L(0); PG8_BAR; PG8_MMA(1, 0, At, B0); PG8_MMA(1, 1, At, B1); PG8_BAR; PG8_SCHED;
            PG8_LDB(B0, 1, 0); PG8_LDB(B1, 1, 1); PG8_SCHED; PG8_LDA(At, 1, 0); PG8_STAGE_A(PG8_SA(0, 1), a2, x10, x11);
            PG8_WAIT_V(8); PG8_WAIT_L(0); PG8_BAR; PG8_MMA(0, 0, At, B0); PG8_MMA(0, 1, At, B1); PG8_BAR; PG8_SCHED;
            PG8_LDA(At, 1, 1); PG8_STAGE(PG8_SB(1, 0), b3, voffB); PG8_STAGE(PG8_SB(1, 1), b3 + hstep, voffB); PG8_STAGE_A(PG8_SA(1, 0), a3, x00, x01);
            PG8_WAIT_V(8); PG8_WAIT_L(0); PG8_BAR; PG8_MMA(1, 0, At, B0); PG8_MMA(1, 1, At, B1); PG8_BAR; PG8_SCHED;
        }
        if constexpr (ALIGN_EPI) { if (wr == 0) PG8_BAR; }
        E(acc, cur, wr, wc, fr, fq);
        if (!has_next) break;
#pragma unroll
        for (int a = 0; a < 2; ++a)
#pragma unroll
            for (int b = 0; b < 2; ++b)
#pragma unroll
                for (int m = 0; m < 4; ++m)
#pragma unroll
                    for (int n = 0; n < 2; ++n) acc[a][b][m][n] = (f32x4){0.f, 0.f, 0.f, 0.f};
        cur = nxt; cA = nA; cB = nB; ++ui;
#pragma unroll
        for (int h = 0; h < 2; ++h)
#pragma unroll
            for (int i = 0; i < 2; ++i) cvA[h][i] = nvA[h][i];
        if constexpr (ALIGN_EPI) { if (wr == 1) PG8_BAR; }
    }
    PG8_WAIT_V(0);
    if constexpr (!ALIGN_EPI) { if (wr == 0) PG8_BAR; }
    PG8_BAR;
#undef PG8_SA
#undef PG8_SB
#undef PG8_STAGE
#undef PG8_STAGE_A
#undef PG8_LDA
#undef PG8_LDB
#undef PG8_MMA
#undef PG8_WAIT_V
#undef PG8_WAIT_L
#undef PG8_BAR
#undef PG8_SCHED
#undef PG8_CALC_VA
}
}

template <class RowFn>
__device__ __forceinline__ void ngemm_tile(LAS float* sA, LAS float* sB, RowFn rowA, const bf16* Bt, int ldb, int K, float (&acc)[4][4]) {
    const int tid = threadIdx.x, tx = tid & 15, ty = tid >> 4;
#pragma unroll
    for (int i = 0; i < 4; ++i)
#pragma unroll
        for (int j = 0; j < 4; ++j) acc[i][j] = 0.f;
    const int ar = tid >> 2, ak = (tid & 3) * 8, br = tid >> 3, bk = (tid & 7) * 4;
    const bf16* ap = rowA(ar);
    const bf16* bp = Bt + (size_t)br * ldb;
    for (int k0 = 0; k0 < K; k0 += 32) {
        u32x4 av = (u32x4){0u, 0u, 0u, 0u};
        if (ap) av = *(const u32x4*)(ap + k0 + ak);
        const u32x2 bv = *(const u32x2*)(bp + k0 + bk);
        __syncthreads();
        LAS float* wa = sA + ar * 33 + ak;
        wa[0] = bflo(av.x); wa[1] = bfhi(av.x); wa[2] = bflo(av.y); wa[3] = bfhi(av.y); wa[4] = bflo(av.z); wa[5] = bfhi(av.z); wa[6] = bflo(av.w); wa[7] = bfhi(av.w);
        LAS float* wb = sB + br * 33 + bk;
        wb[0] = bflo(bv.x); wb[1] = bfhi(bv.x); wb[2] = bflo(bv.y); wb[3] = bfhi(bv.y);
        __syncthreads();
#pragma unroll 8
        for (int kk = 0; kk < 32; ++kk) {
            float a[4], b[4];
#pragma unroll
            for (int i = 0; i < 4; ++i) a[i] = sA[(ty * 4 + i) * 33 + kk];
#pragma unroll
            for (int j = 0; j < 4; ++j) b[j] = sB[(tx * 4 + j) * 33 + kk];
#pragma unroll
            for (int i = 0; i < 4; ++i)
#pragma unroll
                for (int j = 0; j < 4; ++j) acc[i][j] = fmaf(a[i], b[j], acc[i][j]);
        }
    }
}

__device__ __forceinline__ void tr_item(const float* W, int ldw, bf16* WT, int ldt, LAS float* scr, int kb, int nb, int lane) {
    const int k0 = 64 * kb, n0 = 32 * nb;
#pragma unroll 8
    for (int i = 0; i < 32; ++i) { const int kk = 2 * i + (lane >> 5); scr[kk * 33 + (lane & 31)] = W[(size_t)(k0 + kk) * ldw + n0 + (lane & 31)]; }
    LDS_WAIT(); asm volatile("" ::: "memory");
    const int c = lane & 7;
#pragma unroll
    for (int j = 0; j < 4; ++j) { const int n = (lane >> 3) + 8 * j; const LAS float* s = scr + (8 * c) * 33 + n;
        u32x4 o; o.x = pk2(s[0 * 33], s[1 * 33]); o.y = pk2(s[2 * 33], s[3 * 33]); o.z = pk2(s[4 * 33], s[5 * 33]); o.w = pk2(s[6 * 33], s[7 * 33]);
        *(u32x4*)(WT + (size_t)(n0 + n) * ldt + k0 + 8 * c) = o; }
    LDS_WAIT(); asm volatile("" ::: "memory");
}

__device__ __forceinline__ void ph0_convert(Frame& F) {
    LAS float* scr = (LAS float*)(F.lds + F.wave * 9216);
    LAS float* gw = (LAS float*)(F.lds + 8 * 9216);
    const float* w0 = F.in[1];
    for (int i = F.tid; i < 8 * 1024; i += NT) { const int j = i >> 10, k = i & 1023; gw[i] = w0[(size_t)k * IN0 + 2048 + j]; }
    __syncthreads();
    const int gwv = F.vcu * NWAVES + F.wave, NGW = F.G * NWAVES;
    bf16* WT0 = (bf16*)(F.ws + WS_WT0); bf16* WO0 = (bf16*)(F.ws + WS_WO0); bf16* WT1 = (bf16*)(F.ws + WS_WT1); bf16* WO1 = (bf16*)(F.ws + WS_WO1);
    constexpr int I0 = 16 * 64, I1 = 16 * 64, I2 = 16 * 32, I3 = 16 * 144, I4 = 8 * 32, NI = I0 + I1 + I2 + I3 + I4;
    for (int it = gwv; it < NI; it += NGW) {
        int r = it;
        if (r < I0) { tr_item(w0, IN0, WT0, 1024, scr, r / 64, r % 64, F.lane); continue; } r -= I0;
        if (r < I1) { tr_item(w0 + 2056, IN0, WT0 + (size_t)2048 * 1024, 1024, scr, r / 64, r % 64, F.lane); continue; } r -= I1;
        if (r < I2) { tr_item(F.in[8], 1024, WO0, 1024, scr, r / 32, r % 32, F.lane); continue; } r -= I2;
        if (r < I3) { tr_item(F.in[9], IN1, WT1, 1024, scr, r / 144, r % 144, F.lane); continue; } r -= I3;
        tr_item(F.in[10], 1024, WO1, 512, scr, r / 32, r % 32, F.lane);
    }
    for (int it = gwv; it < 64; it += NGW) { const int layer = it >> 5, e = it & 31;
        const float* rw = F.in[11]; const float* lg = F.in[16] + (size_t)(layer * 2) * D; const float* lb = F.in[17] + (size_t)(layer * 2) * D;
        bf16* th = (bf16*)((char*)F.ctl + CB_GWT) + (size_t)((layer * 2 + 0) * 32 + e) * GWS; bf16* tl = (bf16*)((char*)F.ctl + CB_GWT) + (size_t)((layer * 2 + 1) * 32 + e) * GWS;
        float s1 = 0.f, s2 = 0.f;
        for (int k = F.lane; k < D; k += 64) { const float wv = rw[(size_t)k * 32 + e], gw = lg[k] * wv; const unsigned hi = f2bf(gw); const float rem = gw - bf2f(hi);
            th[k] = (bf16)hi; tl[k] = (bf16)f2bf(rem); s1 += gw; s2 += lb[k] * wv; }
        s1 = wave_sum(s1); s2 = wave_sum(s2);
        if (F.lane == 0) { float* c12 = (float*)((char*)F.ctl + CB_C12) + layer * 64; c12[e] = s1; c12[32 + e] = s2; } }
    const float* x = F.in[0]; bf16* XB = (bf16*)(F.ws + WS_XB); float* G = (float*)(F.ws + WS_G);
    const float* ib = F.in[2]; const float* fb = F.in[3];
    f32x4 nx[4];
    if (gwv < M) { const f32x4* xr = (const f32x4*)(x + (size_t)gwv * D) + F.lane;
#pragma unroll
        for (int j = 0; j < 4; ++j) nx[j] = xr[64 * j]; }
    for (int m = gwv; m < M; m += NGW) {
        f32x4 v[4];
#pragma unroll
        for (int j = 0; j < 4; ++j) v[j] = nx[j];
        if (m + NGW < M) { const f32x4* xr = (const f32x4*)(x + (size_t)(m + NGW) * D) + F.lane;
#pragma unroll
            for (int j = 0; j < 4; ++j) nx[j] = xr[64 * j]; }
        unsigned long long* o8 = (unsigned long long*)(XB + (size_t)m * D) + F.lane;
#pragma unroll
        for (int j = 0; j < 4; ++j) o8[64 * j] = (unsigned long long)pk2(v[j].x, v[j].y) | ((unsigned long long)pk2(v[j].z, v[j].w) << 32);
        float acc[8];
#pragma unroll
        for (int g = 0; g < 8; ++g) { float a = 0.f;
#pragma unroll
            for (int j = 0; j < 4; ++j) { const f32x4 w = *(const LAS f32x4*)(gw + g * 1024 + 4 * F.lane + 256 * j); a += v[j].x * w.x + v[j].y * w.y + v[j].z * w.z + v[j].w * w.w; }
            acc[g] = wave_sum(a); }
        if (F.lane == 0) {
#pragma unroll
            for (int g = 0; g < 4; ++g) G[(size_t)m * 8 + g] = acc[g] + ib[g];
#pragma unroll
            for (int g = 0; g < 4; ++g) { const float z = acc[4 + g] + fb[g]; G[(size_t)m * 8 + 4 + g] = fminf(z, 0.f) - log1pf(__expf(-fabsf(z))); }
        }
    }
}

__device__ __forceinline__ void convert_experts(Frame& F, int layer) {
    LAS float* scr = (LAS float*)(F.lds + F.wave * 9216);
    const int gwv = F.vcu * NWAVES + F.wave, NGW = F.G * NWAVES;
    const float* wg = F.in[13] + (size_t)layer * NE * D * DE; const float* wu = F.in[14] + (size_t)layer * NE * D * DE; const float* wd = F.in[15] + (size_t)layer * NE * DE * D;
    for (int it = gwv; it < NE * 384; it += NGW) {
        const int e = it / 384; int r = it % 384;
        bf16* GU = (bf16*)(F.ws + WS_EW + (size_t)e * EW_STRIDE); bf16* DN = (bf16*)(F.ws + WS_EW + (size_t)e * EW_STRIDE + EW_DN);
        if (r < 256) { const int job = r >> 6, q = r & 63;
            const float* src = ((job < 2) ? wg : wu) + (size_t)e * D * DE + (job & 1) * 128;
            bf16* dst = GU + (size_t)((job & 1) * 256 + (job >> 1) * 128) * 1024;
            tr_item(src, DE, dst, 1024, scr, q >> 2, q & 3, F.lane);
        } else { r -= 256;
            tr_item(wd + (size_t)e * DE * D, D, DN, DE, scr, r >> 5, r & 31, F.lane); }
    }
}

__device__ __forceinline__ void ph_inproj_naive(Frame& F, const bf16* Bt, int N) {
    LAS float* sA = (LAS float*)F.lds; LAS float* sB = sA + 128 * 33;
    const bf16* XB = (const bf16*)(F.ws + WS_XB); bf16* P = (bf16*)(F.ws + WS_P);
    const int nnb = N / 64, ntiles = (M / 128) * nnb, tx = F.tid & 15, ty = F.tid >> 4;
    for (int t = blockIdx.x; t < ntiles; t += F.G) {
        const int mb = t / nnb, nb = t % nnb; float acc[4][4];
        ngemm_tile(sA, sB, [&](int r) { return XB + (size_t)(mb * 128 + r) * D; }, Bt + (size_t)nb * 64 * D, D, D, acc);
#pragma unroll
        for (int i = 0; i < 4; ++i) { u32x2 o; o.x = pk2(acc[i][0], acc[i][1]); o.y = pk2(acc[i][2], acc[i][3]);
            *(u32x2*)(P + (size_t)(mb * 128 + ty * 4 + i) * N + nb * 64 + tx * 4) = o; }
    }
}
__device__ __forceinline__ void ph_outproj_naive(Frame& F, const bf16* A, int K, const bf16* Bt, const float* base) {
    LAS float* sA = (LAS float*)F.lds; LAS float* sB = sA + 128 * 33;
    const int nnb = D / 64, ntiles = (M / 128) * nnb, tx = F.tid & 15, ty = F.tid >> 4;
    for (int t = blockIdx.x; t < ntiles; t += F.G) {
        const int mb = t / nnb, nb = t % nnb; float acc[4][4];
        ngemm_tile(sA, sB, [&](int r) { return A + (size_t)(mb * 128 + r) * K; }, Bt + (size_t)nb * 64 * K, K, K, acc);
#pragma unroll
        for (int i = 0; i < 4; ++i) { const size_t off = (size_t)(mb * 128 + ty * 4 + i) * D + nb * 64 + tx * 4;
            const f32x4 b = *(const f32x4*)(base + off);
            *(f32x4*)(F.out + off) = (f32x4){ALPHA * b.x + acc[i][0], ALPHA * b.y + acc[i][1], ALPHA * b.z + acc[i][2], ALPHA * b.w + acc[i][3]}; }
    }
}

__device__ __forceinline__ void ph_conv_naive(Frame& F) {
    const bf16* P = (const bf16*)(F.ws + WS_P); bf16* QKC = (bf16*)(F.ws + WS_QKC);
    const float* cw = F.in[4]; const float* cb = F.in[5];
    const size_t total = (size_t)M * 1024, nth = (size_t)F.G * NT;
    for (size_t i = (size_t)blockIdx.x * NT + F.tid; i < total; i += nth) {
        const int m = (int)(i >> 10), c = (int)(i & 1023), t = m & (T - 1);
        float a = cb[c];
#pragma unroll
        for (int j = 0; j < 4; ++j) { const int tt = t - 3 + j; if (tt >= 0) a += cw[j * 1024 + c] * bf2f(P[(size_t)(m - 3 + j) * NP0 + c]); }
        QKC[i] = (bf16)f2bf(siluf_(a));
    }
}
__device__ __forceinline__ void ph_recurrent_naive(Frame& F) {
    if (blockIdx.x >= 16) return;
    const int type = blockIdx.x >> 3, b = (blockIdx.x >> 2) & 1, h = blockIdx.x & 3;
    LAS float* sin = (LAS float*)F.lds;
    LAS float* red = sin + 1024;
    LAS float* redd = red + 512;
    LAS float* sc = redd + 4;
    const bf16* P = (const bf16*)(F.ws + WS_P); const bf16* QKC = (const bf16*)(F.ws + WS_QKC); const float* G = (const float*)(F.ws + WS_G);
    bf16* Y = (bf16*)(F.ws + WS_Y);
    const float* gain = (type == 0 ? F.in[6] : F.in[7]) + h * 128;
    const int e = F.tid & 127, dg = F.tid >> 7, which = dg;
    const float gamma = 1.f - exp2f(-5.f - (float)h);
    float C[32], nn[32];
#pragma unroll
    for (int j = 0; j < 32; ++j) { C[j] = 0.f; nn[j] = 0.f; }
    const bf16* src; size_t stride;
    if (type == 0) { if (which < 2) { src = QKC + which * 512 + h * 128 + e; stride = 1024; } else { src = P + 1024 + (which - 2) * 512 + h * 128 + e; stride = NP0; } }
    else { src = P + 2048 + which * 512 + h * 128 + e; stride = NP0; }
    const float mul = (which == 1) ? KSCALE : 1.f;
    const size_t m0 = (size_t)b * T;
    float val = bf2f(src[m0 * stride]) * mul;
    float s0 = 0.f, s1 = 0.f;
    if (F.tid == 0) { if (type == 0) { s0 = __expf(G[m0 * 8 + 4 + h]); s1 = __expf(G[m0 * 8 + h]); } else { s0 = gamma; s1 = 1.f; } }
    for (int t = 0; t < T; ++t) {
        const size_t m = m0 + t; const int pb = t & 1;
        sin[pb * 512 + F.tid] = val;
        if (F.tid == 0) { sc[pb * 2] = s0; sc[pb * 2 + 1] = s1; }
        if (t + 1 < T) { val = bf2f(src[(m + 1) * stride]) * mul;
            if (F.tid == 0 && type == 0) { s0 = __expf(G[(m + 1) * 8 + 4 + h]); s1 = __expf(G[(m + 1) * 8 + h]); } }
        __syncthreads();
        const float f = sc[pb * 2], ig = sc[pb * 2 + 1];
        const LAS float* sq = sin + pb * 512; const LAS float* sk = sq + 128; const LAS float* sv = sq + 256; const LAS float* so = sq + 384;
        const float ve = sv[e] * ig;
        float pn = 0.f, pd = 0.f;
#pragma unroll
        for (int j = 0; j < 32; ++j) { const int d = dg * 32 + j; const float kd = sk[d], qd = sq[d];
            C[j] = fmaf(f, C[j], kd * ve); nn[j] = fmaf(f, nn[j], ig * kd); pn = fmaf(C[j], qd, pn); pd = fmaf(nn[j], qd, pd); }
        red[dg * 128 + e] = pn; if (e == 0) redd[dg] = pd;
        __syncthreads();
        if (F.tid < 64) {
            const int e0 = F.tid, e1 = F.tid + 64;
            float h0 = (red[e0] + red[128 + e0]) + (red[256 + e0] + red[384 + e0]);
            float h1 = (red[e1] + red[128 + e1]) + (red[256 + e1] + red[384 + e1]);
            if (type == 0) { const float den = (redd[0] + redd[1]) + (redd[2] + redd[3]); const float dn = fmaxf(fabsf(den), 1.f);
                h0 = h0 / dn * sigmoidf_(so[e0]); h1 = h1 / dn * sigmoidf_(so[e1]); }
            const float mean = wave_sum(h0 + h1) * (1.f / 128.f); const float d0 = h0 - mean, d1 = h1 - mean;
            const float rstd = 1.f / sqrtf(wave_sum(d0 * d0 + d1 * d1) * (1.f / 128.f) + LN_EPS);
            float y0 = d0 * rstd * gain[e0], y1 = d1 * rstd * gain[e1];
            if (type == 1) { y0 *= siluf_(so[e0]); y1 *= siluf_(so[e1]); }
            Y[m * 1024 + type * 512 + h * 128 + e0] = (bf16)f2bf(y0); Y[m * 1024 + type * 512 + h * 128 + e1] = (bf16)f2bf(y1);
        }
    }
}

constexpr size_t WS_S = WS_SE;
constexpr size_t WS_DN = WS_G + 768 * 1024;
constexpr size_t WS_QKC2 = WS_SE + 32 * MiB;
constexpr size_t WS_SCANV = WS_P + 128 * MiB;
constexpr int CB_GL = 512 * 1024, CB_MSC = 520 * 1024;
constexpr int TRS = 144, RWS = 136;
template <int O0, int O1>
__device__ __forceinline__ void tr2(unsigned a, u32x2& r0, u32x2& r1) {
    asm volatile("ds_read_b64_tr_b16 %0, %2 offset:%3\n\tds_read_b64_tr_b16 %1, %2 offset:%4\n\ts_waitcnt lgkmcnt(0)" : "=&v"(r0), "=&v"(r1) : "v"(a), "i"(O0), "i"(O1) : "memory");
}
template <int B, int H>
__device__ __forceinline__ void tr8(unsigned a, u32x2& r0, u32x2& r1, u32x2& r2, u32x2& r3, u32x2& r4, u32x2& r5, u32x2& r6, u32x2& r7) {
    asm volatile("ds_read_b64_tr_b16 %0, %8 offset:%9\n\tds_read_b64_tr_b16 %1, %8 offset:%10\n\tds_read_b64_tr_b16 %2, %8 offset:%11\n\tds_read_b64_tr_b16 %3, %8 offset:%12\n\t"
                 "ds_read_b64_tr_b16 %4, %8 offset:%13\n\tds_read_b64_tr_b16 %5, %8 offset:%14\n\tds_read_b64_tr_b16 %6, %8 offset:%15\n\tds_read_b64_tr_b16 %7, %8 offset:%16\n\ts_waitcnt lgkmcnt(0)"
                 : "=&v"(r0), "=&v"(r1), "=&v"(r2), "=&v"(r3), "=&v"(r4), "=&v"(r5), "=&v"(r6), "=&v"(r7)
                 : "v"(a), "i"(B), "i"(B + H), "i"(B + 32), "i"(B + 32 + H), "i"(B + 64), "i"(B + 64 + H), "i"(B + 96), "i"(B + 96 + H) : "memory");
}
__device__ __forceinline__ bf16x8_t pack_frag(u32x2 a, u32x2 b) { return __builtin_bit_cast(bf16x8_t, (u32x4){a.x, a.y, b.x, b.y}); }
__device__ __forceinline__ void scan128_sum(float& x0, float& x1, int lane) {
#pragma unroll
    for (int o = 1; o < 64; o <<= 1) { const float t0 = __shfl_up(x0, o), t1 = __shfl_up(x1, o); if (lane >= o) { x0 += t0; x1 += t1; } }
    x1 += __shfl(x0, 63);
}
__device__ __forceinline__ void scan128_max(float& x0, float& x1, int lane) {
#pragma unroll
    for (int o = 1; o < 64; o <<= 1) { const float t0 = __shfl_up(x0, o), t1 = __shfl_up(x1, o); if (lane >= o) { x0 = fmaxf(x0, t0); x1 = fmaxf(x1, t1); } }
    x1 = fmaxf(x1, __shfl(x0, 63));
}
__device__ __forceinline__ float wave_max(float v) {
#pragma unroll
    for (int o = 1; o < 64; o <<= 1) v = fmaxf(v, __shfl_xor(v, o));
    return v;
}
__device__ __forceinline__ void conv8(const bf16* Pc, int row, int tpos0, const LAS float* cwp, float (&o)[8]) {
    { const f32x4 b0 = *(const LAS f32x4*)(cwp + 512), b1 = *(const LAS f32x4*)(cwp + 516); o[0] = b0.x; o[1] = b0.y; o[2] = b0.z; o[3] = b0.w; o[4] = b1.x; o[5] = b1.y; o[6] = b1.z; o[7] = b1.w; }
#pragma unroll
    for (int j = 0; j < 4; ++j) { const int r = row - 3 + j;
        if (tpos0 + r >= 0) { const u32x4 x = *(const u32x4*)(Pc + (long)r * NP0); const f32x4 w0 = *(const LAS f32x4*)(cwp + j * 128), w1 = *(const LAS f32x4*)(cwp + j * 128 + 4);
            o[0] += w0.x * bflo(x.x); o[1] += w0.y * bfhi(x.x); o[2] += w0.z * bflo(x.y); o[3] += w0.w * bfhi(x.y); o[4] += w1.x * bflo(x.z); o[5] += w1.y * bfhi(x.z); o[6] += w1.z * bflo(x.w); o[7] += w1.w * bfhi(x.w); } }
#pragma unroll
    for (int e = 0; e < 8; ++e) o[e] = siluf_(o[e]);
}
__device__ __forceinline__ u32x4 pack8(const float (&o)[8], float sc) {
    u32x4 w; w.x = pg8::cvt_pk_bf16(o[0] * sc, o[1] * sc); w.y = pg8::cvt_pk_bf16(o[2] * sc, o[3] * sc); w.z = pg8::cvt_pk_bf16(o[4] * sc, o[5] * sc); w.w = pg8::cvt_pk_bf16(o[6] * sc, o[7] * sc); return w; }
__device__ __forceinline__ void unpack8(u32x4 x, float (&o)[8]) { o[0] = bflo(x.x); o[1] = bfhi(x.x); o[2] = bflo(x.y); o[3] = bfhi(x.y); o[4] = bflo(x.z); o[5] = bfhi(x.z); o[6] = bflo(x.w); o[7] = bfhi(x.w); }

__device__ __forceinline__ void ph_mix_a(Frame& F) {
    LAS bf16* Vl = (LAS bf16*)F.lds;
    LAS bf16* Kl = Vl + 128 * TRS;
    LAS float* cwl = (LAS float*)(Kl + 128 * TRS);
    LAS float* wl = cwl + 1280;
    const bf16* P = (const bf16*)(F.ws + WS_P); const float* G = (const float*)(F.ws + WS_G); bf16* S = (bf16*)(F.ws + WS_S); float* DN = (float*)(F.ws + WS_DN);
    float* GL = (float*)((char*)F.ctl + CB_GL); bf16* QKC = (bf16*)(F.ws + WS_QKC2); float* SCANV = (float*)(F.ws + WS_SCANV);
    const float* cw = F.in[4]; const float* cb = F.in[5];
    const int tid = F.tid, lane = F.lane, w = F.wave, fr = lane & 15, fq = lane >> 4;
    const unsigned vaddr = (unsigned)(size_t)Vl + (unsigned)(((4 * fq + (fr >> 2)) * TRS + 16 * w + 4 * (fr & 3)) * 2);
    const unsigned kaddr = (unsigned)(size_t)Kl + (unsigned)(((4 * fq + (fr >> 2)) * TRS + 4 * (fr & 3)) * 2);
    for (int u = blockIdx.x; u < 1024; u += F.G) {
        const int type = u >> 9, b = (u >> 8) & 1, h = (u >> 6) & 3, c = u & 63, chain = type * 8 + b * 4 + h;
        const size_t m0 = (size_t)b * T + c * 128;
        const int kcol = (type == 0 ? 512 : 2560) + h * 128, vcol = (type == 0 ? 1024 : 3072) + h * 128;
        __syncthreads();
        if (type == 0) for (int i = tid; i < 1280; i += NT) { const int part = i / 640, r = i % 640, j = r >> 7, d = r & 127, col = part * 512 + h * 128 + d; cwl[i] = j < 4 ? cw[j * 1024 + col] : cb[col]; }
        if (w == 0) {
            float w0, w1;
            if (type == 0) {
                const float i0 = G[(m0 + lane) * 8 + h], i1 = G[(m0 + lane + 64) * 8 + h];
                float b0 = G[(m0 + lane) * 8 + 4 + h], b1 = G[(m0 + lane + 64) * 8 + 4 + h];
                scan128_sum(b0, b1, lane);
                const float g = __shfl(b1, 63), lw0 = g - b0 + i0, lw1 = g - b1 + i1, ml = wave_max(fmaxf(lw0, lw1));
                w0 = __expf(lw0 - ml); w1 = __expf(lw1 - ml);
                if (lane == 0) { GL[(chain * 64 + c) * 2] = g; GL[(chain * 64 + c) * 2 + 1] = ml; }
                const float u0 = i0 - b0, u1 = i1 - b1; float p0 = u0, p1 = u1; scan128_max(p0, p1, lane);
                float* sv = SCANV + (size_t)(chain * 64 + c) * 384; sv[lane] = b0; sv[lane + 64] = b1; sv[128 + lane] = u0; sv[192 + lane] = u1; sv[256 + lane] = p0; sv[320 + lane] = p1;
            } else { const float lg = log1pf(-exp2f(-5.f - (float)h)); w0 = __expf(lg * (float)(127 - lane)); w1 = __expf(lg * (float)(63 - lane)); }
            wl[lane] = w0 * KSCALE; wl[lane + 64] = w1 * KSCALE;
        }
#pragma unroll
        for (int it = 0; it < 4; ++it) { const int s = (tid >> 4) + 32 * it, ch = tid & 15;
            *(LAS u32x4*)(Vl + s * TRS + ch * 8) = *(const u32x4*)(P + (m0 + s) * NP0 + vcol + ch * 8); }
        __syncthreads();
#pragma unroll
        for (int it = 0; it < 4; ++it) { const int s = (tid >> 4) + 32 * it, ch = tid & 15; float o[8];
            if (type == 0) { conv8(P + m0 * NP0 + kcol + ch * 8, s, c * 128, cwl + 640 + ch * 8, o); *(u32x4*)(QKC + (m0 + s) * 1024 + 512 + h * 128 + ch * 8) = pack8(o, KSCALE); }
            else unpack8(*(const u32x4*)(P + (m0 + s) * NP0 + kcol + ch * 8), o);
            *(LAS u32x4*)(Kl + s * TRS + ch * 8) = pack8(o, wl[s]); }
        __syncthreads();
        f32x4 acc[8], accn = (f32x4){0.f, 0.f, 0.f, 0.f};
#pragma unroll
        for (int dt = 0; dt < 8; ++dt) acc[dt] = (f32x4){0.f, 0.f, 0.f, 0.f};
        const bf16x8_t ones = (bf16x8_t){0x3F80, 0x3F80, 0x3F80, 0x3F80, 0x3F80, 0x3F80, 0x3F80, 0x3F80};
#pragma unroll
        for (int ks = 0; ks < 4; ++ks) {
            u32x2 a0, a1, n0, n1, b0, b1, b2, b3, b4, b5, b6, b7, c0, c1, c2, c3, c4, c5, c6, c7;
            tr2<0, 16 * TRS * 2>(vaddr + ks * 32 * TRS * 2, a0, a1);
            tr2<0, 16 * TRS * 2>(kaddr + ks * 32 * TRS * 2 + 32 * w, n0, n1);
            tr8<0, 16 * TRS * 2>(kaddr + ks * 32 * TRS * 2, b0, b1, b2, b3, b4, b5, b6, b7);
            tr8<128, 16 * TRS * 2>(kaddr + ks * 32 * TRS * 2, c0, c1, c2, c3, c4, c5, c6, c7);
            __builtin_amdgcn_sched_barrier(0);
            const bf16x8_t A = pack_frag(a0, a1);
            acc[0] = __builtin_amdgcn_mfma_f32_16x16x32_bf16(pack_frag(b0, b1), A, acc[0], 0, 0, 0);
            acc[1] = __builtin_amdgcn_mfma_f32_16x16x32_bf16(pack_frag(b2, b3), A, acc[1], 0, 0, 0);
            acc[2] = __builtin_amdgcn_mfma_f32_16x16x32_bf16(pack_frag(b4, b5), A, acc[2], 0, 0, 0);
            acc[3] = __builtin_amdgcn_mfma_f32_16x16x32_bf16(pack_frag(b6, b7), A, acc[3], 0, 0, 0);
            acc[4] = __builtin_amdgcn_mfma_f32_16x16x32_bf16(pack_frag(c0, c1), A, acc[4], 0, 0, 0);
            acc[5] = __builtin_amdgcn_mfma_f32_16x16x32_bf16(pack_frag(c2, c3), A, acc[5], 0, 0, 0);
            acc[6] = __builtin_amdgcn_mfma_f32_16x16x32_bf16(pack_frag(c4, c5), A, acc[6], 0, 0, 0);
            acc[7] = __builtin_amdgcn_mfma_f32_16x16x32_bf16(pack_frag(c6, c7), A, acc[7], 0, 0, 0);
            accn = __builtin_amdgcn_mfma_f32_16x16x32_bf16(pack_frag(n0, n1), ones, accn, 0, 0, 0);
        }
        bf16* Sp = S + ((size_t)(chain * 64 + c) * 128 + 16 * w + fr) * 128 + 4 * fq;
#pragma unroll
        for (int dt = 0; dt < 8; ++dt) { u32x2 wv; wv.x = pg8::cvt_pk_bf16(acc[dt][0], acc[dt][1]); wv.y = pg8::cvt_pk_bf16(acc[dt][2], acc[dt][3]); *(u32x2*)(Sp + 16 * dt) = wv; }
        if (type == 0 && fr == 0) *(f32x4*)(DN + (size_t)(chain * 64 + c) * 128 + 16 * w + 4 * fq) = accn;
        if (type == 0) {
#pragma unroll
            for (int it = 0; it < 4; ++it) { const int s = (tid >> 4) + 32 * it, ch = tid & 15; float o[8];
                conv8(P + m0 * NP0 + h * 128 + ch * 8, s, c * 128, cwl + ch * 8, o); *(u32x4*)(QKC + (m0 + s) * 1024 + h * 128 + ch * 8) = pack8(o, 1.f); } }
    }
}

__device__ __forceinline__ void ph_mix_b(Frame& F) {
    LAS float* gl = (LAS float*)F.lds; LAS float* dec = gl + 1024; LAS float* scl = dec + 512;
    const float* GL = (const float*)((char*)F.ctl + CB_GL); float* MSC = (float*)((char*)F.ctl + CB_MSC);
    bf16* S = (bf16*)(F.ws + WS_S); float* DN = (float*)(F.ws + WS_DN);
    for (int i = F.tid; i < 1024; i += NT) gl[i] = GL[i];
    __syncthreads();
    if (F.tid < 8) { float m = 0.f;
        for (int c = 0; c < 64; ++c) { const float g = gl[(F.tid * 64 + c) * 2], ml = gl[(F.tid * 64 + c) * 2 + 1];
            if (blockIdx.x == 0) MSC[F.tid * 64 + c] = m;
            const float mn = fmaxf(g + m, ml); dec[F.tid * 64 + c] = __expf(g + m - mn); scl[F.tid * 64 + c] = __expf(ml - mn); m = mn; } }
    __syncthreads();
    for (int j = blockIdx.x * NT + F.tid; j < 131072; j += F.G * NT) {
        const int chain = j >> 13, el = j & 8191;
        unsigned* p = (unsigned*)S + (size_t)chain * 64 * 8192 + el;
        const bool ml = chain < 8;
        const float g128 = __expf(128.f * log1pf(-exp2f(-5.f - (float)(chain & 3))));
        float C0 = 0.f, C1 = 0.f;
        for (int c0 = 0; c0 < 64; c0 += 16) { unsigned x[16];
#pragma unroll
            for (int k = 0; k < 16; ++k) x[k] = p[(size_t)(c0 + k) * 8192];
#pragma unroll
            for (int k = 0; k < 16; ++k) { p[(size_t)(c0 + k) * 8192] = pg8::cvt_pk_bf16(C0, C1);
                const float dk = ml ? dec[(chain & 7) * 64 + c0 + k] : g128, sk = ml ? scl[(chain & 7) * 64 + c0 + k] : 1.f;
                C0 = dk * C0 + sk * bflo(x[k]); C1 = dk * C1 + sk * bfhi(x[k]); } }
    }
    for (int j = blockIdx.x * NT + F.tid; j < 1024; j += F.G * NT) { const int chain = j >> 7, d = j & 127; float* p = DN + (size_t)chain * 64 * 128 + d; float n = 0.f;
        for (int c = 0; c < 64; ++c) { const float x = p[c * 128]; p[c * 128] = n; n = dec[chain * 64 + c] * n + scl[chain * 64 + c] * x; } }
}

template <int VAR>
__device__ __forceinline__ void ph_mix_c(Frame& F) {
    LAS bf16* Kl = (LAS bf16*)F.lds;
    LAS bf16* Vl = Kl + 128 * RWS;
    LAS bf16* Cl = Vl + 128 * TRS;
    LAS float* ul = (LAS float*)(Cl + 144 * RWS);
    const bf16* P = (const bf16*)(F.ws + WS_P); const bf16* S = (const bf16*)(F.ws + WS_S); const float* DN = (const float*)(F.ws + WS_DN);
    const bf16* QKC = (const bf16*)(F.ws + WS_QKC2); const float* SCANV = (const float*)(F.ws + WS_SCANV);
    const float* MSC = (const float*)((char*)F.ctl + CB_MSC); bf16* Y = (bf16*)(F.ws + WS_Y);
    const int tid = F.tid, lane = F.lane, w = F.wave, fr = lane & 15, fq = lane >> 4;
    const int lt = w < 4 ? w : 11 - w, l = 16 * lt + fr;
    const unsigned vaddr = (unsigned)(size_t)Vl + (unsigned)(((4 * fq + (fr >> 2)) * TRS + 4 * (fr & 3)) * 2);
    for (int u = blockIdx.x; u < 1024; u += F.G) {
        const int type = u >> 9, b = (u >> 8) & 1, h = (u >> 6) & 3, c = u & 63, chain = type * 8 + b * 4 + h;
        const size_t m0 = (size_t)b * T + c * 128;
        const int base = type == 0 ? 0 : 2048, vcol = base + 1024 + h * 128, gcol = base + 1536 + h * 128;
        const bf16* Kg = type == 0 ? QKC + m0 * 1024 + 512 + h * 128 : P + m0 * NP0 + 2560 + h * 128;
        const bf16* Qg = type == 0 ? QKC + m0 * 1024 + h * 128 : P + m0 * NP0 + 2048 + h * 128;
        const size_t ldqk = type == 0 ? 1024 : NP0;
        const float lg = log1pf(-exp2f(-5.f - (float)h));
        __syncthreads();
        float mc = 0.f, b_l = 0.f, pm_l = 0.f;
        if (type == 0) { const float* sv = SCANV + (size_t)((b * 4 + h) * 64 + c) * 384; mc = MSC[(b * 4 + h) * 64 + c]; b_l = sv[l]; pm_l = sv[256 + l]; if (tid < 128) ul[tid] = sv[128 + tid]; }
        bf16x8_t qf[4];
#pragma unroll
        for (int ks = 0; ks < 4; ++ks) qf[ks] = *(const bf16x8_t*)(Qg + (size_t)l * ldqk + 32 * ks + 8 * fq);
        if (VAR != 2)
#pragma unroll
        for (int it = 0; it < 4; ++it) { const int s = (tid >> 4) + 32 * it, ch = tid & 15;
            *(LAS u32x4*)(Kl + s * RWS + ch * 8) = *(const u32x4*)(Kg + (size_t)s * ldqk + ch * 8);
            *(LAS u32x4*)(Vl + s * TRS + ch * 8) = *(const u32x4*)(P + (m0 + s) * NP0 + vcol + ch * 8);
            *(LAS u32x4*)(Cl + s * RWS + ch * 8) = *(const u32x4*)(S + ((size_t)(chain * 64 + c) * 128 + s) * 128 + ch * 8); }
        if (tid < 256) { const int r = tid >> 4, ch = tid & 15; u32x4 wv = (u32x4){0u, 0u, 0u, 0u};
            if (type == 0 && r == 0) { const float* np = DN + (size_t)((b * 4 + h) * 64 + c) * 128 + ch * 8; const f32x4 x0 = *(const f32x4*)np, x1 = *(const f32x4*)(np + 4);
                wv.x = pg8::cvt_pk_bf16(x0.x, x0.y); wv.y = pg8::cvt_pk_bf16(x0.z, x0.w); wv.z = pg8::cvt_pk_bf16(x1.x, x1.y); wv.w = pg8::cvt_pk_bf16(x1.z, x1.w); }
            *(LAS u32x4*)(Cl + (128 + r) * RWS + ch * 8) = wv; }
        __syncthreads();
        if (VAR == 1) { if (qf[0][0] == 12345 && qf[1][1] == 7 && qf[2][2] == 9 && qf[3][3] == 11) Y[tid] = 0; continue; }
        f32x4 st[8];
#pragma unroll
        for (int t = 0; t < 8; ++t) { st[t] = (f32x4){0.f, 0.f, 0.f, 0.f};
            if (t <= lt) {
#pragma unroll
                for (int ks = 0; ks < 4; ++ks) st[t] = __builtin_amdgcn_mfma_f32_16x16x32_bf16(*(const LAS bf16x8_t*)(Kl + (16 * t + fr) * RWS + 32 * ks + 8 * fq), qf[ks], st[t], 0, 0, 0); }
            if (t & 1) __builtin_amdgcn_sched_barrier(0); }
        int lz = l, fz = 4 * fq; asm volatile("" : "+v"(lz), "+v"(fz));
        const float Mme = (type == 0) ? fmaxf(mc, pm_l) : 0.f;
        float den = 0.f;
#pragma unroll
        for (int t = 0; t < 8; ++t) if (t <= lt) {
#pragma unroll
            for (int rg = 0; rg < 4; ++rg) { const int s = 16 * t + fz + rg;
                float e = (type == 0) ? (ul[s] - Mme) : (lg * (float)(lz - s) - 2.42601513f  ); e = (s <= lz) ? e : -1e30f;
                const float p = st[t][rg] * __expf(e); st[t][rg] = p; den += p; } }
        den += __shfl_xor(den, 16); den += __shfl_xor(den, 32);
        f32x4 o1[8], o2[9];
#pragma unroll
        for (int et = 0; et < 8; ++et) o1[et] = (f32x4){0.f, 0.f, 0.f, 0.f};
#pragma unroll
        for (int et = 0; et < 9; ++et) o2[et] = (f32x4){0.f, 0.f, 0.f, 0.f};
#pragma unroll
        for (int j = 0; j < 4; ++j) if (2 * j <= lt) {
            u32x4 pw; pw.x = pg8::cvt_pk_bf16(st[2 * j][0], st[2 * j][1]); pw.y = pg8::cvt_pk_bf16(st[2 * j][2], st[2 * j][3]);
            pw.z = pg8::cvt_pk_bf16(st[2 * j + 1][0], st[2 * j + 1][1]); pw.w = pg8::cvt_pk_bf16(st[2 * j + 1][2], st[2 * j + 1][3]);
            const bf16x8_t pf = __builtin_bit_cast(bf16x8_t, pw);
            u32x2 b0, b1, b2, b3, b4, b5, b6, b7, c0, c1, c2, c3, c4, c5, c6, c7;
            tr8<0, 16 * TRS * 2>(vaddr + j * 32 * TRS * 2, b0, b1, b2, b3, b4, b5, b6, b7);
            tr8<128, 16 * TRS * 2>(vaddr + j * 32 * TRS * 2, c0, c1, c2, c3, c4, c5, c6, c7);
            __builtin_amdgcn_sched_barrier(0);
            o1[0] = __builtin_amdgcn_mfma_f32_16x16x32_bf16(pack_frag(b0, b1), pf, o1[0], 0, 0, 0);
            o1[1] = __builtin_amdgcn_mfma_f32_16x16x32_bf16(pack_frag(b2, b3), pf, o1[1], 0, 0, 0);
            o1[2] = __builtin_amdgcn_mfma_f32_16x16x32_bf16(pack_frag(b4, b5), pf, o1[2], 0, 0, 0);
            o1[3] = __builtin_amdgcn_mfma_f32_16x16x32_bf16(pack_frag(b6, b7), pf, o1[3], 0, 0, 0);
            o1[4] = __builtin_amdgcn_mfma_f32_16x16x32_bf16(pack_frag(c0, c1), pf, o1[4], 0, 0, 0);
            o1[5] = __builtin_amdgcn_mfma_f32_16x16x32_bf16(pack_frag(c2, c3), pf, o1[5], 0, 0, 0);
            o1[6] = __builtin_amdgcn_mfma_f32_16x16x32_bf16(pack_frag(c4, c5), pf, o1[6], 0, 0, 0);
            o1[7] = __builtin_amdgcn_mfma_f32_16x16x32_bf16(pack_frag(c6, c7), pf, o1[7], 0, 0, 0);
        }
        __builtin_amdgcn_sched_barrier(0);
#pragma unroll
        for (int ks = 0; ks < 4; ++ks) {
#pragma unroll
            for (int et = 0; et < 9; ++et) o2[et] = __builtin_amdgcn_mfma_f32_16x16x32_bf16(*(const LAS bf16x8_t*)(Cl + (16 * et + fr) * RWS + 32 * ks + 8 * fq), qf[ks], o2[et], 0, 0, 0);
            __builtin_amdgcn_sched_barrier(0); }
        float inter, rden = 1.f;
        if (type == 0) { inter = __expf(mc - Mme); const float qn = __shfl(o2[8][0], fr); const float dtot = den + inter * qn; rden = 1.f / fmaxf(fabsf(dtot), __expf(-(b_l + Mme))); }
        else inter = __expf(lg * (float)(l + 1));
        const bf16* gp = P + (m0 + l) * NP0 + gcol + 4 * fq;
        float sum = 0.f;
#pragma unroll
        for (int et = 0; et < 8; ++et) { const u32x2 gw = *(const u32x2*)(gp + 16 * et); const float g0 = bflo(gw.x), g1 = bfhi(gw.x), g2 = bflo(gw.y), g3 = bfhi(gw.y);
            f32x4 hv = (o1[et] + o2[et] * inter) * rden;
            if (type == 0) { hv[0] *= sigmoidf_(g0); hv[1] *= sigmoidf_(g1); hv[2] *= sigmoidf_(g2); hv[3] *= sigmoidf_(g3); o2[et] = (f32x4){1.f, 1.f, 1.f, 1.f}; }
            else o2[et] = (f32x4){siluf_(g0), siluf_(g1), siluf_(g2), siluf_(g3)};
            o1[et] = hv; sum += (hv[0] + hv[1]) + (hv[2] + hv[3]); if (et & 1) asm volatile("" ::: "memory"); }
        sum += __shfl_xor(sum, 16); sum += __shfl_xor(sum, 32);
        const float mean = sum * (1.f / 128.f); float sq = 0.f;
#pragma unroll
        for (int et = 0; et < 8; ++et) { o1[et] = o1[et] - mean; sq += (o1[et][0] * o1[et][0] + o1[et][1] * o1[et][1]) + (o1[et][2] * o1[et][2] + o1[et][3] * o1[et][3]); }
        sq += __shfl_xor(sq, 16); sq += __shfl_xor(sq, 32);
        const float rstd = 1.f / sqrtf(sq * (1.f / 128.f) + LN_EPS);
        const float* g6 = F.in[6]; const float* g7 = F.in[7]; asm volatile("" : "+s"(g6), "+s"(g7));
        const float* gain = (type == 0 ? g6 : g7) + h * 128 + 4 * fq;
        bf16* yp = Y + (m0 + l) * 1024 + type * 512 + h * 128 + 4 * fq;
#pragma unroll
        for (int et = 0; et < 8; ++et) { const f32x4 gn = *(const f32x4*)(gain + 16 * et); const f32x4 yv = o1[et] * rstd * gn * o2[et];
            u32x2 wv; wv.x = pg8::cvt_pk_bf16(yv[0], yv[1]); wv.y = pg8::cvt_pk_bf16(yv[2], yv[3]); *(u32x2*)(yp + 16 * et) = wv; if (et & 1) asm volatile("" ::: "memory"); }
    }
}

constexpr int RWT = 1028;
template <int MODE, bool ROUTE, int OUTK>
__device__ __forceinline__ void ph_ln(Frame& F, int layer, bool dry = false) {
    LAS float* rwT = (LAS float*)F.lds;
    LAS int* rsel = (LAS int*)(rwT + 32 * RWT);
    int nrow = 0;
    if (ROUTE) { const float* rw = F.in[11]; for (int i = F.tid; i < 32 * 1024; i += NT) { const int k = i >> 5, e = i & 31; rwT[e * RWT + k] = rw[i]; } __syncthreads(); }
    const int gwv = F.vcu * NWAVES + F.wave, NGW = F.G * NWAVES;
    const float* lg = F.in[16] + (size_t)(layer * 2 + MODE) * D; const float* lb = F.in[17] + (size_t)(layer * 2 + MODE) * D;
    bf16* XB = (bf16*)(F.ws + WS_XB); const bf16* YB = (const bf16*)(F.ws + WS_YB); const bf16* PRE = (const bf16*)((const char*)F.out + 32 * MiB); bf16* RES = (bf16*)F.out;
    int* EIDX = (int*)(F.ws + WS_EIDX); float* GATEV = (float*)(F.ws + WS_GATEV); int* LIST = (int*)(F.ws + WS_LIST);
    unsigned* cnt = F.ctl + CW_CNT + layer * 32 * 64;
    const float* rbias = F.in[12];
    f32x4 gv[4], bv[4];
#pragma unroll
    for (int j = 0; j < 4; ++j) { gv[j] = *((const f32x4*)lg + F.lane + 64 * j); bv[j] = *((const f32x4*)lb + F.lane + 64 * j); }
    u32x2 rx[4], ry0[4], ry1[4]; float rg0 = 0.f, rg1 = 0.f;
#define LN_LOAD(mm) do { if (MODE == 0) { const u32x2* pr = (const u32x2*)(PRE + (size_t)(mm) * D) + F.lane; _Pragma("unroll") for (int j = 0; j < 4; ++j) rx[j] = pr[64 * j]; } \
        else { rg0 = GATEV[2 * (mm)]; rg1 = GATEV[2 * (mm) + 1]; const u32x2* xr = (const u32x2*)(XB + (size_t)(mm) * D) + F.lane; \
            const u32x2* y0 = (const u32x2*)(YB + (size_t)(2 * (mm)) * D) + F.lane; const u32x2* y1 = (const u32x2*)(YB + (size_t)(2 * (mm) + 1) * D) + F.lane; \
            _Pragma("unroll") for (int j = 0; j < 4; ++j) { rx[j] = xr[64 * j]; ry0[j] = y0[64 * j]; ry1[j] = y1[64 * j]; } } } while (0)
    if (gwv < M) LN_LOAD(gwv);
    for (int m = gwv; m < M; m += NGW) {
        f32x4 v[4]; float s = 0.f;
        if (MODE == 0) {
#pragma unroll
            for (int j = 0; j < 4; ++j) { const u32x2 a = rx[j]; v[j] = (f32x4){bflo(a.x), bfhi(a.x), bflo(a.y), bfhi(a.y)}; } }
        else {
            const float g0 = rg0, g1 = rg1;
#pragma unroll
            for (int j = 0; j < 4; ++j) { const u32x2 x = rx[j], a = ry0[j], b = ry1[j];
                v[j].x = ALPHA * bflo(x.x) + g0 * bflo(a.x) + g1 * bflo(b.x); v[j].y = ALPHA * bfhi(x.x) + g0 * bfhi(a.x) + g1 * bfhi(b.x);
                v[j].z = ALPHA * bflo(x.y) + g0 * bflo(a.y) + g1 * bflo(b.y); v[j].w = ALPHA * bfhi(x.y) + g0 * bfhi(a.y) + g1 * bfhi(b.y); }
        }
        if (m + NGW < M) LN_LOAD(m + NGW);
#pragma unroll
        for (int j = 0; j < 4; ++j) s += (v[j].x + v[j].y) + (v[j].z + v[j].w);
        const float mean = wave_sum(s) * (1.f / D); float s2 = 0.f;
#pragma unroll
        for (int j = 0; j < 4; ++j) { v[j] = v[j] - mean; s2 += (v[j].x * v[j].x + v[j].y * v[j].y) + (v[j].z * v[j].z + v[j].w * v[j].w); }
        const float rstd = 1.f / sqrtf(wave_sum(s2) * (1.f / D) + LN_EPS);
#pragma unroll
        for (int j = 0; j < 4; ++j) v[j] = v[j] * rstd * gv[j] + bv[j];
        if (OUTK == 2) { f32x4* orow = (f32x4*)(F.out + (size_t)m * D) + F.lane;
#pragma unroll
            for (int j = 0; j < 4; ++j) orow[64 * j] = v[j]; }
        else { u32x2* o8 = (u32x2*)((OUTK == 0 ? XB : RES) + (size_t)m * D) + F.lane;
#pragma unroll
            for (int j = 0; j < 4; ++j) { u32x2 w; w.x = pg8::cvt_pk_bf16(v[j].x, v[j].y); w.y = pg8::cvt_pk_bf16(v[j].z, v[j].w); o8[64 * j] = w; } }
        if (ROUTE) {
            float pv[32];
#pragma unroll
            for (int e = 0; e < 32; ++e) { float a = 0.f;
#pragma unroll
                for (int j = 0; j < 4; ++j) { const f32x4 w = *(const LAS f32x4*)(rwT + e * RWT + 4 * F.lane + 256 * j); a += v[j].x * w.x + v[j].y * w.y + v[j].z * w.z + v[j].w * w.w; }
                pv[e] = a; if ((e & 7) == 7) __builtin_amdgcn_sched_barrier(0); }
#define LN_HALVE(N, MASK) { const bool up = (F.lane & (MASK)) != 0; _Pragma("unroll") for (int j = 0; j < (N); ++j) { const float keep = up ? pv[(N) + j] : pv[j], send = up ? pv[j] : pv[(N) + j]; pv[j] = keep + __shfl_xor(send, (MASK)); } }
            LN_HALVE(16, 32) LN_HALVE(8, 16) LN_HALVE(4, 8) LN_HALVE(2, 4) LN_HALVE(1, 2)
#undef LN_HALVE
            const float mylog = pv[0] + __shfl_xor(pv[0], 1);
            const int mye = F.lane >> 1;
            const float myaff = 1.f / (1.f + expf(-mylog)), mysel = myaff + rbias[mye];
            float m1 = -1e30f, m2 = -1e30f; int i1 = 0, i2 = 0; float a1 = 0.f, a2 = 0.f;
            const int lbase = F.lane & 48, ebase = (F.lane >> 4) * 8;
#pragma unroll
            for (int j = 0; j < 8; ++j) { const float sv = __shfl(mysel, lbase + 2 * j), av = __shfl(myaff, lbase + 2 * j);
                if (sv > m1) { m2 = m1; i2 = i1; a2 = a1; m1 = sv; i1 = ebase + j; a1 = av; }
                else if (sv > m2) { m2 = sv; i2 = ebase + j; a2 = av; } }
            const float score = m1 + m2;
            float bestscore = -1e30f; int bg = 0;
#pragma unroll
            for (int g = 0; g < 4; ++g) { const float sg = __shfl(score, 16 * g); if (sg > bestscore) { bestscore = sg; bg = g; } }
            const int bi0 = __shfl(i1, 16 * bg), bi1 = __shfl(i2, 16 * bg); const float ba0 = __shfl(a1, 16 * bg), ba1 = __shfl(a2, 16 * bg);
            if (F.lane == 0) {
                const float inv = 1.f / (ba0 + ba1);
                EIDX[2 * m] = bi0; EIDX[2 * m + 1] = bi1; GATEV[2 * m] = ba0 * inv; GATEV[2 * m + 1] = ba1 * inv;
                if (dry) {} else if (nrow < 16) { rsel[(F.wave * 16 + nrow) * 2] = (bi0 << 24) | (2 * m); rsel[(F.wave * 16 + nrow) * 2 + 1] = (bi1 << 24) | (2 * m + 1); }
                else {
                    const unsigned p0 = __hip_atomic_fetch_add(cnt + bi0 * 64, 1u, RLX_AGENT); LIST[bi0 * M + p0] = 2 * m;
                    const unsigned p1 = __hip_atomic_fetch_add(cnt + bi1 * 64, 1u, RLX_AGENT); LIST[bi1 * M + p1] = 2 * m + 1; }
            }
            ++nrow;
        }
    }
    if (ROUTE && !dry) {
        if (F.lane == 0) rsel[256 + 32 + F.wave] = nrow < 16 ? nrow : 16;
        if (F.tid < 32) rsel[256 + F.tid] = 0;
        __syncthreads();
        const int wv = F.tid >> 5, k = (F.tid >> 1) & 15;
        const bool have = F.tid < 256 && k < rsel[256 + 32 + (wv & 7)];
        int ent = 0, lp = 0;
        if (have) { ent = rsel[(wv * 16 + k) * 2 + (F.tid & 1)]; lp = __hip_atomic_fetch_add(&rsel[256 + (ent >> 24)], 1, __ATOMIC_RELAXED, __HIP_MEMORY_SCOPE_WORKGROUP); }
        __syncthreads();
        if (F.tid < 32) { const int c = rsel[256 + F.tid]; rsel[256 + F.tid] = c > 0 ? (int)__hip_atomic_fetch_add(cnt + F.tid * 64, (unsigned)c, RLX_AGENT) : 0; }
        __syncthreads();
        if (have) { const int e = ent >> 24; LIST[e * M + rsel[256 + e] + lp] = ent & 0xffffff; }
    }
}

#undef LN_LOAD
__device__ __forceinline__ void ph_ln1_router(Frame& F, int layer) {
    LAS bf16* GH = (LAS bf16*)F.lds;
    LAS bf16* GLo = GH + 32 * GWS;
    LAS float* stat = (LAS float*)(GLo + 32 * GWS);
    LAS float* c12 = stat + 128;
    LAS int* rsel = (LAS int*)(c12 + 64);
    const int tid = F.tid, lane = F.lane, w = F.wave, fr = lane & 15, fq = lane >> 4;
    { const u32x4* src = (const u32x4*)((const char*)F.ctl + CB_GWT + (size_t)layer * 2 * 32 * GWS * 2); LAS u32x4* dst = (LAS u32x4*)GH;
      for (int i = tid; i < 2 * 32 * GWS * 2 / 16; i += NT) dst[i] = src[i];
      if (tid < 64) c12[tid] = ((const float*)((const char*)F.ctl + CB_C12))[layer * 64 + tid]; }
    const float* lg = F.in[16] + (size_t)(layer * 2) * D; const float* lb = F.in[17] + (size_t)(layer * 2) * D;
    bf16* XB = (bf16*)(F.ws + WS_XB); const bf16* PRE = (const bf16*)((const char*)F.out + 32 * MiB);
    int* EIDX = (int*)(F.ws + WS_EIDX); float* GATEV = (float*)(F.ws + WS_GATEV); int* LIST = (int*)(F.ws + WS_LIST);
    unsigned* cnt = F.ctl + CW_CNT + layer * 32 * 64;
    const float* rbias = F.in[12];
    f32x4 gv[4], bv[4];
#pragma unroll
    for (int j = 0; j < 4; ++j) { gv[j] = *((const f32x4*)lg + lane + 64 * j); bv[j] = *((const f32x4*)lb + lane + 64 * j); }
    const float rb0 = rbias[fr], rb1 = rbias[16 + fr];
    for (int grp = F.vcu; grp < M / 64; grp += F.G) {
        const int row0 = grp * 64;
        __syncthreads();
        u32x2 rx[4];
        { const u32x2* pr = (const u32x2*)(PRE + (size_t)(row0 + 8 * w) * D) + lane;
#pragma unroll
          for (int j = 0; j < 4; ++j) rx[j] = pr[64 * j]; }
        for (int k = 0; k < 8; ++k) { const int m = row0 + 8 * w + k;
            f32x4 v[4]; float s = 0.f;
#pragma unroll
            for (int j = 0; j < 4; ++j) { const u32x2 a = rx[j]; v[j] = (f32x4){bflo(a.x), bfhi(a.x), bflo(a.y), bfhi(a.y)}; }
            if (k < 7) { const u32x2* pr = (const u32x2*)(PRE + (size_t)(m + 1) * D) + lane;
#pragma unroll
                for (int j = 0; j < 4; ++j) rx[j] = pr[64 * j]; }
#pragma unroll
            for (int j = 0; j < 4; ++j) s += (v[j].x + v[j].y) + (v[j].z + v[j].w);
            const float mean = wave_sum(s) * (1.f / D); float s2 = 0.f;
#pragma unroll
            for (int j = 0; j < 4; ++j) { v[j] = v[j] - mean; s2 += (v[j].x * v[j].x + v[j].y * v[j].y) + (v[j].z * v[j].z + v[j].w * v[j].w); }
            const float rstd = 1.f / sqrtf(wave_sum(s2) * (1.f / D) + LN_EPS);
            u32x2* o8 = (u32x2*)(XB + (size_t)m * D) + lane;
#pragma unroll
            for (int j = 0; j < 4; ++j) { const f32x4 y = v[j] * rstd * gv[j] + bv[j]; u32x2 wv; wv.x = pg8::cvt_pk_bf16(y.x, y.y); wv.y = pg8::cvt_pk_bf16(y.z, y.w); o8[64 * j] = wv; }
            if (lane == 0) { stat[(8 * w + k) * 2] = mean; stat[(8 * w + k) * 2 + 1] = rstd; }
        }
        __syncthreads();
        if (w < 4) {
            f32x4 d0 = (f32x4){0.f, 0.f, 0.f, 0.f}, d1 = d0;
            const bf16* arow = PRE + (size_t)(row0 + 16 * w + fr) * D + 8 * fq;
            const LAS bf16* b0h = GH + fr * GWS + 8 * fq; const LAS bf16* b1h = GH + (16 + fr) * GWS + 8 * fq;
            const LAS bf16* b0l = GLo + fr * GWS + 8 * fq; const LAS bf16* b1l = GLo + (16 + fr) * GWS + 8 * fq;
#pragma unroll 8
            for (int ks = 0; ks < 32; ++ks) { const bf16x8_t a = *(const bf16x8_t*)(arow + 32 * ks);
                d0 = __builtin_amdgcn_mfma_f32_16x16x32_bf16(a, *(const LAS bf16x8_t*)(b0h + 32 * ks), d0, 0, 0, 0);
                d1 = __builtin_amdgcn_mfma_f32_16x16x32_bf16(a, *(const LAS bf16x8_t*)(b1h + 32 * ks), d1, 0, 0, 0);
                d0 = __builtin_amdgcn_mfma_f32_16x16x32_bf16(a, *(const LAS bf16x8_t*)(b0l + 32 * ks), d0, 0, 0, 0);
                d1 = __builtin_amdgcn_mfma_f32_16x16x32_bf16(a, *(const LAS bf16x8_t*)(b1l + 32 * ks), d1, 0, 0, 0); }
            const float c1a = c12[fr], c1b = c12[16 + fr], c2a = c12[32 + fr], c2b = c12[48 + fr];
            const int sub = lane & ~7;
#pragma unroll
            for (int rg = 0; rg < 4; ++rg) {
                const int rl = 16 * w + 4 * fq + rg; const float mean = stat[rl * 2], rstd = stat[rl * 2 + 1];
                const float l0 = rstd * (d0[rg] - mean * c1a) + c2a, l1 = rstd * (d1[rg] - mean * c1b) + c2b;
                const float af0 = 1.f / (1.f + expf(-l0)), af1 = 1.f / (1.f + expf(-l1)), se0 = af0 + rb0, se1 = af1 + rb1;
                float m1 = -1e30f, m2 = -1e30f, a1 = 0.f, a2 = 0.f; int i1 = 0, i2 = 0;
                float n1 = -1e30f, n2 = -1e30f, b1 = 0.f, b2 = 0.f; int j1 = 0, j2 = 0;
#pragma unroll
                for (int j = 0; j < 8; ++j) { const float sv = __shfl(se0, sub + j), av = __shfl(af0, sub + j), tv = __shfl(se1, sub + j), bvv = __shfl(af1, sub + j);
                    const int e0 = (fr & 8) + j, e1 = 16 + (fr & 8) + j;
                    if (sv > m1) { m2 = m1; i2 = i1; a2 = a1; m1 = sv; i1 = e0; a1 = av; } else if (sv > m2) { m2 = sv; i2 = e0; a2 = av; }
                    if (tv > n1) { n2 = n1; j2 = j1; b2 = b1; n1 = tv; j1 = e1; b1 = bvv; } else if (tv > n2) { n2 = tv; j2 = e1; b2 = bvv; } }
                const float sc0 = m1 + m2, sc1 = n1 + n2;
                const int g16 = lane & 48;
                const float sg0 = __shfl(sc0, g16), sg1 = __shfl(sc0, g16 + 8), sg2 = __shfl(sc1, g16), sg3 = __shfl(sc1, g16 + 8);
                int bg = 0; float bs = sg0; if (sg1 > bs) { bs = sg1; bg = 1; } if (sg2 > bs) { bs = sg2; bg = 2; } if (sg3 > bs) { bs = sg3; bg = 3; }
                const int srcl = g16 + 8 * (bg & 1);
                const int x1 = __shfl(bg < 2 ? i1 : j1, srcl), x2 = __shfl(bg < 2 ? i2 : j2, srcl); const float y1 = __shfl(bg < 2 ? a1 : b1, srcl), y2 = __shfl(bg < 2 ? a2 : b2, srcl);
                if (fr == 0) { const int m = row0 + rl; const float inv = 1.f / (y1 + y2);
                    EIDX[2 * m] = x1; EIDX[2 * m + 1] = x2; GATEV[2 * m] = y1 * inv; GATEV[2 * m + 1] = y2 * inv;
                    rsel[rl * 2] = (x1 << 24) | (2 * m); rsel[rl * 2 + 1] = (x2 << 24) | (2 * m + 1); }
            }
        }
        if (tid < 32) rsel[128 + tid] = 0;
        __syncthreads();
        int ent = 0, lp = 0;
        if (tid < 128) { ent = rsel[tid]; lp = __hip_atomic_fetch_add(&rsel[128 + (ent >> 24)], 1, __ATOMIC_RELAXED, __HIP_MEMORY_SCOPE_WORKGROUP); }
        __syncthreads();
        if (tid < 32) { const int c = rsel[128 + tid]; rsel[128 + tid] = c > 0 ? (int)__hip_atomic_fetch_add(cnt + tid * 64, (unsigned)c, RLX_AGENT) : 0; }
        __syncthreads();
        if (tid < 128) { const int e = ent >> 24; LIST[e * M + rsel[128 + e] + lp] = ent & 0xffffff; }
    }
}
struct ExpertMap { int cnt[32]; };
__device__ __forceinline__ int moe_find(Frame& F, int layer, int unit_rows, int per_row_tiles, int t, int& e_out, int& mb_out, int& nb_out, int& hb_out, int& cnt_out) {
    const unsigned* cnt = F.ctl + CW_CNT + layer * 32 * 64;
    int base = 0, hb = 0;
    for (int e = 0; e < 32; ++e) {
        const int c = (int)cnt[e * 64]; const int nmb = (c + unit_rows - 1) / unit_rows; const int nt = nmb * per_row_tiles;
        if (t < base + nt) { const int r = t - base; e_out = e; mb_out = r / per_row_tiles; nb_out = r % per_row_tiles; hb_out = hb; cnt_out = c; return 1; }
        base += nt; hb += ((c + 255) >> 8) << 8;
    }
    return 0;
}
__device__ __forceinline__ void ph_moe1_naive(Frame& F, int layer) {
    LAS float* sA = (LAS float*)F.lds; LAS float* sB = sA + 128 * 33;
    const bf16* XB = (const bf16*)(F.ws + WS_XB); bf16* HID = (bf16*)(F.ws + WS_HID); const int* LIST = (const int*)(F.ws + WS_LIST);
    const int tx = F.tid & 15, ty = F.tid >> 4;
    for (int t = blockIdx.x;; t += F.G) {
        int e, mb, nb, hb, c; if (!moe_find(F, layer, 128, 4, t, e, mb, nb, hb, c)) break;
        const bf16* GU = (const bf16*)(F.ws + WS_EW + (size_t)e * EW_STRIDE);
        const int j0 = nb * 64, rg = (j0 >> 7) * 256 + (j0 & 127);
        auto rowA = [&](int r) -> const bf16* { const int i = mb * 128 + r; return i < c ? XB + (size_t)(LIST[e * M + i] >> 1) * D : (const bf16*)nullptr; };
        float ag[4][4], au[4][4];
        ngemm_tile(sA, sB, rowA, GU + (size_t)rg * D, D, D, ag);
        ngemm_tile(sA, sB, rowA, GU + (size_t)(rg + 128) * D, D, D, au);
#pragma unroll
        for (int i = 0; i < 4; ++i) { const int ri = mb * 128 + ty * 4 + i;
            if (ri < c) { u32x2 o; o.x = pk2(siluf_(ag[i][0]) * au[i][0], siluf_(ag[i][1]) * au[i][1]); o.y = pk2(siluf_(ag[i][2]) * au[i][2], siluf_(ag[i][3]) * au[i][3]);
                *(u32x2*)(HID + (size_t)(hb + ri) * DE + j0 + tx * 4) = o; } }
    }
}
__device__ __forceinline__ void ph_moe2_naive(Frame& F, int layer) {
    LAS float* sA = (LAS float*)F.lds; LAS float* sB = sA + 128 * 33;
    const bf16* HID = (const bf16*)(F.ws + WS_HID); bf16* YB = (bf16*)(F.ws + WS_YB); const int* LIST = (const int*)(F.ws + WS_LIST);
    const int tx = F.tid & 15, ty = F.tid >> 4;
    for (int t = blockIdx.x;; t += F.G) {
        int e, mb, nb, hb, c; if (!moe_find(F, layer, 128, 16, t, e, mb, nb, hb, c)) break;
        const bf16* DN = (const bf16*)(F.ws + WS_EW + (size_t)e * EW_STRIDE + EW_DN);
        auto rowA = [&](int r) -> const bf16* { const int i = mb * 128 + r; return i < c ? HID + (size_t)(hb + i) * DE : (const bf16*)nullptr; };
        float acc[4][4];
        ngemm_tile(sA, sB, rowA, DN + (size_t)(nb * 64) * DE, DE, DE, acc);
#pragma unroll
        for (int i = 0; i < 4; ++i) { const int ri = mb * 128 + ty * 4 + i;
            if (ri < c) { const int a = LIST[e * M + ri]; u32x2 o; o.x = pk2(acc[i][0], acc[i][1]); o.y = pk2(acc[i][2], acc[i][3]);
                *(u32x2*)(YB + (size_t)a * D + nb * 64 + tx * 4) = o; } }
    }
}

__device__ __forceinline__ void ph_attn_naive(Frame& F) {
    const bf16* P = (const bf16*)(F.ws + WS_P); bf16* OG = (bf16*)(F.ws + WS_OG); float* LSE = (float*)(F.ws + WS_LSE);
    const int total = 3 * M * 8, nth = F.G * NT;
    for (int idx = blockIdx.x * NT + F.tid; idx < total; idx += nth) {
        const int h = idx & 7, m = (idx >> 3) & (M - 1), g = idx >> 17;
        const int t = m & (T - 1), dil = (g == 0) ? 1 : (g == 1 ? 4 : 16);
        const float slope = exp2f(-(float)(h + 1));
        const bf16* qp = P + (size_t)m * IN1 + g * 1536 + h * 64;
        float q[64], o[64];
#pragma unroll
        for (int c = 0; c < 8; ++c) { const u32x4 w = *(const u32x4*)(qp + 8 * c);
            q[8 * c + 0] = bflo(w.x); q[8 * c + 1] = bfhi(w.x); q[8 * c + 2] = bflo(w.y); q[8 * c + 3] = bfhi(w.y); q[8 * c + 4] = bflo(w.z); q[8 * c + 5] = bfhi(w.z); q[8 * c + 6] = bflo(w.w); q[8 * c + 7] = bfhi(w.w); }
#pragma unroll
        for (int d = 0; d < 64; ++d) o[d] = 0.f;
        float mx = -1e30f, den = 0.f;
        for (int j = 0; j <= 128; ++j) {
            const int tk = t - j * dil; if (tk < 0) break;
            const bf16* kp = P + (size_t)(m - j * dil) * IN1 + g * 1536 + 512 + h * 64; const bf16* vp = kp + 512;
            float s = 0.f;
#pragma unroll
            for (int c = 0; c < 8; ++c) { const u32x4 w = *(const u32x4*)(kp + 8 * c);
                s += q[8 * c + 0] * bflo(w.x) + q[8 * c + 1] * bfhi(w.x) + q[8 * c + 2] * bflo(w.y) + q[8 * c + 3] * bfhi(w.y) + q[8 * c + 4] * bflo(w.z) + q[8 * c + 5] * bfhi(w.z) + q[8 * c + 6] * bflo(w.w) + q[8 * c + 7] * bfhi(w.w); }
            s = s * 0.125f - slope * (float)(j * dil);
            const float mn = fmaxf(mx, s), corr = __expf(mx - mn), p = __expf(s - mn);
            den = den * corr + p; mx = mn;
#pragma unroll
            for (int c = 0; c < 8; ++c) { const u32x4 w = *(const u32x4*)(vp + 8 * c);
                o[8 * c + 0] = o[8 * c + 0] * corr + p * bflo(w.x); o[8 * c + 1] = o[8 * c + 1] * corr + p * bfhi(w.x); o[8 * c + 2] = o[8 * c + 2] * corr + p * bflo(w.y); o[8 * c + 3] = o[8 * c + 3] * corr + p * bfhi(w.y);
                o[8 * c + 4] = o[8 * c + 4] * corr + p * bflo(w.z); o[8 * c + 5] = o[8 * c + 5] * corr + p * bfhi(w.z); o[8 * c + 6] = o[8 * c + 6] * corr + p * bflo(w.w); o[8 * c + 7] = o[8 * c + 7] * corr + p * bfhi(w.w); }
        }
        const float inv = 1.f / den;
        bf16* op = OG + ((size_t)g * M + m) * 512 + h * 64;
#pragma unroll
        for (int c = 0; c < 8; ++c) { u32x4 w; w.x = pk2(o[8 * c + 0] * inv, o[8 * c + 1] * inv); w.y = pk2(o[8 * c + 2] * inv, o[8 * c + 3] * inv); w.z = pk2(o[8 * c + 4] * inv, o[8 * c + 5] * inv); w.w = pk2(o[8 * c + 6] * inv, o[8 * c + 7] * inv);
            *(u32x4*)(op + 8 * c) = w; }
        LSE[((size_t)g * M + m) * 8 + h] = mx + __logf(den);
    }
}
__device__ __forceinline__ void ph_attn_mfma(Frame& F) {
    const bf16* P = (const bf16*)(F.ws + WS_P); bf16* OG = (bf16*)(F.ws + WS_OG); float* LSE = (float*)(F.ws + WS_LSE);
    LAS bf16* Vl = (LAS bf16*)F.lds;
    const int tid = F.tid, lane = F.lane, w = F.wave, fr = lane & 15, fq = lane >> 4;
    const int ct0 = 2 * (w >> 1);
    const unsigned vaddr0 = (unsigned)(size_t)(F.lds) + (unsigned)(((16 * ct0 + 4 * fq + (fr >> 2)) * 72 + 4 * (fr & 3)) * 2);
    for (int u = blockIdx.x; u < 3072; u += F.G) {
        const int g = u >> 10, rem = u & 1023, b = rem >> 9, h = (rem >> 6) & 7, x = rem & 63;
        const int dil = (g == 0) ? 1 : (g == 1 ? 4 : 16), nnb = 64 / dil, nb = x % nnb, r = x / nnb;
        const long rowbase = (long)b * T + (long)nb * 128 * dil + r;
        const bf16* Qp = P + g * 1536 + h * 64; const bf16* Kp = Qp + 512; const bf16* Vp = Qp + 1024;
        const float sl = exp2f(-(float)(h + 1)) * (float)dil;
        __syncthreads();
#pragma unroll
        for (int it = 0; it < 4; ++it) { const int kr = (tid >> 3) + 64 * it, ch = tid & 7; u32x4 v = (u32x4){0u, 0u, 0u, 0u};
            if (nb > 0 || kr >= 128) v = *(const u32x4*)(Vp + (size_t)(rowbase + (long)(kr - 128) * dil) * IN1 + ch * 8);
            *(LAS u32x4*)(Vl + kr * 72 + ch * 8) = v; }
        bf16x8_t qf[2];
        { const bf16* qrow = Qp + (size_t)(rowbase + (long)(16 * w + fr) * dil) * IN1 + 8 * fq; qf[0] = *(const bf16x8_t*)qrow; qf[1] = *(const bf16x8_t*)(qrow + 32); }
        f32x4 s[10];
#pragma unroll
        for (int c = 0; c < 10; ++c) { const int kr = 16 * (ct0 + c) + fr; bf16x8_t k0 = (bf16x8_t){0, 0, 0, 0, 0, 0, 0, 0}, k1 = k0;
            if (nb > 0 || kr >= 128) { const bf16* krow = Kp + (size_t)(rowbase + (long)(kr - 128) * dil) * IN1 + 8 * fq; k0 = *(const bf16x8_t*)krow; k1 = *(const bf16x8_t*)(krow + 32); }
            s[c] = __builtin_amdgcn_mfma_f32_16x16x32_bf16(k0, qf[0], (f32x4){0.f, 0.f, 0.f, 0.f}, 0, 0, 0);
            s[c] = __builtin_amdgcn_mfma_f32_16x16x32_bf16(k1, qf[1], s[c], 0, 0, 0); }
        const int l = 16 * w + fr;
        float mx = -1e30f;
#pragma unroll
        for (int c = 0; c < 10; ++c)
#pragma unroll
            for (int rg = 0; rg < 4; ++rg) { const int kr = 16 * (ct0 + c) + 4 * fq + rg, steps = l + 128 - kr;
                const bool ok = steps >= 0 && steps <= 128 && (nb > 0 || kr >= 128);
                const float v = ok ? s[c][rg] * 0.125f - sl * (float)steps : -1e30f; s[c][rg] = v; mx = fmaxf(mx, v); }
        mx = fmaxf(mx, __shfl_xor(mx, 16)); mx = fmaxf(mx, __shfl_xor(mx, 32));
        float den = 0.f;
#pragma unroll
        for (int c = 0; c < 10; ++c)
#pragma unroll
            for (int rg = 0; rg < 4; ++rg) { const float p = (s[c][rg] > -1e29f) ? __expf(s[c][rg] - mx) : 0.f; s[c][rg] = p; den += p; }
        den += __shfl_xor(den, 16); den += __shfl_xor(den, 32);
        bf16x8_t pf[5];
#pragma unroll
        for (int k = 0; k < 5; ++k) { u32x4 wv; wv.x = pg8::cvt_pk_bf16(s[2 * k][0], s[2 * k][1]); wv.y = pg8::cvt_pk_bf16(s[2 * k][2], s[2 * k][3]);
            wv.z = pg8::cvt_pk_bf16(s[2 * k + 1][0], s[2 * k + 1][1]); wv.w = pg8::cvt_pk_bf16(s[2 * k + 1][2], s[2 * k + 1][3]); pf[k] = __builtin_bit_cast(bf16x8_t, wv); }
        __syncthreads();
        f32x4 o[4];
#pragma unroll
        for (int dt = 0; dt < 4; ++dt) o[dt] = (f32x4){0.f, 0.f, 0.f, 0.f};
#pragma unroll
        for (int k = 0; k < 5; ++k) {
            u32x2 a0, a1, a2, a3, a4, a5, a6, a7; const unsigned va = vaddr0 + (unsigned)(k * 32 * 72 * 2);
            asm volatile("ds_read_b64_tr_b16 %0, %8\n\tds_read_b64_tr_b16 %1, %8 offset:2304\n\tds_read_b64_tr_b16 %2, %8 offset:32\n\tds_read_b64_tr_b16 %3, %8 offset:2336\n\t"
                         "ds_read_b64_tr_b16 %4, %8 offset:64\n\tds_read_b64_tr_b16 %5, %8 offset:2368\n\tds_read_b64_tr_b16 %6, %8 offset:96\n\tds_read_b64_tr_b16 %7, %8 offset:2400\n\ts_waitcnt lgkmcnt(0)"
                         : "=&v"(a0), "=&v"(a1), "=&v"(a2), "=&v"(a3), "=&v"(a4), "=&v"(a5), "=&v"(a6), "=&v"(a7) : "v"(va) : "memory");
            __builtin_amdgcn_sched_barrier(0);
            o[0] = __builtin_amdgcn_mfma_f32_16x16x32_bf16(__builtin_bit_cast(bf16x8_t, (u32x4){a0.x, a0.y, a1.x, a1.y}), pf[k], o[0], 0, 0, 0);
            o[1] = __builtin_amdgcn_mfma_f32_16x16x32_bf16(__builtin_bit_cast(bf16x8_t, (u32x4){a2.x, a2.y, a3.x, a3.y}), pf[k], o[1], 0, 0, 0);
            o[2] = __builtin_amdgcn_mfma_f32_16x16x32_bf16(__builtin_bit_cast(bf16x8_t, (u32x4){a4.x, a4.y, a5.x, a5.y}), pf[k], o[2], 0, 0, 0);
            o[3] = __builtin_amdgcn_mfma_f32_16x16x32_bf16(__builtin_bit_cast(bf16x8_t, (u32x4){a6.x, a6.y, a7.x, a7.y}), pf[k], o[3], 0, 0, 0);
        }
        const float inv = 1.f / den; const size_t tok = (size_t)(rowbase + (long)l * dil);
        bf16* op = OG + ((size_t)g * M + tok) * 512 + h * 64 + 4 * fq;
#pragma unroll
        for (int dt = 0; dt < 4; ++dt) { u32x2 wv; wv.x = pg8::cvt_pk_bf16(o[dt][0] * inv, o[dt][1] * inv); wv.y = pg8::cvt_pk_bf16(o[dt][2] * inv, o[dt][3] * inv); *(u32x2*)(op + 16 * dt) = wv; }
        if (fq == 0) LSE[((size_t)g * M + tok) * 8 + h] = mx + __logf(den);
    }
}

__device__ __forceinline__ void ph_attn_v2(Frame& F) {
    const bf16* P = (const bf16*)(F.ws + WS_P); bf16* OG = (bf16*)(F.ws + WS_OG); float* LSE = (float*)(F.ws + WS_LSE);
    LAS bf16* Kl = (LAS bf16*)F.lds;
    LAS bf16* Vl = Kl + 2 * 128 * 72;
    constexpr int SLOT = 128 * 72;
    const int tid = F.tid, lane = F.lane, w = F.wave, fr = lane & 15, fq = lane >> 4;
    const int ct0 = 2 * (w >> 1), l = 16 * w + fr;
    const int srow = tid >> 3, sch = tid & 7;
    for (int p = blockIdx.x; p < 512; p += F.G) {
        int g, b, h, r, nb0, nun;
        if (p < 128) { g = 0; const int seq = p >> 3; b = seq >> 3; h = seq & 7; r = 0; nb0 = (p & 7) * 8; nun = 8; }
        else if (p < 256) { g = 1; const int q = p - 128, seq = q >> 1; b = seq >> 5; h = (seq >> 2) & 7; r = seq & 3; nb0 = (q & 1) * 8; nun = 8; }
        else { g = 2; const int q = p - 256; b = q >> 7; h = (q >> 4) & 7; r = q & 15; nb0 = 0; nun = 4; }
        const int dil = (g == 0) ? 1 : (g == 1 ? 4 : 16);
        const size_t rstride = (size_t)dil * IN1;
        const bf16* Qp = P + g * 1536 + h * 64 + ((size_t)b * T + r) * IN1; const bf16* Kp = Qp + 512; const bf16* Vp = Qp + 1024;
        const float sl = exp2f(-(float)(h + 1)) * (float)dil;
        __syncthreads();
#pragma unroll
        for (int it = 0; it < 2; ++it) { const int row = srow + 64 * it;
            u32x4 k0 = (u32x4){0u, 0u, 0u, 0u}, v0 = k0;
            if (nb0 > 0) { const size_t off = (size_t)((nb0 - 1) * 128 + row) * rstride + sch * 8; k0 = *(const u32x4*)(Kp + off); v0 = *(const u32x4*)(Vp + off); }
            const size_t off1 = (size_t)(nb0 * 128 + row) * rstride + sch * 8; const u32x4 k1 = *(const u32x4*)(Kp + off1), v1 = *(const u32x4*)(Vp + off1);
            const int ps = (nb0 + 1) & 1, cs = nb0 & 1;
            *(LAS u32x4*)(Kl + ps * SLOT + row * 72 + sch * 8) = k0; *(LAS u32x4*)(Vl + ps * SLOT + row * 72 + sch * 8) = v0;
            *(LAS u32x4*)(Kl + cs * SLOT + row * 72 + sch * 8) = k1; *(LAS u32x4*)(Vl + cs * SLOT + row * 72 + sch * 8) = v1; }
        bf16x8_t qn0, qn1;
        { const bf16* qrow = Qp + (size_t)(nb0 * 128 + l) * rstride + 8 * fq; qn0 = *(const bf16x8_t*)qrow; qn1 = *(const bf16x8_t*)(qrow + 32); }
        __syncthreads();
        for (int i = 0; i < nun; ++i) {
            const int nb = nb0 + i; const bool more = (i + 1 < nun);
            const bf16x8_t qf0 = qn0, qf1 = qn1;
            u32x4 pk0 = (u32x4){0u, 0u, 0u, 0u}, pk1 = pk0, pv0 = pk0, pv1 = pk0;
            if (more) { const size_t off = (size_t)((nb + 1) * 128 + srow) * rstride + sch * 8;
                pk0 = *(const u32x4*)(Kp + off); pv0 = *(const u32x4*)(Vp + off); pk1 = *(const u32x4*)(Kp + off + 64 * rstride); pv1 = *(const u32x4*)(Vp + off + 64 * rstride);
                const bf16* qrow = Qp + (size_t)((nb + 1) * 128 + l) * rstride + 8 * fq; qn0 = *(const bf16x8_t*)qrow; qn1 = *(const bf16x8_t*)(qrow + 32); }
            const int ps = (nb + 1) & 1, cs = nb & 1;
            f32x4 s[10];
#pragma unroll
            for (int c = 0; c < 10; ++c) { const int ct = ct0 + c; const LAS bf16* kb = Kl + (ct < 8 ? ps : cs) * SLOT + ((ct & 7) * 16 + fr) * 72 + 8 * fq;
                s[c] = __builtin_amdgcn_mfma_f32_16x16x32_bf16(*(const LAS bf16x8_t*)kb, qf0, (f32x4){0.f, 0.f, 0.f, 0.f}, 0, 0, 0);
                s[c] = __builtin_amdgcn_mfma_f32_16x16x32_bf16(*(const LAS bf16x8_t*)(kb + 32), qf1, s[c], 0, 0, 0); }
            int lz = l, fz = 4 * fq; asm volatile("" : "+v"(lz), "+v"(fz));
            float mx = -1e30f;
#pragma unroll
            for (int c = 0; c < 10; ++c)
#pragma unroll
                for (int rg = 0; rg < 4; ++rg) { const int kr = 16 * (ct0 + c) + fz + rg, steps = lz + 128 - kr;
                    const bool ok = steps >= 0 && steps <= 128 && (nb > 0 || kr >= 128);
                    const float v = ok ? s[c][rg] * 0.125f - sl * (float)steps : -1e30f; s[c][rg] = v; mx = fmaxf(mx, v); }
            mx = fmaxf(mx, __shfl_xor(mx, 16)); mx = fmaxf(mx, __shfl_xor(mx, 32));
            float den = 0.f;
#pragma unroll
            for (int c = 0; c < 10; ++c)
#pragma unroll
                for (int rg = 0; rg < 4; ++rg) { const float pe = __expf(s[c][rg] - mx); s[c][rg] = pe; den += pe; }
            den += __shfl_xor(den, 16); den += __shfl_xor(den, 32);
            f32x4 o[4];
#pragma unroll
            for (int dt = 0; dt < 4; ++dt) o[dt] = (f32x4){0.f, 0.f, 0.f, 0.f};
#pragma unroll
            for (int k = 0; k < 5; ++k) { const int ct = ct0 + 2 * k;
                u32x4 wv; wv.x = pg8::cvt_pk_bf16(s[2 * k][0], s[2 * k][1]); wv.y = pg8::cvt_pk_bf16(s[2 * k][2], s[2 * k][3]);
                wv.z = pg8::cvt_pk_bf16(s[2 * k + 1][0], s[2 * k + 1][1]); wv.w = pg8::cvt_pk_bf16(s[2 * k + 1][2], s[2 * k + 1][3]);
                const bf16x8_t pf = __builtin_bit_cast(bf16x8_t, wv);
                const unsigned va = (unsigned)(size_t)(Vl + (ct < 8 ? ps : cs) * SLOT) + (unsigned)((((ct & 7) * 16 + 4 * fq + (fr >> 2)) * 72 + 4 * (fr & 3)) * 2);
                u32x2 a0, a1, a2, a3, a4, a5, a6, a7;
                tr8<0, 16 * 72 * 2>(va, a0, a1, a2, a3, a4, a5, a6, a7);
                __builtin_amdgcn_sched_barrier(0);
                o[0] = __builtin_amdgcn_mfma_f32_16x16x32_bf16(pack_frag(a0, a1), pf, o[0], 0, 0, 0);
                o[1] = __builtin_amdgcn_mfma_f32_16x16x32_bf16(pack_frag(a2, a3), pf, o[1], 0, 0, 0);
                o[2] = __builtin_amdgcn_mfma_f32_16x16x32_bf16(pack_frag(a4, a5), pf, o[2], 0, 0, 0);
                o[3] = __builtin_amdgcn_mfma_f32_16x16x32_bf16(pack_frag(a6, a7), pf, o[3], 0, 0, 0); }
            const float inv = 1.f / den; const size_t tok = (size_t)b * T + (size_t)(nb * 128 + l) * dil + r;
            bf16* op = OG + ((size_t)g * M + tok) * 512 + h * 64 + 4 * fq;
#pragma unroll
            for (int dt = 0; dt < 4; ++dt) { u32x2 wv; wv.x = pg8::cvt_pk_bf16(o[dt][0] * inv, o[dt][1] * inv); wv.y = pg8::cvt_pk_bf16(o[dt][2] * inv, o[dt][3] * inv); *(u32x2*)(op + 16 * dt) = wv; }
            if (fq == 0) LSE[((size_t)g * M + tok) * 8 + h] = mx + __logf(den);
            __syncthreads();
            if (more) { *(LAS u32x4*)(Kl + ps * SLOT + srow * 72 + sch * 8) = pk0; *(LAS u32x4*)(Vl + ps * SLOT + srow * 72 + sch * 8) = pv0;
                *(LAS u32x4*)(Kl + ps * SLOT + (srow + 64) * 72 + sch * 8) = pk1; *(LAS u32x4*)(Vl + ps * SLOT + (srow + 64) * 72 + sch * 8) = pv1; }
            __syncthreads();
        }
    }
}

__device__ __forceinline__ void ph_merge(Frame& F) {
    const bf16* OG = (const bf16*)(F.ws + WS_OG); const float* LSE = (const float*)(F.ws + WS_LSE); bf16* Y2 = (bf16*)(F.ws + WS_Y2);
    const int total = M * 64, nth = F.G * NT;
    for (int idx = blockIdx.x * NT + F.tid; idx < total; idx += nth) {
        const int m = idx >> 6, c8 = idx & 63, h = c8 >> 3;
        const float l0 = LSE[((size_t)0 * M + m) * 8 + h], l1 = LSE[((size_t)1 * M + m) * 8 + h], l2 = LSE[((size_t)2 * M + m) * 8 + h];
        const float mx = fmaxf(l0, fmaxf(l1, l2)); float w0 = __expf(l0 - mx), w1 = __expf(l1 - mx), w2 = __expf(l2 - mx); const float inv = 1.f / (w0 + w1 + w2);
        w0 *= inv; w1 *= inv; w2 *= inv;
        const u32x4 a = *(const u32x4*)(OG + ((size_t)0 * M + m) * 512 + c8 * 8), b = *(const u32x4*)(OG + ((size_t)1 * M + m) * 512 + c8 * 8), c = *(const u32x4*)(OG + ((size_t)2 * M + m) * 512 + c8 * 8);
        u32x4 o;
        o.x = pk2(w0 * bflo(a.x) + w1 * bflo(b.x) + w2 * bflo(c.x), w0 * bfhi(a.x) + w1 * bfhi(b.x) + w2 * bfhi(c.x));
        o.y = pk2(w0 * bflo(a.y) + w1 * bflo(b.y) + w2 * bflo(c.y), w0 * bfhi(a.y) + w1 * bfhi(b.y) + w2 * bfhi(c.y));
        o.z = pk2(w0 * bflo(a.z) + w1 * bflo(b.z) + w2 * bflo(c.z), w0 * bfhi(a.z) + w1 * bfhi(b.z) + w2 * bfhi(c.z));
        o.w = pk2(w0 * bflo(a.w) + w1 * bflo(b.w) + w2 * bflo(c.w), w0 * bfhi(a.w) + w1 * bfhi(b.w) + w2 * bfhi(c.w));
        *(u32x4*)(Y2 + (size_t)m * 512 + c8 * 8) = o;
    }
}

__device__ __forceinline__ void gemm_inproj(Frame& F, const void* A, size_t wt, int N) {
    pg8::StaticOrder S; S.init(A, F.ws + wt, M, N, D, F.G, (int)blockIdx.x); pg8::EpiBf16 E{(bf16*)(F.ws + WS_P), N};
    pg8::gemm_phase<pg8::EpiBf16, pg8::StaticOrder, true, false>(F.lds, D, S, E);
}
template <bool BASE_BF16>
__device__ __forceinline__ void gemm_outproj(Frame& F, size_t a, size_t wt, int K, const void* base) {
    pg8::StaticOrder S; S.init(F.ws + a, F.ws + wt, M, D, K, F.G, (int)blockIdx.x); pg8::EpiResBf16<BASE_BF16> E{base, (bf16*)((char*)F.out + 32 * MiB), ALPHA};
    pg8::gemm_phase<pg8::EpiResBf16<BASE_BF16>, pg8::StaticOrder, false, false>(F.lds, K, S, E);
}
__device__ __forceinline__ int moe_row_tiles(Frame& F, int layer) { const unsigned* cnt = F.ctl + CW_CNT + layer * 32 * 64; int n = 0; for (int e = 0; e < 32; ++e) n += ((int)cnt[e * 64] + 255) >> 8; return n; }
__device__ __forceinline__ void gemm_moe1(Frame& F, int layer, int Lbase, int Lend, int G, int c) {
    pg8::MoeOrder S{F.ctl + CW_CNT + layer * 32 * 64, (const int*)(F.ws + WS_LIST), (const char*)(F.ws + WS_XB), (const char*)(F.ws + WS_EW), 2, G, c, D, 0, Lbase, Lend};
    pg8::EpiSwiGLU E{(bf16*)(F.ws + WS_HID)}; pg8::gemm_phase<pg8::EpiSwiGLU, pg8::MoeOrder, true, true>(F.lds, D, S, E);
}
__device__ __forceinline__ void gemm_moe2(Frame& F, int layer, int Lbase, int Lend, int G, int c) {
    pg8::MoeOrder S{F.ctl + CW_CNT + layer * 32 * 64, (const int*)(F.ws + WS_LIST), (const char*)(F.ws + WS_HID), (const char*)(F.ws + WS_EW + EW_DN), 4, G, c, DE, 1, Lbase, Lend};
    pg8::EpiMoeOut E{(bf16*)(F.ws + WS_YB), (const int*)(F.ws + WS_LIST)}; pg8::gemm_phase<pg8::EpiMoeOut, pg8::MoeOrder, true, false>(F.lds, DE, S, E);
}
__device__ __forceinline__ void moe_alpha(Frame& F, int layer) { const int n1 = 2 * moe_row_tiles(F, layer); gemm_moe1(F, layer, 0, n1 < F.G ? n1 : F.G, F.G, (int)blockIdx.x); }
__device__ __forceinline__ void moe_beta(Frame& F, int layer) {
    const int nrt = moe_row_tiles(F, layer), n1 = 2 * nrt, c = (int)blockIdx.x;
    int nb1 = n1 - F.G; nb1 = nb1 < 0 ? 0 : (nb1 > F.G / 2 ? F.G / 2 : nb1);
    const int rt_a = nrt < F.G / 2 ? nrt : F.G / 2;
    if (c < nb1) gemm_moe1(F, layer, F.G, n1, nb1, c);
    else gemm_moe2(F, layer, 0, 4 * rt_a, F.G - nb1, c - nb1);
}
__device__ __forceinline__ void moe_gamma(Frame& F, int layer) {
    const int nrt = moe_row_tiles(F, layer), rt_a = nrt < F.G / 2 ? nrt : F.G / 2;
    gemm_moe2(F, layer, 4 * rt_a, 4 * nrt, F.G, (int)blockIdx.x);
}

struct Args { const float* in[18]; float* out; unsigned char* ws; int ph_lo, ph_hi, li, pad; };
__global__ void __launch_bounds__(NT, 2) mega_fwd(Args args) {
    extern __shared__ __attribute__((aligned(16))) unsigned char lds_raw[];
    Frame F;
    F.lds = (LAS unsigned char*)lds_raw;
    F.tid = threadIdx.x; F.lane = F.tid & 63; F.wave = __builtin_amdgcn_readfirstlane(F.tid >> 6);
    F.G = gridDim.x; { const int bx = blockIdx.x; F.vcu = (F.G % 8 == 0) ? (bx % 8) * (F.G / 8) + bx / 8 : bx; }
#pragma unroll
    for (int i = 0; i < 18; ++i) F.in[i] = args.in[i];
    F.out = args.out; F.ws = args.ws; F.ctl = (unsigned*)(args.ws + WS_CTL);
    volatile LAS unsigned* MISC = (volatile LAS unsigned*)(F.lds + LDS_BYTES - 128);
    if (F.tid < 32) MISC[F.tid] = 0u;
    __syncthreads();
    XcdBarrier bar; bar.bar = F.ctl + CW_BAR; bar.x = 0; bar.st = nullptr;
    if (MK_N_LAUNCHES == 1) bar = xcd_barrier_post(F.ctl + CW_BAR, MISC + 8);
    const int lo = args.ph_lo, hi = args.ph_hi;
#define IN(k) (lo <= (k) && (k) < hi)
#define SEAM(k) do { if (IN(k) && IN((k) + 1)) xcd_barrier(bar); } while (0)
#define DUP(k) ((PROBE_DUP >> (k)) & 1)
#define PHASE(k, ...) do { if (IN(k)) { __VA_ARGS__; if (DUP(k)) { xcd_barrier(bar); __VA_ARGS__; } } SEAM(k); } while (0)
    PHASE(0, ph0_convert(F));
    PHASE(1, gemm_inproj(F, F.ws + WS_XB, WS_WT0, NP0));
    PHASE(2, ph_mix_a(F); xcd_barrier(bar); ph_mix_b(F));
    if (IN(3)) { if (DUP(3)) { ph_mix_c<PROBE_CVAR>(F); xcd_barrier(bar); } ph_mix_c<0>(F); } SEAM(3);
    PHASE(4, gemm_outproj<false>(F, WS_Y, WS_WO0, D, F.in[0]));
    if (IN(5)) { convert_experts(F, 0); if (DUP(5)) { __syncthreads(); convert_experts(F, 0); } __syncthreads(); ph_ln1_router(F, 0); } SEAM(5);
    PHASE(6, moe_alpha(F, 0));
    PHASE(7, moe_beta(F, 0); xcd_barrier(bar); moe_gamma(F, 0));
    if (IN(8)) { ph_ln<1, false, 1>(F, 0); __syncthreads(); convert_experts(F, 1); if (DUP(8)) { __syncthreads(); convert_experts(F, 1); } } SEAM(8);
    PHASE(9, gemm_inproj(F, F.out, WS_WT1, IN1));
    PHASE(10, ph_attn_v2(F));
    PHASE(11, ph_merge(F));
    PHASE(12, gemm_outproj<true>(F, WS_Y2, WS_WO1, 512, F.out));
    if (IN(13)) { ph_ln1_router(F, 1); } SEAM(13);
    PHASE(14, moe_alpha(F, 1));
    PHASE(15, moe_beta(F, 1); xcd_barrier(bar); moe_gamma(F, 1));
    if (IN(16)) { ph_ln<1, false, 2>(F, 1); if (DUP(16)) { xcd_barrier(bar); ph_ln<1, false, 2>(F, 1); } }
#undef IN
#undef SEAM
#undef PHASE
#undef DUP
}

extern "C" void kernel_launch(void* const* d_in, const int* in_sizes, int n_in, void* d_out, int out_size, void* d_ws, size_t ws_size, hipStream_t stream) {
    static int grid = 0;
    if (grid == 0) {
        if (n_in != 18 || in_sizes[0] != M * D || out_size != M * D || ws_size < WS_END) {
            fprintf(stderr, "kernel_launch: unexpected problem (n_in %d, in0 %d, out %d, ws %zu < %zu)\n", n_in, n_in > 0 ? in_sizes[0] : -1, out_size, ws_size, (size_t)WS_END); grid = -1; return; }
        int dev = 0, cus = 0;
        if (hipGetDevice(&dev) != hipSuccess || hipDeviceGetAttribute(&cus, hipDeviceAttributeMultiprocessorCount, dev) != hipSuccess) { grid = -1; return; }
        if (hipFuncSetAttribute((const void*)mega_fwd, hipFuncAttributeMaxDynamicSharedMemorySize, LDS_BYTES) != hipSuccess) { fprintf(stderr, "kernel_launch: hipFuncSetAttribute failed\n"); grid = -1; return; }
        int per_cu = 0;
        if (hipOccupancyMaxActiveBlocksPerMultiprocessor(&per_cu, (const void*)mega_fwd, NT, LDS_BYTES) != hipSuccess || per_cu < 1) fprintf(stderr, "kernel_launch: occupancy query says %d\n", per_cu);
        (void)hipGetLastError();
        grid = cus;
    }
    if (grid < 0) return;
    (void)hipMemsetAsync((char*)d_ws + WS_CTL, 0, CTL_ZERO_BYTES, stream);
    Args a{};
    for (int i = 0; i < 18; ++i) a.in[i] = (const float*)d_in[i];
    a.out = (float*)d_out; a.ws = (unsigned char*)d_ws;
    if (MK_N_LAUNCHES == 1) {
        a.ph_lo = 0; a.ph_hi = N_PHASES; a.li = 0;
        hipLaunchKernelGGL(mega_fwd, dim3(grid), dim3(NT), LDS_BYTES, stream, a);
    } else {
        for (int p = 0; p < N_PHASES; ++p) { a.ph_lo = p; a.ph_hi = p + 1; a.li = p; hipLaunchKernelGGL(mega_fwd, dim3(grid), dim3(NT), LDS_BYTES, stream, a); }
    }
}
```

```cpp
#include <hip/hip_runtime.h>
#include <cstdio>
#include <cstdint>

#ifndef PROBE_DUP
#define PROBE_DUP 0
#endif
#ifndef PROBE_CVAR
#define PROBE_CVAR 0
#endif
#ifndef MK_N_LAUNCHES
#define MK_N_LAUNCHES 1
#endif

#define LAS __attribute__((address_space(3)))
typedef unsigned short bf16;
typedef float f32x4 __attribute__((ext_vector_type(4)));
typedef unsigned u32x4 __attribute__((ext_vector_type(4)));
typedef unsigned u32x2 __attribute__((ext_vector_type(2)));
typedef short bf16x8_t __attribute__((ext_vector_type(8)));
#define RLX_AGENT __ATOMIC_RELAXED, __HIP_MEMORY_SCOPE_AGENT
#define LDS_WAIT() asm volatile("s_waitcnt lgkmcnt(0)" ::: "memory")
#define VM_WAIT() asm volatile("s_waitcnt vmcnt(0)" ::: "memory")

constexpr int NWAVES = 8, NT = NWAVES * 64;
constexpr int BATCH = 2, T = 8192, D = 1024, M = BATCH * T;
constexpr int IN0 = 4104, IN1 = 4608, NP0 = 4096;
constexpr int NE = 32, DE = 256;
constexpr float ALPHA = 1.41421356237309515f;
constexpr float LN_EPS = 1e-5f;
constexpr float KSCALE = 0.08838834764831845f;
constexpr int N_PHASES = 17;

constexpr size_t MiB = 1u << 20;
constexpr size_t WS_CTL = 0, CTL_ZERO_BYTES = 1 * MiB;
constexpr size_t WS_G = 1 * MiB;
constexpr size_t WS_EIDX = WS_G + 512 * 1024;
constexpr size_t WS_GATEV = WS_EIDX + 128 * 1024;
constexpr size_t WS_WT0 = 2 * MiB;
constexpr size_t WS_WO0 = 10 * MiB;
constexpr size_t WS_WT1 = 12 * MiB;
constexpr size_t WS_WO1 = 21 * MiB;
constexpr size_t WS_SE = 22 * MiB;
constexpr size_t WS_EW = WS_SE;
constexpr size_t EW_STRIDE = 3 * MiB / 2, EW_DN = 1 * MiB;
constexpr size_t WS_LIST = WS_SE + 48 * MiB;
constexpr size_t WS_LSE = WS_SE + 50 * MiB;
constexpr size_t WS_XB = 86 * MiB;
constexpr size_t WS_Y = 118 * MiB;
constexpr size_t WS_OG = WS_XB;
constexpr size_t WS_Y2 = WS_XB + 48 * MiB;
constexpr size_t WS_P = 150 * MiB;
constexpr size_t WS_YB = WS_P;
constexpr size_t WS_HID = WS_P + 64 * MiB;
constexpr size_t WS_END = 294 * MiB;
constexpr size_t WS_QKC = WS_SE;

constexpr int GWS = 1032;
constexpr int CB_GWT = 640 * 1024;
constexpr int CB_C12 = 960 * 1024;
constexpr int CW_BAR = 4096;
constexpr int CW_CNT = 16384;

constexpr int LDS_BYTES = 147456;

__device__ __forceinline__ unsigned f2bf(float f) { unsigned u = __builtin_bit_cast(unsigned, f); return (u + 0x7fffu + ((u >> 16) & 1u)) >> 16; }
__device__ __forceinline__ unsigned pk2(float lo, float hi) { return f2bf(lo) | (f2bf(hi) << 16); }
__device__ __forceinline__ float bf2f(unsigned b) { return __builtin_bit_cast(float, b << 16); }
__device__ __forceinline__ float bflo(unsigned w) { return __builtin_bit_cast(float, w << 16); }
__device__ __forceinline__ float bfhi(unsigned w) { return __builtin_bit_cast(float, w & 0xffff0000u); }
__device__ __forceinline__ float wave_sum(float v) {
#pragma unroll
    for (int o = 1; o < 64; o <<= 1) v += __shfl_xor(v, o);
    return v;
}
__device__ __forceinline__ float sigmoidf_(float x) { return 1.f / (1.f + __expf(-x)); }
__device__ __forceinline__ float siluf_(float x) { return x / (1.f + __expf(-x)); }

#define XB_TMO      128
#define XB_XCNT(j)  (256  + 64 * (j))
#define XB_XSUB(j)  (1280 + 64 * (j))
#define XB_XGEN(j)  (2304 + 64 * (j))
#define XB_TOP      3328
#define XB_TOPGEN   3392
#define XCD_BAR_WORDS 3456
#define XB_SPIN_CAP (1u << 22)
__device__ __forceinline__ unsigned xb_ld(unsigned* p)              { return __hip_atomic_load(p, __ATOMIC_RELAXED, __HIP_MEMORY_SCOPE_AGENT); }
__device__ __forceinline__ unsigned xb_add(unsigned* p, unsigned v) { return __hip_atomic_fetch_add(p, v, __ATOMIC_RELAXED, __HIP_MEMORY_SCOPE_AGENT); }
__device__ __forceinline__ unsigned xb_xcc_id() { return (unsigned)__builtin_amdgcn_s_getreg((3 << 11) | 20) & 0xFu; }
#define XB_SPIN(cond, bar) do { unsigned _sp = 0; while (cond) { __builtin_amdgcn_s_sleep(1); \
    if ((++_sp & 255u) == 0u) { if (xb_ld(&(bar)[XB_TMO])) break; if (_sp > XB_SPIN_CAP) { atomicAdd(&(bar)[XB_TMO], 1u); break; } } } } while (0)
struct XcdBarrier { unsigned* bar; unsigned x; volatile LAS unsigned* st; };
__device__ __forceinline__ XcdBarrier xcd_barrier_post(unsigned* bar, volatile LAS unsigned* st) {
    XcdBarrier b; b.bar = bar; b.x = xb_xcc_id(); b.st = st;
    if (threadIdx.x == 0) (void)xb_add(&bar[XB_XCNT(b.x)], 1u);
    return b;
}
__device__ __forceinline__ void xcd_barrier_complete(unsigned* bar, unsigned x, unsigned& nloc, unsigned& nx) {
    const unsigned G = gridDim.x * gridDim.y * gridDim.z;
    unsigned sum, cnt, mine, sp = 0u;
    for (;;) {
        sum = 0u; cnt = 0u; mine = 0u;
#pragma unroll
        for (unsigned j = 0; j < 16; ++j) { const unsigned c = xb_ld(&bar[XB_XCNT(j)]); sum += c; cnt += (c > 0u) ? 1u : 0u; mine = (j == x) ? c : mine; }
        if (sum == G) break;
        __builtin_amdgcn_s_sleep(1);
        if ((++sp & 255u) == 0u) { if (xb_ld(&bar[XB_TMO])) break; if (sp > XB_SPIN_CAP) { atomicAdd(&bar[XB_TMO], 1u); break; } }
    }
    nloc = mine > 0u ? mine : 1u; nx = cnt > 0u ? cnt : 1u;
}
__device__ __forceinline__ void xcd_barrier(const XcdBarrier& b) {
    asm volatile("s_waitcnt vmcnt(0)" ::: "memory");
    __syncthreads();
    if (threadIdx.x == 0) {
        unsigned* bar = b.bar;
        __builtin_amdgcn_s_waitcnt(0);
        unsigned nloc = b.st[0], nx = b.st[1];
        if (nloc == 0u) { xcd_barrier_complete(bar, b.x, nloc, nx); b.st[0] = nloc; b.st[1] = nx; }
        const unsigned old = xb_add(&bar[XB_XSUB(b.x)], 1u);
        const unsigned gen = old / nloc;
        if (old + 1u == (gen + 1u) * nloc) {
            __builtin_amdgcn_fence(__ATOMIC_RELEASE, "agent");
            asm volatile("s_waitcnt vmcnt(0)" ::: "memory");
            const unsigned og = xb_add(&bar[XB_TOP], 1u);
            const unsigned tg = og / nx;
            if (og + 1u == (tg + 1u) * nx) xb_add(&bar[XB_TOPGEN], 1u);
            else XB_SPIN(xb_ld(&bar[XB_TOPGEN]) == tg, bar);
            __builtin_amdgcn_fence(__ATOMIC_ACQUIRE, "agent");
            xb_add(&bar[XB_XGEN(b.x)], 1u);
            asm volatile("s_waitcnt vmcnt(0)" ::: "memory");
        } else {
            XB_SPIN(xb_ld(&bar[XB_XGEN(b.x)]) == gen, bar);
            __builtin_amdgcn_fence(__ATOMIC_ACQUIRE, "agent");
            asm volatile("s_waitcnt vmcnt(0)" ::: "memory");
        }
    }
    __syncthreads();
}

struct Frame {
    LAS unsigned char* lds;
    unsigned* ctl;
    int tid, lane, wave, vcu, G;
    const float* in[18];
    float* out;
    unsigned char* ws;
};

namespace pg8 {
typedef short bf16x8 __attribute__((ext_vector_type(8)));
constexpr int BM = 256, BK = 64, HALF = 128, HTB = HALF * BK * 2, STAGE_BYTES = 8 * HTB, NXCD = 8, WGM = 8;
__host__ __device__ __forceinline__ int lds_byte(int r, int c) { const int st = (r >> 4) * 2 + (c >> 5), rr = r & 15, cc = c & 31, ob = rr * 64 + cc * 2; return st * 1024 + (ob ^ (((ob >> 9) & 1) << 5)); }
__host__ __device__ __forceinline__ void stage_rc(int b, int& R, int& C) { const int st = b / 1024, sb = b % 1024, swz = sb ^ (((sb >> 9) & 1) << 5); R = (st >> 1) * 16 + swz / 64; C = (st & 1) * 32 + (swz % 64) / 2; }
__host__ __device__ __forceinline__ int perm32(int rho) { const int n = rho >> 4, i = rho & 15; return 8 * (i >> 2) + 4 * n + (i & 3); }
struct Unit { int pm, pn, e, cnt, hb; };
typedef __bf16 bf16n2 __attribute__((ext_vector_type(2)));
typedef float f32x2n __attribute__((ext_vector_type(2)));
__device__ __forceinline__ unsigned cvt_pk_bf16(float lo, float hi) { const bf16n2 v = __builtin_convertvector((f32x2n){lo, hi}, bf16n2); return __builtin_bit_cast(unsigned, v); }

struct StaticOrder {
    int nM, nN, nwg, G, c, K; const char* A; const char* Bt;
    __device__ void init(const void* A_, const void* Bt_, int M_, int N_, int K_, int G_, int c_) { A = (const char*)A_; Bt = (const char*)Bt_; nM = M_ / BM; nN = N_ / BM; nwg = nM * nN; G = G_; c = c_; K = K_; }
    __device__ bool next(int i, Unit& u) const {
        const long L = (long)i * G + c; if (L >= nwg) return false;
        int wgid = (int)L; { const int q = nwg / NXCD, r = nwg % NXCD, xcd = wgid % NXCD, off = wgid / NXCD; wgid = (xcd < r ? xcd * (q + 1) : r * (q + 1) + (xcd - r) * q) + off; }
        const int nig = WGM * nN, gid = wgid / nig, fm = gid * WGM, gsz = (nM - fm) < WGM ? (nM - fm) : WGM;
        u.pm = fm + ((wgid % nig) % gsz); u.pn = (wgid % nig) / gsz; u.e = 0; u.cnt = 0; u.hb = 0; return true;
    }
    __device__ __forceinline__ void base(const Unit& u, const char*& cA, const char*& cB) const { cA = A + (size_t)u.pm * BM * K * 2; cB = Bt + (size_t)u.pn * BM * K * 2; }
    __device__ __forceinline__ unsigned rowoff(const Unit&, int) const { return 0u; }
};

struct EpiBf16 {
    static constexpr bool PERM = true;
    bf16* O; int ldc;
    __device__ __forceinline__ void operator()(const f32x4 (&acc)[2][2][4][2], const Unit& u, int wr, int wc, int fr, int fq) const {
        const int row0 = u.pm * BM + wr * 64 + fr, col0 = u.pn * BM + wc * 32 + 8 * fq;
#pragma unroll
        for (int ai = 0; ai < 2; ++ai)
#pragma unroll
            for (int m = 0; m < 4; ++m) { bf16* rowp = O + (size_t)(row0 + ai * HALF + m * 16) * ldc + col0;
#pragma unroll
                for (int bj = 0; bj < 2; ++bj) { const f32x4 v0 = acc[ai][bj][m][0], v1 = acc[ai][bj][m][1];
                    u32x4 w; w.x = cvt_pk_bf16(v0[0], v0[1]); w.y = cvt_pk_bf16(v0[2], v0[3]); w.z = cvt_pk_bf16(v1[0], v1[1]); w.w = cvt_pk_bf16(v1[2], v1[3]);
                    *(u32x4*)(rowp + bj * HALF) = w; } }
    }
};
template <bool BASE_BF16>
struct EpiResBf16 {
    static constexpr bool PERM = true;
    const void* base; bf16* out; float alpha;
    __device__ __forceinline__ void operator()(const f32x4 (&acc)[2][2][4][2], const Unit& u, int wr, int wc, int fr, int fq) const {
        const int col0 = u.pn * BM + wc * 32 + 8 * fq;
#pragma unroll
        for (int ai = 0; ai < 2; ++ai)
#pragma unroll
            for (int m = 0; m < 4; ++m) { const size_t off = (size_t)(u.pm * BM + ai * HALF + wr * 64 + m * 16 + fr) * 1024 + col0;
#pragma unroll
                for (int bj = 0; bj < 2; ++bj) { f32x4 b0, b1;
                    if (BASE_BF16) { const u32x4 x = *(const u32x4*)((const bf16*)base + off + bj * HALF); b0 = (f32x4){bflo(x.x), bfhi(x.x), bflo(x.y), bfhi(x.y)}; b1 = (f32x4){bflo(x.z), bfhi(x.z), bflo(x.w), bfhi(x.w)}; }
                    else { b0 = *(const f32x4*)((const float*)base + off + bj * HALF); b1 = *(const f32x4*)((const float*)base + off + bj * HALF + 4); }
                    const f32x4 v0 = b0 * alpha + acc[ai][bj][m][0], v1 = b1 * alpha + acc[ai][bj][m][1];
                    u32x4 w; w.x = cvt_pk_bf16(v0[0], v0[1]); w.y = cvt_pk_bf16(v0[2], v0[3]); w.z = cvt_pk_bf16(v1[0], v1[1]); w.w = cvt_pk_bf16(v1[2], v1[3]);
                    *(u32x4*)(out + off + bj * HALF) = w; }
                if (m & 1) asm volatile("" ::: "memory"); }
    }
};

struct MoeOrder {
    const unsigned* cnt; const int* LIST; const char* A; const char* B; int NTN, G, c, K, mode, Lbase, Lend;
    __device__ bool next(int i, Unit& u) const {
        if (c < 0) return false;
        const int L = Lbase + i * G + c; if (L >= Lend) return false;
        int base = 0, hb = 0;
        for (int e = 0; e < 32; ++e) { const int cc = (int)cnt[e * 64]; const int nmb = (cc + 255) >> 8; const int ntl = nmb * NTN;
            if (L < base + ntl) { const int r = L - base; u.e = e; u.pm = r / NTN; u.pn = r % NTN; u.cnt = cc; u.hb = hb; return true; }
            base += ntl; hb += nmb << 8; }
        return false;
    }
    __device__ __forceinline__ void base(const Unit& u, const char*& cA, const char*& cB) const {
        cA = mode == 0 ? A : A + (size_t)(u.hb + u.pm * 256) * K * 2; cB = B + (size_t)u.e * EW_STRIDE + (size_t)u.pn * 256 * K * 2; }
    __device__ __forceinline__ unsigned rowoff(const Unit& u, int r) const { int i = u.pm * 256 + r; i = i < u.cnt ? i : 0; return (unsigned)(LIST[u.e * M + i] >> 1) * 2048u; }
};
struct EpiSwiGLU {
    static constexpr bool PERM = true;
    bf16* HID;
    __device__ __forceinline__ void operator()(const f32x4 (&acc)[2][2][4][2], const Unit& u, int wr, int wc, int fr, int fq) const {
#pragma unroll
        for (int ai = 0; ai < 2; ++ai)
#pragma unroll
            for (int m = 0; m < 4; ++m) { const int i = u.pm * 256 + ai * HALF + wr * 64 + m * 16 + fr;
                if (i < u.cnt) { const f32x4 g0 = acc[ai][0][m][0], g1 = acc[ai][0][m][1], u0 = acc[ai][1][m][0], u1 = acc[ai][1][m][1];
                    u32x4 w; w.x = cvt_pk_bf16(siluf_(g0[0]) * u0[0], siluf_(g0[1]) * u0[1]); w.y = cvt_pk_bf16(siluf_(g0[2]) * u0[2], siluf_(g0[3]) * u0[3]);
                    w.z = cvt_pk_bf16(siluf_(g1[0]) * u1[0], siluf_(g1[1]) * u1[1]); w.w = cvt_pk_bf16(siluf_(g1[2]) * u1[2], siluf_(g1[3]) * u1[3]);
                    *(u32x4*)(HID + (size_t)(u.hb + i) * DE + u.pn * 128 + wc * 32 + 8 * fq) = w; } }
    }
};
struct EpiMoeOut {
    static constexpr bool PERM = true;
    bf16* YB; const int* LIST;
    __device__ __forceinline__ void operator()(const f32x4 (&acc)[2][2][4][2], const Unit& u, int wr, int wc, int fr, int fq) const {
#pragma unroll
        for (int ai = 0; ai < 2; ++ai)
#pragma unroll
            for (int m = 0; m < 4; ++m) { const int i = u.pm * 256 + ai * HALF + wr * 64 + m * 16 + fr;
                if (i < u.cnt) { const int a = LIST[u.e * M + i]; bf16* rowp = YB + (size_t)a * D + u.pn * 256 + wc * 32 + 8 * fq;
#pragma unroll
                    for (int bj = 0; bj < 2; ++bj) { const f32x4 v0 = acc[ai][bj][m][0], v1 = acc[ai][bj][m][1];
                        u32x4 w; w.x = cvt_pk_bf16(v0[0], v0[1]); w.y = cvt_pk_bf16(v0[2], v0[3]); w.z = cvt_pk_bf16(v1[0], v1[1]); w.w = cvt_pk_bf16(v1[2], v1[3]);
                        *(u32x4*)(rowp + bj * HALF) = w; } }
                asm volatile("" ::: "memory"); }
    }
};

template <class Epi, class Sched, bool ALIGN_EPI, bool GATHER>
__device__ __forceinline__ void gemm_phase(LAS unsigned char* lds, const int K, const Sched& S, const Epi& E) {
    const int tid = threadIdx.x, wid = __builtin_amdgcn_readfirstlane(tid >> 6), lane = tid & 63, wr = wid >> 2, wc = wid & 3, fr = lane & 15, fq = lane >> 4;
    const int nt = K / BK;
    int Rr[2], Cc[2]; unsigned voffB[2];
#pragma unroll
    for (int i = 0; i < 2; ++i) { int R, C; stage_rc(tid * 16 + i * 8192, R, C); const int Rb = Epi::PERM ? ((R & ~31) + perm32(R & 31)) : R; Rr[i] = R; Cc[i] = C; voffB[i] = (unsigned)(Rb * K + C) * 2u; }
    const size_t kstep = (size_t)(BK * 2);
    const size_t hstep = (size_t)HALF * K * 2;
    const unsigned ldsw = (unsigned)wid * 1024u;
    const int aoff = lds_byte(wr * 64 + fr, fq * 8), boff = lds_byte(wc * 32 + fr, fq * 8);
#define PG8_SA(b, h) (((b) * 2 + (h)) * HTB)
#define PG8_SB(b, h) ((4 + (b) * 2 + (h)) * HTB)
#define PG8_STAGE(bufoff, gbase, voff) do { _Pragma("unroll") for (int _i = 0; _i < 2; ++_i) \
        __builtin_amdgcn_global_load_lds((const unsigned*)((const char*)(gbase) + (voff)[_i]), (LAS unsigned*)(lds + (bufoff) + ldsw + _i * 8192), 16, 0, 0); } while (0)
#define PG8_STAGE_A(bufoff, gbase, o0, o1) do { \
        __builtin_amdgcn_global_load_lds((const unsigned*)((const char*)(gbase) + (o0)), (LAS unsigned*)(lds + (bufoff) + ldsw), 16, 0, 0); \
        __builtin_amdgcn_global_load_lds((const unsigned*)((const char*)(gbase) + (o1)), (LAS unsigned*)(lds + (bufoff) + ldsw + 8192), 16, 0, 0); } while (0)
#define PG8_LDA(dst, b, h) do { _Pragma("unroll") for (int m = 0; m < 4; ++m) _Pragma("unroll") for (int k = 0; k < 2; ++k) dst[m][k] = *(const LAS bf16x8*)(lds + PG8_SA(b, h) + aoff + m * 2048 + k * 1024); } while (0)
#define PG8_LDB(dst, b, h) do { _Pragma("unroll") for (int n = 0; n < 2; ++n) _Pragma("unroll") for (int k = 0; k < 2; ++k) dst[n][k] = *(const LAS bf16x8*)(lds + PG8_SB(b, h) + boff + n * 2048 + k * 1024); } while (0)
#define PG8_MMA(ai, bj, At, Bt) do { __builtin_amdgcn_s_setprio(1); _Pragma("unroll") for (int m = 0; m < 4; ++m) _Pragma("unroll") for (int n = 0; n < 2; ++n) _Pragma("unroll") for (int k = 0; k < 2; ++k) \
        acc[ai][bj][m][n] = __builtin_amdgcn_mfma_f32_16x16x32_bf16(Bt[n][k], At[m][k], acc[ai][bj][m][n], 0, 0, 0); __builtin_amdgcn_s_setprio(0); } while (0)
#define PG8_WAIT_V(n) asm volatile("s_waitcnt vmcnt(" #n ")" ::: "memory")
#define PG8_WAIT_L(n) asm volatile("s_waitcnt lgkmcnt(" #n ")" ::: "memory")
#define PG8_BAR __builtin_amdgcn_s_barrier()
#define PG8_SCHED __builtin_amdgcn_sched_barrier(0)
#define PG8_CALC_VA(u, v) do { _Pragma("unroll") for (int _h = 0; _h < 2; ++_h) _Pragma("unroll") for (int _i = 0; _i < 2; ++_i) \
        v[_h][_i] = GATHER ? (S.rowoff(u, _h * HALF + Rr[_i]) + (unsigned)Cc[_i] * 2u) : (unsigned)((_h * HALF + Rr[_i]) * K + Cc[_i]) * 2u; } while (0)
    Unit cur, nxt; int ui = 0;
    if (!S.next(0, cur)) return;
    f32x4 acc[2][2][4][2];
#pragma unroll
    for (int a = 0; a < 2; ++a)
#pragma unroll
        for (int b = 0; b < 2; ++b)
#pragma unroll
            for (int m = 0; m < 4; ++m)
#pragma unroll
                for (int n = 0; n < 2; ++n) acc[a][b][m][n] = (f32x4){0.f, 0.f, 0.f, 0.f};
    bf16x8 At[4][2], B0[2][2], B1[2][2];
    const char* cA; const char* cB; S.base(cur, cA, cB);
    unsigned cvA[2][2], nvA[2][2];
    PG8_CALC_VA(cur, cvA);
    PG8_STAGE(PG8_SB(0, 0), cB, voffB); PG8_STAGE(PG8_SB(0, 1), cB + hstep, voffB); PG8_STAGE_A(PG8_SA(0, 0), cA, cvA[0][0], cvA[0][1]); PG8_STAGE_A(PG8_SA(0, 1), cA, cvA[1][0], cvA[1][1]);
    if (wr == 1) PG8_BAR;
    PG8_WAIT_V(2); PG8_BAR;
    PG8_STAGE(PG8_SB(1, 0), cB + kstep, voffB); PG8_STAGE_A(PG8_SA(1, 0), cA + kstep, cvA[0][0], cvA[0][1]); PG8_STAGE(PG8_SB(1, 1), cB + hstep + kstep, voffB);
    PG8_WAIT_V(6); PG8_BAR;
    for (;;) {
        const bool has_next = S.next(ui + 1, nxt);
        const char* nA = cA; const char* nB = cB;
        if (has_next) { S.base(nxt, nA, nB); PG8_CALC_VA(nxt, nvA); }
        else {
#pragma unroll
            for (int h = 0; h < 2; ++h)
#pragma unroll
                for (int i = 0; i < 2; ++i) nvA[h][i] = cvA[h][i]; }
        if (GATHER) { asm volatile("s_waitcnt vmcnt(0)" ::: "memory"); asm volatile("" : "+v"(nvA[0][0]), "+v"(nvA[0][1]), "+v"(nvA[1][0]), "+v"(nvA[1][1])); }
#pragma unroll 1
        for (int t = 0; t < nt; t += 2) {
            const bool last = (t == nt - 2);
            const char* a1 = cA + (size_t)(t + 1) * kstep;
            const char* a2 = last ? nA : cA + (size_t)(t + 2) * kstep; const char* b2 = last ? nB : cB + (size_t)(t + 2) * kstep;
            const char* a3 = a2 + kstep; const char* b3 = b2 + kstep;
            const unsigned x00 = last ? nvA[0][0] : cvA[0][0], x01 = last ? nvA[0][1] : cvA[0][1], x10 = last ? nvA[1][0] : cvA[1][0], x11 = last ? nvA[1][1] : cvA[1][1];
            PG8_LDB(B0, 0, 0); PG8_LDB(B1, 0, 1); PG8_SCHED; PG8_LDA(At, 0, 0); PG8_STAGE_A(PG8_SA(1, 1), a1, cvA[1][0], cvA[1][1]);
            PG8_WAIT_V(8); PG8_WAIT_L(0); PG8_BAR; PG8_MMA(0, 0, At, B0); PG8_MMA(0, 1, At, B1); PG8_BAR; PG8_SCHED;
            PG8_LDA(At, 0, 1); PG8_STAGE(PG8_SB(0, 0), b2, voffB); PG8_STAGE(PG8_SB(0, 1), b2 + hstep, voffB); PG8_STAGE_A(PG8_SA(0, 0), a2, x00, x01);
            PG8_WAIT_V(8); PG8_WAIT_L(0); PG8_BAR; PG8_MMA(1, 0, At, B0); PG8_MMA(1, 1, At, B1); PG8_BAR; PG8_SCHED;
            PG8_LDB(B0, 1, 0); PG8_LDB(B1, 1, 1); PG8_SCHED; PG8_LDA(At, 1, 0); PG8_STAGE_A(PG8_SA(0, 1), a2, x10, x11);
            PG8_WAIT_V(8); PG8_WAIT_L(0); PG8_BAR; PG8_MMA(0, 0, At, B0); PG8_MMA(0, 1, At, B1); PG8_BAR; PG8_SCHED;
            PG8_LDA(At, 1, 1); PG8_STAGE(PG8_SB(1, 0), b3, voffB); PG8_STAGE(PG8_SB(1, 1), b3 + hstep, voffB); PG8_STAGE_A(PG8_SA(1, 0), a3, x00, x01);
            PG8_WAIT_V(8); PG8_WAIT_L(0); PG8_BAR; PG8_MMA(1, 0, At, B0); PG8_MMA(1, 1, At, B1); PG8_BAR; PG8_SCHED;
        }
        if constexpr (ALIGN_EPI) { if (wr == 0) PG8_BAR; }
        E(acc, cur, wr, wc, fr, fq);
        if (!has_next) break;
#pragma unroll
        for (int a = 0; a < 2; ++a)
#pragma unroll
            for (int b = 0; b < 2; ++b)
#pragma unroll
                for (int m = 0; m < 4; ++m)
#pragma unroll
                    for (int n = 0; n < 2; ++n) acc[a][b][m][n] = (f32x4){0.f, 0.f, 0.f, 0.f};
        cur = nxt; cA = nA; cB = nB; ++ui;
#pragma unroll
        for (int h = 0; h < 2; ++h)
#pragma unroll
            for (int i = 0; i < 2; ++i) cvA[h][i] = nvA[h][i];
        if constexpr (ALIGN_EPI) { if (wr == 1) PG8_BAR; }
    }
    PG8_WAIT_V(0);
    if constexpr (!ALIGN_EPI) { if (wr == 0) PG8_BAR; }
    PG8_BAR;
#undef PG8_SA
#undef PG8_SB
#undef PG8_STAGE
#undef PG8_STAGE_A
#undef PG8_LDA
#undef PG8_LDB
#undef PG8_MMA
#undef PG8_WAIT_V
#undef PG8_WAIT_L
#undef PG8_BAR
#undef PG8_SCHED
#undef PG8_CALC_VA
}
}

template <class RowFn>
__device__ __forceinline__ void ngemm_tile(LAS float* sA, LAS float* sB, RowFn rowA, const bf16* Bt, int ldb, int K, float (&acc)[4][4]) {
    const int tid = threadIdx.x, tx = tid & 15, ty = tid >> 4;
#pragma unroll
    for (int i = 0; i < 4; ++i)
#pragma unroll
        for (int j = 0; j < 4; ++j) acc[i][j] = 0.f;
    const int ar = tid >> 2, ak = (tid & 3) * 8, br = tid >> 3, bk = (tid & 7) * 4;
    const bf16* ap = rowA(ar);
    const bf16* bp = Bt + (size_t)br * ldb;
    for (int k0 = 0; k0 < K; k0 += 32) {
        u32x4 av = (u32x4){0u, 0u, 0u, 0u};
        if (ap) av = *(const u32x4*)(ap + k0 + ak);
        const u32x2 bv = *(const u32x2*)(bp + k0 + bk);
        __syncthreads();
        LAS float* wa = sA + ar * 33 + ak;
        wa[0] = bflo(av.x); wa[1] = bfhi(av.x); wa[2] = bflo(av.y); wa[3] = bfhi(av.y); wa[4] = bflo(av.z); wa[5] = bfhi(av.z); wa[6] = bflo(av.w); wa[7] = bfhi(av.w);
        LAS float* wb = sB + br * 33 + bk;
        wb[0] = bflo(bv.x); wb[1] = bfhi(bv.x); wb[2] = bflo(bv.y); wb[3] = bfhi(bv.y);
        __syncthreads();
#pragma unroll 8
        for (int kk = 0; kk < 32; ++kk) {
            float a[4], b[4];
#pragma unroll
            for (int i = 0; i < 4; ++i) a[i] = sA[(ty * 4 + i) * 33 + kk];
#pragma unroll
            for (int j = 0; j < 4; ++j) b[j] = sB[(tx * 4 + j) * 33 + kk];
#pragma unroll
            for (int i = 0; i < 4; ++i)
#pragma unroll
                for (int j = 0; j < 4; ++j) acc[i][j] = fmaf(a[i], b[j], acc[i][j]);
        }
    }
}

__device__ __forceinline__ void tr_item(const float* W, int ldw, bf16* WT, int ldt, LAS float* scr, int kb, int nb, int lane) {
    const int k0 = 64 * kb, n0 = 32 * nb;
#pragma unroll 8
    for (int i = 0; i < 32; ++i) { const int kk = 2 * i + (lane >> 5); scr[kk * 33 + (lane & 31)] = W[(size_t)(k0 + kk) * ldw + n0 + (lane & 31)]; }
    LDS_WAIT(); asm volatile("" ::: "memory");
    const int c = lane & 7;
#pragma unroll
    for (int j = 0; j < 4; ++j) { const int n = (lane >> 3) + 8 * j; const LAS float* s = scr + (8 * c) * 33 + n;
        u32x4 o; o.x = pk2(s[0 * 33], s[1 * 33]); o.y = pk2(s[2 * 33], s[3 * 33]); o.z = pk2(s[4 * 33], s[5 * 33]); o.w = pk2(s[6 * 33], s[7 * 33]);
        *(u32x4*)(WT + (size_t)(n0 + n) * ldt + k0 + 8 * c) = o; }
    LDS_WAIT(); asm volatile("" ::: "memory");
}

__device__ __forceinline__ void ph0_convert(Frame& F) {
    LAS float* scr = (LAS float*)(F.lds + F.wave * 9216);
    LAS float* gw = (LAS float*)(F.lds + 8 * 9216);
    const float* w0 = F.in[1];
    for (int i = F.tid; i < 8 * 1024; i += NT) { const int j = i >> 10, k = i & 1023; gw[i] = w0[(size_t)k * IN0 + 2048 + j]; }
    __syncthreads();
    const int gwv = F.vcu * NWAVES + F.wave, NGW = F.G * NWAVES;
    bf16* WT0 = (bf16*)(F.ws + WS_WT0); bf16* WO0 = (bf16*)(F.ws + WS_WO0); bf16* WT1 = (bf16*)(F.ws + WS_WT1); bf16* WO1 = (bf16*)(F.ws + WS_WO1);
    constexpr int I0 = 16 * 64, I1 = 16 * 64, I2 = 16 * 32, I3 = 16 * 144, I4 = 8 * 32, NI = I0 + I1 + I2 + I3 + I4;
    for (int it = gwv; it < NI; it += NGW) {
        int r = it;
        if (r < I0) { tr_item(w0, IN0, WT0, 1024, scr, r / 64, r % 64, F.lane); continue; } r -= I0;
        if (r < I1) { tr_item(w0 + 2056, IN0, WT0 + (size_t)2048 * 1024, 1024, scr, r / 64, r % 64, F.lane); continue; } r -= I1;
        if (r < I2) { tr_item(F.in[8], 1024, WO0, 1024, scr, r / 32, r % 32, F.lane); continue; } r -= I2;
        if (r < I3) { tr_item(F.in[9], IN1, WT1, 1024, scr, r / 144, r % 144, F.lane); continue; } r -= I3;
        tr_item(F.in[10], 1024, WO1, 512, scr, r / 32, r % 32, F.lane);
    }
    for (int it = gwv; it < 64; it += NGW) { const int layer = it >> 5, e = it & 31;
        const float* rw = F.in[11]; const float* lg = F.in[16] + (size_t)(layer * 2) * D; const float* lb = F.in[17] + (size_t)(layer * 2) * D;
        bf16* th = (bf16*)((char*)F.ctl + CB_GWT) + (size_t)((layer * 2 + 0) * 32 + e) * GWS; bf16* tl = (bf16*)((char*)F.ctl + CB_GWT) + (size_t)((layer * 2 + 1) * 32 + e) * GWS;
        float s1 = 0.f, s2 = 0.f;
        for (int k = F.lane; k < D; k += 64) { const float wv = rw[(size_t)k * 32 + e], gw = lg[k] * wv; const unsigned hi = f2bf(gw); const float rem = gw - bf2f(hi);
            th[k] = (bf16)hi; tl[k] = (bf16)f2bf(rem); s1 += gw; s2 += lb[k] * wv; }
        s1 = wave_sum(s1); s2 = wave_sum(s2);
        if (F.lane == 0) { float* c12 = (float*)((char*)F.ctl + CB_C12) + layer * 64; c12[e] = s1; c12[32 + e] = s2; } }
    const float* x = F.in[0]; bf16* XB = (bf16*)(F.ws + WS_XB); float* G = (float*)(F.ws + WS_G);
    const float* ib = F.in[2]; const float* fb = F.in[3];
    f32x4 nx[4];
    if (gwv < M) { const f32x4* xr = (const f32x4*)(x + (size_t)gwv * D) + F.lane;
#pragma unroll
        for (int j = 0; j < 4; ++j) nx[j] = xr[64 * j]; }
    for (int m = gwv; m < M; m += NGW) {
        f32x4 v[4];
#pragma unroll
        for (int j = 0; j < 4; ++j) v[j] = nx[j];
        if (m + NGW < M) { const f32x4* xr = (const f32x4*)(x + (size_t)(m + NGW) * D) + F.lane;
#pragma unroll
            for (int j = 0; j < 4; ++j) nx[j] = xr[64 * j]; }
        unsigned long long* o8 = (unsigned long long*)(XB + (size_t)m * D) + F.lane;
#pragma unroll
        for (int j = 0; j < 4; ++j) o8[64 * j] = (unsigned long long)pk2(v[j].x, v[j].y) | ((unsigned long long)pk2(v[j].z, v[j].w) << 32);
        float acc[8];
#pragma unroll
        for (int g = 0; g < 8; ++g) { float a = 0.f;
#pragma unroll
            for (int j = 0; j < 4; ++j) { const f32x4 w = *(const LAS f32x4*)(gw + g * 1024 + 4 * F.lane + 256 * j); a += v[j].x * w.x + v[j].y * w.y + v[j].z * w.z + v[j].w * w.w; }
            acc[g] = wave_sum(a); }
        if (F.lane == 0) {
#pragma unroll
            for (int g = 0; g < 4; ++g) G[(size_t)m * 8 + g] = acc[g] + ib[g];
#pragma unroll
            for (int g = 0; g < 4; ++g) { const float z = acc[4 + g] + fb[g]; G[(size_t)m * 8 + 4 + g] = fminf(z, 0.f) - log1pf(__expf(-fabsf(z))); }
        }
    }
}

__device__ __forceinline__ void convert_experts(Frame& F, int layer, int part = -1, int nparts = 0) {
    LAS float* scr = (LAS float*)(F.lds + F.wave * 9216);
    const int gwv = (part < 0 ? F.vcu : part) * NWAVES + F.wave, NGW = (part < 0 ? F.G : nparts) * NWAVES;
    const float* wg = F.in[13] + (size_t)layer * NE * D * DE; const float* wu = F.in[14] + (size_t)layer * NE * D * DE; const float* wd = F.in[15] + (size_t)layer * NE * DE * D;
    for (int it = gwv; it < NE * 384; it += NGW) {
        const int e = it / 384; int r = it % 384;
        bf16* GU = (bf16*)(F.ws + WS_EW + (size_t)e * EW_STRIDE); bf16* DN = (bf16*)(F.ws + WS_EW + (size_t)e * EW_STRIDE + EW_DN);
        if (r < 256) { const int job = r >> 6, q = r & 63;
            const float* src = ((job < 2) ? wg : wu) + (size_t)e * D * DE + (job & 1) * 128;
            bf16* dst = GU + (size_t)((job & 1) * 256 + (job >> 1) * 128) * 1024;
            tr_item(src, DE, dst, 1024, scr, q >> 2, q & 3, F.lane);
        } else { r -= 256;
            tr_item(wd + (size_t)e * DE * D, D, DN, DE, scr, r >> 5, r & 31, F.lane); }
    }
}

__device__ __forceinline__ void ph_inproj_naive(Frame& F, const bf16* Bt, int N) {
    LAS float* sA = (LAS float*)F.lds; LAS float* sB = sA + 128 * 33;
    const bf16* XB = (const bf16*)(F.ws + WS_XB); bf16* P = (bf16*)(F.ws + WS_P);
    const int nnb = N / 64, ntiles = (M / 128) * nnb, tx = F.tid & 15, ty = F.tid >> 4;
    for (int t = blockIdx.x; t < ntiles; t += F.G) {
        const int mb = t / nnb, nb = t % nnb; float acc[4][4];
        ngemm_tile(sA, sB, [&](int r) { return XB + (size_t)(mb * 128 + r) * D; }, Bt + (size_t)nb * 64 * D, D, D, acc);
#pragma unroll
        for (int i = 0; i < 4; ++i) { u32x2 o; o.x = pk2(acc[i][0], acc[i][1]); o.y = pk2(acc[i][2], acc[i][3]);
            *(u32x2*)(P + (size_t)(mb * 128 + ty * 4 + i) * N + nb * 64 + tx * 4) = o; }
    }
}
__device__ __forceinline__ void ph_outproj_naive(Frame& F, const bf16* A, int K, const bf16* Bt, const float* base) {
    LAS float* sA = (LAS float*)F.lds; LAS float* sB = sA + 128 * 33;
    const int nnb = D / 64, ntiles = (M / 128) * nnb, tx = F.tid & 15, ty = F.tid >> 4;
    for (int t = blockIdx.x; t < ntiles; t += F.G) {
        const int mb = t / nnb, nb = t % nnb; float acc[4][4];
        ngemm_tile(sA, sB, [&](int r) { return A + (size_t)(mb * 128 + r) * K; }, Bt + (size_t)nb * 64 * K, K, K, acc);
#pragma unroll
        for (int i = 0; i < 4; ++i) { const size_t off = (size_t)(mb * 128 + ty * 4 + i) * D + nb * 64 + tx * 4;
            const f32x4 b = *(const f32x4*)(base + off);
            *(f32x4*)(F.out + off) = (f32x4){ALPHA * b.x + acc[i][0], ALPHA * b.y + acc[i][1], ALPHA * b.z + acc[i][2], ALPHA * b.w + acc[i][3]}; }
    }
}

__device__ __forceinline__ void ph_conv_naive(Frame& F) {
    const bf16* P = (const bf16*)(F.ws + WS_P); bf16* QKC = (bf16*)(F.ws + WS_QKC);
    const float* cw = F.in[4]; const float* cb = F.in[5];
    const size_t total = (size_t)M * 1024, nth = (size_t)F.G * NT;
    for (size_t i = (size_t)blockIdx.x * NT + F.tid; i < total; i += nth) {
        const int m = (int)(i >> 10), c = (int)(i & 1023), t = m & (T - 1);
        float a = cb[c];
#pragma unroll
        for (int j = 0; j < 4; ++j) { const int tt = t - 3 + j; if (tt >= 0) a += cw[j * 1024 + c] * bf2f(P[(size_t)(m - 3 + j) * NP0 + c]); }
        QKC[i] = (bf16)f2bf(siluf_(a));
    }
}
__device__ __forceinline__ void ph_recurrent_naive(Frame& F) {
    if (blockIdx.x >= 16) return;
    const int type = blockIdx.x >> 3, b = (blockIdx.x >> 2) & 1, h = blockIdx.x & 3;
    LAS float* sin = (LAS float*)F.lds;
    LAS float* red = sin + 1024;
    LAS float* redd = red + 512;
    LAS float* sc = redd + 4;
    const bf16* P = (const bf16*)(F.ws + WS_P); const bf16* QKC = (const bf16*)(F.ws + WS_QKC); const float* G = (const float*)(F.ws + WS_G);
    bf16* Y = (bf16*)(F.ws + WS_Y);
    const float* gain = (type == 0 ? F.in[6] : F.in[7]) + h * 128;
    const int e = F.tid & 127, dg = F.tid >> 7, which = dg;
    const float gamma = 1.f - exp2f(-5.f - (float)h);
    float C[32], nn[32];
#pragma unroll
    for (int j = 0; j < 32; ++j) { C[j] = 0.f; nn[j] = 0.f; }
    const bf16* src; size_t stride;
    if (type == 0) { if (which < 2) { src = QKC + which * 512 + h * 128 + e; stride = 1024; } else { src = P + 1024 + (which - 2) * 512 + h * 128 + e; stride = NP0; } }
    else { src = P + 2048 + which * 512 + h * 128 + e; stride = NP0; }
    const float mul = (which == 1) ? KSCALE : 1.f;
    const size_t m0 = (size_t)b * T;
    float val = bf2f(src[m0 * stride]) * mul;
    float s0 = 0.f, s1 = 0.f;
    if (F.tid == 0) { if (type == 0) { s0 = __expf(G[m0 * 8 + 4 + h]); s1 = __expf(G[m0 * 8 + h]); } else { s0 = gamma; s1 = 1.f; } }
    for (int t = 0; t < T; ++t) {
        const size_t m = m0 + t; const int pb = t & 1;
        sin[pb * 512 + F.tid] = val;
        if (F.tid == 0) { sc[pb * 2] = s0; sc[pb * 2 + 1] = s1; }
        if (t + 1 < T) { val = bf2f(src[(m + 1) * stride]) * mul;
            if (F.tid == 0 && type == 0) { s0 = __expf(G[(m + 1) * 8 + 4 + h]); s1 = __expf(G[(m + 1) * 8 + h]); } }
        __syncthreads();
        const float f = sc[pb * 2], ig = sc[pb * 2 + 1];
        const LAS float* sq = sin + pb * 512; const LAS float* sk = sq + 128; const LAS float* sv = sq + 256; const LAS float* so = sq + 384;
        const float ve = sv[e] * ig;
        float pn = 0.f, pd = 0.f;
#pragma unroll
        for (int j = 0; j < 32; ++j) { const int d = dg * 32 + j; const float kd = sk[d], qd = sq[d];
            C[j] = fmaf(f, C[j], kd * ve); nn[j] = fmaf(f, nn[j], ig * kd); pn = fmaf(C[j], qd, pn); pd = fmaf(nn[j], qd, pd); }
        red[dg * 128 + e] = pn; if (e == 0) redd[dg] = pd;
        __syncthreads();
        if (F.tid < 64) {
            const int e0 = F.tid, e1 = F.tid + 64;
            float h0 = (red[e0] + red[128 + e0]) + (red[256 + e0] + red[384 + e0]);
            float h1 = (red[e1] + red[128 + e1]) + (red[256 + e1] + red[384 + e1]);
            if (type == 0) { const float den = (redd[0] + redd[1]) + (redd[2] + redd[3]); const float dn = fmaxf(fabsf(den), 1.f);
                h0 = h0 / dn * sigmoidf_(so[e0]); h1 = h1 / dn * sigmoidf_(so[e1]); }
            const float mean = wave_sum(h0 + h1) * (1.f / 128.f); const float d0 = h0 - mean, d1 = h1 - mean;
            const float rstd = 1.f / sqrtf(wave_sum(d0 * d0 + d1 * d1) * (1.f / 128.f) + LN_EPS);
            float y0 = d0 * rstd * gain[e0], y1 = d1 * rstd * gain[e1];
            if (type == 1) { y0 *= siluf_(so[e0]); y1 *= siluf_(so[e1]); }
            Y[m * 1024 + type * 512 + h * 128 + e0] = (bf16)f2bf(y0); Y[m * 1024 + type * 512 + h * 128 + e1] = (bf16)f2bf(y1);
        }
    }
}

constexpr size_t WS_S = WS_SE;
constexpr size_t WS_DN = WS_G + 768 * 1024;
constexpr size_t WS_QKC2 = WS_SE + 32 * MiB;
constexpr size_t WS_SCANV = WS_P + 128 * MiB;
constexpr int CB_GL = 512 * 1024, CB_MSC = 520 * 1024;
constexpr int TRS = 144, RWS = 136;
template <int O0, int O1>
__device__ __forceinline__ void tr2(unsigned a, u32x2& r0, u32x2& r1) {
    asm volatile("ds_read_b64_tr_b16 %0, %2 offset:%3\n\tds_read_b64_tr_b16 %1, %2 offset:%4\n\ts_waitcnt lgkmcnt(0)" : "=&v"(r0), "=&v"(r1) : "v"(a), "i"(O0), "i"(O1) : "memory");
}
template <int B, int H>
__device__ __forceinline__ void tr8(unsigned a, u32x2& r0, u32x2& r1, u32x2& r2, u32x2& r3, u32x2& r4, u32x2& r5, u32x2& r6, u32x2& r7) {
    asm volatile("ds_read_b64_tr_b16 %0, %8 offset:%9\n\tds_read_b64_tr_b16 %1, %8 offset:%10\n\tds_read_b64_tr_b16 %2, %8 offset:%11\n\tds_read_b64_tr_b16 %3, %8 offset:%12\n\t"
                 "ds_read_b64_tr_b16 %4, %8 offset:%13\n\tds_read_b64_tr_b16 %5, %8 offset:%14\n\tds_read_b64_tr_b16 %6, %8 offset:%15\n\tds_read_b64_tr_b16 %7, %8 offset:%16\n\ts_waitcnt lgkmcnt(0)"
                 : "=&v"(r0), "=&v"(r1), "=&v"(r2), "=&v"(r3), "=&v"(r4), "=&v"(r5), "=&v"(r6), "=&v"(r7)
                 : "v"(a), "i"(B), "i"(B + H), "i"(B + 32), "i"(B + 32 + H), "i"(B + 64), "i"(B + 64 + H), "i"(B + 96), "i"(B + 96 + H) : "memory");
}
__device__ __forceinline__ bf16x8_t pack_frag(u32x2 a, u32x2 b) { return __builtin_bit_cast(bf16x8_t, (u32x4){a.x, a.y, b.x, b.y}); }
__device__ __forceinline__ void scan128_sum(float& x0, float& x1, int lane) {
#pragma unroll
    for (int o = 1; o < 64; o <<= 1) { const float t0 = __shfl_up(x0, o), t1 = __shfl_up(x1, o); if (lane >= o) { x0 += t0; x1 += t1; } }
    x1 += __shfl(x0, 63);
}
__device__ __forceinline__ void scan128_max(float& x0, float& x1, int lane) {
#pragma unroll
    for (int o = 1; o < 64; o <<= 1) { const float t0 = __shfl_up(x0, o), t1 = __shfl_up(x1, o); if (lane >= o) { x0 = fmaxf(x0, t0); x1 = fmaxf(x1, t1); } }
    x1 = fmaxf(x1, __shfl(x0, 63));
}
__device__ __forceinline__ float wave_max(float v) {
#pragma unroll
    for (int o = 1; o < 64; o <<= 1) v = fmaxf(v, __shfl_xor(v, o));
    return v;
}
__device__ __forceinline__ void conv8(const bf16* Pc, int row, int tpos0, const LAS float* cwp, float (&o)[8]) {
    { const f32x4 b0 = *(const LAS f32x4*)(cwp + 512), b1 = *(const LAS f32x4*)(cwp + 516); o[0] = b0.x; o[1] = b0.y; o[2] = b0.z; o[3] = b0.w; o[4] = b1.x; o[5] = b1.y; o[6] = b1.z; o[7] = b1.w; }
#pragma unroll
    for (int j = 0; j < 4; ++j) { const int r = row - 3 + j;
        if (tpos0 + r >= 0) { const u32x4 x = *(const u32x4*)(Pc + (long)r * NP0); const f32x4 w0 = *(const LAS f32x4*)(cwp + j * 128), w1 = *(const LAS f32x4*)(cwp + j * 128 + 4);
            o[0] += w0.x * bflo(x.x); o[1] += w0.y * bfhi(x.x); o[2] += w0.z * bflo(x.y); o[3] += w0.w * bfhi(x.y); o[4] += w1.x * bflo(x.z); o[5] += w1.y * bfhi(x.z); o[6] += w1.z * bflo(x.w); o[7] += w1.w * bfhi(x.w); } }
#pragma unroll
    for (int e = 0; e < 8; ++e) o[e] = siluf_(o[e]);
}
__device__ __forceinline__ u32x4 pack8(const float (&o)[8], float sc) {
    u32x4 w; w.x = pg8::cvt_pk_bf16(o[0] * sc, o[1] * sc); w.y = pg8::cvt_pk_bf16(o[2] * sc, o[3] * sc); w.z = pg8::cvt_pk_bf16(o[4] * sc, o[5] * sc); w.w = pg8::cvt_pk_bf16(o[6] * sc, o[7] * sc); return w; }
__device__ __forceinline__ void unpack8(u32x4 x, float (&o)[8]) { o[0] = bflo(x.x); o[1] = bfhi(x.x); o[2] = bflo(x.y); o[3] = bfhi(x.y); o[4] = bflo(x.z); o[5] = bfhi(x.z); o[6] = bflo(x.w); o[7] = bfhi(x.w); }

__device__ __forceinline__ void ph_mix_a(Frame& F) {
    LAS bf16* Vl = (LAS bf16*)F.lds;
    LAS bf16* Kl = Vl + 128 * TRS;
    LAS float* cwl = (LAS float*)(Kl + 128 * TRS);
    LAS float* wl = cwl + 1280;
    const bf16* P = (const bf16*)(F.ws + WS_P); const float* G = (const float*)(F.ws + WS_G); bf16* S = (bf16*)(F.ws + WS_S); float* DN = (float*)(F.ws + WS_DN);
    float* GL = (float*)((char*)F.ctl + CB_GL); bf16* QKC = (bf16*)(F.ws + WS_QKC2); float* SCANV = (float*)(F.ws + WS_SCANV);
    const float* cw = F.in[4]; const float* cb = F.in[5];
    const int tid = F.tid, lane = F.lane, w = F.wave, fr = lane & 15, fq = lane >> 4;
    const unsigned vaddr = (unsigned)(size_t)Vl + (unsigned)(((4 * fq + (fr >> 2)) * TRS + 16 * w + 4 * (fr & 3)) * 2);
    const unsigned kaddr = (unsigned)(size_t)Kl + (unsigned)(((4 * fq + (fr >> 2)) * TRS + 4 * (fr & 3)) * 2);
    for (int u = blockIdx.x; u < 1024; u += F.G) {
        const int type = u >> 9, b = (u >> 8) & 1, h = (u >> 6) & 3, c = u & 63, chain = type * 8 + b * 4 + h;
        const size_t m0 = (size_t)b * T + c * 128;
        const int kcol = (type == 0 ? 512 : 2560) + h * 128, vcol = (type == 0 ? 1024 : 3072) + h * 128;
        __syncthreads();
        if (type == 0) for (int i = tid; i < 1280; i += NT) { const int part = i / 640, r = i % 640, j = r >> 7, d = r & 127, col = part * 512 + h * 128 + d; cwl[i] = j < 4 ? cw[j * 1024 + col] : cb[col]; }
        if (w == 0) {
            float w0, w1;
            if (type == 0) {
                const float i0 = G[(m0 + lane) * 8 + h], i1 = G[(m0 + lane + 64) * 8 + h];
                float b0 = G[(m0 + lane) * 8 + 4 + h], b1 = G[(m0 + lane + 64) * 8 + 4 + h];
                scan128_sum(b0, b1, lane);
                const float g = __shfl(b1, 63), lw0 = g - b0 + i0, lw1 = g - b1 + i1, ml = wave_max(fmaxf(lw0, lw1));
                w0 = __expf(lw0 - ml); w1 = __expf(lw1 - ml);
                if (lane == 0) { GL[(chain * 64 + c) * 2] = g; GL[(chain * 64 + c) * 2 + 1] = ml; }
                const float u0 = i0 - b0, u1 = i1 - b1; float p0 = u0, p1 = u1; scan128_max(p0, p1, lane);
                float* sv = SCANV + (size_t)(chain * 64 + c) * 384; sv[lane] = b0; sv[lane + 64] = b1; sv[128 + lane] = u0; sv[192 + lane] = u1; sv[256 + lane] = p0; sv[320 + lane] = p1;
            } else { const float lg = log1pf(-exp2f(-5.f - (float)h)); w0 = __expf(lg * (float)(127 - lane)); w1 = __expf(lg * (float)(63 - lane)); }
            wl[lane] = w0 * KSCALE; wl[lane + 64] = w1 * KSCALE;
        }
#pragma unroll
        for (int it = 0; it < 4; ++it) { const int s = (tid >> 4) + 32 * it, ch = tid & 15;
            *(LAS u32x4*)(Vl + s * TRS + ch * 8) = *(const u32x4*)(P + (m0 + s) * NP0 + vcol + ch * 8); }
        __syncthreads();
#pragma unroll
        for (int it = 0; it < 4; ++it) { const int s = (tid >> 4) + 32 * it, ch = tid & 15; float o[8];
            if (type == 0) { conv8(P + m0 * NP0 + kcol + ch * 8, s, c * 128, cwl + 640 + ch * 8, o); *(u32x4*)(QKC + (m0 + s) * 1024 + 512 + h * 128 + ch * 8) = pack8(o, KSCALE); }
            else unpack8(*(const u32x4*)(P + (m0 + s) * NP0 + kcol + ch * 8), o);
            *(LAS u32x4*)(Kl + s * TRS + ch * 8) = pack8(o, wl[s]); }
        __syncthreads();
        f32x4 acc[8], accn = (f32x4){0.f, 0.f, 0.f, 0.f};
#pragma unroll
        for (int dt = 0; dt < 8; ++dt) acc[dt] = (f32x4){0.f, 0.f, 0.f, 0.f};
        const bf16x8_t ones = (bf16x8_t){0x3F80, 0x3F80, 0x3F80, 0x3F80, 0x3F80, 0x3F80, 0x3F80, 0x3F80};
#pragma unroll
        for (int ks = 0; ks < 4; ++ks) {
            u32x2 a0, a1, n0, n1, b0, b1, b2, b3, b4, b5, b6, b7, c0, c1, c2, c3, c4, c5, c6, c7;
            tr2<0, 16 * TRS * 2>(vaddr + ks * 32 * TRS * 2, a0, a1);
            tr2<0, 16 * TRS * 2>(kaddr + ks * 32 * TRS * 2 + 32 * w, n0, n1);
            tr8<0, 16 * TRS * 2>(kaddr + ks * 32 * TRS * 2, b0, b1, b2, b3, b4, b5, b6, b7);
            tr8<128, 16 * TRS * 2>(kaddr + ks * 32 * TRS * 2, c0, c1, c2, c3, c4, c5, c6, c7);
            __builtin_amdgcn_sched_barrier(0);
            const bf16x8_t A = pack_frag(a0, a1);
            acc[0] = __builtin_amdgcn_mfma_f32_16x16x32_bf16(pack_frag(b0, b1), A, acc[0], 0, 0, 0);
            acc[1] = __builtin_amdgcn_mfma_f32_16x16x32_bf16(pack_frag(b2, b3), A, acc[1], 0, 0, 0);
            acc[2] = __builtin_amdgcn_mfma_f32_16x16x32_bf16(pack_frag(b4, b5), A, acc[2], 0, 0, 0);
            acc[3] = __builtin_amdgcn_mfma_f32_16x16x32_bf16(pack_frag(b6, b7), A, acc[3], 0, 0, 0);
            acc[4] = __builtin_amdgcn_mfma_f32_16x16x32_bf16(pack_frag(c0, c1), A, acc[4], 0, 0, 0);
            acc[5] = __builtin_amdgcn_mfma_f32_16x16x32_bf16(pack_frag(c2, c3), A, acc[5], 0, 0, 0);
            acc[6] = __builtin_amdgcn_mfma_f32_16x16x32_bf16(pack_frag(c4, c5), A, acc[6], 0, 0, 0);
            acc[7] = __builtin_amdgcn_mfma_f32_16x16x32_bf16(pack_frag(c6, c7), A, acc[7], 0, 0, 0);
            accn = __builtin_amdgcn_mfma_f32_16x16x32_bf16(pack_frag(n0, n1), ones, accn, 0, 0, 0);
        }
        bf16* Sp = S + ((size_t)(chain * 64 + c) * 128 + 16 * w + fr) * 128 + 4 * fq;
#pragma unroll
        for (int dt = 0; dt < 8; ++dt) { u32x2 wv; wv.x = pg8::cvt_pk_bf16(acc[dt][0], acc[dt][1]); wv.y = pg8::cvt_pk_bf16(acc[dt][2], acc[dt][3]); *(u32x2*)(Sp + 16 * dt) = wv; }
        if (type == 0 && fr == 0) *(f32x4*)(DN + (size_t)(chain * 64 + c) * 128 + 16 * w + 4 * fq) = accn;
        if (type == 0) {
#pragma unroll
            for (int it = 0; it < 4; ++it) { const int s = (tid >> 4) + 32 * it, ch = tid & 15; float o[8];
                conv8(P + m0 * NP0 + h * 128 + ch * 8, s, c * 128, cwl + ch * 8, o); *(u32x4*)(QKC + (m0 + s) * 1024 + h * 128 + ch * 8) = pack8(o, 1.f); } }
    }
}

__device__ __forceinline__ void ph_mix_b(Frame& F) {
    LAS float* gl = (LAS float*)F.lds; LAS float* dec = gl + 1024; LAS float* scl = dec + 512;
    const float* GL = (const float*)((char*)F.ctl + CB_GL); float* MSC = (float*)((char*)F.ctl + CB_MSC);
    bf16* S = (bf16*)(F.ws + WS_S); float* DN = (float*)(F.ws + WS_DN);
    for (int i = F.tid; i < 1024; i += NT) gl[i] = GL[i];
    __syncthreads();
    if (F.tid < 8) { float m = 0.f;
        for (int c = 0; c < 64; ++c) { const float g = gl[(F.tid * 64 + c) * 2], ml = gl[(F.tid * 64 + c) * 2 + 1];
            if (blockIdx.x == 0) MSC[F.tid * 64 + c] = m;
            const float mn = fmaxf(g + m, ml); dec[F.tid * 64 + c] = __expf(g + m - mn); scl[F.tid * 64 + c] = __expf(ml - mn); m = mn; } }
    __syncthreads();
    for (int j = blockIdx.x * NT + F.tid; j < 131072; j += F.G * NT) {
        const int chain = j >> 13, el = j & 8191;
        unsigned* p = (unsigned*)S + (size_t)chain * 64 * 8192 + el;
        const bool ml = chain < 8;
        const float g128 = __expf(128.f * log1pf(-exp2f(-5.f - (float)(chain & 3))));
        float C0 = 0.f, C1 = 0.f;
        for (int c0 = 0; c0 < 64; c0 += 16) { unsigned x[16];
#pragma unroll
            for (int k = 0; k < 16; ++k) x[k] = p[(size_t)(c0 + k) * 8192];
#pragma unroll
            for (int k = 0; k < 16; ++k) { p[(size_t)(c0 + k) * 8192] = pg8::cvt_pk_bf16(C0, C1);
                const float dk = ml ? dec[(chain & 7) * 64 + c0 + k] : g128, sk = ml ? scl[(chain & 7) * 64 + c0 + k] : 1.f;
                C0 = dk * C0 + sk * bflo(x[k]); C1 = dk * C1 + sk * bfhi(x[k]); } }
    }
    for (int j = blockIdx.x * NT + F.tid; j < 1024; j += F.G * NT) { const int chain = j >> 7, d = j & 127; float* p = DN + (size_t)chain * 64 * 128 + d; float n = 0.f;
        for (int c = 0; c < 64; ++c) { const float x = p[c * 128]; p[c * 128] = n; n = dec[chain * 64 + c] * n + scl[chain * 64 + c] * x; } }
}

__device__ __forceinline__ void ph_mix_c(Frame& F) {
    LAS bf16* Kl = (LAS bf16*)F.lds;
    LAS bf16* Vl = Kl + 128 * RWS;
    LAS bf16* Cl = Vl + 128 * TRS;
    LAS float* ul = (LAS float*)(Cl + 144 * RWS);
    const bf16* P = (const bf16*)(F.ws + WS_P); const bf16* S = (const bf16*)(F.ws + WS_S); const float* DN = (const float*)(F.ws + WS_DN);
    const bf16* QKC = (const bf16*)(F.ws + WS_QKC2); const float* SCANV = (const float*)(F.ws + WS_SCANV);
    const float* MSC = (const float*)((char*)F.ctl + CB_MSC); bf16* Y = (bf16*)(F.ws + WS_Y);
    const int tid = F.tid, lane = F.lane, w = F.wave, fr = lane & 15, fq = lane >> 4;
    const int lt = w < 4 ? w : 11 - w, l = 16 * lt + fr;
    const int srow = tid >> 4, sch = tid & 15;
    const unsigned vaddr = (unsigned)(size_t)Vl + (unsigned)(((4 * fq + (fr >> 2)) * TRS + 4 * (fr & 3)) * 2);
    u32x4 pK[4], pV[4], pC[4], pN = (u32x4){0u, 0u, 0u, 0u}; bf16x8_t qn[4]; float mcn = 0.f, bln = 0.f, pmn = 0.f, uln = 0.f;
#define MIXC_LOAD(uu) do { const int type_ = (uu) >> 9, b_ = ((uu) >> 8) & 1, h_ = ((uu) >> 6) & 3, c_ = (uu) & 63, chain_ = type_ * 8 + b_ * 4 + h_; const size_t m0_ = (size_t)b_ * T + c_ * 128; \
        const bf16* Kg_ = type_ == 0 ? QKC + m0_ * 1024 + 512 + h_ * 128 : P + m0_ * NP0 + 2560 + h_ * 128; const bf16* Qg_ = type_ == 0 ? QKC + m0_ * 1024 + h_ * 128 : P + m0_ * NP0 + 2048 + h_ * 128; \
        const size_t ld_ = type_ == 0 ? 1024 : NP0; const int vcol_ = (type_ == 0 ? 1024 : 3072) + h_ * 128; \
        _Pragma("unroll") for (int it = 0; it < 4; ++it) { const int s_ = srow + 32 * it; pK[it] = *(const u32x4*)(Kg_ + (size_t)s_ * ld_ + sch * 8); pV[it] = *(const u32x4*)(P + (m0_ + s_) * NP0 + vcol_ + sch * 8); \
            pC[it] = *(const u32x4*)(S + ((size_t)(chain_ * 64 + c_) * 128 + s_) * 128 + sch * 8); } \
        _Pragma("unroll") for (int ks = 0; ks < 4; ++ks) qn[ks] = *(const bf16x8_t*)(Qg_ + (size_t)l * ld_ + 32 * ks + 8 * fq); \
        pN = (u32x4){0u, 0u, 0u, 0u}; mcn = 0.f; bln = 0.f; pmn = 0.f; uln = 0.f; \
        if (type_ == 0) { const float* sv_ = SCANV + (size_t)((b_ * 4 + h_) * 64 + c_) * 384; mcn = MSC[(b_ * 4 + h_) * 64 + c_]; bln = sv_[l]; pmn = sv_[256 + l]; if (tid < 128) uln = sv_[128 + tid]; \
            if (tid < 16) { const float* np_ = DN + (size_t)((b_ * 4 + h_) * 64 + c_) * 128 + tid * 8; const f32x4 x0 = *(const f32x4*)np_, x1 = *(const f32x4*)(np_ + 4); \
                pN.x = pg8::cvt_pk_bf16(x0.x, x0.y); pN.y = pg8::cvt_pk_bf16(x0.z, x0.w); pN.z = pg8::cvt_pk_bf16(x1.x, x1.y); pN.w = pg8::cvt_pk_bf16(x1.z, x1.w); } } } while (0)
    if ((int)blockIdx.x < 1024) MIXC_LOAD((int)blockIdx.x);
    for (int u = blockIdx.x; u < 1024; u += F.G) {
        const int type = u >> 9, b = (u >> 8) & 1, h = (u >> 6) & 3, c = u & 63;
        const size_t m0 = (size_t)b * T + c * 128;
        const int gcol = (type == 0 ? 1536 : 3584) + h * 128;
        const float lg = log1pf(-exp2f(-5.f - (float)h));
        __syncthreads();
#pragma unroll
        for (int it = 0; it < 4; ++it) { const int s = srow + 32 * it;
            *(LAS u32x4*)(Kl + s * RWS + sch * 8) = pK[it]; *(LAS u32x4*)(Vl + s * TRS + sch * 8) = pV[it]; *(LAS u32x4*)(Cl + s * RWS + sch * 8) = pC[it]; }
        if (tid < 256) *(LAS u32x4*)(Cl + (128 + srow) * RWS + sch * 8) = pN;
        if (tid < 128) ul[tid] = uln;
        bf16x8_t qf[4];
#pragma unroll
        for (int ks = 0; ks < 4; ++ks) qf[ks] = qn[ks];
        const float mc = mcn, b_l = bln, pm_l = pmn;
        __syncthreads();
        if (u + F.G < 1024) MIXC_LOAD(u + F.G);
        u32x2 gw[8];
        { const bf16* gp = P + (m0 + l) * NP0 + gcol + 4 * fq;
#pragma unroll
          for (int et = 0; et < 8; ++et) gw[et] = *(const u32x2*)(gp + 16 * et); }
        f32x4 st[8];
#pragma unroll
        for (int t = 0; t < 8; ++t) { st[t] = (f32x4){0.f, 0.f, 0.f, 0.f};
            if (t <= lt) {
#pragma unroll
                for (int ks = 0; ks < 4; ++ks) st[t] = __builtin_amdgcn_mfma_f32_16x16x32_bf16(*(const LAS bf16x8_t*)(Kl + (16 * t + fr) * RWS + 32 * ks + 8 * fq), qf[ks], st[t], 0, 0, 0); }
            if (t & 1) __builtin_amdgcn_sched_barrier(0); }
        int lz = l, fz = 4 * fq; asm volatile("" : "+v"(lz), "+v"(fz));
        const float Mme = (type == 0) ? fmaxf(mc, pm_l) : 0.f;
        float den = 0.f;
#pragma unroll
        for (int t = 0; t < 8; ++t) if (t <= lt) {
#pragma unroll
            for (int rg = 0; rg < 4; ++rg) { const int s = 16 * t + fz + rg;
                float e = (type == 0) ? (ul[s] - Mme) : (lg * (float)(lz - s) - 2.42601513f  ); e = (s <= lz) ? e : -1e30f;
                const float p = st[t][rg] * __expf(e); st[t][rg] = p; den += p; } }
        den += __shfl_xor(den, 16); den += __shfl_xor(den, 32);
        bf16x8_t pf[4];
#pragma unroll
        for (int j = 0; j < 4; ++j) { u32x4 pw; pw.x = pg8::cvt_pk_bf16(st[2 * j][0], st[2 * j][1]); pw.y = pg8::cvt_pk_bf16(st[2 * j][2], st[2 * j][3]);
            pw.z = pg8::cvt_pk_bf16(st[2 * j + 1][0], st[2 * j + 1][1]); pw.w = pg8::cvt_pk_bf16(st[2 * j + 1][2], st[2 * j + 1][3]); pf[j] = __builtin_bit_cast(bf16x8_t, pw); }
        f32x4 acc[9];
#pragma unroll
        for (int et = 0; et < 9; ++et) acc[et] = (f32x4){0.f, 0.f, 0.f, 0.f};
        __builtin_amdgcn_sched_barrier(0);
#pragma unroll
        for (int ks = 0; ks < 4; ++ks) {
#pragma unroll
            for (int et = 0; et < 9; ++et) acc[et] = __builtin_amdgcn_mfma_f32_16x16x32_bf16(*(const LAS bf16x8_t*)(Cl + (16 * et + fr) * RWS + 32 * ks + 8 * fq), qf[ks], acc[et], 0, 0, 0);
            __builtin_amdgcn_sched_barrier(0); }
        float inter, rden = 1.f;
        if (type == 0) { inter = __expf(mc - Mme); const float qnv = __shfl(acc[8][0], fr); const float dtot = den + inter * qnv; rden = 1.f / fmaxf(fabsf(dtot), __expf(-(b_l + Mme))); }
        else inter = __expf(lg * (float)(l + 1));
#pragma unroll
        for (int et = 0; et < 8; ++et) acc[et] = acc[et] * inter;
#pragma unroll
        for (int j = 0; j < 4; ++j) if (2 * j <= lt) {
            u32x2 b0, b1, b2, b3, b4, b5, b6, b7, c0, c1, c2, c3, c4, c5, c6, c7;
            tr8<0, 16 * TRS * 2>(vaddr + j * 32 * TRS * 2, b0, b1, b2, b3, b4, b5, b6, b7);
            tr8<128, 16 * TRS * 2>(vaddr + j * 32 * TRS * 2, c0, c1, c2, c3, c4, c5, c6, c7);
            __builtin_amdgcn_sched_barrier(0);
            acc[0] = __builtin_amdgcn_mfma_f32_16x16x32_bf16(pack_frag(b0, b1), pf[j], acc[0], 0, 0, 0);
            acc[1] = __builtin_amdgcn_mfma_f32_16x16x32_bf16(pack_frag(b2, b3), pf[j], acc[1], 0, 0, 0);
            acc[2] = __builtin_amdgcn_mfma_f32_16x16x32_bf16(pack_frag(b4, b5), pf[j], acc[2], 0, 0, 0);
            acc[3] = __builtin_amdgcn_mfma_f32_16x16x32_bf16(pack_frag(b6, b7), pf[j], acc[3], 0, 0, 0);
            acc[4] = __builtin_amdgcn_mfma_f32_16x16x32_bf16(pack_frag(c0, c1), pf[j], acc[4], 0, 0, 0);
            acc[5] = __builtin_amdgcn_mfma_f32_16x16x32_bf16(pack_frag(c2, c3), pf[j], acc[5], 0, 0, 0);
            acc[6] = __builtin_amdgcn_mfma_f32_16x16x32_bf16(pack_frag(c4, c5), pf[j], acc[6], 0, 0, 0);
            acc[7] = __builtin_amdgcn_mfma_f32_16x16x32_bf16(pack_frag(c6, c7), pf[j], acc[7], 0, 0, 0);
        }
        f32x4 mul[8]; float sum = 0.f;
#pragma unroll
        for (int et = 0; et < 8; ++et) { const float g0 = bflo(gw[et].x), g1 = bfhi(gw[et].x), g2 = bflo(gw[et].y), g3 = bfhi(gw[et].y);
            f32x4 hv = acc[et] * rden;
            if (type == 0) { hv[0] *= sigmoidf_(g0); hv[1] *= sigmoidf_(g1); hv[2] *= sigmoidf_(g2); hv[3] *= sigmoidf_(g3); mul[et] = (f32x4){1.f, 1.f, 1.f, 1.f}; }
            else mul[et] = (f32x4){siluf_(g0), siluf_(g1), siluf_(g2), siluf_(g3)};
            acc[et] = hv; sum += (hv[0] + hv[1]) + (hv[2] + hv[3]); }
        sum += __shfl_xor(sum, 16); sum += __shfl_xor(sum, 32);
        const float mean = sum * (1.f / 128.f); float sq = 0.f;
#pragma unroll
        for (int et = 0; et < 8; ++et) { acc[et] = acc[et] - mean; sq += (acc[et][0] * acc[et][0] + acc[et][1] * acc[et][1]) + (acc[et][2] * acc[et][2] + acc[et][3] * acc[et][3]); }
        sq += __shfl_xor(sq, 16); sq += __shfl_xor(sq, 32);
        const float rstd = 1.f / sqrtf(sq * (1.f / 128.f) + LN_EPS);
        const float* g6 = F.in[6]; const float* g7 = F.in[7]; asm volatile("" : "+s"(g6), "+s"(g7));
        const float* gain = (type == 0 ? g6 : g7) + h * 128 + 4 * fq;
        bf16* yp = Y + (m0 + l) * 1024 + type * 512 + h * 128 + 4 * fq;
#pragma unroll
        for (int et = 0; et < 8; ++et) { const f32x4 gn = *(const f32x4*)(gain + 16 * et); const f32x4 yv = acc[et] * rstd * gn * mul[et];
            u32x2 wv; wv.x = pg8::cvt_pk_bf16(yv[0], yv[1]); wv.y = pg8::cvt_pk_bf16(yv[2], yv[3]); *(u32x2*)(yp + 16 * et) = wv; if (et & 1) asm volatile("" ::: "memory"); }
    }
#undef MIXC_LOAD
}

constexpr int RWT = 1028;
template <int MODE, bool ROUTE, int OUTK>
__device__ __forceinline__ void ph_ln(Frame& F, int layer, bool dry = false) {
    LAS float* rwT = (LAS float*)F.lds;
    LAS int* rsel = (LAS int*)(rwT + 32 * RWT);
    int nrow = 0;
    if (ROUTE) { const float* rw = F.in[11]; for (int i = F.tid; i < 32 * 1024; i += NT) { const int k = i >> 5, e = i & 31; rwT[e * RWT + k] = rw[i]; } __syncthreads(); }
    const int gwv = F.vcu * NWAVES + F.wave, NGW = F.G * NWAVES;
    const float* lg = F.in[16] + (size_t)(layer * 2 + MODE) * D; const float* lb = F.in[17] + (size_t)(layer * 2 + MODE) * D;
    bf16* XB = (bf16*)(F.ws + WS_XB); const bf16* YB = (const bf16*)(F.ws + WS_YB); const bf16* PRE = (const bf16*)((const char*)F.out + 32 * MiB); bf16* RES = (bf16*)F.out;
    int* EIDX = (int*)(F.ws + WS_EIDX); float* GATEV = (float*)(F.ws + WS_GATEV); int* LIST = (int*)(F.ws + WS_LIST);
    unsigned* cnt = F.ctl + CW_CNT + layer * 32 * 64;
    const float* rbias = F.in[12];
    f32x4 gv[4], bv[4];
#pragma unroll
    for (int j = 0; j < 4; ++j) { gv[j] = *((const f32x4*)lg + F.lane + 64 * j); bv[j] = *((const f32x4*)lb + F.lane + 64 * j); }
    u32x2 rx[4], ry0[4], ry1[4]; float rg0 = 0.f, rg1 = 0.f;
#define LN_LOAD(mm) do { if (MODE == 0) { const u32x2* pr = (const u32x2*)(PRE + (size_t)(mm) * D) + F.lane; _Pragma("unroll") for (int j = 0; j < 4; ++j) rx[j] = pr[64 * j]; } \
        else { rg0 = GATEV[2 * (mm)]; rg1 = GATEV[2 * (mm) + 1]; const u32x2* xr = (const u32x2*)(XB + (size_t)(mm) * D) + F.lane; \
            const u32x2* y0 = (const u32x2*)(YB + (size_t)(2 * (mm)) * D) + F.lane; const u32x2* y1 = (const u32x2*)(YB + (size_t)(2 * (mm) + 1) * D) + F.lane; \
            _Pragma("unroll") for (int j = 0; j < 4; ++j) { rx[j] = xr[64 * j]; ry0[j] = y0[64 * j]; ry1[j] = y1[64 * j]; } } } while (0)
    if (gwv < M) LN_LOAD(gwv);
    for (int m = gwv; m < M; m += NGW) {
        f32x4 v[4]; float s = 0.f;
        if (MODE == 0) {
#pragma unroll
            for (int j = 0; j < 4; ++j) { const u32x2 a = rx[j]; v[j] = (f32x4){bflo(a.x), bfhi(a.x), bflo(a.y), bfhi(a.y)}; } }
        else {
            const float g0 = rg0, g1 = rg1;
#pragma unroll
            for (int j = 0; j < 4; ++j) { const u32x2 x = rx[j], a = ry0[j], b = ry1[j];
                v[j].x = ALPHA * bflo(x.x) + g0 * bflo(a.x) + g1 * bflo(b.x); v[j].y = ALPHA * bfhi(x.x) + g0 * bfhi(a.x) + g1 * bfhi(b.x);
                v[j].z = ALPHA * bflo(x.y) + g0 * bflo(a.y) + g1 * bflo(b.y); v[j].w = ALPHA * bfhi(x.y) + g0 * bfhi(a.y) + g1 * bfhi(b.y); }
        }
        if (m + NGW < M) LN_LOAD(m + NGW);
#pragma unroll
        for (int j = 0; j < 4; ++j) s += (v[j].x + v[j].y) + (v[j].z + v[j].w);
        const float mean = wave_sum(s) * (1.f / D); float s2 = 0.f;
#pragma unroll
        for (int j = 0; j < 4; ++j) { v[j] = v[j] - mean; s2 += (v[j].x * v[j].x + v[j].y * v[j].y) + (v[j].z * v[j].z + v[j].w * v[j].w); }
        const float rstd = 1.f / sqrtf(wave_sum(s2) * (1.f / D) + LN_EPS);
#pragma unroll
        for (int j = 0; j < 4; ++j) v[j] = v[j] * rstd * gv[j] + bv[j];
        if (OUTK == 2) { f32x4* orow = (f32x4*)(F.out + (size_t)m * D) + F.lane;
#pragma unroll
            for (int j = 0; j < 4; ++j) orow[64 * j] = v[j]; }
        else { u32x2* o8 = (u32x2*)((OUTK == 0 ? XB : RES) + (size_t)m * D) + F.lane;
#pragma unroll
            for (int j = 0; j < 4; ++j) { u32x2 w; w.x = pg8::cvt_pk_bf16(v[j].x, v[j].y); w.y = pg8::cvt_pk_bf16(v[j].z, v[j].w); o8[64 * j] = w; } }
        if (ROUTE) {
            float pv[32];
#pragma unroll
            for (int e = 0; e < 32; ++e) { float a = 0.f;
#pragma unroll
                for (int j = 0; j < 4; ++j) { const f32x4 w = *(const LAS f32x4*)(rwT + e * RWT + 4 * F.lane + 256 * j); a += v[j].x * w.x + v[j].y * w.y + v[j].z * w.z + v[j].w * w.w; }
                pv[e] = a; if ((e & 7) == 7) __builtin_amdgcn_sched_barrier(0); }
#define LN_HALVE(N, MASK) { const bool up = (F.lane & (MASK)) != 0; _Pragma("unroll") for (int j = 0; j < (N); ++j) { const float keep = up ? pv[(N) + j] : pv[j], send = up ? pv[j] : pv[(N) + j]; pv[j] = keep + __shfl_xor(send, (MASK)); } }
            LN_HALVE(16, 32) LN_HALVE(8, 16) LN_HALVE(4, 8) LN_HALVE(2, 4) LN_HALVE(1, 2)
#undef LN_HALVE
            const float mylog = pv[0] + __shfl_xor(pv[0], 1);
            const int mye = F.lane >> 1;
            const float myaff = 1.f / (1.f + expf(-mylog)), mysel = myaff + rbias[mye];
            float m1 = -1e30f, m2 = -1e30f; int i1 = 0, i2 = 0; float a1 = 0.f, a2 = 0.f;
            const int lbase = F.lane & 48, ebase = (F.lane >> 4) * 8;
#pragma unroll
            for (int j = 0; j < 8; ++j) { const float sv = __shfl(mysel, lbase + 2 * j), av = __shfl(myaff, lbase + 2 * j);
                if (sv > m1) { m2 = m1; i2 = i1; a2 = a1; m1 = sv; i1 = ebase + j; a1 = av; }
                else if (sv > m2) { m2 = sv; i2 = ebase + j; a2 = av; } }
            const float score = m1 + m2;
            float bestscore = -1e30f; int bg = 0;
#pragma unroll
            for (int g = 0; g < 4; ++g) { const float sg = __shfl(score, 16 * g); if (sg > bestscore) { bestscore = sg; bg = g; } }
            const int bi0 = __shfl(i1, 16 * bg), bi1 = __shfl(i2, 16 * bg); const float ba0 = __shfl(a1, 16 * bg), ba1 = __shfl(a2, 16 * bg);
            if (F.lane == 0) {
                const float inv = 1.f / (ba0 + ba1);
                EIDX[2 * m] = bi0; EIDX[2 * m + 1] = bi1; GATEV[2 * m] = ba0 * inv; GATEV[2 * m + 1] = ba1 * inv;
                if (dry) {} else if (nrow < 16) { rsel[(F.wave * 16 + nrow) * 2] = (bi0 << 24) | (2 * m); rsel[(F.wave * 16 + nrow) * 2 + 1] = (bi1 << 24) | (2 * m + 1); }
                else {
                    const unsigned p0 = __hip_atomic_fetch_add(cnt + bi0 * 64, 1u, RLX_AGENT); LIST[bi0 * M + p0] = 2 * m;
                    const unsigned p1 = __hip_atomic_fetch_add(cnt + bi1 * 64, 1u, RLX_AGENT); LIST[bi1 * M + p1] = 2 * m + 1; }
            }
            ++nrow;
        }
    }
    if (ROUTE && !dry) {
        if (F.lane == 0) rsel[256 + 32 + F.wave] = nrow < 16 ? nrow : 16;
        if (F.tid < 32) rsel[256 + F.tid] = 0;
        __syncthreads();
        const int wv = F.tid >> 5, k = (F.tid >> 1) & 15;
        const bool have = F.tid < 256 && k < rsel[256 + 32 + (wv & 7)];
        int ent = 0, lp = 0;
        if (have) { ent = rsel[(wv * 16 + k) * 2 + (F.tid & 1)]; lp = __hip_atomic_fetch_add(&rsel[256 + (ent >> 24)], 1, __ATOMIC_RELAXED, __HIP_MEMORY_SCOPE_WORKGROUP); }
        __syncthreads();
        if (F.tid < 32) { const int c = rsel[256 + F.tid]; rsel[256 + F.tid] = c > 0 ? (int)__hip_atomic_fetch_add(cnt + F.tid * 64, (unsigned)c, RLX_AGENT) : 0; }
        __syncthreads();
        if (have) { const int e = ent >> 24; LIST[e * M + rsel[256 + e] + lp] = ent & 0xffffff; }
    }
}

#undef LN_LOAD
__device__ __forceinline__ void ph_ln1_router(Frame& F, int layer) {
    LAS bf16* GH = (LAS bf16*)F.lds;
    LAS bf16* GLo = GH + 32 * GWS;
    LAS float* stat = (LAS float*)(GLo + 32 * GWS);
    LAS float* c12 = stat + 128;
    LAS int* rsel = (LAS int*)(c12 + 64);
    const int tid = F.tid, lane = F.lane, w = F.wave, fr = lane & 15, fq = lane >> 4;
    { const u32x4* src = (const u32x4*)((const char*)F.ctl + CB_GWT + (size_t)layer * 2 * 32 * GWS * 2); LAS u32x4* dst = (LAS u32x4*)GH;
      for (int i = tid; i < 2 * 32 * GWS * 2 / 16; i += NT) dst[i] = src[i];
      if (tid < 64) c12[tid] = ((const float*)((const char*)F.ctl + CB_C12))[layer * 64 + tid]; }
    const float* lg = F.in[16] + (size_t)(layer * 2) * D; const float* lb = F.in[17] + (size_t)(layer * 2) * D;
    bf16* XB = (bf16*)(F.ws + WS_XB); const bf16* PRE = (const bf16*)((const char*)F.out + 32 * MiB);
    int* EIDX = (int*)(F.ws + WS_EIDX); float* GATEV = (float*)(F.ws + WS_GATEV); int* LIST = (int*)(F.ws + WS_LIST);
    unsigned* cnt = F.ctl + CW_CNT + layer * 32 * 64;
    const float* rbias = F.in[12];
    f32x4 gv[4], bv[4];
#pragma unroll
    for (int j = 0; j < 4; ++j) { gv[j] = *((const f32x4*)lg + lane + 64 * j); bv[j] = *((const f32x4*)lb + lane + 64 * j); }
    const float rb0 = rbias[fr], rb1 = rbias[16 + fr];
    for (int grp = F.vcu; grp < M / 64; grp += F.G) {
        const int row0 = grp * 64;
        __syncthreads();
        u32x2 rx[4];
        { const u32x2* pr = (const u32x2*)(PRE + (size_t)(row0 + 8 * w) * D) + lane;
#pragma unroll
          for (int j = 0; j < 4; ++j) rx[j] = pr[64 * j]; }
        for (int k = 0; k < 8; ++k) { const int m = row0 + 8 * w + k;
            f32x4 v[4]; float s = 0.f;
#pragma unroll
            for (int j = 0; j < 4; ++j) { const u32x2 a = rx[j]; v[j] = (f32x4){bflo(a.x), bfhi(a.x), bflo(a.y), bfhi(a.y)}; }
            if (k < 7) { const u32x2* pr = (const u32x2*)(PRE + (size_t)(m + 1) * D) + lane;
#pragma unroll
                for (int j = 0; j < 4; ++j) rx[j] = pr[64 * j]; }
#pragma unroll
            for (int j = 0; j < 4; ++j) s += (v[j].x + v[j].y) + (v[j].z + v[j].w);
            const float mean = wave_sum(s) * (1.f / D); float s2 = 0.f;
#pragma unroll
            for (int j = 0; j < 4; ++j) { v[j] = v[j] - mean; s2 += (v[j].x * v[j].x + v[j].y * v[j].y) + (v[j].z * v[j].z + v[j].w * v[j].w); }
            const float rstd = 1.f / sqrtf(wave_sum(s2) * (1.f / D) + LN_EPS);
            u32x2* o8 = (u32x2*)(XB + (size_t)m * D) + lane;
#pragma unroll
            for (int j = 0; j < 4; ++j) { const f32x4 y = v[j] * rstd * gv[j] + bv[j]; u32x2 wv; wv.x = pg8::cvt_pk_bf16(y.x, y.y); wv.y = pg8::cvt_pk_bf16(y.z, y.w); o8[64 * j] = wv; }
            if (lane == 0) { stat[(8 * w + k) * 2] = mean; stat[(8 * w + k) * 2 + 1] = rstd; }
        }
        __syncthreads();
        if (w < 4) {
            f32x4 d0 = (f32x4){0.f, 0.f, 0.f, 0.f}, d1 = d0;
            const bf16* arow = PRE + (size_t)(row0 + 16 * w + fr) * D + 8 * fq;
            const LAS bf16* b0h = GH + fr * GWS + 8 * fq; const LAS bf16* b1h = GH + (16 + fr) * GWS + 8 * fq;
            const LAS bf16* b0l = GLo + fr * GWS + 8 * fq; const LAS bf16* b1l = GLo + (16 + fr) * GWS + 8 * fq;
#pragma unroll 8
            for (int ks = 0; ks < 32; ++ks) { const bf16x8_t a = *(const bf16x8_t*)(arow + 32 * ks);
                d0 = __builtin_amdgcn_mfma_f32_16x16x32_bf16(a, *(const LAS bf16x8_t*)(b0h + 32 * ks), d0, 0, 0, 0);
                d1 = __builtin_amdgcn_mfma_f32_16x16x32_bf16(a, *(const LAS bf16x8_t*)(b1h + 32 * ks), d1, 0, 0, 0);
                d0 = __builtin_amdgcn_mfma_f32_16x16x32_bf16(a, *(const LAS bf16x8_t*)(b0l + 32 * ks), d0, 0, 0, 0);
                d1 = __builtin_amdgcn_mfma_f32_16x16x32_bf16(a, *(const LAS bf16x8_t*)(b1l + 32 * ks), d1, 0, 0, 0); }
            const float c1a = c12[fr], c1b = c12[16 + fr], c2a = c12[32 + fr], c2b = c12[48 + fr];
            const int sub = lane & ~7;
#pragma unroll
            for (int rg = 0; rg < 4; ++rg) {
                const int rl = 16 * w + 4 * fq + rg; const float mean = stat[rl * 2], rstd = stat[rl * 2 + 1];
                const float l0 = rstd * (d0[rg] - mean * c1a) + c2a, l1 = rstd * (d1[rg] - mean * c1b) + c2b;
                const float af0 = 1.f / (1.f + expf(-l0)), af1 = 1.f / (1.f + expf(-l1)), se0 = af0 + rb0, se1 = af1 + rb1;
                float m1 = -1e30f, m2 = -1e30f, a1 = 0.f, a2 = 0.f; int i1 = 0, i2 = 0;
                float n1 = -1e30f, n2 = -1e30f, b1 = 0.f, b2 = 0.f; int j1 = 0, j2 = 0;
#pragma unroll
                for (int j = 0; j < 8; ++j) { const float sv = __shfl(se0, sub + j), av = __shfl(af0, sub + j), tv = __shfl(se1, sub + j), bvv = __shfl(af1, sub + j);
                    const int e0 = (fr & 8) + j, e1 = 16 + (fr & 8) + j;
                    if (sv > m1) { m2 = m1; i2 = i1; a2 = a1; m1 = sv; i1 = e0; a1 = av; } else if (sv > m2) { m2 = sv; i2 = e0; a2 = av; }
                    if (tv > n1) { n2 = n1; j2 = j1; b2 = b1; n1 = tv; j1 = e1; b1 = bvv; } else if (tv > n2) { n2 = tv; j2 = e1; b2 = bvv; } }
                const float sc0 = m1 + m2, sc1 = n1 + n2;
                const int g16 = lane & 48;
                const float sg0 = __shfl(sc0, g16), sg1 = __shfl(sc0, g16 + 8), sg2 = __shfl(sc1, g16), sg3 = __shfl(sc1, g16 + 8);
                int bg = 0; float bs = sg0; if (sg1 > bs) { bs = sg1; bg = 1; } if (sg2 > bs) { bs = sg2; bg = 2; } if (sg3 > bs) { bs = sg3; bg = 3; }
                const int srcl = g16 + 8 * (bg & 1);
                const int x1 = __shfl(bg < 2 ? i1 : j1, srcl), x2 = __shfl(bg < 2 ? i2 : j2, srcl); const float y1 = __shfl(bg < 2 ? a1 : b1, srcl), y2 = __shfl(bg < 2 ? a2 : b2, srcl);
                if (fr == 0) { const int m = row0 + rl; const float inv = 1.f / (y1 + y2);
                    EIDX[2 * m] = x1; EIDX[2 * m + 1] = x2; GATEV[2 * m] = y1 * inv; GATEV[2 * m + 1] = y2 * inv;
                    rsel[rl * 2] = (x1 << 24) | (2 * m); rsel[rl * 2 + 1] = (x2 << 24) | (2 * m + 1); }
            }
        }
        if (tid < 32) rsel[128 + tid] = 0;
        __syncthreads();
        int ent = 0, lp = 0;
        if (tid < 128) { ent = rsel[tid]; lp = __hip_atomic_fetch_add(&rsel[128 + (ent >> 24)], 1, __ATOMIC_RELAXED, __HIP_MEMORY_SCOPE_WORKGROUP); }
        __syncthreads();
        if (tid < 32) { const int c = rsel[128 + tid]; rsel[128 + tid] = c > 0 ? (int)__hip_atomic_fetch_add(cnt + tid * 64, (unsigned)c, RLX_AGENT) : 0; }
        __syncthreads();
        if (tid < 128) { const int e = ent >> 24; LIST[e * M + rsel[128 + e] + lp] = ent & 0xffffff; }
    }
}
struct ExpertMap { int cnt[32]; };
__device__ __forceinline__ int moe_find(Frame& F, int layer, int unit_rows, int per_row_tiles, int t, int& e_out, int& mb_out, int& nb_out, int& hb_out, int& cnt_out) {
    const unsigned* cnt = F.ctl + CW_CNT + layer * 32 * 64;
    int base = 0, hb = 0;
    for (int e = 0; e < 32; ++e) {
        const int c = (int)cnt[e * 64]; const int nmb = (c + unit_rows - 1) / unit_rows; const int nt = nmb * per_row_tiles;
        if (t < base + nt) { const int r = t - base; e_out = e; mb_out = r / per_row_tiles; nb_out = r % per_row_tiles; hb_out = hb; cnt_out = c; return 1; }
        base += nt; hb += ((c + 255) >> 8) << 8;
    }
    return 0;
}
__device__ __forceinline__ void ph_moe1_naive(Frame& F, int layer) {
    LAS float* sA = (LAS float*)F.lds; LAS float* sB = sA + 128 * 33;
    const bf16* XB = (const bf16*)(F.ws + WS_XB); bf16* HID = (bf16*)(F.ws + WS_HID); const int* LIST = (const int*)(F.ws + WS_LIST);
    const int tx = F.tid & 15, ty = F.tid >> 4;
    for (int t = blockIdx.x;; t += F.G) {
        int e, mb, nb, hb, c; if (!moe_find(F, layer, 128, 4, t, e, mb, nb, hb, c)) break;
        const bf16* GU = (const bf16*)(F.ws + WS_EW + (size_t)e * EW_STRIDE);
        const int j0 = nb * 64, rg = (j0 >> 7) * 256 + (j0 & 127);
        auto rowA = [&](int r) -> const bf16* { const int i = mb * 128 + r; return i < c ? XB + (size_t)(LIST[e * M + i] >> 1) * D : (const bf16*)nullptr; };
        float ag[4][4], au[4][4];
        ngemm_tile(sA, sB, rowA, GU + (size_t)rg * D, D, D, ag);
        ngemm_tile(sA, sB, rowA, GU + (size_t)(rg + 128) * D, D, D, au);
#pragma unroll
        for (int i = 0; i < 4; ++i) { const int ri = mb * 128 + ty * 4 + i;
            if (ri < c) { u32x2 o; o.x = pk2(siluf_(ag[i][0]) * au[i][0], siluf_(ag[i][1]) * au[i][1]); o.y = pk2(siluf_(ag[i][2]) * au[i][2], siluf_(ag[i][3]) * au[i][3]);
                *(u32x2*)(HID + (size_t)(hb + ri) * DE + j0 + tx * 4) = o; } }
    }
}
__device__ __forceinline__ void ph_moe2_naive(Frame& F, int layer) {
    LAS float* sA = (LAS float*)F.lds; LAS float* sB = sA + 128 * 33;
    const bf16* HID = (const bf16*)(F.ws + WS_HID); bf16* YB = (bf16*)(F.ws + WS_YB); const int* LIST = (const int*)(F.ws + WS_LIST);
    const int tx = F.tid & 15, ty = F.tid >> 4;
    for (int t = blockIdx.x;; t += F.G) {
        int e, mb, nb, hb, c; if (!moe_find(F, layer, 128, 16, t, e, mb, nb, hb, c)) break;
        const bf16* DN = (const bf16*)(F.ws + WS_EW + (size_t)e * EW_STRIDE + EW_DN);
        auto rowA = [&](int r) -> const bf16* { const int i = mb * 128 + r; return i < c ? HID + (size_t)(hb + i) * DE : (const bf16*)nullptr; };
        float acc[4][4];
        ngemm_tile(sA, sB, rowA, DN + (size_t)(nb * 64) * DE, DE, DE, acc);
#pragma unroll
        for (int i = 0; i < 4; ++i) { const int ri = mb * 128 + ty * 4 + i;
            if (ri < c) { const int a = LIST[e * M + ri]; u32x2 o; o.x = pk2(acc[i][0], acc[i][1]); o.y = pk2(acc[i][2], acc[i][3]);
                *(u32x2*)(YB + (size_t)a * D + nb * 64 + tx * 4) = o; } }
    }
}

__device__ __forceinline__ void ph_attn_naive(Frame& F) {
    const bf16* P = (const bf16*)(F.ws + WS_P); bf16* OG = (bf16*)(F.ws + WS_OG); float* LSE = (float*)(F.ws + WS_LSE);
    const int total = 3 * M * 8, nth = F.G * NT;
    for (int idx = blockIdx.x * NT + F.tid; idx < total; idx += nth) {
        const int h = idx & 7, m = (idx >> 3) & (M - 1), g = idx >> 17;
        const int t = m & (T - 1), dil = (g == 0) ? 1 : (g == 1 ? 4 : 16);
        const float slope = exp2f(-(float)(h + 1));
        const bf16* qp = P + (size_t)m * IN1 + g * 1536 + h * 64;
        float q[64], o[64];
#pragma unroll
        for (int c = 0; c < 8; ++c) { const u32x4 w = *(const u32x4*)(qp + 8 * c);
            q[8 * c + 0] = bflo(w.x); q[8 * c + 1] = bfhi(w.x); q[8 * c + 2] = bflo(w.y); q[8 * c + 3] = bfhi(w.y); q[8 * c + 4] = bflo(w.z); q[8 * c + 5] = bfhi(w.z); q[8 * c + 6] = bflo(w.w); q[8 * c + 7] = bfhi(w.w); }
#pragma unroll
        for (int d = 0; d < 64; ++d) o[d] = 0.f;
        float mx = -1e30f, den = 0.f;
        for (int j = 0; j <= 128; ++j) {
            const int tk = t - j * dil; if (tk < 0) break;
            const bf16* kp = P + (size_t)(m - j * dil) * IN1 + g * 1536 + 512 + h * 64; const bf16* vp = kp + 512;
            float s = 0.f;
#pragma unroll
            for (int c = 0; c < 8; ++c) { const u32x4 w = *(const u32x4*)(kp + 8 * c);
                s += q[8 * c + 0] * bflo(w.x) + q[8 * c + 1] * bfhi(w.x) + q[8 * c + 2] * bflo(w.y) + q[8 * c + 3] * bfhi(w.y) + q[8 * c + 4] * bflo(w.z) + q[8 * c + 5] * bfhi(w.z) + q[8 * c + 6] * bflo(w.w) + q[8 * c + 7] * bfhi(w.w); }
            s = s * 0.125f - slope * (float)(j * dil);
            const float mn = fmaxf(mx, s), corr = __expf(mx - mn), p = __expf(s - mn);
            den = den * corr + p; mx = mn;
#pragma unroll
            for (int c = 0; c < 8; ++c) { const u32x4 w = *(const u32x4*)(vp + 8 * c);
                o[8 * c + 0] = o[8 * c + 0] * corr + p * bflo(w.x); o[8 * c + 1] = o[8 * c + 1] * corr + p * bfhi(w.x); o[8 * c + 2] = o[8 * c + 2] * corr + p * bflo(w.y); o[8 * c + 3] = o[8 * c + 3] * corr + p * bfhi(w.y);
                o[8 * c + 4] = o[8 * c + 4] * corr + p * bflo(w.z); o[8 * c + 5] = o[8 * c + 5] * corr + p * bfhi(w.z); o[8 * c + 6] = o[8 * c + 6] * corr + p * bflo(w.w); o[8 * c + 7] = o[8 * c + 7] * corr + p * bfhi(w.w); }
        }
        const float inv = 1.f / den;
        bf16* op = OG + ((size_t)g * M + m) * 512 + h * 64;
#pragma unroll
        for (int c = 0; c < 8; ++c) { u32x4 w; w.x = pk2(o[8 * c + 0] * inv, o[8 * c + 1] * inv); w.y = pk2(o[8 * c + 2] * inv, o[8 * c + 3] * inv); w.z = pk2(o[8 * c + 4] * inv, o[8 * c + 5] * inv); w.w = pk2(o[8 * c + 6] * inv, o[8 * c + 7] * inv);
            *(u32x4*)(op + 8 * c) = w; }
        LSE[((size_t)g * M + m) * 8 + h] = mx + __logf(den);
    }
}
__device__ __forceinline__ void ph_attn_mfma(Frame& F) {
    const bf16* P = (const bf16*)(F.ws + WS_P); bf16* OG = (bf16*)(F.ws + WS_OG); float* LSE = (float*)(F.ws + WS_LSE);
    LAS bf16* Vl = (LAS bf16*)F.lds;
    const int tid = F.tid, lane = F.lane, w = F.wave, fr = lane & 15, fq = lane >> 4;
    const int ct0 = 2 * (w >> 1);
    const unsigned vaddr0 = (unsigned)(size_t)(F.lds) + (unsigned)(((16 * ct0 + 4 * fq + (fr >> 2)) * 72 + 4 * (fr & 3)) * 2);
    for (int u = blockIdx.x; u < 3072; u += F.G) {
        const int g = u >> 10, rem = u & 1023, b = rem >> 9, h = (rem >> 6) & 7, x = rem & 63;
        const int dil = (g == 0) ? 1 : (g == 1 ? 4 : 16), nnb = 64 / dil, nb = x % nnb, r = x / nnb;
        const long rowbase = (long)b * T + (long)nb * 128 * dil + r;
        const bf16* Qp = P + g * 1536 + h * 64; const bf16* Kp = Qp + 512; const bf16* Vp = Qp + 1024;
        const float sl = exp2f(-(float)(h + 1)) * (float)dil;
        __syncthreads();
#pragma unroll
        for (int it = 0; it < 4; ++it) { const int kr = (tid >> 3) + 64 * it, ch = tid & 7; u32x4 v = (u32x4){0u, 0u, 0u, 0u};
            if (nb > 0 || kr >= 128) v = *(const u32x4*)(Vp + (size_t)(rowbase + (long)(kr - 128) * dil) * IN1 + ch * 8);
            *(LAS u32x4*)(Vl + kr * 72 + ch * 8) = v; }
        bf16x8_t qf[2];
        { const bf16* qrow = Qp + (size_t)(rowbase + (long)(16 * w + fr) * dil) * IN1 + 8 * fq; qf[0] = *(const bf16x8_t*)qrow; qf[1] = *(const bf16x8_t*)(qrow + 32); }
        f32x4 s[10];
#pragma unroll
        for (int c = 0; c < 10; ++c) { const int kr = 16 * (ct0 + c) + fr; bf16x8_t k0 = (bf16x8_t){0, 0, 0, 0, 0, 0, 0, 0}, k1 = k0;
            if (nb > 0 || kr >= 128) { const bf16* krow = Kp + (size_t)(rowbase + (long)(kr - 128) * dil) * IN1 + 8 * fq; k0 = *(const bf16x8_t*)krow; k1 = *(const bf16x8_t*)(krow + 32); }
            s[c] = __builtin_amdgcn_mfma_f32_16x16x32_bf16(k0, qf[0], (f32x4){0.f, 0.f, 0.f, 0.f}, 0, 0, 0);
            s[c] = __builtin_amdgcn_mfma_f32_16x16x32_bf16(k1, qf[1], s[c], 0, 0, 0); }
        const int l = 16 * w + fr;
        float mx = -1e30f;
#pragma unroll
        for (int c = 0; c < 10; ++c)
#pragma unroll
            for (int rg = 0; rg < 4; ++rg) { const int kr = 16 * (ct0 + c) + 4 * fq + rg, steps = l + 128 - kr;
                const bool ok = steps >= 0 && steps <= 128 && (nb > 0 || kr >= 128);
                const float v = ok ? s[c][rg] * 0.125f - sl * (float)steps : -1e30f; s[c][rg] = v; mx = fmaxf(mx, v); }
        mx = fmaxf(mx, __shfl_xor(mx, 16)); mx = fmaxf(mx, __shfl_xor(mx, 32));
        float den = 0.f;
#pragma unroll
        for (int c = 0; c < 10; ++c)
#pragma unroll
            for (int rg = 0; rg < 4; ++rg) { const float p = (s[c][rg] > -1e29f) ? __expf(s[c][rg] - mx) : 0.f; s[c][rg] = p; den += p; }
        den += __shfl_xor(den, 16); den += __shfl_xor(den, 32);
        bf16x8_t pf[5];
#pragma unroll
        for (int k = 0; k < 5; ++k) { u32x4 wv; wv.x = pg8::cvt_pk_bf16(s[2 * k][0], s[2 * k][1]); wv.y = pg8::cvt_pk_bf16(s[2 * k][2], s[2 * k][3]);
            wv.z = pg8::cvt_pk_bf16(s[2 * k + 1][0], s[2 * k + 1][1]); wv.w = pg8::cvt_pk_bf16(s[2 * k + 1][2], s[2 * k + 1][3]); pf[k] = __builtin_bit_cast(bf16x8_t, wv); }
        __syncthreads();
        f32x4 o[4];
#pragma unroll
        for (int dt = 0; dt < 4; ++dt) o[dt] = (f32x4){0.f, 0.f, 0.f, 0.f};
#pragma unroll
        for (int k = 0; k < 5; ++k) {
            u32x2 a0, a1, a2, a3, a4, a5, a6, a7; const unsigned va = vaddr0 + (unsigned)(k * 32 * 72 * 2);
            asm volatile("ds_read_b64_tr_b16 %0, %8\n\tds_read_b64_tr_b16 %1, %8 offset:2304\n\tds_read_b64_tr_b16 %2, %8 offset:32\n\tds_read_b64_tr_b16 %3, %8 offset:2336\n\t"
                         "ds_read_b64_tr_b16 %4, %8 offset:64\n\tds_read_b64_tr_b16 %5, %8 offset:2368\n\tds_read_b64_tr_b16 %6, %8 offset:96\n\tds_read_b64_tr_b16 %7, %8 offset:2400\n\ts_waitcnt lgkmcnt(0)"
                         : "=&v"(a0), "=&v"(a1), "=&v"(a2), "=&v"(a3), "=&v"(a4), "=&v"(a5), "=&v"(a6), "=&v"(a7) : "v"(va) : "memory");
            __builtin_amdgcn_sched_barrier(0);
            o[0] = __builtin_amdgcn_mfma_f32_16x16x32_bf16(__builtin_bit_cast(bf16x8_t, (u32x4){a0.x, a0.y, a1.x, a1.y}), pf[k], o[0], 0, 0, 0);
            o[1] = __builtin_amdgcn_mfma_f32_16x16x32_bf16(__builtin_bit_cast(bf16x8_t, (u32x4){a2.x, a2.y, a3.x, a3.y}), pf[k], o[1], 0, 0, 0);
            o[2] = __builtin_amdgcn_mfma_f32_16x16x32_bf16(__builtin_bit_cast(bf16x8_t, (u32x4){a4.x, a4.y, a5.x, a5.y}), pf[k], o[2], 0, 0, 0);
            o[3] = __builtin_amdgcn_mfma_f32_16x16x32_bf16(__builtin_bit_cast(bf16x8_t, (u32x4){a6.x, a6.y, a7.x, a7.y}), pf[k], o[3], 0, 0, 0);
        }
        const float inv = 1.f / den; const size_t tok = (size_t)(rowbase + (long)l * dil);
        bf16* op = OG + ((size_t)g * M + tok) * 512 + h * 64 + 4 * fq;
#pragma unroll
        for (int dt = 0; dt < 4; ++dt) { u32x2 wv; wv.x = pg8::cvt_pk_bf16(o[dt][0] * inv, o[dt][1] * inv); wv.y = pg8::cvt_pk_bf16(o[dt][2] * inv, o[dt][3] * inv); *(u32x2*)(op + 16 * dt) = wv; }
        if (fq == 0) LSE[((size_t)g * M + tok) * 8 + h] = mx + __logf(den);
    }
}

__device__ __forceinline__ void ph_attn_v2(Frame& F) {
    const bf16* P = (const bf16*)(F.ws + WS_P); bf16* OG = (bf16*)(F.ws + WS_OG); float* LSE = (float*)(F.ws + WS_LSE);
    LAS bf16* Kl = (LAS bf16*)F.lds;
    LAS bf16* Vl = Kl + 2 * 128 * 72;
    constexpr int SLOT = 128 * 72;
    const int tid = F.tid, lane = F.lane, w = F.wave, fr = lane & 15, fq = lane >> 4;
    const int ct0 = 2 * (w >> 1), l = 16 * w + fr;
    const int srow = tid >> 3, sch = tid & 7;
    for (int p = blockIdx.x; p < 512; p += F.G) {
        int g, b, h, r, nb0, nun;
        if (p < 128) { g = 0; const int seq = p >> 3; b = seq >> 3; h = seq & 7; r = 0; nb0 = (p & 7) * 8; nun = 8; }
        else if (p < 256) { g = 1; const int q = p - 128, seq = q >> 1; b = seq >> 5; h = (seq >> 2) & 7; r = seq & 3; nb0 = (q & 1) * 8; nun = 8; }
        else { g = 2; const int q = p - 256; b = q >> 7; h = (q >> 4) & 7; r = q & 15; nb0 = 0; nun = 4; }
        const int dil = (g == 0) ? 1 : (g == 1 ? 4 : 16);
        const size_t rstride = (size_t)dil * IN1;
        const bf16* Qp = P + g * 1536 + h * 64 + ((size_t)b * T + r) * IN1; const bf16* Kp = Qp + 512; const bf16* Vp = Qp + 1024;
        const float sl = exp2f(-(float)(h + 1)) * (float)dil;
        __syncthreads();
#pragma unroll
        for (int it = 0; it < 2; ++it) { const int row = srow + 64 * it;
            u32x4 k0 = (u32x4){0u, 0u, 0u, 0u}, v0 = k0;
            if (nb0 > 0) { const size_t off = (size_t)((nb0 - 1) * 128 + row) * rstride + sch * 8; k0 = *(const u32x4*)(Kp + off); v0 = *(const u32x4*)(Vp + off); }
            const size_t off1 = (size_t)(nb0 * 128 + row) * rstride + sch * 8; const u32x4 k1 = *(const u32x4*)(Kp + off1), v1 = *(const u32x4*)(Vp + off1);
            const int ps = (nb0 + 1) & 1, cs = nb0 & 1;
            *(LAS u32x4*)(Kl + ps * SLOT + row * 72 + sch * 8) = k0; *(LAS u32x4*)(Vl + ps * SLOT + row * 72 + sch * 8) = v0;
            *(LAS u32x4*)(Kl + cs * SLOT + row * 72 + sch * 8) = k1; *(LAS u32x4*)(Vl + cs * SLOT + row * 72 + sch * 8) = v1; }
        bf16x8_t qn0, qn1;
        { const bf16* qrow = Qp + (size_t)(nb0 * 128 + l) * rstride + 8 * fq; qn0 = *(const bf16x8_t*)qrow; qn1 = *(const bf16x8_t*)(qrow + 32); }
        __syncthreads();
        for (int i = 0; i < nun; ++i) {
            const int nb = nb0 + i; const bool more = (i + 1 < nun);
            const bf16x8_t qf0 = qn0, qf1 = qn1;
            u32x4 pk0 = (u32x4){0u, 0u, 0u, 0u}, pk1 = pk0, pv0 = pk0, pv1 = pk0;
            if (more) { const size_t off = (size_t)((nb + 1) * 128 + srow) * rstride + sch * 8;
                pk0 = *(const u32x4*)(Kp + off); pv0 = *(const u32x4*)(Vp + off); pk1 = *(const u32x4*)(Kp + off + 64 * rstride); pv1 = *(const u32x4*)(Vp + off + 64 * rstride);
                const bf16* qrow = Qp + (size_t)((nb + 1) * 128 + l) * rstride + 8 * fq; qn0 = *(const bf16x8_t*)qrow; qn1 = *(const bf16x8_t*)(qrow + 32); }
            const int ps = (nb + 1) & 1, cs = nb & 1;
            f32x4 s[10];
#pragma unroll
            for (int c = 0; c < 10; ++c) { const int ct = ct0 + c; const LAS bf16* kb = Kl + (ct < 8 ? ps : cs) * SLOT + ((ct & 7) * 16 + fr) * 72 + 8 * fq;
                s[c] = __builtin_amdgcn_mfma_f32_16x16x32_bf16(*(const LAS bf16x8_t*)kb, qf0, (f32x4){0.f, 0.f, 0.f, 0.f}, 0, 0, 0);
                s[c] = __builtin_amdgcn_mfma_f32_16x16x32_bf16(*(const LAS bf16x8_t*)(kb + 32), qf1, s[c], 0, 0, 0); }
            int lz = l, fz = 4 * fq; asm volatile("" : "+v"(lz), "+v"(fz));
            float mx = -1e30f;
#pragma unroll
            for (int c = 0; c < 10; ++c)
#pragma unroll
                for (int rg = 0; rg < 4; ++rg) { const int kr = 16 * (ct0 + c) + fz + rg, steps = lz + 128 - kr;
                    const bool ok = steps >= 0 && steps <= 128 && (nb > 0 || kr >= 128);
                    const float v = ok ? s[c][rg] * 0.125f - sl * (float)steps : -1e30f; s[c][rg] = v; mx = fmaxf(mx, v); }
            mx = fmaxf(mx, __shfl_xor(mx, 16)); mx = fmaxf(mx, __shfl_xor(mx, 32));
            float den = 0.f;
#pragma unroll
            for (int c = 0; c < 10; ++c)
#pragma unroll
                for (int rg = 0; rg < 4; ++rg) { const float pe = __expf(s[c][rg] - mx); s[c][rg] = pe; den += pe; }
            den += __shfl_xor(den, 16); den += __shfl_xor(den, 32);
            f32x4 o[4];
#pragma unroll
            for (int dt = 0; dt < 4; ++dt) o[dt] = (f32x4){0.f, 0.f, 0.f, 0.f};
#pragma unroll
            for (int k = 0; k < 5; ++k) { const int ct = ct0 + 2 * k;
                u32x4 wv; wv.x = pg8::cvt_pk_bf16(s[2 * k][0], s[2 * k][1]); wv.y = pg8::cvt_pk_bf16(s[2 * k][2], s[2 * k][3]);
                wv.z = pg8::cvt_pk_bf16(s[2 * k + 1][0], s[2 * k + 1][1]); wv.w = pg8::cvt_pk_bf16(s[2 * k + 1][2], s[2 * k + 1][3]);
                const bf16x8_t pf = __builtin_bit_cast(bf16x8_t, wv);
                const unsigned va = (unsigned)(size_t)(Vl + (ct < 8 ? ps : cs) * SLOT) + (unsigned)((((ct & 7) * 16 + 4 * fq + (fr >> 2)) * 72 + 4 * (fr & 3)) * 2);
                u32x2 a0, a1, a2, a3, a4, a5, a6, a7;
                tr8<0, 16 * 72 * 2>(va, a0, a1, a2, a3, a4, a5, a6, a7);
                __builtin_amdgcn_sched_barrier(0);
                o[0] = __builtin_amdgcn_mfma_f32_16x16x32_bf16(pack_frag(a0, a1), pf, o[0], 0, 0, 0);
                o[1] = __builtin_amdgcn_mfma_f32_16x16x32_bf16(pack_frag(a2, a3), pf, o[1], 0, 0, 0);
                o[2] = __builtin_amdgcn_mfma_f32_16x16x32_bf16(pack_frag(a4, a5), pf, o[2], 0, 0, 0);
                o[3] = __builtin_amdgcn_mfma_f32_16x16x32_bf16(pack_frag(a6, a7), pf, o[3], 0, 0, 0); }
            const float inv = 1.f / den; const size_t tok = (size_t)b * T + (size_t)(nb * 128 + l) * dil + r;
            bf16* op = OG + ((size_t)g * M + tok) * 512 + h * 64 + 4 * fq;
#pragma unroll
            for (int dt = 0; dt < 4; ++dt) { u32x2 wv; wv.x = pg8::cvt_pk_bf16(o[dt][0] * inv, o[dt][1] * inv); wv.y = pg8::cvt_pk_bf16(o[dt][2] * inv, o[dt][3] * inv); *(u32x2*)(op + 16 * dt) = wv; }
            if (fq == 0) LSE[((size_t)g * M + tok) * 8 + h] = mx + __logf(den);
            __syncthreads();
            if (more) { *(LAS u32x4*)(Kl + ps * SLOT + srow * 72 + sch * 8) = pk0; *(LAS u32x4*)(Vl + ps * SLOT + srow * 72 + sch * 8) = pv0;
                *(LAS u32x4*)(Kl + ps * SLOT + (srow + 64) * 72 + sch * 8) = pk1; *(LAS u32x4*)(Vl + ps * SLOT + (srow + 64) * 72 + sch * 8) = pv1; }
            __syncthreads();
        }
    }
}

__device__ __forceinline__ void ph_merge(Frame& F) {
    const bf16* OG = (const bf16*)(F.ws + WS_OG); const float* LSE = (const float*)(F.ws + WS_LSE); bf16* Y2 = (bf16*)(F.ws + WS_Y2);
    const int total = M * 64, nth = F.G * NT;
    for (int idx = blockIdx.x * NT + F.tid; idx < total; idx += nth) {
        const int m = idx >> 6, c8 = idx & 63, h = c8 >> 3;
        const float l0 = LSE[((size_t)0 * M + m) * 8 + h], l1 = LSE[((size_t)1 * M + m) * 8 + h], l2 = LSE[((size_t)2 * M + m) * 8 + h];
        const float mx = fmaxf(l0, fmaxf(l1, l2)); float w0 = __expf(l0 - mx), w1 = __expf(l1 - mx), w2 = __expf(l2 - mx); const float inv = 1.f / (w0 + w1 + w2);
        w0 *= inv; w1 *= inv; w2 *= inv;
        const u32x4 a = *(const u32x4*)(OG + ((size_t)0 * M + m) * 512 + c8 * 8), b = *(const u32x4*)(OG + ((size_t)1 * M + m) * 512 + c8 * 8), c = *(const u32x4*)(OG + ((size_t)2 * M + m) * 512 + c8 * 8);
        u32x4 o;
        o.x = pk2(w0 * bflo(a.x) + w1 * bflo(b.x) + w2 * bflo(c.x), w0 * bfhi(a.x) + w1 * bfhi(b.x) + w2 * bfhi(c.x));
        o.y = pk2(w0 * bflo(a.y) + w1 * bflo(b.y) + w2 * bflo(c.y), w0 * bfhi(a.y) + w1 * bfhi(b.y) + w2 * bfhi(c.y));
        o.z = pk2(w0 * bflo(a.z) + w1 * bflo(b.z) + w2 * bflo(c.z), w0 * bfhi(a.z) + w1 * bfhi(b.z) + w2 * bfhi(c.z));
        o.w = pk2(w0 * bflo(a.w) + w1 * bflo(b.w) + w2 * bflo(c.w), w0 * bfhi(a.w) + w1 * bfhi(b.w) + w2 * bfhi(c.w));
        *(u32x4*)(Y2 + (size_t)m * 512 + c8 * 8) = o;
    }
}

__device__ __forceinline__ void gemm_inproj(Frame& F, const void* A, size_t wt, int N) {
    pg8::StaticOrder S; S.init(A, F.ws + wt, M, N, D, F.G, (int)blockIdx.x); pg8::EpiBf16 E{(bf16*)(F.ws + WS_P), N};
    pg8::gemm_phase<pg8::EpiBf16, pg8::StaticOrder, true, false>(F.lds, D, S, E);
}
template <bool BASE_BF16>
__device__ __forceinline__ void gemm_outproj(Frame& F, size_t a, size_t wt, int K, const void* base) {
    pg8::StaticOrder S; S.init(F.ws + a, F.ws + wt, M, D, K, F.G, (int)blockIdx.x); pg8::EpiResBf16<BASE_BF16> E{base, (bf16*)((char*)F.out + 32 * MiB), ALPHA};
    pg8::gemm_phase<pg8::EpiResBf16<BASE_BF16>, pg8::StaticOrder, false, false>(F.lds, K, S, E);
}
__device__ __forceinline__ int moe_row_tiles(Frame& F, int layer) { const unsigned* cnt = F.ctl + CW_CNT + layer * 32 * 64; int n = 0; for (int e = 0; e < 32; ++e) n += ((int)cnt[e * 64] + 255) >> 8; return n; }
__device__ __forceinline__ void gemm_moe1(Frame& F, int layer, int Lbase, int Lend, int G, int c) {
    pg8::MoeOrder S{F.ctl + CW_CNT + layer * 32 * 64, (const int*)(F.ws + WS_LIST), (const char*)(F.ws + WS_XB), (const char*)(F.ws + WS_EW), 2, G, c, D, 0, Lbase, Lend};
    pg8::EpiSwiGLU E{(bf16*)(F.ws + WS_HID)}; pg8::gemm_phase<pg8::EpiSwiGLU, pg8::MoeOrder, true, true>(F.lds, D, S, E);
}
__device__ __forceinline__ void gemm_moe2(Frame& F, int layer, int Lbase, int Lend, int G, int c) {
    pg8::MoeOrder S{F.ctl + CW_CNT + layer * 32 * 64, (const int*)(F.ws + WS_LIST), (const char*)(F.ws + WS_HID), (const char*)(F.ws + WS_EW + EW_DN), 4, G, c, DE, 1, Lbase, Lend};
    pg8::EpiMoeOut E{(bf16*)(F.ws + WS_YB), (const int*)(F.ws + WS_LIST)}; pg8::gemm_phase<pg8::EpiMoeOut, pg8::MoeOrder, true, false>(F.lds, DE, S, E);
}
__device__ __forceinline__ void moe_alpha(Frame& F, int layer) { const int n1 = 2 * moe_row_tiles(F, layer); gemm_moe1(F, layer, 0, n1 < F.G ? n1 : F.G, F.G, F.vcu); }
__device__ __forceinline__ void moe_beta(Frame& F, int layer) {
    const int nrt = moe_row_tiles(F, layer), n1 = 2 * nrt, c = (int)blockIdx.x;
    int nb1 = n1 - F.G; nb1 = nb1 < 0 ? 0 : (nb1 > F.G / 2 ? F.G / 2 : nb1);
    const int rt_a = nrt < F.G / 2 ? nrt : F.G / 2;
    if (c < nb1) gemm_moe1(F, layer, F.G, n1, nb1, c);
    else { const int gp = F.G - nb1; int cc = c - nb1;
        if ((nb1 & 7) == 0 && (gp & 7) == 0) cc = (c & 7) * (gp >> 3) + ((c - nb1) >> 3);
        gemm_moe2(F, layer, 0, 4 * rt_a, gp, cc); }
}
__device__ __forceinline__ void moe_gamma(Frame& F, int layer) {
    const int nrt = moe_row_tiles(F, layer), rt_a = nrt < F.G / 2 ? nrt : F.G / 2;
    gemm_moe2(F, layer, 4 * rt_a, 4 * nrt, F.G, F.vcu);
}

struct Args { const float* in[18]; float* out; unsigned char* ws; int ph_lo, ph_hi, li, pad; };
__global__ void __launch_bounds__(NT, 2) mega_fwd(Args args) {
    extern __shared__ __attribute__((aligned(16))) unsigned char lds_raw[];
    Frame F;
    F.lds = (LAS unsigned char*)lds_raw;
    F.tid = threadIdx.x; F.lane = F.tid & 63; F.wave = __builtin_amdgcn_readfirstlane(F.tid >> 6);
    F.G = gridDim.x; { const int bx = blockIdx.x; F.vcu = (F.G % 8 == 0) ? (bx % 8) * (F.G / 8) + bx / 8 : bx; }
#pragma unroll
    for (int i = 0; i < 18; ++i) F.in[i] = args.in[i];
    F.out = args.out; F.ws = args.ws; F.ctl = (unsigned*)(args.ws + WS_CTL);
    volatile LAS unsigned* MISC = (volatile LAS unsigned*)(F.lds + LDS_BYTES - 128);
    if (F.tid < 32) MISC[F.tid] = 0u;
    __syncthreads();
    XcdBarrier bar; bar.bar = F.ctl + CW_BAR; bar.x = 0; bar.st = nullptr;
    if (MK_N_LAUNCHES == 1) bar = xcd_barrier_post(F.ctl + CW_BAR, MISC + 8);
    const int lo = args.ph_lo, hi = args.ph_hi;
#define IN(k) (lo <= (k) && (k) < hi)
#define SEAM(k) do { if (IN(k) && IN((k) + 1)) xcd_barrier(bar); } while (0)
#define DUP(k) ((PROBE_DUP >> (k)) & 1)
#define PHASE(k, ...) do { if (IN(k)) { __VA_ARGS__; if (DUP(k)) { xcd_barrier(bar); __VA_ARGS__; } } SEAM(k); } while (0)
    PHASE(0, ph0_convert(F));
    PHASE(1, gemm_inproj(F, F.ws + WS_XB, WS_WT0, NP0));
    PHASE(2, ph_mix_a(F); xcd_barrier(bar); ph_mix_b(F));
    PHASE(3, ph_mix_c(F));
    PHASE(4, gemm_outproj<false>(F, WS_Y, WS_WO0, D, F.in[0]));
    if (IN(5)) { convert_experts(F, 0); if (DUP(5)) { __syncthreads(); convert_experts(F, 0); } __syncthreads(); ph_ln1_router(F, 0); } SEAM(5);
    PHASE(6, moe_alpha(F, 0));
    PHASE(7, moe_beta(F, 0); xcd_barrier(bar); moe_gamma(F, 0));
    if (IN(8)) { ph_ln<1, false, 1>(F, 0); } SEAM(8);
    if (IN(9)) { gemm_inproj(F, F.out, WS_WT1, IN1);
        const int nu = (M / 256) * (IN1 / 256), rem = nu % F.G;
        if (rem == 0) convert_experts(F, 1); else if ((int)blockIdx.x >= rem) convert_experts(F, 1, (int)blockIdx.x - rem, F.G - rem); } SEAM(9);
    PHASE(10, ph_attn_v2(F));
    PHASE(11, ph_merge(F));
    PHASE(12, gemm_outproj<true>(F, WS_Y2, WS_WO1, 512, F.out));
    if (IN(13)) { ph_ln1_router(F, 1); } SEAM(13);
    PHASE(14, moe_alpha(F, 1));
    PHASE(15, moe_beta(F, 1); xcd_barrier(bar); moe_gamma(F, 1));
    if (IN(16)) { ph_ln<1, false, 2>(F, 1); if (DUP(16)) { xcd_barrier(bar); ph_ln<1, false, 2>(F, 1); } }
#undef IN
#undef SEAM
#undef PHASE
#undef DUP
}

extern "C" void kernel_launch(void* const* d_in, const int* in_sizes, int n_in, void* d_out, int out_size, void* d_ws, size_t ws_size, hipStream_t stream) {
    static int grid = 0;
    if (grid == 0) {
        if (n_in != 18 || in_sizes[0] != M * D || out_size != M * D || ws_size < WS_END) {
            fprintf(stderr, "kernel_launch: unexpected problem (n_in %d, in0 %d, out %d, ws %zu < %zu)\n", n_in, n_in > 0 ? in_sizes[0] : -1, out_size, ws_size, (size_t)WS_END); grid = -1; return; }
        int dev = 0, cus = 0;
        if (hipGetDevice(&dev) != hipSuccess || hipDeviceGetAttribute(&cus, hipDeviceAttributeMultiprocessorCount, dev) != hipSuccess) { grid = -1; return; }
        if (hipFuncSetAttribute((const void*)mega_fwd, hipFuncAttributeMaxDynamicSharedMemorySize, LDS_BYTES) != hipSuccess) { fprintf(stderr, "kernel_launch: hipFuncSetAttribute failed\n"); grid = -1; return; }
        int per_cu = 0;
        if (hipOccupancyMaxActiveBlocksPerMultiprocessor(&per_cu, (const void*)mega_fwd, NT, LDS_BYTES) != hipSuccess || per_cu < 1) fprintf(stderr, "kernel_launch: occupancy query says %d\n", per_cu);
        (void)hipGetLastError();
        grid = cus;
    }
    if (grid < 0) return;
    (void)hipMemsetAsync((char*)d_ws + WS_CTL, 0, CTL_ZERO_BYTES, stream);
    Args a{};
    for (int i = 0; i < 18; ++i) a.in[i] = (const float*)d_in[i];
    a.out = (float*)d_out; a.ws = (unsigned char*)d_ws;
    if (MK_N_LAUNCHES == 1) {
        a.ph_lo = 0; a.ph_hi = N_PHASES; a.li = 0;
        hipLaunchKernelGGL(mega_fwd, dim3(grid), dim3(NT), LDS_BYTES, stream, a);
    } else {
        for (int p = 0; p < N_PHASES; ++p) { a.ph_lo = p; a.ph_hi = p + 1; a.li = p; hipLaunchKernelGGL(mega_fwd, dim3(grid), dim3(NT), LDS_BYTES, stream, a); }
    }
}
```
